# Optimizing an MI355X kernel written in HIP

```python
import math
import jax, jax.numpy as jnp
from jax import lax
import numpy as np

D_MODEL = 2048
BATCH = 8
SEQ = 2048
DEPTH = 1

HEAD_DIM = 64
MIX_WIDTH = D_MODEL
DIFF_WIDTH = MIX_WIDTH // 2
DIFF_HEADS = DIFF_WIDTH // (2 * HEAD_DIM)
SWA_WIDTH = MIX_WIDTH - DIFF_WIDTH
SWA_Q_HEADS = SWA_WIDTH // HEAD_DIM
SWA_KV_HEADS = SWA_Q_HEADS // 4
SWA_GROUP = SWA_Q_HEADS // SWA_KV_HEADS
WINDOW = 128
Q_BLOCK = 128
D_FF = -(-8 * D_MODEL // (3 * 256)) * 256
RMS_EPS = 1e-5

DIFF_Q_COLS = DIFF_HEADS * 2 * HEAD_DIM
DIFF_K_COLS = DIFF_HEADS * 2 * HEAD_DIM
DIFF_V_COLS = DIFF_HEADS * 2 * HEAD_DIM
SWA_Q_COLS = SWA_Q_HEADS * HEAD_DIM
SWA_K_COLS = SWA_KV_HEADS * HEAD_DIM
SWA_V_COLS = SWA_KV_HEADS * HEAD_DIM
IN_COLS = DIFF_Q_COLS + DIFF_K_COLS + DIFF_V_COLS + SWA_Q_COLS + SWA_K_COLS + SWA_V_COLS

kernel_name = "hymba_diffattn_swa_sink_alibi_swiglu"


def alibi_slopes(n_heads):
    return np.array([2.0 ** (-8.0 * (h + 1) / n_heads) for h in range(n_heads)], dtype=np.float32)


def lambda_init_fn(layer_idx):
    return 0.8 - 0.6 * math.exp(-0.3 * layer_idx)


def rmsnorm(x, w):
    xf = x.astype(jnp.float32)
    y = xf * lax.rsqrt(jnp.mean(xf * xf, axis=-1, keepdims=True) + RMS_EPS)
    return (y * w.astype(jnp.float32)).astype(x.dtype)


def diff_attention(q, k, v, lq1, lk1, lq2, lk2, subln_w, lambda_init):
    B, S = q.shape[0], q.shape[1]
    nblk = S // Q_BLOCK
    lam = (jnp.exp(jnp.sum(lq1.astype(jnp.float32) * lk1.astype(jnp.float32)))
           - jnp.exp(jnp.sum(lq2.astype(jnp.float32) * lk2.astype(jnp.float32)))
           + lambda_init)
    slopes = jnp.asarray(alibi_slopes(DIFF_HEADS))
    scale = HEAD_DIM ** -0.5
    kpos = jnp.arange(S)
    qb = q.reshape(B, nblk, Q_BLOCK, DIFF_HEADS, 2, HEAD_DIM).transpose(1, 0, 2, 3, 4, 5)

    def one_block(args):
        qblk, n = args
        qpos = n * Q_BLOCK + jnp.arange(Q_BLOCK)
        s = jnp.einsum('bqhcd,bkhcd->bhcqk', qblk, k).astype(jnp.float32) * scale
        dist = (qpos[:, None] - kpos[None, :]).astype(jnp.float32)
        s = s - slopes[None, :, None, None, None] * dist
        s = jnp.where(dist >= 0, s, -jnp.inf)
        p = jax.nn.softmax(s, axis=-1)
        a = p[:, :, 0] - lam * p[:, :, 1]
        return jnp.einsum('bhqk,bkhe->bqhe', a.astype(v.dtype), v)

    o = lax.map(one_block, (qb, jnp.arange(nblk)))
    o = o.transpose(1, 0, 2, 3, 4).reshape(B, S, DIFF_HEADS, 2 * HEAD_DIM)
    o = rmsnorm(o, subln_w) * (1.0 - lambda_init)
    return o.reshape(B, S, DIFF_HEADS * 2 * HEAD_DIM)


def swa_sink_attention(q, k, v, sinks):
    B, S = q.shape[0], q.shape[1]
    nblk = S // WINDOW
    scale = HEAD_DIM ** -0.5
    qb = q.reshape(B, nblk, WINDOW, SWA_KV_HEADS, SWA_GROUP, HEAD_DIM)

    def band(t):
        tp = jnp.pad(t, ((0, 0), (WINDOW, 0), (0, 0), (0, 0)))
        tb = tp.reshape(B, nblk + 1, WINDOW, SWA_KV_HEADS, HEAD_DIM)
        return jnp.concatenate([tb[:, :-1], tb[:, 1:]], axis=2)

    kb, vb = band(k), band(v)
    s = jnp.einsum('bnqhgd,bnkhd->bnhgqk', qb, kb).astype(jnp.float32) * scale
    i = jnp.arange(WINDOW)[:, None]
    j = jnp.arange(2 * WINDOW)[None, :]
    dist = WINDOW + i - j
    blk = jnp.arange(nblk)[:, None, None]
    valid = (dist >= 0) & (dist < WINDOW) & (blk * WINDOW - WINDOW + j >= 0)
    slopes = jnp.asarray(alibi_slopes(SWA_Q_HEADS)).reshape(SWA_KV_HEADS, SWA_GROUP)
    s = s - slopes[:, :, None, None] * dist.astype(jnp.float32)
    s = jnp.where(valid[None, :, None, None], s, -jnp.inf)
    sink = jnp.broadcast_to(
        sinks.astype(jnp.float32).reshape(SWA_KV_HEADS, SWA_GROUP)[None, None, :, :, None, None],
        s.shape[:-1] + (1,))
    p = jax.nn.softmax(jnp.concatenate([s, sink], axis=-1), axis=-1)[..., :-1]
    o = jnp.einsum('bnhgqk,bnkhd->bnqhgd', p.astype(v.dtype), vb)
    return o.reshape(B, S, SWA_Q_HEADS * HEAD_DIM)


def setup_inputs(seed: int = 0) -> dict:
    key = jax.random.key(seed)
    ks = jax.random.split(key, 16)
    f32 = jnp.float32
    nrm = lambda k, shape, s: jax.random.normal(k, shape, f32) * s
    return {
        "x": nrm(ks[0], (BATCH, SEQ, D_MODEL), 1.0),
        "attn_norm_w": 1.0 + nrm(ks[1], (DEPTH, D_MODEL), 0.02),
        "w_in": nrm(ks[2], (DEPTH, D_MODEL, IN_COLS), D_MODEL ** -0.5),
        "lambda_q1": nrm(ks[3], (DEPTH, HEAD_DIM), 0.1),
        "lambda_k1": nrm(ks[4], (DEPTH, HEAD_DIM), 0.1),
        "lambda_q2": nrm(ks[5], (DEPTH, HEAD_DIM), 0.1),
        "lambda_k2": nrm(ks[6], (DEPTH, HEAD_DIM), 0.1),
        "subln_w": 1.0 + nrm(ks[7], (DEPTH, 2 * HEAD_DIM), 0.02),
        "sinks": nrm(ks[8], (DEPTH, SWA_Q_HEADS), 0.5),
        "w_out": nrm(ks[9], (DEPTH, MIX_WIDTH, D_MODEL), MIX_WIDTH ** -0.5),
        "ffn_norm_w": 1.0 + nrm(ks[10], (DEPTH, D_MODEL), 0.02),
        "w_gate": nrm(ks[11], (DEPTH, D_MODEL, D_FF), D_MODEL ** -0.5),
        "w_up": nrm(ks[12], (DEPTH, D_MODEL, D_FF), D_MODEL ** -0.5),
        "w_down": nrm(ks[13], (DEPTH, D_FF, D_MODEL), D_FF ** -0.5),
        "final_norm_w": 1.0 + nrm(ks[14], (D_MODEL,), 0.02),
    }


def reference(x, attn_norm_w, w_in, lambda_q1, lambda_k1, lambda_q2, lambda_k2, subln_w,
              sinks, w_out, ffn_norm_w, w_gate, w_up, w_down, final_norm_w):
    B, S = x.shape[0], x.shape[1]
    splits = np.cumsum([DIFF_Q_COLS, DIFF_K_COLS, DIFF_V_COLS, SWA_Q_COLS, SWA_K_COLS]).tolist()
    for l in range(DEPTH):
        lambda_init = lambda_init_fn(l)
        h = rmsnorm(x, attn_norm_w[l])
        proj = jnp.einsum('bsd,dc->bsc', h, w_in[l])
        qa, ka, va, qs, ksw, vs = jnp.split(proj, splits, axis=-1)
        oa = diff_attention(
            qa.reshape(B, S, DIFF_HEADS, 2, HEAD_DIM),
            ka.reshape(B, S, DIFF_HEADS, 2, HEAD_DIM),
            va.reshape(B, S, DIFF_HEADS, 2 * HEAD_DIM),
            lambda_q1[l], lambda_k1[l], lambda_q2[l], lambda_k2[l], subln_w[l], lambda_init)
        ob = swa_sink_attention(
            qs.reshape(B, S, SWA_Q_HEADS, HEAD_DIM),
            ksw.reshape(B, S, SWA_KV_HEADS, HEAD_DIM),
            vs.reshape(B, S, SWA_KV_HEADS, HEAD_DIM),
            sinks[l])
        mixed = jnp.concatenate([oa, ob], axis=-1)
        x = x + jnp.einsum('bsc,cd->bsd', mixed, w_out[l])
        h = rmsnorm(x, ffn_norm_w[l])
        g = jnp.einsum('bsd,df->bsf', h, w_gate[l])
        u = jnp.einsum('bsd,df->bsf', h, w_up[l])
        x = x + jnp.einsum('bsf,fd->bsd', jax.nn.silu(g) * u, w_down[l])
    return rmsnorm(x, final_norm_w)
```

```cpp
#include <hip/hip_runtime.h>
#include <hip/hip_cooperative_groups.h>
#include <hip/hip_bf16.h>
#include <cstdio>
#include <cstdint>
#include <cmath>
namespace cg = cooperative_groups;
#define MK_N_LAUNCHES 1
namespace pg8 {
#define PG8_LAS __attribute__((address_space(3)))
typedef unsigned short bf16_t;
typedef short bf16x8 __attribute__((ext_vector_type(8)));
typedef float f32x4 __attribute__((ext_vector_type(4)));
typedef unsigned u32x4 __attribute__((ext_vector_type(4)));
constexpr int BM = 256, BK = 64, HALF = 128, HTB = HALF * BK * 2  , STAGE_BYTES = 8 * HTB, NXCD = 8, WGM = 8;

__host__ __device__ __forceinline__ int lds_byte(int r, int c) { const int st = (r >> 4) * 2 + (c >> 5), rr = r & 15, cc = c & 31, ob = rr * 64 + cc * 2; return st * 1024 + (ob ^ (((ob >> 9) & 1) << 5)); }
__host__ __device__ __forceinline__ void stage_rc(int b, int& R, int& C) { const int st = b / 1024, sb = b % 1024, swz = sb ^ (((sb >> 9) & 1) << 5); R = (st >> 1) * 16 + swz / 64; C = (st & 1) * 32 + (swz % 64) / 2; }
__host__ __device__ __forceinline__ int perm32(int rho) { const int n = rho >> 4, i = rho & 15; return 8 * (i >> 2) + 4 * n + (i & 3); }

struct Unit { int pm, pn; };
struct Gemm { const bf16_t* A; const bf16_t* Bt; int M, N, K; };

struct StaticOrder {
    int nM, nN, nwg, G, c;
    __host__ __device__ void init(int M, int N, int G_, int c_) { nM = M / BM; nN = N / BM; nwg = nM * nN; G = G_; c = c_; }
    __host__ __device__ bool next(int i, Unit& u) const {
        const long L = (long)i * G + c; if (L >= nwg) return false;
        int wgid = (int)L; { const int q = nwg / NXCD, r = nwg % NXCD, xcd = wgid % NXCD, off = wgid / NXCD; wgid = (xcd < r ? xcd * (q + 1) : r * (q + 1) + (xcd - r) * q) + off; }
        const int nig = WGM * nN, gid = wgid / nig, fm = gid * WGM, gsz = (nM - fm) < WGM ? (nM - fm) : WGM;
        u.pm = fm + ((wgid % nig) % gsz); u.pn = (wgid % nig) / gsz; return true;
    }
    __device__ __forceinline__ void a_ready(const Unit&) const {}
    __device__ __forceinline__ void done(const Unit&) const {}
};

__device__ __forceinline__ unsigned cvt_pk_bf16(float lo, float hi) { typedef float f2_t __attribute__((ext_vector_type(2))); typedef __bf16 b2_t __attribute__((ext_vector_type(2))); f2_t v = {lo, hi}; b2_t b = __builtin_convertvector(v, b2_t); return __builtin_bit_cast(unsigned, b); }
typedef unsigned u32x2 __attribute__((ext_vector_type(2)));
struct EpiStore {
    static constexpr bool PERM = true, AFTER_DRAIN = false;
    bf16_t* O; int ldc;
    __device__ __forceinline__ void operator()(const f32x4 (&acc)[2][2][4][2], const Unit& u, int wr, int wc, int fr, int fq) const {
        const int row0 = u.pm * BM + wr * 64 + fr, col0 = u.pn * BM + wc * 32 + 8 * fq;
#pragma unroll
        for (int ai = 0; ai < 2; ++ai)
#pragma unroll
            for (int m = 0; m < 4; ++m) { bf16_t* rowp = O + (size_t)(row0 + ai * HALF + m * 16) * ldc + col0;
#pragma unroll
                for (int bj = 0; bj < 2; ++bj) { const f32x4 v0 = acc[ai][bj][m][0], v1 = acc[ai][bj][m][1];
                    u32x4 w; w.x = cvt_pk_bf16(v0[0], v0[1]); w.y = cvt_pk_bf16(v0[2], v0[3]); w.z = cvt_pk_bf16(v1[0], v1[1]); w.w = cvt_pk_bf16(v1[2], v1[3]);
                    *(u32x4*)(rowp + bj * HALF) = w; } }
    }
};
struct EpiResid {
    static constexpr bool PERM = false, AFTER_DRAIN = false;
    const float* base; float* out; bf16_t* xb; float* part; int ldc;
    __device__ __forceinline__ void operator()(const f32x4 (&acc)[2][2][4][2], const Unit& u, int wr, int wc, int fr, int fq) const {
        const int row0 = u.pm * BM + wr * 64 + fr, col0 = u.pn * BM + wc * 32 + 4 * fq;
#pragma unroll
        for (int ai = 0; ai < 2; ++ai)
#pragma unroll
            for (int m = 0; m < 4; ++m) { const int r = row0 + ai * HALF + m * 16; const size_t off = (size_t)r * ldc + col0; float ss = 0.f;
#pragma unroll
                for (int bj = 0; bj < 2; ++bj)
#pragma unroll
                    for (int n = 0; n < 2; ++n) { const f32x4 bs = *(const f32x4*)(base + off + bj * HALF + n * 16); const f32x4 v = bs + acc[ai][bj][m][n];
                        *(f32x4*)(out + off + bj * HALF + n * 16) = v; ss += (v[0] * v[0] + v[1] * v[1]) + (v[2] * v[2] + v[3] * v[3]);
                        if (xb) { u32x2 w; w.x = cvt_pk_bf16(v[0], v[1]); w.y = cvt_pk_bf16(v[2], v[3]); *(u32x2*)(xb + off + bj * HALF + n * 16) = w; } }
                ss += __shfl_xor(ss, 16); ss += __shfl_xor(ss, 32);
                if (fq == 0) part[(size_t)r * 32 + u.pn * 4 + wc] = ss; }
    }
};
struct EpiSwiGLU {
    static constexpr bool PERM = true, AFTER_DRAIN = false;
    bf16_t* H; int ldh; const float* part; float inv_n, eps;
    __device__ __forceinline__ static float silu_mul(float g, float uu) { const float e = __builtin_amdgcn_exp2f(g * -1.4426950408889634f); return g * uu * __builtin_amdgcn_rcpf(1.f + e); }
    __device__ __forceinline__ void operator()(const f32x4 (&acc)[2][2][4][2], const Unit& u, int wr, int wc, int fr, int fq) const {
        const int row0 = u.pm * BM + wr * 64 + fr, col0 = u.pn * HALF + wc * 32 + 8 * fq;
#pragma unroll
        for (int ai = 0; ai < 2; ++ai)
#pragma unroll
            for (int m = 0; m < 4; ++m) { const int r = row0 + ai * HALF + m * 16;
                const f32x4* pp = (const f32x4*)(part + (size_t)r * 32 + fq * 8); const f32x4 pa = pp[0], pb = pp[1];
                float s = ((pa[0] + pa[1]) + (pa[2] + pa[3])) + ((pb[0] + pb[1]) + (pb[2] + pb[3]));
                s += __shfl_xor(s, 16); s += __shfl_xor(s, 32);
                const float rstd = rsqrtf(s * inv_n + eps);
                const f32x4 g0 = acc[ai][0][m][0] * rstd, g1 = acc[ai][0][m][1] * rstd, u0 = acc[ai][1][m][0] * rstd, u1 = acc[ai][1][m][1] * rstd;
                u32x4 w; w.x = cvt_pk_bf16(silu_mul(g0[0], u0[0]), silu_mul(g0[1], u0[1])); w.y = cvt_pk_bf16(silu_mul(g0[2], u0[2]), silu_mul(g0[3], u0[3]));
                w.z = cvt_pk_bf16(silu_mul(g1[0], u1[0]), silu_mul(g1[1], u1[1])); w.w = cvt_pk_bf16(silu_mul(g1[2], u1[2]), silu_mul(g1[3], u1[3]));
                *(u32x4*)(H + (size_t)r * ldh + col0) = w; }
    }
};
template <class Epi, class Sched, bool ALIGN_EPI = false, bool SP2 = false>
__device__ __forceinline__ void gemm_phase(PG8_LAS unsigned char* lds, const Gemm g, const Sched& S, const Epi& E) {
    const int tid = threadIdx.x, wid = __builtin_amdgcn_readfirstlane(tid >> 6), lane = tid & 63, wr = wid >> 2, wc = wid & 3, fr = lane & 15, fq = lane >> 4;
    const int K = g.K, nt = K / BK;
    unsigned voffA[2], voffB[2];
#pragma unroll
    for (int i = 0; i < 2; ++i) { int R, C; stage_rc(tid * 16 + i * 8192, R, C); const int Rb = Epi::PERM ? ((R & ~31) + perm32(R & 31)) : R;
        voffA[i] = (unsigned)(R * K + C) * 2u; voffB[i] = (unsigned)(Rb * K + C) * 2u; }
    const size_t kstep = (size_t)(BK * 2);
    const size_t hstep = (size_t)HALF * K * 2;
    const size_t tstep = 2 * hstep;
    const unsigned ldsw = (unsigned)wid * 1024u;
    const int aoff = lds_byte(wr * 64 + fr, fq * 8), boff = lds_byte(wc * 32 + fr, fq * 8);
#define PG8_SA(b, h) (((b) * 2 + (h)) * HTB)
#define PG8_SB(b, h) ((4 + (b) * 2 + (h)) * HTB)
#define PG8_STAGE(bufoff, gbase, voff) do { _Pragma("unroll") for (int _i = 0; _i < 2; ++_i) \
        __builtin_amdgcn_global_load_lds((const unsigned*)((const char*)(gbase) + (voff)[_i]), (PG8_LAS unsigned*)(lds + (bufoff) + ldsw + _i * 8192), 16, 0, 0); } while (0)
#define PG8_LDA(dst, b, h) do { _Pragma("unroll") for (int m = 0; m < 4; ++m) _Pragma("unroll") for (int k = 0; k < 2; ++k) dst[m][k] = *(const PG8_LAS bf16x8*)(lds + PG8_SA(b, h) + aoff + m * 2048 + k * 1024); } while (0)
#define PG8_LDB(dst, b, h) do { _Pragma("unroll") for (int n = 0; n < 2; ++n) _Pragma("unroll") for (int k = 0; k < 2; ++k) dst[n][k] = *(const PG8_LAS bf16x8*)(lds + PG8_SB(b, h) + boff + n * 2048 + k * 1024); } while (0)
#define PG8_MMA(ai, bj, At, Bt) do { __builtin_amdgcn_s_setprio(1); _Pragma("unroll") for (int m = 0; m < 4; ++m) _Pragma("unroll") for (int n = 0; n < 2; ++n) _Pragma("unroll") for (int k = 0; k < 2; ++k) \
        acc[ai][bj][m][n] = __builtin_amdgcn_mfma_f32_16x16x32_bf16(Bt[n][k], At[m][k], acc[ai][bj][m][n], 0, 0, 0); __builtin_amdgcn_s_setprio(0); } while (0)
#define PG8_WAIT_V(n) asm volatile("s_waitcnt vmcnt(" #n ")" ::: "memory")
#define PG8_WAIT_L(n) asm volatile("s_waitcnt lgkmcnt(" #n ")" ::: "memory")
#define PG8_BAR __builtin_amdgcn_s_barrier()
#define PG8_SCHED __builtin_amdgcn_sched_barrier(0)
    Unit cur, nxt; int ui = 0;
    if (!S.next(0, cur)) return;
    f32x4 acc[2][2][4][2];
#pragma unroll
    for (int a = 0; a < 2; ++a)
#pragma unroll
        for (int b = 0; b < 2; ++b)
#pragma unroll
            for (int m = 0; m < 4; ++m)
#pragma unroll
                for (int n = 0; n < 2; ++n) acc[a][b][m][n] = (f32x4){0.f, 0.f, 0.f, 0.f};
    bf16x8 At[4][2], B0[2][2], B1[2][2];
    const char* cA = (const char*)g.A + (size_t)cur.pm * tstep; const char* cB = (const char*)g.Bt + (size_t)cur.pn * tstep;
    S.a_ready(cur);
    if constexpr (SP2) {
        PG8_STAGE(PG8_SB(0, 0), cB, voffB); PG8_STAGE(PG8_SB(0, 1), cB + hstep, voffB); PG8_STAGE(PG8_SA(0, 0), cA, voffA); PG8_STAGE(PG8_SA(0, 1), cA + hstep, voffA);
        if (wr == 1) PG8_BAR;
        PG8_WAIT_V(2); PG8_BAR;
        PG8_STAGE(PG8_SB(1, 0), cB + kstep, voffB); PG8_STAGE(PG8_SA(1, 0), cA + kstep, voffA); PG8_STAGE(PG8_SB(1, 1), cB + hstep + kstep, voffB);
        PG8_WAIT_V(6); PG8_BAR;
    } else {
        PG8_STAGE(PG8_SB(0, 0), cB, voffB); PG8_STAGE(PG8_SA(0, 0), cA, voffA); PG8_STAGE(PG8_SB(0, 1), cB + hstep, voffB); PG8_STAGE(PG8_SA(0, 1), cA + hstep, voffA);
        if (wr == 1) PG8_BAR;
        PG8_WAIT_V(4); PG8_BAR;
        PG8_STAGE(PG8_SB(1, 0), cB + kstep, voffB); PG8_STAGE(PG8_SA(1, 0), cA + kstep, voffA); PG8_STAGE(PG8_SB(1, 1), cB + hstep + kstep, voffB);
        PG8_WAIT_V(6); PG8_BAR;
    }
    for (;;) {
        const bool has_next = S.next(ui + 1, nxt);
        const char* nA = has_next ? (const char*)g.A + (size_t)nxt.pm * tstep : cA; const char* nB = has_next ? (const char*)g.Bt + (size_t)nxt.pn * tstep : cB;
        for (int t = 0; t < nt; t += 2) {
            const bool last = (t == nt - 2);
            const char* a1 = cA + (size_t)(t + 1) * kstep;
            const char* a2 = last ? nA : cA + (size_t)(t + 2) * kstep; const char* b2 = last ? nB : cB + (size_t)(t + 2) * kstep;
            const char* a3 = a2 + kstep; const char* b3 = b2 + kstep;
            if (last && has_next) S.a_ready(nxt);
            if constexpr (SP2) {
            PG8_LDB(B0, 0, 0); PG8_LDB(B1, 0, 1); PG8_SCHED; PG8_LDA(At, 0, 0); PG8_STAGE(PG8_SA(1, 1), a1 + hstep, voffA);
            PG8_WAIT_V(8); PG8_WAIT_L(0); PG8_BAR; PG8_MMA(0, 0, At, B0); PG8_MMA(0, 1, At, B1); PG8_BAR; PG8_SCHED;
            PG8_LDA(At, 0, 1); PG8_STAGE(PG8_SB(0, 0), b2, voffB); PG8_STAGE(PG8_SB(0, 1), b2 + hstep, voffB); PG8_STAGE(PG8_SA(0, 0), a2, voffA);
            PG8_WAIT_V(8); PG8_WAIT_L(0); PG8_BAR; PG8_MMA(1, 0, At, B0); PG8_MMA(1, 1, At, B1); PG8_BAR; PG8_SCHED;
            PG8_LDB(B0, 1, 0); PG8_LDB(B1, 1, 1); PG8_SCHED; PG8_LDA(At, 1, 0); PG8_STAGE(PG8_SA(0, 1), a2 + hstep, voffA);
            PG8_WAIT_V(8); PG8_WAIT_L(0); PG8_BAR; PG8_MMA(0, 0, At, B0); PG8_MMA(0, 1, At, B1); PG8_BAR; PG8_SCHED;
            PG8_LDA(At, 1, 1); PG8_STAGE(PG8_SB(1, 0), b3, voffB); PG8_STAGE(PG8_SB(1, 1), b3 + hstep, voffB); PG8_STAGE(PG8_SA(1, 0), a3, voffA);
            PG8_WAIT_V(8); PG8_WAIT_L(0); PG8_BAR; PG8_MMA(1, 0, At, B0); PG8_MMA(1, 1, At, B1); PG8_BAR; PG8_SCHED;
            } else {
            PG8_LDB(B0, 0, 0); PG8_SCHED; PG8_LDA(At, 0, 0); PG8_STAGE(PG8_SA(1, 1), a1 + hstep, voffA);
            PG8_WAIT_L(8); PG8_BAR; PG8_WAIT_L(0); PG8_MMA(0, 0, At, B0); PG8_BAR; PG8_SCHED;
            PG8_LDB(B1, 0, 1); PG8_STAGE(PG8_SB(0, 0), b2, voffB);
            PG8_BAR; PG8_WAIT_L(0); PG8_MMA(0, 1, At, B1); PG8_BAR;
            PG8_LDA(At, 0, 1); PG8_STAGE(PG8_SA(0, 0), a2, voffA);
            PG8_BAR; PG8_WAIT_L(0); PG8_MMA(1, 0, At, B0); PG8_BAR; PG8_SCHED;
            PG8_STAGE(PG8_SB(0, 1), b2 + hstep, voffB);
            PG8_WAIT_V(6); PG8_BAR; PG8_MMA(1, 1, At, B1); PG8_BAR;
            PG8_LDB(B0, 1, 0); PG8_SCHED; PG8_LDA(At, 1, 0); PG8_STAGE(PG8_SA(0, 1), a2 + hstep, voffA);
            PG8_WAIT_L(8); PG8_BAR; PG8_WAIT_L(0); PG8_MMA(0, 0, At, B0); PG8_BAR; PG8_SCHED;
            PG8_LDB(B1, 1, 1); PG8_STAGE(PG8_SB(1, 0), b3, voffB);
            PG8_BAR; PG8_WAIT_L(0); PG8_MMA(0, 1, At, B1); PG8_BAR;
            PG8_LDA(At, 1, 1); PG8_STAGE(PG8_SA(1, 0), a3, voffA);
            PG8_BAR; PG8_WAIT_L(0); PG8_MMA(1, 0, At, B0); PG8_BAR; PG8_SCHED;
            PG8_STAGE(PG8_SB(1, 1), b3 + hstep, voffB);
            PG8_WAIT_V(6); PG8_BAR; PG8_MMA(1, 1, At, B1); PG8_BAR;
            }
        }
        if constexpr (ALIGN_EPI) { if (wr == 0) PG8_BAR; }
        if constexpr (!Epi::AFTER_DRAIN) { E(acc, cur, wr, wc, fr, fq); S.done(cur); }
        if (!has_next) break;
#pragma unroll
        for (int a = 0; a < 2; ++a)
#pragma unroll
            for (int b = 0; b < 2; ++b)
#pragma unroll
                for (int m = 0; m < 4; ++m)
#pragma unroll
                    for (int n = 0; n < 2; ++n) acc[a][b][m][n] = (f32x4){0.f, 0.f, 0.f, 0.f};
        cur = nxt; cA = nA; cB = nB; ++ui;
        if constexpr (ALIGN_EPI) { if (wr == 1) PG8_BAR; }
    }
    PG8_WAIT_V(0);
    if constexpr (!ALIGN_EPI) { if (wr == 0) PG8_BAR; }
    PG8_BAR;
    if constexpr (Epi::AFTER_DRAIN) { E.fused(acc, cur, wr, wc, fr, fq, lds, wid, lane); S.done(cur); }
#undef PG8_SA
#undef PG8_SB
#undef PG8_STAGE
#undef PG8_LDA
#undef PG8_LDB
#undef PG8_MMA
#undef PG8_WAIT_V
#undef PG8_WAIT_L
#undef PG8_BAR
#undef PG8_SCHED
}
}
namespace att {
#define ATT_LAS __attribute__((address_space(3)))
typedef unsigned short bf16_t;
typedef short bf16x8 __attribute__((ext_vector_type(8)));
typedef short s16x4 __attribute__((ext_vector_type(4)));
typedef float f32x16 __attribute__((ext_vector_type(16)));
typedef float f32x4 __attribute__((ext_vector_type(4)));
typedef unsigned u32x4 __attribute__((ext_vector_type(4)));
typedef unsigned u32x2 __attribute__((ext_vector_type(2)));
constexpr int SEQ = 2048, PITCH = 4608, OPITCH = 2048;
__device__ __forceinline__ unsigned cvtpk(float lo, float hi) { typedef float f2_t __attribute__((ext_vector_type(2))); typedef __bf16 b2_t __attribute__((ext_vector_type(2))); f2_t v = {lo, hi}; b2_t b = __builtin_convertvector(v, b2_t); return __builtin_bit_cast(unsigned, b); }
__device__ __forceinline__ float swapmax(float m) { auto rr = __builtin_amdgcn_permlane32_swap(__float_as_uint(m), __float_as_uint(m), false, false); return fmaxf(__uint_as_float(rr[0]), __uint_as_float(rr[1])); }
__device__ __forceinline__ float swapsum(float m) { auto rr = __builtin_amdgcn_permlane32_swap(__float_as_uint(m), __float_as_uint(m), false, false); return __uint_as_float(rr[0]) + __uint_as_float(rr[1]); }
__device__ __forceinline__ s16x4 vtr(ATT_LAS const char* p) { return __builtin_bit_cast(s16x4, __builtin_amdgcn_ds_read_tr16_b64_v4i16((ATT_LAS s16x4*)p)); }

struct UnitP {
    int b, q0;
    int qcol, kcol, vcol;
    int kofs;
    float slope2;
    float m_init, l_init;
    int T0, T1;
    int tlo, thi;
    int window;
    int maskall;
    int ocol;
};

template <int DV, int KW>
__device__ __forceinline__ void attn_unit(ATT_LAS char* lds, const bf16_t* __restrict__ P, bf16_t* __restrict__ MIX, const UnitP up, bool diff, float lam, const float* __restrict__ subln_w, int tid) {
    constexpr int KS = KW * 2 + 16, VS = DV * 2 + 64, STG = 64 * KS + 64 * VS;
    constexpr int KCH = KW / 8, VCH = DV / 8, NKC = KCH * 64 / 512, NVC = VCH * 64 / 512, NEB = DV / 32;
    const int lane = tid & 63, wid = __builtin_amdgcn_readfirstlane(tid >> 6), r32 = lane & 31, hi = lane >> 5, wq = wid & 3, g = wid >> 2;
    const int qw = up.q0 + 32 * wq, q = qw + r32;
    const size_t rowbase = (size_t)up.b * SEQ;
    __syncthreads();
    bf16x8 qr[4];
    { const bf16_t* qp = P + (rowbase + q) * PITCH + up.qcol + hi * 8;
#pragma unroll
      for (int d0 = 0; d0 < 4; ++d0) qr[d0] = *(const bf16x8*)(qp + d0 * 16); }
    f32x16 o[NEB];
#pragma unroll
    for (int e = 0; e < NEB; ++e)
#pragma unroll
        for (int r = 0; r < 16; ++r) o[e][r] = 0.f;
    float m = up.l_init != 0.f ? up.m_init + up.slope2 * (float)q : up.m_init, l = hi == 0 ? up.l_init : 0.f;
    u32x4 kreg[NKC], vreg[NVC];
#define ATT_GLOAD(t) do { \
    _Pragma("unroll") for (int i_ = 0; i_ < NKC; ++i_) { const int c_ = tid + 512 * i_, row_ = c_ / KCH, ch_ = c_ % KCH; kreg[i_] = *(const u32x4*)(P + (rowbase + 64 * (t) + row_) * PITCH + up.kcol + ch_ * 8); } \
    _Pragma("unroll") for (int i_ = 0; i_ < NVC; ++i_) { const int c_ = tid + 512 * i_, row_ = c_ / VCH, ch_ = c_ % VCH; vreg[i_] = *(const u32x4*)(P + (rowbase + 64 * (t) + row_) * PITCH + up.vcol + ch_ * 8); } } while (0)
#define ATT_SWRITE(buf) do { \
    _Pragma("unroll") for (int i_ = 0; i_ < NKC; ++i_) { const int c_ = tid + 512 * i_, row_ = c_ / KCH, ch_ = c_ % KCH; *(ATT_LAS u32x4*)(lds + (buf) * STG + row_ * KS + ch_ * 16) = kreg[i_]; } \
    _Pragma("unroll") for (int i_ = 0; i_ < NVC; ++i_) { const int c_ = tid + 512 * i_, row_ = c_ / VCH, ch_ = c_ % VCH; *(ATT_LAS u32x4*)(lds + (buf) * STG + 64 * KS + row_ * VS + ch_ * 16) = vreg[i_]; } } while (0)
    ATT_GLOAD(up.T0); ATT_SWRITE(0);
    __syncthreads();
    const int i16 = lane & 15, vlane = (4 * hi + (i16 >> 2)) * VS + (16 * ((lane >> 4) & 1) + 4 * (i16 & 3)) * 2;
    for (int t = up.T0; t <= up.T1; ++t) {
        const int buf = (t - up.T0) & 1;
        if (t < up.T1) ATT_GLOAD(t + 1);
        if (t >= up.tlo && t <= up.thi) {
            ATT_LAS const char* Kb = lds + buf * STG + up.kofs + r32 * KS + hi * 16;
            ATT_LAS const char* Vb = lds + buf * STG + 64 * KS + vlane;
            f32x16 p0, p1;
            { const float fb = (float)(64 * t + 4 * hi);
#pragma unroll
              for (int r = 0; r < 16; ++r) { const float c = (float)((r & 3) + 8 * (r >> 2)); p0[r] = up.slope2 * (fb + c); p1[r] = up.slope2 * (fb + c + 32.f); } }
#pragma unroll
            for (int d0 = 0; d0 < 4; ++d0) {
                const bf16x8 k0 = *(ATT_LAS const bf16x8*)(Kb + d0 * 32), k1 = *(ATT_LAS const bf16x8*)(Kb + 32 * KS + d0 * 32);
                p0 = __builtin_amdgcn_mfma_f32_32x32x16_bf16(k0, qr[d0], p0, 0, 0, 0);
                p1 = __builtin_amdgcn_mfma_f32_32x32x16_bf16(k1, qr[d0], p1, 0, 0, 0);
            }
            if (up.maskall || t == up.thi) {
                const int kvb = 64 * t + 4 * hi, qlo = q - up.window;
#pragma unroll
                for (int r = 0; r < 16; ++r) { const int kv = kvb + (r & 3) + 8 * (r >> 2);
                    if (kv > q || kv <= qlo) p0[r] = -INFINITY;
                    if (kv + 32 > q || kv + 32 <= qlo) p1[r] = -INFINITY; }
            }
            float rm = fmaxf(p0[0], p1[0]);
#pragma unroll
            for (int r = 1; r < 16; ++r) rm = fmaxf(rm, fmaxf(p0[r], p1[r]));
            rm = swapmax(rm);
            const float mn = fmaxf(m, rm), alpha = __builtin_amdgcn_exp2f(m - mn);
            m = mn;
            float ps = 0.f;
#pragma unroll
            for (int r = 0; r < 16; ++r) { p0[r] = __builtin_amdgcn_exp2f(p0[r] - mn); p1[r] = __builtin_amdgcn_exp2f(p1[r] - mn); ps += p0[r] + p1[r]; }
            l = l * alpha + ps;
#pragma unroll
            for (int e = 0; e < NEB; ++e)
#pragma unroll
                for (int r = 0; r < 16; ++r) o[e][r] *= alpha;
            bf16x8 pa[4];
#pragma unroll
            for (int s = 0; s < 2; ++s) {
                u32x4 w0, w1;
                w0.x = cvtpk(p0[8 * s + 0], p0[8 * s + 1]); w0.y = cvtpk(p0[8 * s + 2], p0[8 * s + 3]); w0.z = cvtpk(p0[8 * s + 4], p0[8 * s + 5]); w0.w = cvtpk(p0[8 * s + 6], p0[8 * s + 7]);
                w1.x = cvtpk(p1[8 * s + 0], p1[8 * s + 1]); w1.y = cvtpk(p1[8 * s + 2], p1[8 * s + 3]); w1.z = cvtpk(p1[8 * s + 4], p1[8 * s + 5]); w1.w = cvtpk(p1[8 * s + 6], p1[8 * s + 7]);
                pa[s] = __builtin_bit_cast(bf16x8, w0); pa[2 + s] = __builtin_bit_cast(bf16x8, w1);
            }
#pragma unroll
            for (int e = 0; e < NEB; ++e)
#pragma unroll
                for (int ks = 0; ks < 4; ++ks) {
                    const s16x4 lo = vtr(Vb + ks * 16 * VS + e * 64), hh = vtr(Vb + ks * 16 * VS + 8 * VS + e * 64);
                    const bf16x8 vf = {lo[0], lo[1], lo[2], lo[3], hh[0], hh[1], hh[2], hh[3]};
                    o[e] = __builtin_amdgcn_mfma_f32_32x32x16_bf16(vf, pa[ks], o[e], 0, 0, 0);
                }
        }
        if (t < up.T1) ATT_SWRITE(buf ^ 1);
        __syncthreads();
    }
#undef ATT_GLOAD
#undef ATT_SWRITE
    const float lt = swapsum(l), inv = 1.f / lt;
    if (!diff) {
        bf16_t* op = MIX + (rowbase + q) * OPITCH + up.ocol + 4 * hi;
#pragma unroll
        for (int e = 0; e < NEB; ++e)
#pragma unroll
            for (int r4 = 0; r4 < 4; ++r4) { u32x2 w; w.x = cvtpk(o[e][4 * r4] * inv, o[e][4 * r4 + 1] * inv); w.y = cvtpk(o[e][4 * r4 + 2] * inv, o[e][4 * r4 + 3] * inv);
                *(u32x2*)(op + e * 32 + 8 * r4) = w; }
    } else {
        ATT_LAS float* xb = (ATT_LAS float*)(lds + wq * (NEB * 16 * 64 * 4)) + lane;
        if (g == 1) { const float sc = lam * inv;
#pragma unroll
            for (int e = 0; e < NEB; ++e)
#pragma unroll
                for (int r = 0; r < 16; ++r) xb[(e * 16 + r) * 64] = o[e][r] * sc; }
        __syncthreads();
        if (g == 0) { float ss = 0.f;
#pragma unroll
            for (int e = 0; e < NEB; ++e)
#pragma unroll
                for (int r = 0; r < 16; ++r) { const float d = o[e][r] * inv - xb[(e * 16 + r) * 64]; o[e][r] = d; ss += d * d; }
            ss = swapsum(ss);
            const float rs = rsqrtf(ss * (1.f / DV) + 1e-5f) * 0.8f;
            bf16_t* op = MIX + (rowbase + q) * OPITCH + up.ocol + 4 * hi;
#pragma unroll
            for (int e = 0; e < NEB; ++e)
#pragma unroll
                for (int r4 = 0; r4 < 4; ++r4) { const f32x4 wv = *(const f32x4*)(subln_w + e * 32 + 8 * r4 + 4 * hi);
                    u32x2 w; w.x = cvtpk(o[e][4 * r4] * rs * wv[0], o[e][4 * r4 + 1] * rs * wv[1]); w.y = cvtpk(o[e][4 * r4 + 2] * rs * wv[2], o[e][4 * r4 + 3] * rs * wv[3]);
                    *(u32x2*)(op + e * 32 + 8 * r4) = w; } }
    }
}
}
constexpr int NWAVES = 8;
#ifndef MK_N_LAUNCHES
#define MK_N_LAUNCHES 1
#endif
constexpr int N_PHASES = 7;
constexpr int BATCH = 8, SEQ = 2048, D = 2048, M = BATCH * SEQ, INC = 4608, DFF = 5632, NGU = 2 * DFF;
constexpr float RMS_EPS = 1e-5f;
constexpr float QSCALE2 = 0.125f * 1.4426950408889634f;
constexpr size_t MiB = 1u << 20;
constexpr size_t WS_PART1 = 1 * MiB, WS_PART2 = 3 * MiB;
constexpr size_t WS_WIN = 8 * MiB, WS_WOUT = 26 * MiB, WS_WGU = 34 * MiB, WS_WDN = 78 * MiB;
constexpr size_t WS_XN = 100 * MiB;
constexpr size_t WS_PROJ = 164 * MiB, WS_MIX = 308 * MiB;
constexpr size_t WS_H = 164 * MiB;
constexpr size_t WS_END = 372 * MiB;
static_assert(WS_H + (size_t)M * DFF * 2 <= WS_END && WS_MIX + (size_t)M * D * 2 <= WS_END && WS_PROJ + (size_t)M * INC * 2 <= WS_MIX, "ws map");
constexpr int RING_BYTES = 131072, LDS_BYTES = 147456;

#define LAS __attribute__((address_space(3)))
typedef unsigned short bf16;
typedef unsigned v4u __attribute__((ext_vector_type(4)));
typedef float f32x4 __attribute__((ext_vector_type(4)));
__device__ __forceinline__ unsigned pk2(float lo, float hi) { return pg8::cvt_pk_bf16(lo, hi); }
__device__ __forceinline__ float wave_sum(float v) {
#pragma unroll
    for (int o = 1; o < 64; o <<= 1) v += __shfl_xor(v, o);
    return v;
}
__device__ __forceinline__ void transpose_item(const float* __restrict__ W, int K, int N, bf16* __restrict__ WT, int dst_row0, const float* __restrict__ kscale, float cscale, LAS float* scr, int k0, int n0, int lane) {
#pragma unroll 8
    for (int i = 0; i < 32; ++i) { const int kk = 2 * i + (lane >> 5); float v = W[(size_t)(k0 + kk) * N + n0 + (lane & 31)] * cscale; if (kscale) v *= kscale[k0 + kk]; scr[kk * 33 + (lane & 31)] = v; }
    asm volatile("s_waitcnt lgkmcnt(0)" ::: "memory");
    const int c = lane & 7;
#pragma unroll
    for (int j = 0; j < 4; ++j) { const int n = (lane >> 3) + 8 * j; const LAS float* s = scr + (8 * c) * 33 + n;
        v4u o; o.x = pk2(s[0 * 33], s[1 * 33]); o.y = pk2(s[2 * 33], s[3 * 33]); o.z = pk2(s[4 * 33], s[5 * 33]); o.w = pk2(s[6 * 33], s[7 * 33]);
        *(v4u*)(WT + (size_t)(dst_row0 + n) * K + k0 + 8 * c) = o; }
    asm volatile("s_waitcnt lgkmcnt(0)" ::: "memory");
}

struct Args { const float* in[15]; float* out; unsigned char* ws; int ph_lo, ph_hi; };
enum { I_X = 0, I_ANW, I_WIN, I_LQ1, I_LK1, I_LQ2, I_LK2, I_SUBLN, I_SINKS, I_WOUT, I_FNW, I_WG, I_WU, I_WD, I_FINW };

__global__ void __launch_bounds__(NWAVES * 64, 2) hymba_fwd(Args args) {
    extern __shared__ __attribute__((aligned(16))) unsigned char lds_raw[];
    cg::grid_group grid = cg::this_grid();
    LAS unsigned char* lds = (LAS unsigned char*)lds_raw;
    const int tid = threadIdx.x, lane = tid & 63, wave = __builtin_amdgcn_readfirstlane(tid >> 6);
    const int G = gridDim.x, bx = blockIdx.x, vcu = (G % 8 == 0) ? (bx % 8) * (G / 8) + bx / 8 : bx;
    unsigned char* ws = args.ws;
    const float* x = args.in[I_X]; float* out = args.out;
    bf16* Win_t = (bf16*)(ws + WS_WIN); bf16* Wout_t = (bf16*)(ws + WS_WOUT); bf16* Wgu_t = (bf16*)(ws + WS_WGU); bf16* Wdn_t = (bf16*)(ws + WS_WDN);
    bf16* XN = (bf16*)(ws + WS_XN); bf16* PROJ = (bf16*)(ws + WS_PROJ); bf16* MIX = (bf16*)(ws + WS_MIX); bf16* HB = (bf16*)(ws + WS_H);
    float* part1 = (float*)(ws + WS_PART1); float* part2 = (float*)(ws + WS_PART2);
    const int lo = args.ph_lo, hi = args.ph_hi;
#define IN(k) (lo <= (k) && (k) < hi)
#define SEAM(k) do { if (IN(k) && IN((k) + 1)) grid.sync(); } while (0)

    if (IN(0)) {
        LAS float* scr = (LAS float*)(lds + wave * 16384);
        const int gw = vcu * NWAVES + wave, NGW = G * NWAVES;
        constexpr int I_IN = (D / 64) * (INC / 32), I_OUT = (D / 64) * (D / 32), I_G = (D / 64) * (DFF / 32), I_DN = (DFF / 64) * (D / 32);
        constexpr int NITEMS = I_IN + I_OUT + 2 * I_G + I_DN;
        for (int it = gw; it < NITEMS; it += NGW) {
            int r = it;
            if (r < I_IN) { const int nblk = INC / 32, k0 = 64 * (r / nblk), n0 = 32 * (r % nblk); const float cs = (n0 < 1024 || (n0 >= 3072 && n0 < 4096)) ? QSCALE2 : 1.f;
                transpose_item(args.in[I_WIN], D, INC, Win_t, n0, nullptr, cs, scr, k0, n0, lane); continue; } r -= I_IN;
            if (r < I_OUT) { const int nblk = D / 32, k0 = 64 * (r / nblk), n0 = 32 * (r % nblk); transpose_item(args.in[I_WOUT], D, D, Wout_t, n0, nullptr, 1.f, scr, k0, n0, lane); continue; } r -= I_OUT;
            if (r < 2 * I_G) { const int up = r >= I_G; if (up) r -= I_G; const int nblk = DFF / 32, k0 = 64 * (r / nblk), n0 = 32 * (r % nblk);
                transpose_item(args.in[up ? I_WU : I_WG], D, DFF, Wgu_t, 256 * (n0 / 128) + 128 * up + (n0 % 128), args.in[I_FNW], 1.f, scr, k0, n0, lane); continue; } r -= 2 * I_G;
            { const int nblk = D / 32, k0 = 64 * (r / nblk), n0 = 32 * (r % nblk); transpose_item(args.in[I_WD], DFF, D, Wdn_t, n0, nullptr, 1.f, scr, k0, n0, lane); }
        }
        const f32x4* wn = (const f32x4*)args.in[I_ANW] + lane;
        for (int m = gw; m < M; m += NGW) {
            const f32x4* xr = (const f32x4*)(x + (size_t)m * D) + lane;
            f32x4 v[8]; float s = 0.f;
#pragma unroll
            for (int j = 0; j < 8; ++j) { v[j] = xr[64 * j]; s += (v[j].x * v[j].x + v[j].y * v[j].y) + (v[j].z * v[j].z + v[j].w * v[j].w); }
            const float rstd = rsqrtf(wave_sum(s) * (1.f / D) + RMS_EPS);
            unsigned long long* o8 = (unsigned long long*)(XN + (size_t)m * D) + lane;
#pragma unroll
            for (int j = 0; j < 8; ++j) { const f32x4 w = wn[64 * j]; o8[64 * j] = (unsigned long long)pk2(v[j].x * rstd * w.x, v[j].y * rstd * w.y) | ((unsigned long long)pk2(v[j].z * rstd * w.z, v[j].w * rstd * w.w) << 32); }
        }
        __syncthreads();
    }
    SEAM(0);
    if (IN(1)) {
        pg8::Gemm g{XN, Win_t, M, INC, D}; pg8::StaticOrder S; S.init(M, INC, G, bx);
        pg8::EpiStore E{PROJ, INC};
        pg8::gemm_phase<pg8::EpiStore, pg8::StaticOrder, true, true>(lds, g, S, E);
    }
    SEAM(1);
    if (IN(2)) {
        const float* lq1 = args.in[I_LQ1]; const float* lk1 = args.in[I_LK1]; const float* lq2 = args.in[I_LQ2]; const float* lk2 = args.in[I_LK2];
        const float s1 = wave_sum(lq1[lane] * lk1[lane]), s2 = wave_sum(lq2[lane] * lk2[lane]);
        const float lam = expf(s1) - expf(s2) + 0.2f;
        const int wq = wave & 3, gsel = wave >> 2;
        for (int i = vcu; i < 512; i += G) {
            const int bh = i >> 3, xq = i & 7, b = bh >> 3, h = bh & 7;
#pragma unroll 1
            for (int k = 0; k < 2; ++k) {
                const int qblk = k ? 15 - xq : xq;
                att::UnitP up; up.b = b; up.q0 = 128 * qblk; up.qcol = h * 128 + gsel * 64; up.kcol = 1024 + h * 128; up.vcol = 2048 + h * 128; up.kofs = gsel * 128;
                up.slope2 = exp2f(-(float)(h + 1)) * 1.4426950408889634f; up.m_init = -1e30f; up.l_init = 0.f;
                up.T0 = 0; up.T1 = 2 * qblk + 1; up.tlo = 0; up.thi = (up.q0 + 32 * wq) >> 6; up.window = 1 << 20; up.maskall = 0; up.ocol = h * 128;
                att::attn_unit<128, 128>((LAS char*)lds, PROJ, MIX, up, true, lam, args.in[I_SUBLN], tid);
            }
        }
        for (int i = vcu; i < 1024; i += G) {
            const int qblk = i & 15, pair = (i >> 4) & 1, hkv = (i >> 5) & 3, b = i >> 7, hq = hkv * 4 + pair * 2 + gsel, a = 2 * qblk;
            att::UnitP up; up.b = b; up.q0 = 128 * qblk; up.qcol = 3072 + hq * 64; up.kcol = 4096 + hkv * 64; up.vcol = 4352 + hkv * 64; up.kofs = 0;
            up.slope2 = exp2f(-0.5f * (float)(hq + 1)) * 1.4426950408889634f; up.m_init = args.in[I_SINKS][hq] * 1.4426950408889634f; up.l_init = 1.f;
            up.T0 = a - 2 < 0 ? 0 : a - 2; up.T1 = a + 1; up.tlo = a - 2 + (wq >> 1); up.thi = a + (wq >> 1); up.window = 128; up.maskall = 1; up.ocol = 1024 + hq * 64;
            att::attn_unit<64, 64>((LAS char*)lds, PROJ, MIX, up, false, 0.f, nullptr, tid);
        }
        __syncthreads();
    }
    SEAM(2);
    if (IN(3)) {
        pg8::Gemm g{MIX, Wout_t, M, D, D}; pg8::StaticOrder S; S.init(M, D, G, bx);
        pg8::EpiResid E{x, out, XN, part1, D};
        pg8::gemm_phase<pg8::EpiResid, pg8::StaticOrder, true, true>(lds, g, S, E);
    }
    SEAM(3);
    if (IN(4)) {
        pg8::Gemm g{XN, Wgu_t, M, NGU, D}; pg8::StaticOrder S; S.init(M, NGU, G, bx);
        pg8::EpiSwiGLU E{HB, DFF, part1, 1.f / D, RMS_EPS};
        pg8::gemm_phase<pg8::EpiSwiGLU, pg8::StaticOrder, true, true>(lds, g, S, E);
    }
    SEAM(4);
    if (IN(5)) {
        pg8::Gemm g{HB, Wdn_t, M, D, DFF}; pg8::StaticOrder S; S.init(M, D, G, bx);
        pg8::EpiResid E{out, out, nullptr, part2, D};
        pg8::gemm_phase<pg8::EpiResid, pg8::StaticOrder, true, true>(lds, g, S, E);
    }
    SEAM(5);
    if (IN(6)) {
        const int gw = vcu * NWAVES + wave, NGW = G * NWAVES;
        const f32x4* wn = (const f32x4*)args.in[I_FINW] + lane;
        for (int m = gw; m < M; m += NGW) {
            const float s = wave_sum(lane < 32 ? part2[(size_t)m * 32 + lane] : 0.f);
            const float rstd = rsqrtf(s * (1.f / D) + RMS_EPS);
            f32x4* xr = (f32x4*)(out + (size_t)m * D) + lane;
#pragma unroll
            for (int j = 0; j < 8; ++j) { const f32x4 v = xr[64 * j], w = wn[64 * j]; xr[64 * j] = v * rstd * w; }
        }
    }
#undef IN
#undef SEAM
}

extern "C" void kernel_launch(void* const* d_in, const int* in_sizes, int n_in, void* d_out, int out_size, void* d_ws, size_t ws_size, hipStream_t stream) {
    static int grid = 0;
    if (grid == 0) {
        if (n_in != 15 || out_size != M * D || ws_size < WS_END) { fprintf(stderr, "kernel_launch: unexpected shapes (n_in %d out %d ws %zu)\n", n_in, out_size, ws_size); grid = -1; return; }
        int dev = 0, cus = 0, per_cu = 0;
        hipGetDevice(&dev); hipDeviceGetAttribute(&cus, hipDeviceAttributeMultiprocessorCount, dev);
        if (hipFuncSetAttribute((const void*)hymba_fwd, hipFuncAttributeMaxDynamicSharedMemorySize, LDS_BYTES) != hipSuccess) { fprintf(stderr, "kernel_launch: hipFuncSetAttribute failed\n"); grid = -1; return; }
        if (hipOccupancyMaxActiveBlocksPerMultiprocessor(&per_cu, (const void*)hymba_fwd, NWAVES * 64, LDS_BYTES) != hipSuccess || per_cu < 1) { fprintf(stderr, "kernel_launch: occupancy query says %d\n", per_cu); per_cu = 1; }
        (void)hipGetLastError();
        grid = cus * 1;
        fprintf(stderr, "kernel_launch: grid %d (cus %d, per_cu %d)\n", grid, cus, per_cu);
    }
    if (grid < 0) return;
    Args a{};
    for (int i = 0; i < 15; ++i) a.in[i] = (const float*)d_in[i];
    a.out = (float*)d_out; a.ws = (unsigned char*)d_ws;
#if MK_N_LAUNCHES == 1
    a.ph_lo = 0; a.ph_hi = N_PHASES;
    void* kargs[] = {&a};
    hipError_t e = hipLaunchCooperativeKernel((const void*)hymba_fwd, dim3(grid), dim3(NWAVES * 64), kargs, LDS_BYTES, stream);
    if (e != hipSuccess) fprintf(stderr, "kernel_launch: cooperative launch failed: %s\n", hipGetErrorString(e));
#else
    for (int p = 0; p < N_PHASES; ++p) { a.ph_lo = p; a.ph_hi = p + 1; hipLaunchKernelGGL(hymba_fwd, dim3(grid), dim3(NWAVES * 64), LDS_BYTES, stream, a); }
#endif
}
```

```cpp
#include <hip/hip_runtime.h>
#include <hip/hip_cooperative_groups.h>
#include <hip/hip_bf16.h>
#include <cstdio>
#include <cstdint>
#include <cmath>
namespace cg = cooperative_groups;
#define MK_N_LAUNCHES 1
namespace pg8 {
#define PG8_LAS __attribute__((address_space(3)))
typedef unsigned short bf16_t;
typedef short bf16x8 __attribute__((ext_vector_type(8)));
typedef float f32x4 __attribute__((ext_vector_type(4)));
typedef unsigned u32x4 __attribute__((ext_vector_type(4)));
constexpr int BM = 256, BK = 64, HALF = 128, HTB = HALF * BK * 2  , STAGE_BYTES = 8 * HTB, NXCD = 8, WGM = 8;

__host__ __device__ __forceinline__ int lds_byte(int r, int c) { const int st = (r >> 4) * 2 + (c >> 5), rr = r & 15, cc = c & 31, ob = rr * 64 + cc * 2; return st * 1024 + (ob ^ (((ob >> 9) & 1) << 5)); }
__host__ __device__ __forceinline__ void stage_rc(int b, int& R, int& C) { const int st = b / 1024, sb = b % 1024, swz = sb ^ (((sb >> 9) & 1) << 5); R = (st >> 1) * 16 + swz / 64; C = (st & 1) * 32 + (swz % 64) / 2; }
__host__ __device__ __forceinline__ int perm32(int rho) { const int n = rho >> 4, i = rho & 15; return 8 * (i >> 2) + 4 * n + (i & 3); }

struct Unit { int pm, pn; };
struct Gemm { const bf16_t* A; const bf16_t* Bt; int M, N, K; };

struct StaticOrder {
    int nM, nN, nwg, G, c;
    __host__ __device__ void init(int M, int N, int G_, int c_) { nM = M / BM; nN = N / BM; nwg = nM * nN; G = G_; c = c_; }
    __host__ __device__ bool next(int i, Unit& u) const {
        const long L = (long)i * G + c; if (L >= nwg) return false;
        int wgid = (int)L; { const int q = nwg / NXCD, r = nwg % NXCD, xcd = wgid % NXCD, off = wgid / NXCD; wgid = (xcd < r ? xcd * (q + 1) : r * (q + 1) + (xcd - r) * q) + off; }
        const int nig = WGM * nN, gid = wgid / nig, fm = gid * WGM, gsz = (nM - fm) < WGM ? (nM - fm) : WGM;
        u.pm = fm + ((wgid % nig) % gsz); u.pn = (wgid % nig) / gsz; return true;
    }
    __device__ __forceinline__ void a_ready(const Unit&) const {}
    __device__ __forceinline__ void done(const Unit&) const {}
};

__device__ __forceinline__ unsigned cvt_pk_bf16(float lo, float hi) { typedef float f2_t __attribute__((ext_vector_type(2))); typedef __bf16 b2_t __attribute__((ext_vector_type(2))); f2_t v = {lo, hi}; b2_t b = __builtin_convertvector(v, b2_t); return __builtin_bit_cast(unsigned, b); }
typedef unsigned u32x2 __attribute__((ext_vector_type(2)));
struct EpiStore {
    static constexpr bool PERM = true, AFTER_DRAIN = false;
    bf16_t* O; int ldc;
    __device__ __forceinline__ void operator()(const f32x4 (&acc)[2][2][4][2], const Unit& u, int wr, int wc, int fr, int fq) const {
        const int row0 = u.pm * BM + wr * 64 + fr, col0 = u.pn * BM + wc * 32 + 8 * fq;
#pragma unroll
        for (int ai = 0; ai < 2; ++ai)
#pragma unroll
            for (int m = 0; m < 4; ++m) { bf16_t* rowp = O + (size_t)(row0 + ai * HALF + m * 16) * ldc + col0;
#pragma unroll
                for (int bj = 0; bj < 2; ++bj) { const f32x4 v0 = acc[ai][bj][m][0], v1 = acc[ai][bj][m][1];
                    u32x4 w; w.x = cvt_pk_bf16(v0[0], v0[1]); w.y = cvt_pk_bf16(v0[2], v0[3]); w.z = cvt_pk_bf16(v1[0], v1[1]); w.w = cvt_pk_bf16(v1[2], v1[3]);
                    *(u32x4*)(rowp + bj * HALF) = w; } }
    }
};
struct EpiResid {
    static constexpr bool PERM = false, AFTER_DRAIN = false;
    const float* base; float* out; bf16_t* xb; float* part; int ldc;
    __device__ __forceinline__ void operator()(const f32x4 (&acc)[2][2][4][2], const Unit& u, int wr, int wc, int fr, int fq) const {
        const int row0 = u.pm * BM + wr * 64 + fr, col0 = u.pn * BM + wc * 32 + 4 * fq;
#pragma unroll
        for (int ai = 0; ai < 2; ++ai)
#pragma unroll
            for (int m = 0; m < 4; ++m) { const int r = row0 + ai * HALF + m * 16; const size_t off = (size_t)r * ldc + col0; float ss = 0.f;
#pragma unroll
                for (int bj = 0; bj < 2; ++bj)
#pragma unroll
                    for (int n = 0; n < 2; ++n) { const f32x4 bs = *(const f32x4*)(base + off + bj * HALF + n * 16); const f32x4 v = bs + acc[ai][bj][m][n];
                        *(f32x4*)(out + off + bj * HALF + n * 16) = v; ss += (v[0] * v[0] + v[1] * v[1]) + (v[2] * v[2] + v[3] * v[3]);
                        if (xb) { u32x2 w; w.x = cvt_pk_bf16(v[0], v[1]); w.y = cvt_pk_bf16(v[2], v[3]); *(u32x2*)(xb + off + bj * HALF + n * 16) = w; } }
                ss += __shfl_xor(ss, 16); ss += __shfl_xor(ss, 32);
                if (fq == 0) part[(size_t)r * 32 + u.pn * 4 + wc] = ss; }
    }
};
struct EpiSwiGLU {
    static constexpr bool PERM = true, AFTER_DRAIN = false;
    bf16_t* H; int ldh; const float* part; float inv_n, eps;
    __device__ __forceinline__ static float silu_mul(float g, float uu) { const float e = __builtin_amdgcn_exp2f(g * -1.4426950408889634f); return g * uu * __builtin_amdgcn_rcpf(1.f + e); }
    __device__ __forceinline__ void operator()(const f32x4 (&acc)[2][2][4][2], const Unit& u, int wr, int wc, int fr, int fq) const {
        const int row0 = u.pm * BM + wr * 64 + fr, col0 = u.pn * HALF + wc * 32 + 8 * fq;
#pragma unroll
        for (int ai = 0; ai < 2; ++ai)
#pragma unroll
            for (int m = 0; m < 4; ++m) { const int r = row0 + ai * HALF + m * 16;
                const f32x4* pp = (const f32x4*)(part + (size_t)r * 32 + fq * 8); const f32x4 pa = pp[0], pb = pp[1];
                float s = ((pa[0] + pa[1]) + (pa[2] + pa[3])) + ((pb[0] + pb[1]) + (pb[2] + pb[3]));
                s += __shfl_xor(s, 16); s += __shfl_xor(s, 32);
                const float rstd = rsqrtf(s * inv_n + eps);
                const f32x4 g0 = acc[ai][0][m][0] * rstd, g1 = acc[ai][0][m][1] * rstd, u0 = acc[ai][1][m][0] * rstd, u1 = acc[ai][1][m][1] * rstd;
                u32x4 w; w.x = cvt_pk_bf16(silu_mul(g0[0], u0[0]), silu_mul(g0[1], u0[1])); w.y = cvt_pk_bf16(silu_mul(g0[2], u0[2]), silu_mul(g0[3], u0[3]));
                w.z = cvt_pk_bf16(silu_mul(g1[0], u1[0]), silu_mul(g1[1], u1[1])); w.w = cvt_pk_bf16(silu_mul(g1[2], u1[2]), silu_mul(g1[3], u1[3]));
                *(u32x4*)(H + (size_t)r * ldh + col0) = w; }
    }
};
template <class Epi, class Sched, bool ALIGN_EPI = false, bool SP2 = false>
__device__ __forceinline__ void gemm_phase(PG8_LAS unsigned char* lds, const Gemm g, const Sched& S, const Epi& E) {
    const int tid = threadIdx.x, wid = __builtin_amdgcn_readfirstlane(tid >> 6), lane = tid & 63, wr = wid >> 2, wc = wid & 3, fr = lane & 15, fq = lane >> 4;
    const int K = g.K, nt = K / BK;
    unsigned voffA[2], voffB[2];
#pragma unroll
    for (int i = 0; i < 2; ++i) { int R, C; stage_rc(tid * 16 + i * 8192, R, C); const int Rb = Epi::PERM ? ((R & ~31) + perm32(R & 31)) : R;
        voffA[i] = (unsigned)(R * K + C) * 2u; voffB[i] = (unsigned)(Rb * K + C) * 2u; }
    const size_t kstep = (size_t)(BK * 2);
    const size_t hstep = (size_t)HALF * K * 2;
    const size_t tstep = 2 * hstep;
    const unsigned ldsw = (unsigned)wid * 1024u;
    const int aoff = lds_byte(wr * 64 + fr, fq * 8), boff = lds_byte(wc * 32 + fr, fq * 8);
#define PG8_SA(b, h) (((b) * 2 + (h)) * HTB)
#define PG8_SB(b, h) ((4 + (b) * 2 + (h)) * HTB)
#define PG8_STAGE(bufoff, gbase, voff) do { _Pragma("unroll") for (int _i = 0; _i < 2; ++_i) \
        __builtin_amdgcn_global_load_lds((const unsigned*)((const char*)(gbase) + (voff)[_i]), (PG8_LAS unsigned*)(lds + (bufoff) + ldsw + _i * 8192), 16, 0, 0); } while (0)
#define PG8_LDA(dst, b, h) do { _Pragma("unroll") for (int m = 0; m < 4; ++m) _Pragma("unroll") for (int k = 0; k < 2; ++k) dst[m][k] = *(const PG8_LAS bf16x8*)(lds + PG8_SA(b, h) + aoff + m * 2048 + k * 1024); } while (0)
#define PG8_LDB(dst, b, h) do { _Pragma("unroll") for (int n = 0; n < 2; ++n) _Pragma("unroll") for (int k = 0; k < 2; ++k) dst[n][k] = *(const PG8_LAS bf16x8*)(lds + PG8_SB(b, h) + boff + n * 2048 + k * 1024); } while (0)
#define PG8_MMA(ai, bj, At, Bt) do { __builtin_amdgcn_s_setprio(1); _Pragma("unroll") for (int m = 0; m < 4; ++m) _Pragma("unroll") for (int n = 0; n < 2; ++n) _Pragma("unroll") for (int k = 0; k < 2; ++k) \
        acc[ai][bj][m][n] = __builtin_amdgcn_mfma_f32_16x16x32_bf16(Bt[n][k], At[m][k], acc[ai][bj][m][n], 0, 0, 0); __builtin_amdgcn_s_setprio(0); } while (0)
#define PG8_WAIT_V(n) asm volatile("s_waitcnt vmcnt(" #n ")" ::: "memory")
#define PG8_WAIT_L(n) asm volatile("s_waitcnt lgkmcnt(" #n ")" ::: "memory")
#define PG8_BAR __builtin_amdgcn_s_barrier()
#define PG8_SCHED __builtin_amdgcn_sched_barrier(0)
    Unit cur, nxt; int ui = 0;
    if (!S.next(0, cur)) return;
    f32x4 acc[2][2][4][2];
#pragma unroll
    for (int a = 0; a < 2; ++a)
#pragma unroll
        for (int b = 0; b < 2; ++b)
#pragma unroll
            for (int m = 0; m < 4; ++m)
#pragma unroll
                for (int n = 0; n < 2; ++n) acc[a][b][m][n] = (f32x4){0.f, 0.f, 0.f, 0.f};
    bf16x8 At[4][2], B0[2][2], B1[2][2];
    const char* cA = (const char*)g.A + (size_t)cur.pm * tstep; const char* cB = (const char*)g.Bt + (size_t)cur.pn * tstep;
    S.a_ready(cur);
    if constexpr (SP2) {
        PG8_STAGE(PG8_SB(0, 0), cB, voffB); PG8_STAGE(PG8_SB(0, 1), cB + hstep, voffB); PG8_STAGE(PG8_SA(0, 0), cA, voffA); PG8_STAGE(PG8_SA(0, 1), cA + hstep, voffA);
        if (wr == 1) PG8_BAR;
        PG8_WAIT_V(2); PG8_BAR;
        PG8_STAGE(PG8_SB(1, 0), cB + kstep, voffB); PG8_STAGE(PG8_SA(1, 0), cA + kstep, voffA); PG8_STAGE(PG8_SB(1, 1), cB + hstep + kstep, voffB);
        PG8_WAIT_V(6); PG8_BAR;
    } else {
        PG8_STAGE(PG8_SB(0, 0), cB, voffB); PG8_STAGE(PG8_SA(0, 0), cA, voffA); PG8_STAGE(PG8_SB(0, 1), cB + hstep, voffB); PG8_STAGE(PG8_SA(0, 1), cA + hstep, voffA);
        if (wr == 1) PG8_BAR;
        PG8_WAIT_V(4); PG8_BAR;
        PG8_STAGE(PG8_SB(1, 0), cB + kstep, voffB); PG8_STAGE(PG8_SA(1, 0), cA + kstep, voffA); PG8_STAGE(PG8_SB(1, 1), cB + hstep + kstep, voffB);
        PG8_WAIT_V(6); PG8_BAR;
    }
    for (;;) {
        const bool has_next = S.next(ui + 1, nxt);
        const char* nA = has_next ? (const char*)g.A + (size_t)nxt.pm * tstep : cA; const char* nB = has_next ? (const char*)g.Bt + (size_t)nxt.pn * tstep : cB;
        for (int t = 0; t < nt; t += 2) {
            const bool last = (t == nt - 2);
            const char* a1 = cA + (size_t)(t + 1) * kstep;
            const char* a2 = last ? nA : cA + (size_t)(t + 2) * kstep; const char* b2 = last ? nB : cB + (size_t)(t + 2) * kstep;
            const char* a3 = a2 + kstep; const char* b3 = b2 + kstep;
            if (last && has_next) S.a_ready(nxt);
            if constexpr (SP2) {
            PG8_LDB(B0, 0, 0); PG8_LDB(B1, 0, 1); PG8_SCHED; PG8_LDA(At, 0, 0); PG8_STAGE(PG8_SA(1, 1), a1 + hstep, voffA);
            PG8_WAIT_V(8); PG8_WAIT_L(0); PG8_BAR; PG8_MMA(0, 0, At, B0); PG8_MMA(0, 1, At, B1); PG8_BAR; PG8_SCHED;
            PG8_LDA(At, 0, 1); PG8_STAGE(PG8_SB(0, 0), b2, voffB); PG8_STAGE(PG8_SB(0, 1), b2 + hstep, voffB); PG8_STAGE(PG8_SA(0, 0), a2, voffA);
            PG8_WAIT_V(8); PG8_WAIT_L(0); PG8_BAR; PG8_MMA(1, 0, At, B0); PG8_MMA(1, 1, At, B1); PG8_BAR; PG8_SCHED;
            PG8_LDB(B0, 1, 0); PG8_LDB(B1, 1, 1); PG8_SCHED; PG8_LDA(At, 1, 0); PG8_STAGE(PG8_SA(0, 1), a2 + hstep, voffA);
            PG8_WAIT_V(8); PG8_WAIT_L(0); PG8_BAR; PG8_MMA(0, 0, At, B0); PG8_MMA(0, 1, At, B1); PG8_BAR; PG8_SCHED;
            PG8_LDA(At, 1, 1); PG8_STAGE(PG8_SB(1, 0), b3, voffB); PG8_STAGE(PG8_SB(1, 1), b3 + hstep, voffB); PG8_STAGE(PG8_SA(1, 0), a3, voffA);
            PG8_WAIT_V(8); PG8_WAIT_L(0); PG8_BAR; PG8_MMA(1, 0, At, B0); PG8_MMA(1, 1, At, B1); PG8_BAR; PG8_SCHED;
            } else {
            PG8_LDB(B0, 0, 0); PG8_SCHED; PG8_LDA(At, 0, 0); PG8_STAGE(PG8_SA(1, 1), a1 + hstep, voffA);
            PG8_WAIT_L(8); PG8_BAR; PG8_WAIT_L(0); PG8_MMA(0, 0, At, B0); PG8_BAR; PG8_SCHED;
            PG8_LDB(B1, 0, 1); PG8_STAGE(PG8_SB(0, 0), b2, voffB);
            PG8_BAR; PG8_WAIT_L(0); PG8_MMA(0, 1, At, B1); PG8_BAR;
            PG8_LDA(At, 0, 1); PG8_STAGE(PG8_SA(0, 0), a2, voffA);
            PG8_BAR; PG8_WAIT_L(0); PG8_MMA(1, 0, At, B0); PG8_BAR; PG8_SCHED;
            PG8_STAGE(PG8_SB(0, 1), b2 + hstep, voffB);
            PG8_WAIT_V(6); PG8_BAR; PG8_MMA(1, 1, At, B1); PG8_BAR;
            PG8_LDB(B0, 1, 0); PG8_SCHED; PG8_LDA(At, 1, 0); PG8_STAGE(PG8_SA(0, 1), a2 + hstep, voffA);
            PG8_WAIT_L(8); PG8_BAR; PG8_WAIT_L(0); PG8_MMA(0, 0, At, B0); PG8_BAR; PG8_SCHED;
            PG8_LDB(B1, 1, 1); PG8_STAGE(PG8_SB(1, 0), b3, voffB);
            PG8_BAR; PG8_WAIT_L(0); PG8_MMA(0, 1, At, B1); PG8_BAR;
            PG8_LDA(At, 1, 1); PG8_STAGE(PG8_SA(1, 0), a3, voffA);
            PG8_BAR; PG8_WAIT_L(0); PG8_MMA(1, 0, At, B0); PG8_BAR; PG8_SCHED;
            PG8_STAGE(PG8_SB(1, 1), b3 + hstep, voffB);
            PG8_WAIT_V(6); PG8_BAR; PG8_MMA(1, 1, At, B1); PG8_BAR;
            }
        }
        if constexpr (ALIGN_EPI) { if (wr == 0) PG8_BAR; }
        if constexpr (!Epi::AFTER_DRAIN) { E(acc, cur, wr, wc, fr, fq); S.done(cur); }
        if (!has_next) break;
#pragma unroll
        for (int a = 0; a < 2; ++a)
#pragma unroll
            for (int b = 0; b < 2; ++b)
#pragma unroll
                for (int m = 0; m < 4; ++m)
#pragma unroll
                    for (int n = 0; n < 2; ++n) acc[a][b][m][n] = (f32x4){0.f, 0.f, 0.f, 0.f};
        cur = nxt; cA = nA; cB = nB; ++ui;
        if constexpr (ALIGN_EPI) { if (wr == 1) PG8_BAR; }
    }
    PG8_WAIT_V(0);
    if constexpr (!ALIGN_EPI) { if (wr == 0) PG8_BAR; }
    PG8_BAR;
    if constexpr (Epi::AFTER_DRAIN) { E.fused(acc, cur, wr, wc, fr, fq, lds, wid, lane); S.done(cur); }
#undef PG8_SA
#undef PG8_SB
#undef PG8_STAGE
#undef PG8_LDA
#undef PG8_LDB
#undef PG8_MMA
#undef PG8_WAIT_V
#undef PG8_WAIT_L
#undef PG8_BAR
#undef PG8_SCHED
}
}
namespace att {
#define ATT_LAS __attribute__((address_space(3)))
typedef unsigned short bf16_t;
typedef short bf16x8 __attribute__((ext_vector_type(8)));
typedef short s16x4 __attribute__((ext_vector_type(4)));
typedef float f32x16 __attribute__((ext_vector_type(16)));
typedef float f32x4 __attribute__((ext_vector_type(4)));
typedef unsigned u32x4 __attribute__((ext_vector_type(4)));
typedef unsigned u32x2 __attribute__((ext_vector_type(2)));
constexpr int SEQ = 2048, PITCH = 4608, OPITCH = 2048;
__device__ __forceinline__ unsigned cvtpk(float lo, float hi) { typedef float f2_t __attribute__((ext_vector_type(2))); typedef __bf16 b2_t __attribute__((ext_vector_type(2))); f2_t v = {lo, hi}; b2_t b = __builtin_convertvector(v, b2_t); return __builtin_bit_cast(unsigned, b); }
__device__ __forceinline__ float swapmax(float m) { auto rr = __builtin_amdgcn_permlane32_swap(__float_as_uint(m), __float_as_uint(m), false, false); return fmaxf(__uint_as_float(rr[0]), __uint_as_float(rr[1])); }
__device__ __forceinline__ float swapsum(float m) { auto rr = __builtin_amdgcn_permlane32_swap(__float_as_uint(m), __float_as_uint(m), false, false); return __uint_as_float(rr[0]) + __uint_as_float(rr[1]); }
__device__ __forceinline__ s16x4 vtr(ATT_LAS const char* p) { return __builtin_bit_cast(s16x4, __builtin_amdgcn_ds_read_tr16_b64_v4i16((ATT_LAS s16x4*)p)); }

struct UnitP {
    int b, q0;
    int qcol, kcol, vcol;
    int kofs;
    float slope2;
    float m_init, l_init;
    int T0, T1;
    int tlo, thi;
    int window;
    int maskall;
    int ocol;
};

template <int DV, int KW>
__device__ __forceinline__ void attn_unit(ATT_LAS char* lds, const bf16_t* __restrict__ P, bf16_t* __restrict__ MIX, const UnitP up, bool diff, float lam, const float* __restrict__ subln_w, int tid) {
    static_assert(KW == DV && (KW == 128 || KW == 64), "tile geometry");
    constexpr int ROWB = KW * 2, CPR = ROWB / 16, RPP = 1024 / ROWB, NP = 64 / RPP / 8, TILEB = 64 * ROWB, STG = 2 * TILEB, NSTG = 4, NEB = DV / 32, NI = 2 * NP;
    constexpr bool WIDE = (KW == 128);
    const int lane = tid & 63, wid = __builtin_amdgcn_readfirstlane(tid >> 6), r32 = lane & 31, hi = lane >> 5, wq = wid & 3, g = wid >> 2;
    const int qw = up.q0 + 32 * wq, q = qw + r32;
    const size_t rowbase = (size_t)up.b * SEQ;
    __syncthreads();
    unsigned kso[NP], vso[NP];
#pragma unroll
    for (int i = 0; i < NP; ++i) { const int piece = wid + 8 * i, row = RPP * piece + lane / CPR, slot = lane % CPR;
        const int kch = WIDE ? (slot ^ (row & 15)) : (slot ^ ((row >> 1) & 7));
        const int vch = ((((slot >> 2) ^ (WIDE ? (row & 3) : ((row >> 1) & 1))) << 2) | (slot & 3));
        kso[i] = (unsigned)(row * PITCH + up.kcol + kch * 8); vso[i] = (unsigned)(row * PITCH + up.vcol + vch * 8); }
    const bf16_t* Pb = P + rowbase * PITCH;
#define ATT_DMA(t, sg) do { const bf16_t* tb_ = Pb + (size_t)(t) * 64 * PITCH; \
    _Pragma("unroll") for (int i_ = 0; i_ < NP; ++i_) { \
        __builtin_amdgcn_global_load_lds((const unsigned*)(tb_ + kso[i_]), (ATT_LAS unsigned*)(lds + (sg) * STG + (wid + 8 * i_) * 1024), 16, 0, 0); \
        __builtin_amdgcn_global_load_lds((const unsigned*)(tb_ + vso[i_]), (ATT_LAS unsigned*)(lds + (sg) * STG + TILEB + (wid + 8 * i_) * 1024), 16, 0, 0); } } while (0)
    bf16x8 qr[4];
    { const bf16_t* qp = P + (rowbase + q) * PITCH + up.qcol + hi * 8;
#pragma unroll
      for (int d0 = 0; d0 < 4; ++d0) qr[d0] = *(const bf16x8*)(qp + d0 * 16); }
#pragma unroll
    for (int j = 0; j < 2; ++j) if (up.T0 + j <= up.T1) ATT_DMA(up.T0 + j, j);
    f32x16 o[NEB];
#pragma unroll
    for (int e = 0; e < NEB; ++e)
#pragma unroll
        for (int r = 0; r < 16; ++r) o[e][r] = 0.f;
    float mhat = up.l_init != 0.f ? up.m_init + up.slope2 * (float)q : 0.f, l = hi == 0 ? up.l_init : 0.f;
    float cb[16];
#pragma unroll
    for (int r = 0; r < 16; ++r) cb[r] = up.slope2 * (float)((r & 3) + 8 * (r >> 2));
    int kad[4];
#pragma unroll
    for (int d0 = 0; d0 < 4; ++d0) { const int c = (up.kofs >> 4) + 2 * d0 + hi; kad[d0] = r32 * ROWB + ((WIDE ? (c ^ (r32 & 15)) : (c ^ ((r32 >> 1) & 7))) << 4); }
    const int i16 = lane & 15, q4 = i16 >> 2, vsw = WIDE ? q4 : (q4 >> 1);
    const int vlane = TILEB + (4 * hi + q4) * ROWB + 32 * ((lane >> 4) & 1) + 8 * (i16 & 3);
    int vad[NEB];
#pragma unroll
    for (int e = 0; e < NEB; ++e) vad[e] = vlane + ((e ^ vsw) << 6);
    bf16x8 pa[4];
#define ATT_PV(sgi) do { ATT_LAS const char* Sv_ = lds + (sgi) * STG; \
    _Pragma("unroll") for (int e = 0; e < NEB; ++e) _Pragma("unroll") for (int ks = 0; ks < 4; ++ks) { \
        const s16x4 lo = vtr(Sv_ + vad[e] + ks * 16 * ROWB), hh = vtr(Sv_ + vad[e] + ks * 16 * ROWB + 8 * ROWB); \
        const bf16x8 vf = {lo[0], lo[1], lo[2], lo[3], hh[0], hh[1], hh[2], hh[3]}; \
        o[e] = __builtin_amdgcn_mfma_f32_32x32x16_bf16(vf, pa[ks], o[e], 0, 0, 0); } } while (0)
    for (int t = up.T0; t <= up.T1 + 1; ++t) {
        const int sg = (t - up.T0) & (NSTG - 1);
        if (t + 1 <= up.T1) { if (NI == 4) asm volatile("s_waitcnt vmcnt(4) lgkmcnt(0)" ::: "memory"); else asm volatile("s_waitcnt vmcnt(2) lgkmcnt(0)" ::: "memory"); }
        else asm volatile("s_waitcnt vmcnt(0) lgkmcnt(0)" ::: "memory");
        __builtin_amdgcn_s_barrier();
        asm volatile("" ::: "memory");
        if (t + 2 <= up.T1) ATT_DMA(t + 2, (sg + 2) & (NSTG - 1));
        if (g == 1 && t - 1 >= up.tlo && t - 1 <= up.thi && t - 1 >= up.T0) ATT_PV((sg + NSTG - 1) & (NSTG - 1));
        if (t >= up.tlo && t <= up.thi && t <= up.T1) {
            ATT_LAS const char* Sb = lds + sg * STG;
            f32x16 p0, p1;
            { const float base0 = up.slope2 * (float)(64 * t + 4 * hi) - mhat, base1 = base0 + 32.f * up.slope2;
#pragma unroll
              for (int r = 0; r < 16; ++r) { p0[r] = cb[r] + base0; p1[r] = cb[r] + base1; } }
#pragma unroll
            for (int d0 = 0; d0 < 4; ++d0) {
                const bf16x8 k0 = *(ATT_LAS const bf16x8*)(Sb + kad[d0]), k1 = *(ATT_LAS const bf16x8*)(Sb + kad[d0] + 32 * ROWB);
                p0 = __builtin_amdgcn_mfma_f32_32x32x16_bf16(k0, qr[d0], p0, 0, 0, 0);
                p1 = __builtin_amdgcn_mfma_f32_32x32x16_bf16(k1, qr[d0], p1, 0, 0, 0);
            }
            if (up.maskall || t == up.thi) {
                const int kvb = 64 * t + 4 * hi, qlo = q - up.window;
#pragma unroll
                for (int r = 0; r < 16; ++r) { const int kv = kvb + (r & 3) + 8 * (r >> 2);
                    if (kv > q || kv <= qlo) p0[r] = -INFINITY;
                    if (kv + 32 > q || kv + 32 <= qlo) p1[r] = -INFINITY; }
            }
            float ra = fmaxf(fmaxf(p0[0], p0[1]), p1[0]), rb = fmaxf(fmaxf(p0[2], p0[3]), p1[1]); ra = fmaxf(fmaxf(ra, p1[2]), p1[3]);
#pragma unroll
            for (int r = 4; r < 16; r += 4) { ra = fmaxf(fmaxf(ra, p0[r]), p0[r + 1]); rb = fmaxf(fmaxf(rb, p0[r + 2]), p0[r + 3]); ra = fmaxf(fmaxf(ra, p1[r]), p1[r + 1]); rb = fmaxf(fmaxf(rb, p1[r + 2]), p1[r + 3]); }
            const float rm = swapmax(fmaxf(ra, rb));
            if (__any(rm > 8.f)) {
                const float dl = fmaxf(rm, 0.f), alpha = __builtin_amdgcn_exp2f(-dl);
                mhat += dl; l *= alpha;
#pragma unroll
                for (int r = 0; r < 16; ++r) { p0[r] -= dl; p1[r] -= dl; }
#pragma unroll
                for (int e = 0; e < NEB; ++e)
#pragma unroll
                    for (int r = 0; r < 16; ++r) o[e][r] *= alpha;
            }
            float ps = 0.f;
#pragma unroll
            for (int r = 0; r < 16; ++r) { p0[r] = __builtin_amdgcn_exp2f(p0[r]); p1[r] = __builtin_amdgcn_exp2f(p1[r]); ps += p0[r] + p1[r]; }
            l += ps;
#pragma unroll
            for (int s = 0; s < 2; ++s) {
                u32x4 w0, w1;
                w0.x = cvtpk(p0[8 * s + 0], p0[8 * s + 1]); w0.y = cvtpk(p0[8 * s + 2], p0[8 * s + 3]); w0.z = cvtpk(p0[8 * s + 4], p0[8 * s + 5]); w0.w = cvtpk(p0[8 * s + 6], p0[8 * s + 7]);
                w1.x = cvtpk(p1[8 * s + 0], p1[8 * s + 1]); w1.y = cvtpk(p1[8 * s + 2], p1[8 * s + 3]); w1.z = cvtpk(p1[8 * s + 4], p1[8 * s + 5]); w1.w = cvtpk(p1[8 * s + 6], p1[8 * s + 7]);
                pa[s] = __builtin_bit_cast(bf16x8, w0); pa[2 + s] = __builtin_bit_cast(bf16x8, w1);
            }
            if (g == 0) ATT_PV(sg);
        }
    }
#undef ATT_PV
#undef ATT_DMA
    asm volatile("s_waitcnt vmcnt(0) lgkmcnt(0)" ::: "memory");
    __builtin_amdgcn_s_barrier();
    asm volatile("" ::: "memory");
    const float lt = swapsum(l), inv = 1.f / lt;
    if (!diff) {
        bf16_t* op = MIX + (rowbase + q) * OPITCH + up.ocol + 4 * hi;
#pragma unroll
        for (int e = 0; e < NEB; ++e)
#pragma unroll
            for (int r4 = 0; r4 < 4; ++r4) { u32x2 w; w.x = cvtpk(o[e][4 * r4] * inv, o[e][4 * r4 + 1] * inv); w.y = cvtpk(o[e][4 * r4 + 2] * inv, o[e][4 * r4 + 3] * inv);
                *(u32x2*)(op + e * 32 + 8 * r4) = w; }
    } else {
        ATT_LAS float* xb = (ATT_LAS float*)(lds + wq * (NEB * 16 * 64 * 4)) + lane;
        if (g == 1) { const float sc = lam * inv;
#pragma unroll
            for (int e = 0; e < NEB; ++e)
#pragma unroll
                for (int r = 0; r < 16; ++r) xb[(e * 16 + r) * 64] = o[e][r] * sc; }
        __syncthreads();
        if (g == 0) { float ss = 0.f;
#pragma unroll
            for (int e = 0; e < NEB; ++e)
#pragma unroll
                for (int r = 0; r < 16; ++r) { const float d = o[e][r] * inv - xb[(e * 16 + r) * 64]; o[e][r] = d; ss += d * d; }
            ss = swapsum(ss);
            const float rs = rsqrtf(ss * (1.f / DV) + 1e-5f) * 0.8f;
            bf16_t* op = MIX + (rowbase + q) * OPITCH + up.ocol + 4 * hi;
#pragma unroll
            for (int e = 0; e < NEB; ++e)
#pragma unroll
                for (int r4 = 0; r4 < 4; ++r4) { const f32x4 wv = *(const f32x4*)(subln_w + e * 32 + 8 * r4 + 4 * hi);
                    u32x2 w; w.x = cvtpk(o[e][4 * r4] * rs * wv[0], o[e][4 * r4 + 1] * rs * wv[1]); w.y = cvtpk(o[e][4 * r4 + 2] * rs * wv[2], o[e][4 * r4 + 3] * rs * wv[3]);
                    *(u32x2*)(op + e * 32 + 8 * r4) = w; } }
    }
}
}
constexpr int NWAVES = 8;
#ifndef MK_N_LAUNCHES
#define MK_N_LAUNCHES 1
#endif
constexpr int N_PHASES = 7;
constexpr int BATCH = 8, SEQ = 2048, D = 2048, M = BATCH * SEQ, INC = 4608, DFF = 5632, NGU = 2 * DFF;
constexpr float RMS_EPS = 1e-5f;
constexpr float QSCALE2 = 0.125f * 1.4426950408889634f;
constexpr size_t MiB = 1u << 20;
constexpr size_t WS_PART1 = 1 * MiB, WS_PART2 = 3 * MiB;
constexpr size_t WS_WIN = 8 * MiB, WS_WOUT = 26 * MiB, WS_WGU = 34 * MiB, WS_WDN = 78 * MiB;
constexpr size_t WS_XN = 100 * MiB;
constexpr size_t WS_PROJ = 164 * MiB, WS_MIX = 308 * MiB;
constexpr size_t WS_H = 164 * MiB;
constexpr size_t WS_END = 372 * MiB;
static_assert(WS_H + (size_t)M * DFF * 2 <= WS_END && WS_MIX + (size_t)M * D * 2 <= WS_END && WS_PROJ + (size_t)M * INC * 2 <= WS_MIX, "ws map");
constexpr int RING_BYTES = 131072, LDS_BYTES = 147456;

#define LAS __attribute__((address_space(3)))
typedef unsigned short bf16;
typedef unsigned v4u __attribute__((ext_vector_type(4)));
typedef float f32x4 __attribute__((ext_vector_type(4)));
__device__ __forceinline__ unsigned pk2(float lo, float hi) { return pg8::cvt_pk_bf16(lo, hi); }
__device__ __forceinline__ float wave_sum(float v) {
#pragma unroll
    for (int o = 1; o < 64; o <<= 1) v += __shfl_xor(v, o);
    return v;
}
__device__ __forceinline__ void transpose_item(const float* __restrict__ W, int K, int N, bf16* __restrict__ WT, int dst_row0, const float* __restrict__ kscale, float cscale, LAS float* scr, int k0, int n0, int lane) {
    f32x4 v[16];
    const float* src = W + (size_t)(k0 + (lane >> 4)) * N + n0 + 4 * (lane & 15);
#pragma unroll
    for (int i = 0; i < 16; ++i) v[i] = __builtin_nontemporal_load((const f32x4*)(src + (size_t)(4 * i) * N));
#pragma unroll
    for (int i = 0; i < 16; ++i) { const int kk = 4 * i + (lane >> 4); float sc = cscale; if (kscale) sc *= kscale[k0 + kk];
        LAS float* d = scr + kk * 65 + 4 * (lane & 15); d[0] = v[i].x * sc; d[1] = v[i].y * sc; d[2] = v[i].z * sc; d[3] = v[i].w * sc; }
    asm volatile("s_waitcnt lgkmcnt(0)" ::: "memory");
    const int c = lane & 7;
#pragma unroll
    for (int j = 0; j < 8; ++j) { const int n = (lane >> 3) + 8 * j; const LAS float* s = scr + (8 * c) * 65 + n;
        v4u o; o.x = pk2(s[0 * 65], s[1 * 65]); o.y = pk2(s[2 * 65], s[3 * 65]); o.z = pk2(s[4 * 65], s[5 * 65]); o.w = pk2(s[6 * 65], s[7 * 65]);
        *(v4u*)(WT + (size_t)(dst_row0 + n) * K + k0 + 8 * c) = o; }
    asm volatile("s_waitcnt lgkmcnt(0)" ::: "memory");
}

struct Args { const float* in[15]; float* out; unsigned char* ws; int ph_lo, ph_hi; };
enum { I_X = 0, I_ANW, I_WIN, I_LQ1, I_LK1, I_LQ2, I_LK2, I_SUBLN, I_SINKS, I_WOUT, I_FNW, I_WG, I_WU, I_WD, I_FINW };

__global__ void __launch_bounds__(NWAVES * 64, 2) hymba_fwd(Args args) {
    extern __shared__ __attribute__((aligned(16))) unsigned char lds_raw[];
    cg::grid_group grid = cg::this_grid();
    LAS unsigned char* lds = (LAS unsigned char*)lds_raw;
    const int tid = threadIdx.x, lane = tid & 63, wave = __builtin_amdgcn_readfirstlane(tid >> 6);
    const int G = gridDim.x, bx = blockIdx.x, vcu = (G % 8 == 0) ? (bx % 8) * (G / 8) + bx / 8 : bx;
    unsigned char* ws = args.ws;
    const float* x = args.in[I_X]; float* out = args.out;
    bf16* Win_t = (bf16*)(ws + WS_WIN); bf16* Wout_t = (bf16*)(ws + WS_WOUT); bf16* Wgu_t = (bf16*)(ws + WS_WGU); bf16* Wdn_t = (bf16*)(ws + WS_WDN);
    bf16* XN = (bf16*)(ws + WS_XN); bf16* PROJ = (bf16*)(ws + WS_PROJ); bf16* MIX = (bf16*)(ws + WS_MIX); bf16* HB = (bf16*)(ws + WS_H);
    float* part1 = (float*)(ws + WS_PART1); float* part2 = (float*)(ws + WS_PART2);
    const int lo = args.ph_lo, hi = args.ph_hi;
#define IN(k) (lo <= (k) && (k) < hi)
#define SEAM(k) do { if (IN(k) && IN((k) + 1)) grid.sync(); } while (0)
#ifndef PROBE_PHASE
#define PROBE_PHASE -1
#endif
#define REP(k) for (int rep_ = 0; rep_ < ((PROBE_PHASE == (k)) ? 2 : 1); ++rep_, ((PROBE_PHASE == (k)) && rep_ < 2 ? (grid.sync(), 0) : 0))

    REP(0) if (IN(0)) {
        LAS float* scr = (LAS float*)(lds + wave * 16640);
        const int gw = vcu * NWAVES + wave, NGW = G * NWAVES;
        constexpr int I_IN = (D / 64) * (INC / 64), I_OUT = (D / 64) * (D / 64), I_G = (D / 64) * (DFF / 64), I_DN = (DFF / 64) * (D / 64);
        constexpr int NITEMS = I_IN + I_OUT + 2 * I_G + I_DN;
        for (int rp_ = 0; rp_ < (PROBE_PHASE == 10 ? 2 : 1); ++rp_)
        for (int it = gw; it < NITEMS; it += NGW) {
            int r = it;
            if (r < I_IN) { const int nblk = INC / 64, k0 = 64 * (r / nblk), n0 = 64 * (r % nblk); const float cs = (n0 < 1024 || (n0 >= 3072 && n0 < 4096)) ? QSCALE2 : 1.f;
                transpose_item(args.in[I_WIN], D, INC, Win_t, n0, nullptr, cs, scr, k0, n0, lane); continue; } r -= I_IN;
            if (r < I_OUT) { const int nblk = D / 64, k0 = 64 * (r / nblk), n0 = 64 * (r % nblk); transpose_item(args.in[I_WOUT], D, D, Wout_t, n0, nullptr, 1.f, scr, k0, n0, lane); continue; } r -= I_OUT;
            if (r < 2 * I_G) { const int up = r >= I_G; if (up) r -= I_G; const int nblk = DFF / 64, k0 = 64 * (r / nblk), n0 = 64 * (r % nblk);
                transpose_item(args.in[up ? I_WU : I_WG], D, DFF, Wgu_t, 256 * (n0 / 128) + 128 * up + (n0 % 128), args.in[I_FNW], 1.f, scr, k0, n0, lane); continue; } r -= 2 * I_G;
            { const int nblk = D / 64, k0 = 64 * (r / nblk), n0 = 64 * (r % nblk); transpose_item(args.in[I_WD], DFF, D, Wdn_t, n0, nullptr, 1.f, scr, k0, n0, lane); }
        }
        const f32x4* wn = (const f32x4*)args.in[I_ANW] + lane;
        for (int rp_ = 0; rp_ < (PROBE_PHASE == 11 ? 2 : 1); ++rp_)
        for (int m = gw; m < M; m += NGW) {
            const f32x4* xr = (const f32x4*)(x + (size_t)m * D) + lane;
            f32x4 v[8]; float s = 0.f;
#pragma unroll
            for (int j = 0; j < 8; ++j) { v[j] = xr[64 * j]; s += (v[j].x * v[j].x + v[j].y * v[j].y) + (v[j].z * v[j].z + v[j].w * v[j].w); }
            const float rstd = rsqrtf(wave_sum(s) * (1.f / D) + RMS_EPS);
            unsigned long long* o8 = (unsigned long long*)(XN + (size_t)m * D) + lane;
#pragma unroll
            for (int j = 0; j < 8; ++j) { const f32x4 w = wn[64 * j]; o8[64 * j] = (unsigned long long)pk2(v[j].x * rstd * w.x, v[j].y * rstd * w.y) | ((unsigned long long)pk2(v[j].z * rstd * w.z, v[j].w * rstd * w.w) << 32); }
        }
        __syncthreads();
    }
    SEAM(0);
    REP(1) if (IN(1)) {
        pg8::Gemm g{XN, Win_t, M, INC, D}; pg8::StaticOrder S; S.init(M, INC, G, bx);
        pg8::EpiStore E{PROJ, INC};
        pg8::gemm_phase<pg8::EpiStore, pg8::StaticOrder, true, true>(lds, g, S, E);
    }
    SEAM(1);
    REP(2) if (IN(2)) {
        const float* lq1 = args.in[I_LQ1]; const float* lk1 = args.in[I_LK1]; const float* lq2 = args.in[I_LQ2]; const float* lk2 = args.in[I_LK2];
        const float s1 = wave_sum(lq1[lane] * lk1[lane]), s2 = wave_sum(lq2[lane] * lk2[lane]);
        const float lam = expf(s1) - expf(s2) + 0.2f;
        const int wq = wave & 3, gsel = wave >> 2;
        for (int i = vcu; i < 512; i += G) {
            const int bh = i >> 3, xq = i & 7, b = bh >> 3, h = bh & 7;
#pragma unroll 1
            for (int k = 0; k < 2; ++k) {
                const int qblk = k ? 15 - xq : xq;
                att::UnitP up; up.b = b; up.q0 = 128 * qblk; up.qcol = h * 128 + gsel * 64; up.kcol = 1024 + h * 128; up.vcol = 2048 + h * 128; up.kofs = gsel * 128;
                up.slope2 = exp2f(-(float)(h + 1)) * 1.4426950408889634f; up.m_init = -1e30f; up.l_init = 0.f;
                up.T0 = 0; up.T1 = 2 * qblk + 1; up.tlo = 0; up.thi = (up.q0 + 32 * wq) >> 6; up.window = 1 << 20; up.maskall = 0; up.ocol = h * 128;
                att::attn_unit<128, 128>((LAS char*)lds, PROJ, MIX, up, true, lam, args.in[I_SUBLN], tid);
            }
        }
        for (int i = vcu; i < 1024; i += G) {
            const int qblk = i & 15, pair = (i >> 4) & 1, hkv = (i >> 5) & 3, b = i >> 7, hq = hkv * 4 + pair * 2 + gsel, a = 2 * qblk;
            att::UnitP up; up.b = b; up.q0 = 128 * qblk; up.qcol = 3072 + hq * 64; up.kcol = 4096 + hkv * 64; up.vcol = 4352 + hkv * 64; up.kofs = 0;
            up.slope2 = exp2f(-0.5f * (float)(hq + 1)) * 1.4426950408889634f; up.m_init = args.in[I_SINKS][hq] * 1.4426950408889634f; up.l_init = 1.f;
            up.T0 = a - 2 < 0 ? 0 : a - 2; up.T1 = a + 1; up.tlo = a - 2 + (wq >> 1); up.thi = a + (wq >> 1); up.window = 128; up.maskall = 1; up.ocol = 1024 + hq * 64;
            att::attn_unit<64, 64>((LAS char*)lds, PROJ, MIX, up, false, 0.f, nullptr, tid);
        }
        __syncthreads();
    }
    SEAM(2);
    REP(3) if (IN(3)) {
        pg8::Gemm g{MIX, Wout_t, M, D, D}; pg8::StaticOrder S; S.init(M, D, G, bx);
        pg8::EpiResid E{x, out, XN, part1, D};
        pg8::gemm_phase<pg8::EpiResid, pg8::StaticOrder, true, true>(lds, g, S, E);
    }
    SEAM(3);
    REP(4) if (IN(4)) {
        pg8::Gemm g{XN, Wgu_t, M, NGU, D}; pg8::StaticOrder S; S.init(M, NGU, G, bx);
        pg8::EpiSwiGLU E{HB, DFF, part1, 1.f / D, RMS_EPS};
        pg8::gemm_phase<pg8::EpiSwiGLU, pg8::StaticOrder, true, true>(lds, g, S, E);
    }
    SEAM(4);
    REP(5) if (IN(5)) {
        pg8::Gemm g{HB, Wdn_t, M, D, DFF}; pg8::StaticOrder S; S.init(M, D, G, bx);
        pg8::EpiResid E{out, out, nullptr, part2, D};
        pg8::gemm_phase<pg8::EpiResid, pg8::StaticOrder, true, true>(lds, g, S, E);
    }
    SEAM(5);
    REP(6) if (IN(6)) {
        const int gw = vcu * NWAVES + wave, NGW = G * NWAVES;
        const f32x4* wn = (const f32x4*)args.in[I_FINW] + lane;
        for (int m = gw; m < M; m += NGW) {
            const float s = wave_sum(lane < 32 ? part2[(size_t)m * 32 + lane] : 0.f);
            const float rstd = rsqrtf(s * (1.f / D) + RMS_EPS);
            f32x4* xr = (f32x4*)(out + (size_t)m * D) + lane;
#pragma unroll
            for (int j = 0; j < 8; ++j) { const f32x4 v = xr[64 * j], w = wn[64 * j]; xr[64 * j] = v * rstd * w; }
        }
    }
#undef IN
#undef SEAM
}

extern "C" void kernel_launch(void* const* d_in, const int* in_sizes, int n_in, void* d_out, int out_size, void* d_ws, size_t ws_size, hipStream_t stream) {
    static int grid = 0;
    if (grid == 0) {
        if (n_in != 15 || out_size != M * D || ws_size < WS_END) { fprintf(stderr, "kernel_launch: unexpected shapes (n_in %d out %d ws %zu)\n", n_in, out_size, ws_size); grid = -1; return; }
        int dev = 0, cus = 0, per_cu = 0;
        hipGetDevice(&dev); hipDeviceGetAttribute(&cus, hipDeviceAttributeMultiprocessorCount, dev);
        if (hipFuncSetAttribute((const void*)hymba_fwd, hipFuncAttributeMaxDynamicSharedMemorySize, LDS_BYTES) != hipSuccess) { fprintf(stderr, "kernel_launch: hipFuncSetAttribute failed\n"); grid = -1; return; }
        if (hipOccupancyMaxActiveBlocksPerMultiprocessor(&per_cu, (const void*)hymba_fwd, NWAVES * 64, LDS_BYTES) != hipSuccess || per_cu < 1) { fprintf(stderr, "kernel_launch: occupancy query says %d\n", per_cu); per_cu = 1; }
        (void)hipGetLastError();
        grid = cus * 1;
        fprintf(stderr, "kernel_launch: grid %d (cus %d, per_cu %d)\n", grid, cus, per_cu);
    }
    if (grid < 0) return;
    Args a{};
    for (int i = 0; i < 15; ++i) a.in[i] = (const float*)d_in[i];
    a.out = (float*)d_out; a.ws = (unsigned char*)d_ws;
#if MK_N_LAUNCHES == 1
    a.ph_lo = 0; a.ph_hi = N_PHASES;
    void* kargs[] = {&a};
    hipError_t e = hipLaunchCooperativeKernel((const void*)hymba_fwd, dim3(grid), dim3(NWAVES * 64), kargs, LDS_BYTES, stream);
    if (e != hipSuccess) fprintf(stderr, "kernel_launch: cooperative launch failed: %s\n", hipGetErrorString(e));
#else
    for (int p = 0; p < N_PHASES; ++p) { a.ph_lo = p; a.ph_hi = p + 1; hipLaunchKernelGGL(hymba_fwd, dim3(grid), dim3(NWAVES * 64), LDS_BYTES, stream, a); }
#endif
}
```

```cpp
#include <hip/hip_runtime.h>
#include <hip/hip_cooperative_groups.h>
#include <hip/hip_bf16.h>
#include <cstdio>
#include <cstdint>
#include <cmath>
namespace cg = cooperative_groups;
#define MK_N_LAUNCHES 1
namespace pg8 {
#define PG8_LAS __attribute__((address_space(3)))
typedef unsigned short bf16_t;
typedef short bf16x8 __attribute__((ext_vector_type(8)));
typedef float f32x4 __attribute__((ext_vector_type(4)));
typedef unsigned u32x4 __attribute__((ext_vector_type(4)));
constexpr int BM = 256, BK = 64, HALF = 128, HTB = HALF * BK * 2  , STAGE_BYTES = 8 * HTB, NXCD = 8, WGM = 8;

__host__ __device__ __forceinline__ int lds_byte(int r, int c) { const int st = (r >> 4) * 2 + (c >> 5), rr = r & 15, cc = c & 31, ob = rr * 64 + cc * 2; return st * 1024 + (ob ^ (((ob >> 9) & 1) << 5)); }
__host__ __device__ __forceinline__ void stage_rc(int b, int& R, int& C) { const int st = b / 1024, sb = b % 1024, swz = sb ^ (((sb >> 9) & 1) << 5); R = (st >> 1) * 16 + swz / 64; C = (st & 1) * 32 + (swz % 64) / 2; }
__host__ __device__ __forceinline__ int perm32(int rho) { const int n = rho >> 4, i = rho & 15; return 8 * (i >> 2) + 4 * n + (i & 3); }

struct Unit { int pm, pn; };
struct Gemm { const bf16_t* A; const bf16_t* Bt; int M, N, K; };

struct StaticOrder {
    int nM, nN, nwg, G, c;
    __host__ __device__ void init(int M, int N, int G_, int c_) { nM = M / BM; nN = N / BM; nwg = nM * nN; G = G_; c = c_; }
    __host__ __device__ bool next(int i, Unit& u) const {
        const long L = (long)i * G + c; if (L >= nwg) return false;
        int wgid = (int)L; { const int q = nwg / NXCD, r = nwg % NXCD, xcd = wgid % NXCD, off = wgid / NXCD; wgid = (xcd < r ? xcd * (q + 1) : r * (q + 1) + (xcd - r) * q) + off; }
        const int nig = WGM * nN, gid = wgid / nig, fm = gid * WGM, gsz = (nM - fm) < WGM ? (nM - fm) : WGM;
        u.pm = fm + ((wgid % nig) % gsz); u.pn = (wgid % nig) / gsz; return true;
    }
    __device__ __forceinline__ void a_ready(const Unit&) const {}
    __device__ __forceinline__ void done(const Unit&) const {}
};

__device__ __forceinline__ unsigned cvt_pk_bf16(float lo, float hi) { typedef float f2_t __attribute__((ext_vector_type(2))); typedef __bf16 b2_t __attribute__((ext_vector_type(2))); f2_t v = {lo, hi}; b2_t b = __builtin_convertvector(v, b2_t); return __builtin_bit_cast(unsigned, b); }
typedef unsigned u32x2 __attribute__((ext_vector_type(2)));
struct EpiStore {
    static constexpr bool PERM = true, AFTER_DRAIN = false;
    bf16_t* O; int ldc;
    __device__ __forceinline__ void operator()(const f32x4 (&acc)[2][2][4][2], const Unit& u, int wr, int wc, int fr, int fq) const {
        const int row0 = u.pm * BM + wr * 64 + fr, col0 = u.pn * BM + wc * 32 + 8 * fq;
#pragma unroll
        for (int ai = 0; ai < 2; ++ai)
#pragma unroll
            for (int m = 0; m < 4; ++m) { bf16_t* rowp = O + (size_t)(row0 + ai * HALF + m * 16) * ldc + col0;
#pragma unroll
                for (int bj = 0; bj < 2; ++bj) { const f32x4 v0 = acc[ai][bj][m][0], v1 = acc[ai][bj][m][1];
                    u32x4 w; w.x = cvt_pk_bf16(v0[0], v0[1]); w.y = cvt_pk_bf16(v0[2], v0[3]); w.z = cvt_pk_bf16(v1[0], v1[1]); w.w = cvt_pk_bf16(v1[2], v1[3]);
                    *(u32x4*)(rowp + bj * HALF) = w; } }
    }
};
template <bool BASE_BF16> struct EpiResid {
    static constexpr bool PERM = true, AFTER_DRAIN = false;
    const void* base; bf16_t* xo; float* part; int ldc;
    __device__ __forceinline__ void operator()(const f32x4 (&acc)[2][2][4][2], const Unit& u, int wr, int wc, int fr, int fq) const {
        const int row0 = u.pm * BM + wr * 64 + fr, col0 = u.pn * BM + wc * 32 + 8 * fq;
#pragma unroll
        for (int ai = 0; ai < 2; ++ai)
#pragma unroll
            for (int m = 0; m < 4; ++m) { const int r = row0 + ai * HALF + m * 16; const size_t off = (size_t)r * ldc + col0; float ss = 0.f;
#pragma unroll
                for (int bj = 0; bj < 2; ++bj) { f32x4 b0, b1;
                    if (BASE_BF16) { const u32x4 w = *(const u32x4*)((const bf16_t*)base + off + bj * HALF);
                        b0 = (f32x4){__uint_as_float(w.x << 16), __uint_as_float(w.x & 0xffff0000u), __uint_as_float(w.y << 16), __uint_as_float(w.y & 0xffff0000u)};
                        b1 = (f32x4){__uint_as_float(w.z << 16), __uint_as_float(w.z & 0xffff0000u), __uint_as_float(w.w << 16), __uint_as_float(w.w & 0xffff0000u)}; }
                    else { const float* bp = (const float*)base + off + bj * HALF; b0 = *(const f32x4*)bp; b1 = *(const f32x4*)(bp + 4); }
                    const f32x4 v0 = b0 + acc[ai][bj][m][0], v1 = b1 + acc[ai][bj][m][1];
                    ss += ((v0[0] * v0[0] + v0[1] * v0[1]) + (v0[2] * v0[2] + v0[3] * v0[3])) + ((v1[0] * v1[0] + v1[1] * v1[1]) + (v1[2] * v1[2] + v1[3] * v1[3]));
                    u32x4 w; w.x = cvt_pk_bf16(v0[0], v0[1]); w.y = cvt_pk_bf16(v0[2], v0[3]); w.z = cvt_pk_bf16(v1[0], v1[1]); w.w = cvt_pk_bf16(v1[2], v1[3]);
                    *(u32x4*)(xo + off + bj * HALF) = w; }
                ss += __shfl_xor(ss, 16); ss += __shfl_xor(ss, 32);
                if (fq == 0) part[(size_t)r * 32 + u.pn * 4 + wc] = ss; }
    }
};
struct EpiSwiGLU {
    static constexpr bool PERM = true, AFTER_DRAIN = false;
    bf16_t* H; int ldh; const float* part; float inv_n, eps;
    __device__ __forceinline__ static float silu_mul(float g, float uu) { const float e = __builtin_amdgcn_exp2f(g * -1.4426950408889634f); return g * uu * __builtin_amdgcn_rcpf(1.f + e); }
    __device__ __forceinline__ void operator()(const f32x4 (&acc)[2][2][4][2], const Unit& u, int wr, int wc, int fr, int fq) const {
        const int row0 = u.pm * BM + wr * 64 + fr, col0 = u.pn * HALF + wc * 32 + 8 * fq;
#pragma unroll
        for (int ai = 0; ai < 2; ++ai)
#pragma unroll
            for (int m = 0; m < 4; ++m) { const int r = row0 + ai * HALF + m * 16;
                const f32x4* pp = (const f32x4*)(part + (size_t)r * 32 + fq * 8); const f32x4 pa = pp[0], pb = pp[1];
                float s = ((pa[0] + pa[1]) + (pa[2] + pa[3])) + ((pb[0] + pb[1]) + (pb[2] + pb[3]));
                s += __shfl_xor(s, 16); s += __shfl_xor(s, 32);
                const float rstd = rsqrtf(s * inv_n + eps);
                const f32x4 g0 = acc[ai][0][m][0] * rstd, g1 = acc[ai][0][m][1] * rstd, u0 = acc[ai][1][m][0] * rstd, u1 = acc[ai][1][m][1] * rstd;
                u32x4 w; w.x = cvt_pk_bf16(silu_mul(g0[0], u0[0]), silu_mul(g0[1], u0[1])); w.y = cvt_pk_bf16(silu_mul(g0[2], u0[2]), silu_mul(g0[3], u0[3]));
                w.z = cvt_pk_bf16(silu_mul(g1[0], u1[0]), silu_mul(g1[1], u1[1])); w.w = cvt_pk_bf16(silu_mul(g1[2], u1[2]), silu_mul(g1[3], u1[3]));
                *(u32x4*)(H + (size_t)r * ldh + col0) = w; }
    }
};
template <class Epi, class Sched, bool ALIGN_EPI = false, bool SP2 = false>
__device__ __forceinline__ void gemm_phase(PG8_LAS unsigned char* lds, const Gemm g, const Sched& S, const Epi& E) {
    const int tid = threadIdx.x, wid = __builtin_amdgcn_readfirstlane(tid >> 6), lane = tid & 63, wr = wid >> 2, wc = wid & 3, fr = lane & 15, fq = lane >> 4;
    const int K = g.K, nt = K / BK;
    unsigned voffA[2], voffB[2];
#pragma unroll
    for (int i = 0; i < 2; ++i) { int R, C; stage_rc(tid * 16 + i * 8192, R, C); const int Rb = Epi::PERM ? ((R & ~31) + perm32(R & 31)) : R;
        voffA[i] = (unsigned)(R * K + C) * 2u; voffB[i] = (unsigned)(Rb * K + C) * 2u; }
    const size_t kstep = (size_t)(BK * 2);
    const size_t hstep = (size_t)HALF * K * 2;
    const size_t tstep = 2 * hstep;
    const unsigned ldsw = (unsigned)wid * 1024u;
    const int aoff = lds_byte(wr * 64 + fr, fq * 8), boff = lds_byte(wc * 32 + fr, fq * 8);
#define PG8_SA(b, h) (((b) * 2 + (h)) * HTB)
#define PG8_SB(b, h) ((4 + (b) * 2 + (h)) * HTB)
#define PG8_STAGE(bufoff, gbase, voff) do { _Pragma("unroll") for (int _i = 0; _i < 2; ++_i) \
        __builtin_amdgcn_global_load_lds((const unsigned*)((const char*)(gbase) + (voff)[_i]), (PG8_LAS unsigned*)(lds + (bufoff) + ldsw + _i * 8192), 16, 0, 0); } while (0)
#define PG8_LDA(dst, b, h) do { _Pragma("unroll") for (int m = 0; m < 4; ++m) _Pragma("unroll") for (int k = 0; k < 2; ++k) dst[m][k] = *(const PG8_LAS bf16x8*)(lds + PG8_SA(b, h) + aoff + m * 2048 + k * 1024); } while (0)
#define PG8_LDB(dst, b, h) do { _Pragma("unroll") for (int n = 0; n < 2; ++n) _Pragma("unroll") for (int k = 0; k < 2; ++k) dst[n][k] = *(const PG8_LAS bf16x8*)(lds + PG8_SB(b, h) + boff + n * 2048 + k * 1024); } while (0)
#define PG8_MMA(ai, bj, At, Bt) do { __builtin_amdgcn_s_setprio(1); _Pragma("unroll") for (int m = 0; m < 4; ++m) _Pragma("unroll") for (int n = 0; n < 2; ++n) _Pragma("unroll") for (int k = 0; k < 2; ++k) \
        acc[ai][bj][m][n] = __builtin_amdgcn_mfma_f32_16x16x32_bf16(Bt[n][k], At[m][k], acc[ai][bj][m][n], 0, 0, 0); __builtin_amdgcn_s_setprio(0); } while (0)
#define PG8_WAIT_V(n) asm volatile("s_waitcnt vmcnt(" #n ")" ::: "memory")
#define PG8_WAIT_L(n) asm volatile("s_waitcnt lgkmcnt(" #n ")" ::: "memory")
#define PG8_BAR __builtin_amdgcn_s_barrier()
#define PG8_SCHED __builtin_amdgcn_sched_barrier(0)
    Unit cur, nxt; int ui = 0;
    if (!S.next(0, cur)) return;
    f32x4 acc[2][2][4][2];
#pragma unroll
    for (int a = 0; a < 2; ++a)
#pragma unroll
        for (int b = 0; b < 2; ++b)
#pragma unroll
            for (int m = 0; m < 4; ++m)
#pragma unroll
                for (int n = 0; n < 2; ++n) acc[a][b][m][n] = (f32x4){0.f, 0.f, 0.f, 0.f};
    bf16x8 At[4][2], B0[2][2], B1[2][2];
    const char* cA = (const char*)g.A + (size_t)cur.pm * tstep; const char* cB = (const char*)g.Bt + (size_t)cur.pn * tstep;
    S.a_ready(cur);
    if constexpr (SP2) {
        PG8_STAGE(PG8_SB(0, 0), cB, voffB); PG8_STAGE(PG8_SB(0, 1), cB + hstep, voffB); PG8_STAGE(PG8_SA(0, 0), cA, voffA); PG8_STAGE(PG8_SA(0, 1), cA + hstep, voffA);
        if (wr == 1) PG8_BAR;
        PG8_WAIT_V(2); PG8_BAR;
        PG8_STAGE(PG8_SB(1, 0), cB + kstep, voffB); PG8_STAGE(PG8_SA(1, 0), cA + kstep, voffA); PG8_STAGE(PG8_SB(1, 1), cB + hstep + kstep, voffB);
        PG8_WAIT_V(6); PG8_BAR;
    } else {
        PG8_STAGE(PG8_SB(0, 0), cB, voffB); PG8_STAGE(PG8_SA(0, 0), cA, voffA); PG8_STAGE(PG8_SB(0, 1), cB + hstep, voffB); PG8_STAGE(PG8_SA(0, 1), cA + hstep, voffA);
        if (wr == 1) PG8_BAR;
        PG8_WAIT_V(4); PG8_BAR;
        PG8_STAGE(PG8_SB(1, 0), cB + kstep, voffB); PG8_STAGE(PG8_SA(1, 0), cA + kstep, voffA); PG8_STAGE(PG8_SB(1, 1), cB + hstep + kstep, voffB);
        PG8_WAIT_V(6); PG8_BAR;
    }
    for (;;) {
        const bool has_next = S.next(ui + 1, nxt);
        const char* nA = has_next ? (const char*)g.A + (size_t)nxt.pm * tstep : cA; const char* nB = has_next ? (const char*)g.Bt + (size_t)nxt.pn * tstep : cB;
        for (int t = 0; t < nt; t += 2) {
            const bool last = (t == nt - 2);
            const char* a1 = cA + (size_t)(t + 1) * kstep;
            const char* a2 = last ? nA : cA + (size_t)(t + 2) * kstep; const char* b2 = last ? nB : cB + (size_t)(t + 2) * kstep;
            const char* a3 = a2 + kstep; const char* b3 = b2 + kstep;
            if (last && has_next) S.a_ready(nxt);
            if constexpr (SP2) {
            PG8_LDB(B0, 0, 0); PG8_LDB(B1, 0, 1); PG8_SCHED; PG8_LDA(At, 0, 0); PG8_STAGE(PG8_SA(1, 1), a1 + hstep, voffA);
            PG8_WAIT_V(8); PG8_WAIT_L(0); PG8_BAR; PG8_MMA(0, 0, At, B0); PG8_MMA(0, 1, At, B1); PG8_BAR; PG8_SCHED;
            PG8_LDA(At, 0, 1); PG8_STAGE(PG8_SB(0, 0), b2, voffB); PG8_STAGE(PG8_SB(0, 1), b2 + hstep, voffB); PG8_STAGE(PG8_SA(0, 0), a2, voffA);
            PG8_WAIT_V(8); PG8_WAIT_L(0); PG8_BAR; PG8_MMA(1, 0, At, B0); PG8_MMA(1, 1, At, B1); PG8_BAR; PG8_SCHED;
            PG8_LDB(B0, 1, 0); PG8_LDB(B1, 1, 1); PG8_SCHED; PG8_LDA(At, 1, 0); PG8_STAGE(PG8_SA(0, 1), a2 + hstep, voffA);
            PG8_WAIT_V(8); PG8_WAIT_L(0); PG8_BAR; PG8_MMA(0, 0, At, B0); PG8_MMA(0, 1, At, B1); PG8_BAR; PG8_SCHED;
            PG8_LDA(At, 1, 1); PG8_STAGE(PG8_SB(1, 0), b3, voffB); PG8_STAGE(PG8_SB(1, 1), b3 + hstep, voffB); PG8_STAGE(PG8_SA(1, 0), a3, voffA);
            PG8_WAIT_V(8); PG8_WAIT_L(0); PG8_BAR; PG8_MMA(1, 0, At, B0); PG8_MMA(1, 1, At, B1); PG8_BAR; PG8_SCHED;
            } else {
            PG8_LDB(B0, 0, 0); PG8_SCHED; PG8_LDA(At, 0, 0); PG8_STAGE(PG8_SA(1, 1), a1 + hstep, voffA);
            PG8_WAIT_L(8); PG8_BAR; PG8_WAIT_L(0); PG8_MMA(0, 0, At, B0); PG8_BAR; PG8_SCHED;
            PG8_LDB(B1, 0, 1); PG8_STAGE(PG8_SB(0, 0), b2, voffB);
            PG8_BAR; PG8_WAIT_L(0); PG8_MMA(0, 1, At, B1); PG8_BAR;
            PG8_LDA(At, 0, 1); PG8_STAGE(PG8_SA(0, 0), a2, voffA);
            PG8_BAR; PG8_WAIT_L(0); PG8_MMA(1, 0, At, B0); PG8_BAR; PG8_SCHED;
            PG8_STAGE(PG8_SB(0, 1), b2 + hstep, voffB);
            PG8_WAIT_V(6); PG8_BAR; PG8_MMA(1, 1, At, B1); PG8_BAR;
            PG8_LDB(B0, 1, 0); PG8_SCHED; PG8_LDA(At, 1, 0); PG8_STAGE(PG8_SA(0, 1), a2 + hstep, voffA);
            PG8_WAIT_L(8); PG8_BAR; PG8_WAIT_L(0); PG8_MMA(0, 0, At, B0); PG8_BAR; PG8_SCHED;
            PG8_LDB(B1, 1, 1); PG8_STAGE(PG8_SB(1, 0), b3, voffB);
            PG8_BAR; PG8_WAIT_L(0); PG8_MMA(0, 1, At, B1); PG8_BAR;
            PG8_LDA(At, 1, 1); PG8_STAGE(PG8_SA(1, 0), a3, voffA);
            PG8_BAR; PG8_WAIT_L(0); PG8_MMA(1, 0, At, B0); PG8_BAR; PG8_SCHED;
            PG8_STAGE(PG8_SB(1, 1), b3 + hstep, voffB);
            PG8_WAIT_V(6); PG8_BAR; PG8_MMA(1, 1, At, B1); PG8_BAR;
            }
        }
        if constexpr (ALIGN_EPI) { if (wr == 0) PG8_BAR; }
        if constexpr (!Epi::AFTER_DRAIN) { E(acc, cur, wr, wc, fr, fq); S.done(cur); }
        if (!has_next) break;
#pragma unroll
        for (int a = 0; a < 2; ++a)
#pragma unroll
            for (int b = 0; b < 2; ++b)
#pragma unroll
                for (int m = 0; m < 4; ++m)
#pragma unroll
                    for (int n = 0; n < 2; ++n) acc[a][b][m][n] = (f32x4){0.f, 0.f, 0.f, 0.f};
        cur = nxt; cA = nA; cB = nB; ++ui;
        if constexpr (ALIGN_EPI) { if (wr == 1) PG8_BAR; }
    }
    PG8_WAIT_V(0);
    if constexpr (!ALIGN_EPI) { if (wr == 0) PG8_BAR; }
    PG8_BAR;
    if constexpr (Epi::AFTER_DRAIN) { E.fused(acc, cur, wr, wc, fr, fq, lds, wid, lane); S.done(cur); }
#undef PG8_SA
#undef PG8_SB
#undef PG8_STAGE
#undef PG8_LDA
#undef PG8_LDB
#undef PG8_MMA
#undef PG8_WAIT_V
#undef PG8_WAIT_L
#undef PG8_BAR
#undef PG8_SCHED
}
}
namespace att {
#define ATT_LAS __attribute__((address_space(3)))
typedef unsigned short bf16_t;
typedef short bf16x8 __attribute__((ext_vector_type(8)));
typedef short s16x4 __attribute__((ext_vector_type(4)));
typedef float f32x16 __attribute__((ext_vector_type(16)));
typedef float f32x4 __attribute__((ext_vector_type(4)));
typedef unsigned u32x4 __attribute__((ext_vector_type(4)));
typedef unsigned u32x2 __attribute__((ext_vector_type(2)));
constexpr int SEQ = 2048, PITCH = 4608, OPITCH = 2048;
__device__ __forceinline__ unsigned cvtpk(float lo, float hi) { typedef float f2_t __attribute__((ext_vector_type(2))); typedef __bf16 b2_t __attribute__((ext_vector_type(2))); f2_t v = {lo, hi}; b2_t b = __builtin_convertvector(v, b2_t); return __builtin_bit_cast(unsigned, b); }
__device__ __forceinline__ float swapmax(float m) { auto rr = __builtin_amdgcn_permlane32_swap(__float_as_uint(m), __float_as_uint(m), false, false); return fmaxf(__uint_as_float(rr[0]), __uint_as_float(rr[1])); }
__device__ __forceinline__ float swapsum(float m) { auto rr = __builtin_amdgcn_permlane32_swap(__float_as_uint(m), __float_as_uint(m), false, false); return __uint_as_float(rr[0]) + __uint_as_float(rr[1]); }
__device__ __forceinline__ s16x4 vtr(ATT_LAS const char* p) { return __builtin_bit_cast(s16x4, __builtin_amdgcn_ds_read_tr16_b64_v4i16((ATT_LAS s16x4*)p)); }

struct UnitP {
    int b, q0;
    int qcol, kcol, vcol;
    int kofs;
    float slope2;
    float m_init, l_init;
    int T0, T1;
    int tlo, thi;
    int window;
    int maskall;
    int ocol;
};

template <int DV, int KW>
__device__ __forceinline__ void attn_unit(ATT_LAS char* lds, const bf16_t* __restrict__ P, bf16_t* __restrict__ MIX, const UnitP up, bool diff, float lam, const float* __restrict__ subln_w, int tid) {
    static_assert(KW == DV && (KW == 128 || KW == 64), "tile geometry");
    constexpr int ROWB = KW * 2, CPR = ROWB / 16, RPP = 1024 / ROWB, NP = 64 / RPP / 8, TILEB = 64 * ROWB, STG = 2 * TILEB, NSTG = 4, NEB = DV / 32, NI = 2 * NP;
    constexpr bool WIDE = (KW == 128);
    const int lane = tid & 63, wid = __builtin_amdgcn_readfirstlane(tid >> 6), r32 = lane & 31, hi = lane >> 5, wq = wid & 3, g = wid >> 2;
    const int qw = up.q0 + 32 * wq, q = qw + r32;
    const size_t rowbase = (size_t)up.b * SEQ;
    __syncthreads();
    unsigned kso[NP], vso[NP];
#pragma unroll
    for (int i = 0; i < NP; ++i) { const int piece = wid + 8 * i, row = RPP * piece + lane / CPR, slot = lane % CPR;
        const int kch = WIDE ? (slot ^ (row & 15)) : (slot ^ ((row >> 1) & 7));
        const int vch = ((((slot >> 2) ^ (WIDE ? (row & 3) : ((row >> 1) & 1))) << 2) | (slot & 3));
        kso[i] = (unsigned)(row * PITCH + up.kcol + kch * 8); vso[i] = (unsigned)(row * PITCH + up.vcol + vch * 8); }
    const bf16_t* Pb = P + rowbase * PITCH;
#define ATT_DMA(t, sg) do { const bf16_t* tb_ = Pb + (size_t)(t) * 64 * PITCH; \
    _Pragma("unroll") for (int i_ = 0; i_ < NP; ++i_) { \
        __builtin_amdgcn_global_load_lds((const unsigned*)(tb_ + kso[i_]), (ATT_LAS unsigned*)(lds + (sg) * STG + (wid + 8 * i_) * 1024), 16, 0, 0); \
        __builtin_amdgcn_global_load_lds((const unsigned*)(tb_ + vso[i_]), (ATT_LAS unsigned*)(lds + (sg) * STG + TILEB + (wid + 8 * i_) * 1024), 16, 0, 0); } } while (0)
    bf16x8 qr[4];
    { const bf16_t* qp = P + (rowbase + q) * PITCH + up.qcol + hi * 8;
#pragma unroll
      for (int d0 = 0; d0 < 4; ++d0) qr[d0] = *(const bf16x8*)(qp + d0 * 16); }
#pragma unroll
    for (int j = 0; j < 2; ++j) if (up.T0 + j <= up.T1) ATT_DMA(up.T0 + j, j);
    f32x16 o[NEB];
#pragma unroll
    for (int e = 0; e < NEB; ++e)
#pragma unroll
        for (int r = 0; r < 16; ++r) o[e][r] = 0.f;
    float mhat = up.l_init != 0.f ? up.m_init + up.slope2 * (float)q : 0.f, l = hi == 0 ? up.l_init : 0.f;
    float cb[16];
#pragma unroll
    for (int r = 0; r < 16; ++r) cb[r] = up.slope2 * (float)((r & 3) + 8 * (r >> 2));
    int kad[4];
#pragma unroll
    for (int d0 = 0; d0 < 4; ++d0) { const int c = (up.kofs >> 4) + 2 * d0 + hi; kad[d0] = r32 * ROWB + ((WIDE ? (c ^ (r32 & 15)) : (c ^ ((r32 >> 1) & 7))) << 4); }
    const int i16 = lane & 15, q4 = i16 >> 2, vsw = WIDE ? q4 : (q4 >> 1);
    const int vlane = TILEB + (4 * hi + q4) * ROWB + 32 * ((lane >> 4) & 1) + 8 * (i16 & 3);
    int vad[NEB];
#pragma unroll
    for (int e = 0; e < NEB; ++e) vad[e] = vlane + ((e ^ vsw) << 6);
    bf16x8 pa[4];
#define ATT_PV(sgi) do { ATT_LAS const char* Sv_ = lds + (sgi) * STG; \
    _Pragma("unroll") for (int e = 0; e < NEB; ++e) _Pragma("unroll") for (int ks = 0; ks < 4; ++ks) { \
        const s16x4 lo = vtr(Sv_ + vad[e] + ks * 16 * ROWB), hh = vtr(Sv_ + vad[e] + ks * 16 * ROWB + 8 * ROWB); \
        const bf16x8 vf = {lo[0], lo[1], lo[2], lo[3], hh[0], hh[1], hh[2], hh[3]}; \
        o[e] = __builtin_amdgcn_mfma_f32_32x32x16_bf16(vf, pa[ks], o[e], 0, 0, 0); } } while (0)
    for (int t = up.T0; t <= up.T1 + 1; ++t) {
        const int sg = (t - up.T0) & (NSTG - 1);
        if (t + 1 <= up.T1) { if (NI == 4) asm volatile("s_waitcnt vmcnt(4) lgkmcnt(0)" ::: "memory"); else asm volatile("s_waitcnt vmcnt(2) lgkmcnt(0)" ::: "memory"); }
        else asm volatile("s_waitcnt vmcnt(0) lgkmcnt(0)" ::: "memory");
        __builtin_amdgcn_s_barrier();
        asm volatile("" ::: "memory");
        if (t + 2 <= up.T1) ATT_DMA(t + 2, (sg + 2) & (NSTG - 1));
        if (g == 1 && t - 1 >= up.tlo && t - 1 <= up.thi && t - 1 >= up.T0) ATT_PV((sg + NSTG - 1) & (NSTG - 1));
        if (t >= up.tlo && t <= up.thi && t <= up.T1) {
            ATT_LAS const char* Sb = lds + sg * STG;
            f32x16 p0, p1;
            { const float base0 = up.slope2 * (float)(64 * t + 4 * hi) - mhat, base1 = base0 + 32.f * up.slope2;
#pragma unroll
              for (int r = 0; r < 16; ++r) { p0[r] = cb[r] + base0; p1[r] = cb[r] + base1; } }
#pragma unroll
            for (int d0 = 0; d0 < 4; ++d0) {
                const bf16x8 k0 = *(ATT_LAS const bf16x8*)(Sb + kad[d0]), k1 = *(ATT_LAS const bf16x8*)(Sb + kad[d0] + 32 * ROWB);
                p0 = __builtin_amdgcn_mfma_f32_32x32x16_bf16(k0, qr[d0], p0, 0, 0, 0);
                p1 = __builtin_amdgcn_mfma_f32_32x32x16_bf16(k1, qr[d0], p1, 0, 0, 0);
            }
            if (up.maskall || t == up.thi) {
                const int kvb = 64 * t + 4 * hi, qlo = q - up.window;
#pragma unroll
                for (int r = 0; r < 16; ++r) { const int kv = kvb + (r & 3) + 8 * (r >> 2);
                    if (kv > q || kv <= qlo) p0[r] = -INFINITY;
                    if (kv + 32 > q || kv + 32 <= qlo) p1[r] = -INFINITY; }
            }
            float ra = fmaxf(fmaxf(p0[0], p0[1]), p1[0]), rb = fmaxf(fmaxf(p0[2], p0[3]), p1[1]); ra = fmaxf(fmaxf(ra, p1[2]), p1[3]);
#pragma unroll
            for (int r = 4; r < 16; r += 4) { ra = fmaxf(fmaxf(ra, p0[r]), p0[r + 1]); rb = fmaxf(fmaxf(rb, p0[r + 2]), p0[r + 3]); ra = fmaxf(fmaxf(ra, p1[r]), p1[r + 1]); rb = fmaxf(fmaxf(rb, p1[r + 2]), p1[r + 3]); }
            const float rm = swapmax(fmaxf(ra, rb));
            if (__any(rm > 8.f)) {
                const float dl = fmaxf(rm, 0.f), alpha = __builtin_amdgcn_exp2f(-dl);
                mhat += dl; l *= alpha;
#pragma unroll
                for (int r = 0; r < 16; ++r) { p0[r] -= dl; p1[r] -= dl; }
#pragma unroll
                for (int e = 0; e < NEB; ++e)
#pragma unroll
                    for (int r = 0; r < 16; ++r) o[e][r] *= alpha;
            }
            float ps = 0.f;
#pragma unroll
            for (int r = 0; r < 16; ++r) { p0[r] = __builtin_amdgcn_exp2f(p0[r]); p1[r] = __builtin_amdgcn_exp2f(p1[r]); ps += p0[r] + p1[r]; }
            l += ps;
#pragma unroll
            for (int s = 0; s < 2; ++s) {
                u32x4 w0, w1;
                w0.x = cvtpk(p0[8 * s + 0], p0[8 * s + 1]); w0.y = cvtpk(p0[8 * s + 2], p0[8 * s + 3]); w0.z = cvtpk(p0[8 * s + 4], p0[8 * s + 5]); w0.w = cvtpk(p0[8 * s + 6], p0[8 * s + 7]);
                w1.x = cvtpk(p1[8 * s + 0], p1[8 * s + 1]); w1.y = cvtpk(p1[8 * s + 2], p1[8 * s + 3]); w1.z = cvtpk(p1[8 * s + 4], p1[8 * s + 5]); w1.w = cvtpk(p1[8 * s + 6], p1[8 * s + 7]);
                pa[s] = __builtin_bit_cast(bf16x8, w0); pa[2 + s] = __builtin_bit_cast(bf16x8, w1);
            }
            if (g == 0) ATT_PV(sg);
        }
    }
#undef ATT_PV
#undef ATT_DMA
    asm volatile("s_waitcnt vmcnt(0) lgkmcnt(0)" ::: "memory");
    __builtin_amdgcn_s_barrier();
    asm volatile("" ::: "memory");
    const float lt = swapsum(l), inv = 1.f / lt;
    if (!diff) {
        bf16_t* op = MIX + (rowbase + q) * OPITCH + up.ocol + 4 * hi;
#pragma unroll
        for (int e = 0; e < NEB; ++e)
#pragma unroll
            for (int r4 = 0; r4 < 4; ++r4) { u32x2 w; w.x = cvtpk(o[e][4 * r4] * inv, o[e][4 * r4 + 1] * inv); w.y = cvtpk(o[e][4 * r4 + 2] * inv, o[e][4 * r4 + 3] * inv);
                *(u32x2*)(op + e * 32 + 8 * r4) = w; }
    } else {
        ATT_LAS float* xb = (ATT_LAS float*)(lds + wq * (NEB * 16 * 64 * 4)) + lane;
        if (g == 1) { const float sc = lam * inv;
#pragma unroll
            for (int e = 0; e < NEB; ++e)
#pragma unroll
                for (int r = 0; r < 16; ++r) xb[(e * 16 + r) * 64] = o[e][r] * sc; }
        __syncthreads();
        if (g == 0) { float ss = 0.f;
#pragma unroll
            for (int e = 0; e < NEB; ++e)
#pragma unroll
                for (int r = 0; r < 16; ++r) { const float d = o[e][r] * inv - xb[(e * 16 + r) * 64]; o[e][r] = d; ss += d * d; }
            ss = swapsum(ss);
            const float rs = rsqrtf(ss * (1.f / DV) + 1e-5f) * 0.8f;
            bf16_t* op = MIX + (rowbase + q) * OPITCH + up.ocol + 4 * hi;
#pragma unroll
            for (int e = 0; e < NEB; ++e)
#pragma unroll
                for (int r4 = 0; r4 < 4; ++r4) { const f32x4 wv = *(const f32x4*)(subln_w + e * 32 + 8 * r4 + 4 * hi);
                    u32x2 w; w.x = cvtpk(o[e][4 * r4] * rs * wv[0], o[e][4 * r4 + 1] * rs * wv[1]); w.y = cvtpk(o[e][4 * r4 + 2] * rs * wv[2], o[e][4 * r4 + 3] * rs * wv[3]);
                    *(u32x2*)(op + e * 32 + 8 * r4) = w; } }
    }
}
}
constexpr int NWAVES = 8;
#ifndef MK_N_LAUNCHES
#define MK_N_LAUNCHES 1
#endif
constexpr int N_PHASES = 7;
constexpr int BATCH = 8, SEQ = 2048, D = 2048, M = BATCH * SEQ, INC = 4608, DFF = 5632, NGU = 2 * DFF;
constexpr float RMS_EPS = 1e-5f;
constexpr float QSCALE2 = 0.125f * 1.4426950408889634f;
constexpr size_t MiB = 1u << 20;
constexpr size_t WS_PART1 = 1 * MiB, WS_PART2 = 3 * MiB;
constexpr size_t WS_WIN = 8 * MiB, WS_WOUT = 26 * MiB, WS_WGU = 34 * MiB, WS_WDN = 78 * MiB;
constexpr size_t WS_XN = 100 * MiB;
constexpr size_t WS_PROJ = 164 * MiB, WS_MIX = 308 * MiB;
constexpr size_t WS_H = 164 * MiB;
constexpr size_t WS_END = 372 * MiB;
static_assert(WS_H + (size_t)M * DFF * 2 <= WS_END && WS_MIX + (size_t)M * D * 2 <= WS_END && WS_PROJ + (size_t)M * INC * 2 <= WS_MIX, "ws map");
constexpr int RING_BYTES = 131072, LDS_BYTES = 147456;

#define LAS __attribute__((address_space(3)))
typedef unsigned short bf16;
typedef unsigned v4u __attribute__((ext_vector_type(4)));
typedef float f32x4 __attribute__((ext_vector_type(4)));
__device__ __forceinline__ unsigned pk2(float lo, float hi) { return pg8::cvt_pk_bf16(lo, hi); }
__device__ __forceinline__ float wave_sum(float v) {
#pragma unroll
    for (int o = 1; o < 64; o <<= 1) v += __shfl_xor(v, o);
    return v;
}
__device__ __forceinline__ void transpose_item(const float* __restrict__ W, int K, int N, bf16* __restrict__ WT, int dst_row0, const float* __restrict__ kscale, float cscale, LAS float* scr, int k0, int n0, int lane) {
    f32x4 v[16];
    const float* src = W + (size_t)(k0 + (lane >> 4)) * N + n0 + 4 * (lane & 15);
#pragma unroll
    for (int i = 0; i < 16; ++i) v[i] = __builtin_nontemporal_load((const f32x4*)(src + (size_t)(4 * i) * N));
#pragma unroll
    for (int i = 0; i < 16; ++i) { const int kk = 4 * i + (lane >> 4); float sc = cscale; if (kscale) sc *= kscale[k0 + kk];
        LAS float* d = scr + kk * 65 + 4 * (lane & 15); d[0] = v[i].x * sc; d[1] = v[i].y * sc; d[2] = v[i].z * sc; d[3] = v[i].w * sc; }
    asm volatile("s_waitcnt lgkmcnt(0)" ::: "memory");
    const int c = lane & 7;
#pragma unroll
    for (int j = 0; j < 8; ++j) { const int n = (lane >> 3) + 8 * j; const LAS float* s = scr + (8 * c) * 65 + n;
        v4u o; o.x = pk2(s[0 * 65], s[1 * 65]); o.y = pk2(s[2 * 65], s[3 * 65]); o.z = pk2(s[4 * 65], s[5 * 65]); o.w = pk2(s[6 * 65], s[7 * 65]);
        *(v4u*)(WT + (size_t)(dst_row0 + n) * K + k0 + 8 * c) = o; }
    asm volatile("s_waitcnt lgkmcnt(0)" ::: "memory");
}

struct TwiceOrder { pg8::StaticOrder S; __device__ bool next(int i, pg8::Unit& u) const { return S.next(i >> 1, u); } __device__ __forceinline__ void a_ready(const pg8::Unit&) const {} __device__ __forceinline__ void done(const pg8::Unit&) const {} };
struct Args { const float* in[15]; float* out; unsigned char* ws; int ph_lo, ph_hi; };
enum { I_X = 0, I_ANW, I_WIN, I_LQ1, I_LK1, I_LQ2, I_LK2, I_SUBLN, I_SINKS, I_WOUT, I_FNW, I_WG, I_WU, I_WD, I_FINW };

#ifndef CV_SPLIT
#define CV_SPLIT 0
#endif
constexpr int CV_IN = (D / 64) * (INC / 64), CV_OUT = (D / 64) * (D / 64), CV_G = (D / 64) * (DFF / 64), CV_DN = (DFF / 64) * (D / 64), CV_ALL = CV_IN + CV_OUT + 2 * CV_G + CV_DN, CV_P0_LAST = CV_SPLIT ? CV_IN : CV_ALL;
__device__ __forceinline__ void convert_weights(const Args& args, unsigned char* ws, LAS float* scr, int first, int last, int widx, int nw, int lane) {
    bf16* Win_t = (bf16*)(ws + WS_WIN); bf16* Wout_t = (bf16*)(ws + WS_WOUT); bf16* Wgu_t = (bf16*)(ws + WS_WGU); bf16* Wdn_t = (bf16*)(ws + WS_WDN);
    for (int it = first + widx; it < last; it += nw) {
        int r = it;
        if (r < CV_IN) { const int nblk = INC / 64, k0 = 64 * (r / nblk), n0 = 64 * (r % nblk); const float cs = (n0 < 1024 || (n0 >= 3072 && n0 < 4096)) ? QSCALE2 : 1.f;
            transpose_item(args.in[I_WIN], D, INC, Win_t, n0, nullptr, cs, scr, k0, n0, lane); continue; } r -= CV_IN;
        if (r < CV_OUT) { const int nblk = D / 64, k0 = 64 * (r / nblk), n0 = 64 * (r % nblk); transpose_item(args.in[I_WOUT], D, D, Wout_t, n0, nullptr, 1.f, scr, k0, n0, lane); continue; } r -= CV_OUT;
        if (r < 2 * CV_G) { const int up = r >= CV_G; if (up) r -= CV_G; const int nblk = DFF / 64, k0 = 64 * (r / nblk), n0 = 64 * (r % nblk);
            transpose_item(args.in[up ? I_WU : I_WG], D, DFF, Wgu_t, 256 * (n0 / 128) + 128 * up + (n0 % 128), args.in[I_FNW], 1.f, scr, k0, n0, lane); continue; } r -= 2 * CV_G;
        { const int nblk = D / 64, k0 = 64 * (r / nblk), n0 = 64 * (r % nblk); transpose_item(args.in[I_WD], DFF, D, Wdn_t, n0, nullptr, 1.f, scr, k0, n0, lane); }
    }
}

__global__ void __launch_bounds__(NWAVES * 64, 2) hymba_fwd(Args args) {
    extern __shared__ __attribute__((aligned(16))) unsigned char lds_raw[];
    cg::grid_group grid = cg::this_grid();
    LAS unsigned char* lds = (LAS unsigned char*)lds_raw;
    const int tid = threadIdx.x, lane = tid & 63, wave = __builtin_amdgcn_readfirstlane(tid >> 6);
    const int G = gridDim.x, bx = blockIdx.x, vcu = (G % 8 == 0) ? (bx % 8) * (G / 8) + bx / 8 : bx;
    unsigned char* ws = args.ws;
    const float* x = args.in[I_X]; float* out = args.out;
    bf16* Win_t = (bf16*)(ws + WS_WIN); bf16* Wout_t = (bf16*)(ws + WS_WOUT); bf16* Wgu_t = (bf16*)(ws + WS_WGU); bf16* Wdn_t = (bf16*)(ws + WS_WDN);
    bf16* XN = (bf16*)(ws + WS_XN); bf16* PROJ = (bf16*)(ws + WS_PROJ); bf16* MIX = (bf16*)(ws + WS_MIX); bf16* HB = (bf16*)(ws + WS_H);
    float* part1 = (float*)(ws + WS_PART1); float* part2 = (float*)(ws + WS_PART2);
    const int lo = args.ph_lo, hi = args.ph_hi;
#define IN(k) (lo <= (k) && (k) < hi)
#define SEAM(k) do { if (IN(k) && IN((k) + 1)) grid.sync(); } while (0)
#ifndef PROBE_PHASE
#define PROBE_PHASE -1
#endif
#define REP(k) for (int rep_ = 0; rep_ < ((PROBE_PHASE == (k)) ? 2 : 1); ++rep_, ((PROBE_PHASE == (k)) && rep_ < 2 ? (grid.sync(), 0) : 0))

    REP(0) if (IN(0)) {
        LAS float* scr = (LAS float*)(lds + wave * 16640);
        const int gw = vcu * NWAVES + wave, NGW = G * NWAVES;
#if defined(P0_TOUCH) && P0_TOUCH
        {
            const int widx[5] = {I_WIN, I_WOUT, I_WG, I_WU, I_WD}; const size_t wn4[5] = {(size_t)D * INC / 4, (size_t)D * D / 4, (size_t)D * DFF / 4, (size_t)D * DFF / 4, (size_t)DFF * D / 4};
            f32x4 acc4 = {0.f, 0.f, 0.f, 0.f};
#pragma unroll
            for (int w = 0; w < 5; ++w) { const f32x4* src = (const f32x4*)args.in[widx[w]];
                for (size_t i = (size_t)gw * 64 + lane; i < wn4[w]; i += (size_t)NGW * 64 * 4) {
                    f32x4 a = src[i], b = (i + (size_t)NGW * 64 < wn4[w]) ? src[i + (size_t)NGW * 64] : acc4, c = (i + (size_t)NGW * 128 < wn4[w]) ? src[i + (size_t)NGW * 128] : acc4, d = (i + (size_t)NGW * 192 < wn4[w]) ? src[i + (size_t)NGW * 192] : acc4;
                    acc4 = acc4 + a + b + c + d; } }
            if (acc4.x + acc4.y + acc4.z + acc4.w == 1.2345e38f) ((float*)(ws + WS_PART2))[gw * 64 + lane] = acc4.x;
        }
#endif
        convert_weights(args, ws, scr, 0, CV_P0_LAST, gw, NGW, lane);
        const f32x4* wn = (const f32x4*)args.in[I_ANW] + lane;
        for (int rp_ = 0; rp_ < (PROBE_PHASE == 11 ? 2 : 1); ++rp_)
        for (int m = gw; m < M; m += NGW) {
            const f32x4* xr = (const f32x4*)(x + (size_t)m * D) + lane;
            f32x4 v[8]; float s = 0.f;
#pragma unroll
            for (int j = 0; j < 8; ++j) { v[j] = xr[64 * j]; s += (v[j].x * v[j].x + v[j].y * v[j].y) + (v[j].z * v[j].z + v[j].w * v[j].w); }
            const float rstd = rsqrtf(wave_sum(s) * (1.f / D) + RMS_EPS);
            unsigned long long* o8 = (unsigned long long*)(XN + (size_t)m * D) + lane;
#pragma unroll
            for (int j = 0; j < 8; ++j) { const f32x4 w = wn[64 * j]; o8[64 * j] = (unsigned long long)pk2(v[j].x * rstd * w.x, v[j].y * rstd * w.y) | ((unsigned long long)pk2(v[j].z * rstd * w.z, v[j].w * rstd * w.w) << 32); }
        }
        __syncthreads();
    }
    SEAM(0);
    REP(1) if (IN(1)) {
        pg8::Gemm g{XN, Win_t, M, INC, D}; pg8::StaticOrder S; S.init(M, INC, G, bx);
        pg8::EpiStore E{PROJ, INC};
#if PROBE_PHASE == 21
        { TwiceOrder S2{S}; pg8::gemm_phase<pg8::EpiStore, TwiceOrder, true, true>(lds, g, S2, E); }
#else
        pg8::gemm_phase<pg8::EpiStore, pg8::StaticOrder, true, true>(lds, g, S, E);
#endif
        { const int nwg = (M / 256) * (INC / 256), maxU = (nwg + G - 1) / G; int nIdle = G * maxU - nwg, idx = bx - (G - nIdle); if (nIdle == 0) { nIdle = G; idx = bx; }
          if (idx >= 0 && CV_P0_LAST < CV_ALL) convert_weights(args, ws, (LAS float*)(lds + wave * 16640), CV_P0_LAST, CV_ALL, idx * NWAVES + wave, nIdle * NWAVES, lane); }
        __syncthreads();
    }
    SEAM(1);
    REP(2) if (IN(2)) {
        const float* lq1 = args.in[I_LQ1]; const float* lk1 = args.in[I_LK1]; const float* lq2 = args.in[I_LQ2]; const float* lk2 = args.in[I_LK2];
        const float s1 = wave_sum(lq1[lane] * lk1[lane]), s2 = wave_sum(lq2[lane] * lk2[lane]);
        const float lam = expf(s1) - expf(s2) + 0.2f;
        const int wq = wave & 3, gsel = wave >> 2;
        for (int i = vcu; i < 512; i += G) {
            const int bh = i >> 3, xq = i & 7, b = bh >> 3, h = bh & 7;
#pragma unroll 1
            for (int k = 0; k < 2; ++k) {
                const int qblk = k ? 15 - xq : xq;
                att::UnitP up; up.b = b; up.q0 = 128 * qblk; up.qcol = h * 128 + gsel * 64; up.kcol = 1024 + h * 128; up.vcol = 2048 + h * 128; up.kofs = gsel * 128;
                up.slope2 = exp2f(-(float)(h + 1)) * 1.4426950408889634f; up.m_init = -1e30f; up.l_init = 0.f;
                up.T0 = 0; up.T1 = 2 * qblk + 1; up.tlo = 0; up.thi = (up.q0 + 32 * wq) >> 6; up.window = 1 << 20; up.maskall = 0; up.ocol = h * 128;
                att::attn_unit<128, 128>((LAS char*)lds, PROJ, MIX, up, true, lam, args.in[I_SUBLN], tid);
            }
        }
        for (int i = vcu; i < 1024; i += G) {
            const int qblk = i & 15, pair = (i >> 4) & 1, hkv = (i >> 5) & 3, b = i >> 7, hq = hkv * 4 + pair * 2 + gsel, a = 2 * qblk;
            att::UnitP up; up.b = b; up.q0 = 128 * qblk; up.qcol = 3072 + hq * 64; up.kcol = 4096 + hkv * 64; up.vcol = 4352 + hkv * 64; up.kofs = 0;
            up.slope2 = exp2f(-0.5f * (float)(hq + 1)) * 1.4426950408889634f; up.m_init = args.in[I_SINKS][hq] * 1.4426950408889634f; up.l_init = 1.f;
            up.T0 = a - 2 < 0 ? 0 : a - 2; up.T1 = a + 1; up.tlo = a - 2 + (wq >> 1); up.thi = a + (wq >> 1); up.window = 128; up.maskall = 1; up.ocol = 1024 + hq * 64;
            att::attn_unit<64, 64>((LAS char*)lds, PROJ, MIX, up, false, 0.f, nullptr, tid);
        }
        __syncthreads();
    }
    SEAM(2);
    REP(3) if (IN(3)) {
        pg8::Gemm g{MIX, Wout_t, M, D, D}; pg8::StaticOrder S; S.init(M, D, G, bx);
        pg8::EpiResid<false> E{x, XN, part1, D};
        pg8::gemm_phase<pg8::EpiResid<false>, pg8::StaticOrder, true, true>(lds, g, S, E);
    }
    SEAM(3);
    REP(4) if (IN(4)) {
        pg8::Gemm g{XN, Wgu_t, M, NGU, D}; pg8::StaticOrder S; S.init(M, NGU, G, bx);
        pg8::EpiSwiGLU E{HB, DFF, part1, 1.f / D, RMS_EPS};
#if PROBE_PHASE == 24
        { TwiceOrder S2{S}; pg8::gemm_phase<pg8::EpiSwiGLU, TwiceOrder, true, true>(lds, g, S2, E); }
#else
        pg8::gemm_phase<pg8::EpiSwiGLU, pg8::StaticOrder, true, true>(lds, g, S, E);
#endif
    }
    SEAM(4);
    REP(5) if (IN(5)) {
        pg8::Gemm g{HB, Wdn_t, M, D, DFF}; pg8::StaticOrder S; S.init(M, D, G, bx);
        pg8::EpiResid<true> E{XN, XN, part2, D};
        pg8::gemm_phase<pg8::EpiResid<true>, pg8::StaticOrder, true, true>(lds, g, S, E);
    }
    SEAM(5);
    REP(6) if (IN(6)) {
        const int gw = vcu * NWAVES + wave, NGW = G * NWAVES;
        const f32x4* wn = (const f32x4*)args.in[I_FINW] + 2 * lane;
        for (int m = gw; m < M; m += NGW) {
            const float s = wave_sum(lane < 32 ? part2[(size_t)m * 32 + lane] : 0.f);
            const float rstd = rsqrtf(s * (1.f / D) + RMS_EPS);
            const v4u* xr = (const v4u*)(XN + (size_t)m * D) + lane; f32x4* orow = (f32x4*)(out + (size_t)m * D) + 2 * lane;
#pragma unroll
            for (int j = 0; j < 4; ++j) { const v4u w = xr[64 * j]; const f32x4 w0 = wn[128 * j], w1 = wn[128 * j + 1];
                const f32x4 a = {__uint_as_float(w.x << 16), __uint_as_float(w.x & 0xffff0000u), __uint_as_float(w.y << 16), __uint_as_float(w.y & 0xffff0000u)};
                const f32x4 b = {__uint_as_float(w.z << 16), __uint_as_float(w.z & 0xffff0000u), __uint_as_float(w.w << 16), __uint_as_float(w.w & 0xffff0000u)};
                __builtin_nontemporal_store(a * rstd * w0, orow + 128 * j); __builtin_nontemporal_store(b * rstd * w1, orow + 128 * j + 1); }
        }
    }
#undef IN
#undef SEAM
}

extern "C" void kernel_launch(void* const* d_in, const int* in_sizes, int n_in, void* d_out, int out_size, void* d_ws, size_t ws_size, hipStream_t stream) {
    static int grid = 0;
    if (grid == 0) {
        if (n_in != 15 || out_size != M * D || ws_size < WS_END) { fprintf(stderr, "kernel_launch: unexpected shapes (n_in %d out %d ws %zu)\n", n_in, out_size, ws_size); grid = -1; return; }
        int dev = 0, cus = 0, per_cu = 0;
        hipGetDevice(&dev); hipDeviceGetAttribute(&cus, hipDeviceAttributeMultiprocessorCount, dev);
        if (hipFuncSetAttribute((const void*)hymba_fwd, hipFuncAttributeMaxDynamicSharedMemorySize, LDS_BYTES) != hipSuccess) { fprintf(stderr, "kernel_launch: hipFuncSetAttribute failed\n"); grid = -1; return; }
        if (hipOccupancyMaxActiveBlocksPerMultiprocessor(&per_cu, (const void*)hymba_fwd, NWAVES * 64, LDS_BYTES) != hipSuccess || per_cu < 1) { fprintf(stderr, "kernel_launch: occupancy query says %d\n", per_cu); per_cu = 1; }
        (void)hipGetLastError();
        grid = cus * 1;
        fprintf(stderr, "kernel_launch: grid %d (cus %d, per_cu %d)\n", grid, cus, per_cu);
    }
    if (grid < 0) return;
    Args a{};
    for (int i = 0; i < 15; ++i) a.in[i] = (const float*)d_in[i];
    a.out = (float*)d_out; a.ws = (unsigned char*)d_ws;
#if MK_N_LAUNCHES == 1
    a.ph_lo = 0; a.ph_hi = N_PHASES;
    void* kargs[] = {&a};
    hipError_t e = hipLaunchCooperativeKernel((const void*)hymba_fwd, dim3(grid), dim3(NWAVES * 64), kargs, LDS_BYTES, stream);
    if (e != hipSuccess) fprintf(stderr, "kernel_launch: cooperative launch failed: %s\n", hipGetErrorString(e));
#else
    for (int p = 0; p < N_PHASES; ++p) { a.ph_lo = p; a.ph_hi = p + 1; hipLaunchKernelGGL(hymba_fwd, dim3(grid), dim3(NWAVES * 64), LDS_BYTES, stream, a); }
#endif
}
```

```cpp
#include <hip/hip_runtime.h>
#include <hip/hip_cooperative_groups.h>
#include <hip/hip_bf16.h>
#include <cstdio>
#include <cstdint>
#include <cmath>
namespace cg = cooperative_groups;
#define MK_N_LAUNCHES 1
namespace pg8 {
#define PG8_LAS __attribute__((address_space(3)))
typedef unsigned short bf16_t;
typedef short bf16x8 __attribute__((ext_vector_type(8)));
typedef float f32x4 __attribute__((ext_vector_type(4)));
typedef unsigned u32x4 __attribute__((ext_vector_type(4)));
constexpr int BM = 256, BK = 64, HALF = 128, HTB = HALF * BK * 2  , STAGE_BYTES = 8 * HTB, NXCD = 8, WGM = 8;

__host__ __device__ __forceinline__ int lds_byte(int r, int c) { const int st = (r >> 4) * 2 + (c >> 5), rr = r & 15, cc = c & 31, ob = rr * 64 + cc * 2; return st * 1024 + (ob ^ (((ob >> 9) & 1) << 5)); }
__host__ __device__ __forceinline__ void stage_rc(int b, int& R, int& C) { const int st = b / 1024, sb = b % 1024, swz = sb ^ (((sb >> 9) & 1) << 5); R = (st >> 1) * 16 + swz / 64; C = (st & 1) * 32 + (swz % 64) / 2; }
__host__ __device__ __forceinline__ int perm32(int rho) { const int n = rho >> 4, i = rho & 15; return 8 * (i >> 2) + 4 * n + (i & 3); }

struct Unit { int pm, pn; };
struct Gemm { const bf16_t* A; const bf16_t* Bt; int M, N, K; };

struct StaticOrder {
    int nM, nN, nwg, G, c;
    __host__ __device__ void init(int M, int N, int G_, int c_) { nM = M / BM; nN = N / BM; nwg = nM * nN; G = G_; c = c_; }
    __host__ __device__ bool next(int i, Unit& u) const {
        const long L = (long)i * G + c; if (L >= nwg) return false;
        int wgid = (int)L; { const int q = nwg / NXCD, r = nwg % NXCD, xcd = wgid % NXCD, off = wgid / NXCD; wgid = (xcd < r ? xcd * (q + 1) : r * (q + 1) + (xcd - r) * q) + off; }
        const int nig = WGM * nN, gid = wgid / nig, fm = gid * WGM, gsz = (nM - fm) < WGM ? (nM - fm) : WGM;
        u.pm = fm + ((wgid % nig) % gsz); u.pn = (wgid % nig) / gsz; return true;
    }
    __device__ __forceinline__ void a_ready(const Unit&) const {}
    __device__ __forceinline__ void done(const Unit&) const {}
};

__device__ __forceinline__ unsigned cvt_pk_bf16(float lo, float hi) { typedef float f2_t __attribute__((ext_vector_type(2))); typedef __bf16 b2_t __attribute__((ext_vector_type(2))); f2_t v = {lo, hi}; b2_t b = __builtin_convertvector(v, b2_t); return __builtin_bit_cast(unsigned, b); }
typedef unsigned u32x2 __attribute__((ext_vector_type(2)));
struct EpiStore {
    static constexpr bool PERM = true, AFTER_DRAIN = false;
    bf16_t* O; int ldc;
    __device__ __forceinline__ void operator()(const f32x4 (&acc)[2][2][4][2], const Unit& u, int wr, int wc, int fr, int fq) const {
        const int row0 = u.pm * BM + wr * 64 + fr, col0 = u.pn * BM + wc * 32 + 8 * fq;
#pragma unroll
        for (int ai = 0; ai < 2; ++ai)
#pragma unroll
            for (int m = 0; m < 4; ++m) { bf16_t* rowp = O + (size_t)(row0 + ai * HALF + m * 16) * ldc + col0;
#pragma unroll
                for (int bj = 0; bj < 2; ++bj) { const f32x4 v0 = acc[ai][bj][m][0], v1 = acc[ai][bj][m][1];
                    u32x4 w; w.x = cvt_pk_bf16(v0[0], v0[1]); w.y = cvt_pk_bf16(v0[2], v0[3]); w.z = cvt_pk_bf16(v1[0], v1[1]); w.w = cvt_pk_bf16(v1[2], v1[3]);
                    *(u32x4*)(rowp + bj * HALF) = w; } }
    }
};
template <bool BASE_BF16> struct EpiResid {
    static constexpr bool PERM = true, AFTER_DRAIN = false;
    const void* base; bf16_t* xo; float* part; int ldc;
    __device__ __forceinline__ void operator()(const f32x4 (&acc)[2][2][4][2], const Unit& u, int wr, int wc, int fr, int fq) const {
        const int row0 = u.pm * BM + wr * 64 + fr, col0 = u.pn * BM + wc * 32 + 8 * fq;
#pragma unroll
        for (int ai = 0; ai < 2; ++ai)
#pragma unroll
            for (int m = 0; m < 4; ++m) { const int r = row0 + ai * HALF + m * 16; const size_t off = (size_t)r * ldc + col0; float ss = 0.f;
#pragma unroll
                for (int bj = 0; bj < 2; ++bj) { f32x4 b0, b1;
                    if (BASE_BF16) { const u32x4 w = *(const u32x4*)((const bf16_t*)base + off + bj * HALF);
                        b0 = (f32x4){__uint_as_float(w.x << 16), __uint_as_float(w.x & 0xffff0000u), __uint_as_float(w.y << 16), __uint_as_float(w.y & 0xffff0000u)};
                        b1 = (f32x4){__uint_as_float(w.z << 16), __uint_as_float(w.z & 0xffff0000u), __uint_as_float(w.w << 16), __uint_as_float(w.w & 0xffff0000u)}; }
                    else { const float* bp = (const float*)base + off + bj * HALF; b0 = *(const f32x4*)bp; b1 = *(const f32x4*)(bp + 4); }
                    const f32x4 v0 = b0 + acc[ai][bj][m][0], v1 = b1 + acc[ai][bj][m][1];
                    ss += ((v0[0] * v0[0] + v0[1] * v0[1]) + (v0[2] * v0[2] + v0[3] * v0[3])) + ((v1[0] * v1[0] + v1[1] * v1[1]) + (v1[2] * v1[2] + v1[3] * v1[3]));
                    u32x4 w; w.x = cvt_pk_bf16(v0[0], v0[1]); w.y = cvt_pk_bf16(v0[2], v0[3]); w.z = cvt_pk_bf16(v1[0], v1[1]); w.w = cvt_pk_bf16(v1[2], v1[3]);
                    *(u32x4*)(xo + off + bj * HALF) = w; }
                ss += __shfl_xor(ss, 16); ss += __shfl_xor(ss, 32);
                if (fq == 0) part[(size_t)r * 32 + u.pn * 4 + wc] = ss; }
    }
};
struct EpiSwiGLU {
    static constexpr bool PERM = true, AFTER_DRAIN = false;
    bf16_t* H; int ldh; const float* part; float inv_n, eps;
    __device__ __forceinline__ static float silu_mul(float g, float uu) { const float e = __builtin_amdgcn_exp2f(g * -1.4426950408889634f); return g * uu * __builtin_amdgcn_rcpf(1.f + e); }
    __device__ __forceinline__ void operator()(const f32x4 (&acc)[2][2][4][2], const Unit& u, int wr, int wc, int fr, int fq) const {
        const int row0 = u.pm * BM + wr * 64 + fr, col0 = u.pn * HALF + wc * 32 + 8 * fq;
#pragma unroll
        for (int ai = 0; ai < 2; ++ai)
#pragma unroll
            for (int m = 0; m < 4; ++m) { const int r = row0 + ai * HALF + m * 16;
                const f32x4* pp = (const f32x4*)(part + (size_t)r * 32 + fq * 8); const f32x4 pa = pp[0], pb = pp[1];
                float s = ((pa[0] + pa[1]) + (pa[2] + pa[3])) + ((pb[0] + pb[1]) + (pb[2] + pb[3]));
                s += __shfl_xor(s, 16); s += __shfl_xor(s, 32);
                const float rstd = rsqrtf(s * inv_n + eps);
                const f32x4 g0 = acc[ai][0][m][0] * rstd, g1 = acc[ai][0][m][1] * rstd, u0 = acc[ai][1][m][0] * rstd, u1 = acc[ai][1][m][1] * rstd;
                u32x4 w; w.x = cvt_pk_bf16(silu_mul(g0[0], u0[0]), silu_mul(g0[1], u0[1])); w.y = cvt_pk_bf16(silu_mul(g0[2], u0[2]), silu_mul(g0[3], u0[3]));
                w.z = cvt_pk_bf16(silu_mul(g1[0], u1[0]), silu_mul(g1[1], u1[1])); w.w = cvt_pk_bf16(silu_mul(g1[2], u1[2]), silu_mul(g1[3], u1[3]));
                *(u32x4*)(H + (size_t)r * ldh + col0) = w; }
    }
};
template <class Epi, class Sched, bool ALIGN_EPI = false, bool SP2 = false>
__device__ __forceinline__ void gemm_phase(PG8_LAS unsigned char* lds, const Gemm g, const Sched& S, const Epi& E) {
    const int tid = threadIdx.x, wid = __builtin_amdgcn_readfirstlane(tid >> 6), lane = tid & 63, wr = wid >> 2, wc = wid & 3, fr = lane & 15, fq = lane >> 4;
    const int K = g.K, nt = K / BK;
    unsigned voffA[2], voffB[2];
#pragma unroll
    for (int i = 0; i < 2; ++i) { int R, C; stage_rc(tid * 16 + i * 8192, R, C); const int Rb = Epi::PERM ? ((R & ~31) + perm32(R & 31)) : R;
        voffA[i] = (unsigned)(R * K + C) * 2u; voffB[i] = (unsigned)(Rb * K + C) * 2u; }
    const size_t kstep = (size_t)(BK * 2);
    const size_t hstep = (size_t)HALF * K * 2;
    const size_t tstep = 2 * hstep;
    const unsigned ldsw = (unsigned)wid * 1024u;
    const int aoff = lds_byte(wr * 64 + fr, fq * 8), boff = lds_byte(wc * 32 + fr, fq * 8);
#define PG8_SA(b, h) (((b) * 2 + (h)) * HTB)
#define PG8_SB(b, h) ((4 + (b) * 2 + (h)) * HTB)
#define PG8_STAGE(bufoff, gbase, voff) do { _Pragma("unroll") for (int _i = 0; _i < 2; ++_i) \
        __builtin_amdgcn_global_load_lds((const unsigned*)((const char*)(gbase) + (voff)[_i]), (PG8_LAS unsigned*)(lds + (bufoff) + ldsw + _i * 8192), 16, 0, 0); } while (0)
#define PG8_LDA(dst, b, h) do { _Pragma("unroll") for (int m = 0; m < 4; ++m) _Pragma("unroll") for (int k = 0; k < 2; ++k) dst[m][k] = *(const PG8_LAS bf16x8*)(lds + PG8_SA(b, h) + aoff + m * 2048 + k * 1024); } while (0)
#define PG8_LDB(dst, b, h) do { _Pragma("unroll") for (int n = 0; n < 2; ++n) _Pragma("unroll") for (int k = 0; k < 2; ++k) dst[n][k] = *(const PG8_LAS bf16x8*)(lds + PG8_SB(b, h) + boff + n * 2048 + k * 1024); } while (0)
#define PG8_MMA(ai, bj, At, Bt) do { __builtin_amdgcn_s_setprio(1); _Pragma("unroll") for (int m = 0; m < 4; ++m) _Pragma("unroll") for (int n = 0; n < 2; ++n) _Pragma("unroll") for (int k = 0; k < 2; ++k) \
        acc[ai][bj][m][n] = __builtin_amdgcn_mfma_f32_16x16x32_bf16(Bt[n][k], At[m][k], acc[ai][bj][m][n], 0, 0, 0); __builtin_amdgcn_s_setprio(0); } while (0)
#define PG8_WAIT_V(n) asm volatile("s_waitcnt vmcnt(" #n ")" ::: "memory")
#define PG8_WAIT_L(n) asm volatile("s_waitcnt lgkmcnt(" #n ")" ::: "memory")
#define PG8_BAR __builtin_amdgcn_s_barrier()
#define PG8_SCHED __builtin_amdgcn_sched_barrier(0)
    Unit cur, nxt; int ui = 0;
    if (!S.next(0, cur)) return;
    f32x4 acc[2][2][4][2];
#pragma unroll
    for (int a = 0; a < 2; ++a)
#pragma unroll
        for (int b = 0; b < 2; ++b)
#pragma unroll
            for (int m = 0; m < 4; ++m)
#pragma unroll
                for (int n = 0; n < 2; ++n) acc[a][b][m][n] = (f32x4){0.f, 0.f, 0.f, 0.f};
    bf16x8 At[4][2], B0[2][2], B1[2][2];
    const char* cA = (const char*)g.A + (size_t)cur.pm * tstep; const char* cB = (const char*)g.Bt + (size_t)cur.pn * tstep;
    S.a_ready(cur);
    if constexpr (SP2) {
        PG8_STAGE(PG8_SB(0, 0), cB, voffB); PG8_STAGE(PG8_SB(0, 1), cB + hstep, voffB); PG8_STAGE(PG8_SA(0, 0), cA, voffA); PG8_STAGE(PG8_SA(0, 1), cA + hstep, voffA);
        if (wr == 1) PG8_BAR;
        PG8_WAIT_V(2); PG8_BAR;
        PG8_STAGE(PG8_SB(1, 0), cB + kstep, voffB); PG8_STAGE(PG8_SA(1, 0), cA + kstep, voffA); PG8_STAGE(PG8_SB(1, 1), cB + hstep + kstep, voffB);
        PG8_WAIT_V(6); PG8_BAR;
    } else {
        PG8_STAGE(PG8_SB(0, 0), cB, voffB); PG8_STAGE(PG8_SA(0, 0), cA, voffA); PG8_STAGE(PG8_SB(0, 1), cB + hstep, voffB); PG8_STAGE(PG8_SA(0, 1), cA + hstep, voffA);
        if (wr == 1) PG8_BAR;
        PG8_WAIT_V(4); PG8_BAR;
        PG8_STAGE(PG8_SB(1, 0), cB + kstep, voffB); PG8_STAGE(PG8_SA(1, 0), cA + kstep, voffA); PG8_STAGE(PG8_SB(1, 1), cB + hstep + kstep, voffB);
        PG8_WAIT_V(6); PG8_BAR;
    }
    for (;;) {
        const bool has_next = S.next(ui + 1, nxt);
        const char* nA = has_next ? (const char*)g.A + (size_t)nxt.pm * tstep : cA; const char* nB = has_next ? (const char*)g.Bt + (size_t)nxt.pn * tstep : cB;
        for (int t = 0; t < nt; t += 2) {
            const bool last = (t == nt - 2);
            const char* a1 = cA + (size_t)(t + 1) * kstep;
            const char* a2 = last ? nA : cA + (size_t)(t + 2) * kstep; const char* b2 = last ? nB : cB + (size_t)(t + 2) * kstep;
            const char* a3 = a2 + kstep; const char* b3 = b2 + kstep;
            if (last && has_next) S.a_ready(nxt);
            if constexpr (SP2) {
            PG8_LDB(B0, 0, 0); PG8_LDB(B1, 0, 1); PG8_SCHED; PG8_LDA(At, 0, 0); PG8_STAGE(PG8_SA(1, 1), a1 + hstep, voffA);
            PG8_WAIT_V(8); PG8_WAIT_L(0); PG8_BAR; PG8_MMA(0, 0, At, B0); PG8_MMA(0, 1, At, B1); PG8_BAR; PG8_SCHED;
            PG8_LDA(At, 0, 1); PG8_STAGE(PG8_SB(0, 0), b2, voffB); PG8_STAGE(PG8_SB(0, 1), b2 + hstep, voffB); PG8_STAGE(PG8_SA(0, 0), a2, voffA);
            PG8_WAIT_V(8); PG8_WAIT_L(0); PG8_BAR; PG8_MMA(1, 0, At, B0); PG8_MMA(1, 1, At, B1); PG8_BAR; PG8_SCHED;
            PG8_LDB(B0, 1, 0); PG8_LDB(B1, 1, 1); PG8_SCHED; PG8_LDA(At, 1, 0); PG8_STAGE(PG8_SA(0, 1), a2 + hstep, voffA);
            PG8_WAIT_V(8); PG8_WAIT_L(0); PG8_BAR; PG8_MMA(0, 0, At, B0); PG8_MMA(0, 1, At, B1); PG8_BAR; PG8_SCHED;
            PG8_LDA(At, 1, 1); PG8_STAGE(PG8_SB(1, 0), b3, voffB); PG8_STAGE(PG8_SB(1, 1), b3 + hstep, voffB); PG8_STAGE(PG8_SA(1, 0), a3, voffA);
            PG8_WAIT_V(8); PG8_WAIT_L(0); PG8_BAR; PG8_MMA(1, 0, At, B0); PG8_MMA(1, 1, At, B1); PG8_BAR; PG8_SCHED;
            } else {
            PG8_LDB(B0, 0, 0); PG8_SCHED; PG8_LDA(At, 0, 0); PG8_STAGE(PG8_SA(1, 1), a1 + hstep, voffA);
            PG8_WAIT_L(8); PG8_BAR; PG8_WAIT_L(0); PG8_MMA(0, 0, At, B0); PG8_BAR; PG8_SCHED;
            PG8_LDB(B1, 0, 1); PG8_STAGE(PG8_SB(0, 0), b2, voffB);
            PG8_BAR; PG8_WAIT_L(0); PG8_MMA(0, 1, At, B1); PG8_BAR;
            PG8_LDA(At, 0, 1); PG8_STAGE(PG8_SA(0, 0), a2, voffA);
            PG8_BAR; PG8_WAIT_L(0); PG8_MMA(1, 0, At, B0); PG8_BAR; PG8_SCHED;
            PG8_STAGE(PG8_SB(0, 1), b2 + hstep, voffB);
            PG8_WAIT_V(6); PG8_BAR; PG8_MMA(1, 1, At, B1); PG8_BAR;
            PG8_LDB(B0, 1, 0); PG8_SCHED; PG8_LDA(At, 1, 0); PG8_STAGE(PG8_SA(0, 1), a2 + hstep, voffA);
            PG8_WAIT_L(8); PG8_BAR; PG8_WAIT_L(0); PG8_MMA(0, 0, At, B0); PG8_BAR; PG8_SCHED;
            PG8_LDB(B1, 1, 1); PG8_STAGE(PG8_SB(1, 0), b3, voffB);
            PG8_BAR; PG8_WAIT_L(0); PG8_MMA(0, 1, At, B1); PG8_BAR;
            PG8_LDA(At, 1, 1); PG8_STAGE(PG8_SA(1, 0), a3, voffA);
            PG8_BAR; PG8_WAIT_L(0); PG8_MMA(1, 0, At, B0); PG8_BAR; PG8_SCHED;
            PG8_STAGE(PG8_SB(1, 1), b3 + hstep, voffB);
            PG8_WAIT_V(6); PG8_BAR; PG8_MMA(1, 1, At, B1); PG8_BAR;
            }
        }
        if constexpr (ALIGN_EPI) { if (wr == 0) PG8_BAR; }
        if constexpr (!Epi::AFTER_DRAIN) { E(acc, cur, wr, wc, fr, fq); S.done(cur); }
        if (!has_next) break;
#pragma unroll
        for (int a = 0; a < 2; ++a)
#pragma unroll
            for (int b = 0; b < 2; ++b)
#pragma unroll
                for (int m = 0; m < 4; ++m)
#pragma unroll
                    for (int n = 0; n < 2; ++n) acc[a][b][m][n] = (f32x4){0.f, 0.f, 0.f, 0.f};
        cur = nxt; cA = nA; cB = nB; ++ui;
        if constexpr (ALIGN_EPI) { if (wr == 1) PG8_BAR; }
    }
    PG8_WAIT_V(0);
    if constexpr (!ALIGN_EPI) { if (wr == 0) PG8_BAR; }
    PG8_BAR;
    if constexpr (Epi::AFTER_DRAIN) { E.fused(acc, cur, wr, wc, fr, fq, lds, wid, lane); S.done(cur); }
#undef PG8_SA
#undef PG8_SB
#undef PG8_STAGE
#undef PG8_LDA
#undef PG8_LDB
#undef PG8_MMA
#undef PG8_WAIT_V
#undef PG8_WAIT_L
#undef PG8_BAR
#undef PG8_SCHED
}
}
namespace att {
#define ATT_LAS __attribute__((address_space(3)))
typedef unsigned short bf16_t;
typedef short bf16x8 __attribute__((ext_vector_type(8)));
typedef short s16x4 __attribute__((ext_vector_type(4)));
typedef float f32x16 __attribute__((ext_vector_type(16)));
typedef float f32x4 __attribute__((ext_vector_type(4)));
typedef unsigned u32x4 __attribute__((ext_vector_type(4)));
typedef unsigned u32x2 __attribute__((ext_vector_type(2)));
constexpr int SEQ = 2048, PITCH = 4608, OPITCH = 2048;
__device__ __forceinline__ unsigned cvtpk(float lo, float hi) { typedef float f2_t __attribute__((ext_vector_type(2))); typedef __bf16 b2_t __attribute__((ext_vector_type(2))); f2_t v = {lo, hi}; b2_t b = __builtin_convertvector(v, b2_t); return __builtin_bit_cast(unsigned, b); }
__device__ __forceinline__ float swapmax(float m) { auto rr = __builtin_amdgcn_permlane32_swap(__float_as_uint(m), __float_as_uint(m), false, false); return fmaxf(__uint_as_float(rr[0]), __uint_as_float(rr[1])); }
__device__ __forceinline__ float swapsum(float m) { auto rr = __builtin_amdgcn_permlane32_swap(__float_as_uint(m), __float_as_uint(m), false, false); return __uint_as_float(rr[0]) + __uint_as_float(rr[1]); }
__device__ __forceinline__ s16x4 vtr(ATT_LAS const char* p) { return __builtin_bit_cast(s16x4, __builtin_amdgcn_ds_read_tr16_b64_v4i16((ATT_LAS s16x4*)p)); }

struct UnitP {
    int b, q0;
    int qcol, kcol, vcol;
    int kofs;
    float slope2;
    float m_init, l_init;
    int T0, T1;
    int tlo, thi;
    int window;
    int maskall;
    int ocol;
};

template <int DV, int KW>
__device__ __forceinline__ void attn_unit(ATT_LAS char* lds, const bf16_t* __restrict__ P, bf16_t* __restrict__ MIX, const UnitP up, bool diff, float lam, const float* __restrict__ subln_w, int tid) {
    static_assert(KW == DV && (KW == 128 || KW == 64), "tile geometry");
    constexpr int ROWB = KW * 2, CPR = ROWB / 16, RPP = 1024 / ROWB, NP = 64 / RPP / 8, TILEB = 64 * ROWB, STG = 2 * TILEB, NSTG = 4, NEB = DV / 32, NI = 2 * NP;
    constexpr bool WIDE = (KW == 128);
    const int lane = tid & 63, wid = __builtin_amdgcn_readfirstlane(tid >> 6), r32 = lane & 31, hi = lane >> 5, wq = wid & 3, g = wid >> 2;
    const int qw = up.q0 + 32 * wq, q = qw + r32;
    const size_t rowbase = (size_t)up.b * SEQ;
    __syncthreads();
    unsigned kso[NP], vso[NP];
#pragma unroll
    for (int i = 0; i < NP; ++i) { const int piece = wid + 8 * i, row = RPP * piece + lane / CPR, slot = lane % CPR;
        const int kch = WIDE ? (slot ^ (row & 15)) : (slot ^ ((row >> 1) & 7));
        const int vch = ((((slot >> 2) ^ (WIDE ? (row & 3) : ((row >> 1) & 1))) << 2) | (slot & 3));
        kso[i] = (unsigned)(row * PITCH + up.kcol + kch * 8); vso[i] = (unsigned)(row * PITCH + up.vcol + vch * 8); }
    const bf16_t* Pb = P + rowbase * PITCH;
#define ATT_DMA(t, sg) do { const bf16_t* tb_ = Pb + (size_t)(t) * 64 * PITCH; \
    _Pragma("unroll") for (int i_ = 0; i_ < NP; ++i_) { \
        __builtin_amdgcn_global_load_lds((const unsigned*)(tb_ + kso[i_]), (ATT_LAS unsigned*)(lds + (sg) * STG + (wid + 8 * i_) * 1024), 16, 0, 0); \
        __builtin_amdgcn_global_load_lds((const unsigned*)(tb_ + vso[i_]), (ATT_LAS unsigned*)(lds + (sg) * STG + TILEB + (wid + 8 * i_) * 1024), 16, 0, 0); } } while (0)
    bf16x8 qr[4];
    { const bf16_t* qp = P + (rowbase + q) * PITCH + up.qcol + hi * 8;
#pragma unroll
      for (int d0 = 0; d0 < 4; ++d0) qr[d0] = *(const bf16x8*)(qp + d0 * 16); }
#pragma unroll
    for (int j = 0; j < 2; ++j) if (up.T0 + j <= up.T1) ATT_DMA(up.T0 + j, j);
    f32x16 o[NEB];
#pragma unroll
    for (int e = 0; e < NEB; ++e)
#pragma unroll
        for (int r = 0; r < 16; ++r) o[e][r] = 0.f;
    float mhat = up.l_init != 0.f ? up.m_init + up.slope2 * (float)q : 0.f, l = hi == 0 ? up.l_init : 0.f;
    float cb[16];
#pragma unroll
    for (int r = 0; r < 16; ++r) cb[r] = up.slope2 * (float)((r & 3) + 8 * (r >> 2));
    int kad[4];
#pragma unroll
    for (int d0 = 0; d0 < 4; ++d0) { const int c = (up.kofs >> 4) + 2 * d0 + hi; kad[d0] = r32 * ROWB + ((WIDE ? (c ^ (r32 & 15)) : (c ^ ((r32 >> 1) & 7))) << 4); }
    const int i16 = lane & 15, q4 = i16 >> 2, vsw = WIDE ? q4 : (q4 >> 1);
    const int vlane = TILEB + (4 * hi + q4) * ROWB + 32 * ((lane >> 4) & 1) + 8 * (i16 & 3);
    int vad[NEB];
#pragma unroll
    for (int e = 0; e < NEB; ++e) vad[e] = vlane + ((e ^ vsw) << 6);
    bf16x8 pa[4];
#define ATT_PV(sgi) do { ATT_LAS const char* Sv_ = lds + (sgi) * STG; \
    _Pragma("unroll") for (int e = 0; e < NEB; ++e) _Pragma("unroll") for (int ks = 0; ks < 4; ++ks) { \
        const s16x4 lo = vtr(Sv_ + vad[e] + ks * 16 * ROWB), hh = vtr(Sv_ + vad[e] + ks * 16 * ROWB + 8 * ROWB); \
        const bf16x8 vf = {lo[0], lo[1], lo[2], lo[3], hh[0], hh[1], hh[2], hh[3]}; \
        o[e] = __builtin_amdgcn_mfma_f32_32x32x16_bf16(vf, pa[ks], o[e], 0, 0, 0); } } while (0)
    for (int t = up.T0; t <= up.T1 + 1; ++t) {
        const int sg = (t - up.T0) & (NSTG - 1);
        if (t + 1 <= up.T1) { if (NI == 4) asm volatile("s_waitcnt vmcnt(4) lgkmcnt(0)" ::: "memory"); else asm volatile("s_waitcnt vmcnt(2) lgkmcnt(0)" ::: "memory"); }
        else asm volatile("s_waitcnt vmcnt(0) lgkmcnt(0)" ::: "memory");
        __builtin_amdgcn_s_barrier();
        asm volatile("" ::: "memory");
        if (t + 2 <= up.T1) ATT_DMA(t + 2, (sg + 2) & (NSTG - 1));
        if (g == 1 && t - 1 >= up.tlo && t - 1 <= up.thi && t - 1 >= up.T0) ATT_PV((sg + NSTG - 1) & (NSTG - 1));
        if (t >= up.tlo && t <= up.thi && t <= up.T1) {
            ATT_LAS const char* Sb = lds + sg * STG;
            f32x16 p0, p1;
            { const float base0 = up.slope2 * (float)(64 * t + 4 * hi) - mhat, base1 = base0 + 32.f * up.slope2;
#pragma unroll
              for (int r = 0; r < 16; ++r) { p0[r] = cb[r] + base0; p1[r] = cb[r] + base1; } }
#pragma unroll
            for (int d0 = 0; d0 < 4; ++d0) {
                const bf16x8 k0 = *(ATT_LAS const bf16x8*)(Sb + kad[d0]), k1 = *(ATT_LAS const bf16x8*)(Sb + kad[d0] + 32 * ROWB);
                p0 = __builtin_amdgcn_mfma_f32_32x32x16_bf16(k0, qr[d0], p0, 0, 0, 0);
                p1 = __builtin_amdgcn_mfma_f32_32x32x16_bf16(k1, qr[d0], p1, 0, 0, 0);
            }
            if (up.maskall || t == up.thi) {
                const int kvb = 64 * t + 4 * hi, qlo = q - up.window;
#pragma unroll
                for (int r = 0; r < 16; ++r) { const int kv = kvb + (r & 3) + 8 * (r >> 2);
                    if (kv > q || kv <= qlo) p0[r] = -INFINITY;
                    if (kv + 32 > q || kv + 32 <= qlo) p1[r] = -INFINITY; }
            }
            float ra = fmaxf(fmaxf(p0[0], p0[1]), p1[0]), rb = fmaxf(fmaxf(p0[2], p0[3]), p1[1]); ra = fmaxf(fmaxf(ra, p1[2]), p1[3]);
#pragma unroll
            for (int r = 4; r < 16; r += 4) { ra = fmaxf(fmaxf(ra, p0[r]), p0[r + 1]); rb = fmaxf(fmaxf(rb, p0[r + 2]), p0[r + 3]); ra = fmaxf(fmaxf(ra, p1[r]), p1[r + 1]); rb = fmaxf(fmaxf(rb, p1[r + 2]), p1[r + 3]); }
            const float rm = swapmax(fmaxf(ra, rb));
            if (__any(rm > 8.f)) {
                const float dl = fmaxf(rm, 0.f), alpha = __builtin_amdgcn_exp2f(-dl);
                mhat += dl; l *= alpha;
#pragma unroll
                for (int r = 0; r < 16; ++r) { p0[r] -= dl; p1[r] -= dl; }
#pragma unroll
                for (int e = 0; e < NEB; ++e)
#pragma unroll
                    for (int r = 0; r < 16; ++r) o[e][r] *= alpha;
            }
            float ps = 0.f;
#pragma unroll
            for (int r = 0; r < 16; ++r) { p0[r] = __builtin_amdgcn_exp2f(p0[r]); p1[r] = __builtin_amdgcn_exp2f(p1[r]); ps += p0[r] + p1[r]; }
            l += ps;
#pragma unroll
            for (int s = 0; s < 2; ++s) {
                u32x4 w0, w1;
                w0.x = cvtpk(p0[8 * s + 0], p0[8 * s + 1]); w0.y = cvtpk(p0[8 * s + 2], p0[8 * s + 3]); w0.z = cvtpk(p0[8 * s + 4], p0[8 * s + 5]); w0.w = cvtpk(p0[8 * s + 6], p0[8 * s + 7]);
                w1.x = cvtpk(p1[8 * s + 0], p1[8 * s + 1]); w1.y = cvtpk(p1[8 * s + 2], p1[8 * s + 3]); w1.z = cvtpk(p1[8 * s + 4], p1[8 * s + 5]); w1.w = cvtpk(p1[8 * s + 6], p1[8 * s + 7]);
                pa[s] = __builtin_bit_cast(bf16x8, w0); pa[2 + s] = __builtin_bit_cast(bf16x8, w1);
            }
            if (g == 0) ATT_PV(sg);
        }
    }
#undef ATT_PV
#undef ATT_DMA
    asm volatile("s_waitcnt vmcnt(0) lgkmcnt(0)" ::: "memory");
    __builtin_amdgcn_s_barrier();
    asm volatile("" ::: "memory");
    const float lt = swapsum(l), inv = 1.f / lt;
    if (!diff) {
        bf16_t* op = MIX + (rowbase + q) * OPITCH + up.ocol + 4 * hi;
#pragma unroll
        for (int e = 0; e < NEB; ++e)
#pragma unroll
            for (int r4 = 0; r4 < 4; ++r4) { u32x2 w; w.x = cvtpk(o[e][4 * r4] * inv, o[e][4 * r4 + 1] * inv); w.y = cvtpk(o[e][4 * r4 + 2] * inv, o[e][4 * r4 + 3] * inv);
                *(u32x2*)(op + e * 32 + 8 * r4) = w; }
    } else {
        ATT_LAS float* xb = (ATT_LAS float*)(lds + wq * (NEB * 16 * 64 * 4)) + lane;
        if (g == 1) { const float sc = lam * inv;
#pragma unroll
            for (int e = 0; e < NEB; ++e)
#pragma unroll
                for (int r = 0; r < 16; ++r) xb[(e * 16 + r) * 64] = o[e][r] * sc; }
        __syncthreads();
        if (g == 0) { float ss = 0.f;
#pragma unroll
            for (int e = 0; e < NEB; ++e)
#pragma unroll
                for (int r = 0; r < 16; ++r) { const float d = o[e][r] * inv - xb[(e * 16 + r) * 64]; o[e][r] = d; ss += d * d; }
            ss = swapsum(ss);
            const float rs = rsqrtf(ss * (1.f / DV) + 1e-5f) * 0.8f;
            bf16_t* op = MIX + (rowbase + q) * OPITCH + up.ocol + 4 * hi;
#pragma unroll
            for (int e = 0; e < NEB; ++e)
#pragma unroll
                for (int r4 = 0; r4 < 4; ++r4) { const f32x4 wv = *(const f32x4*)(subln_w + e * 32 + 8 * r4 + 4 * hi);
                    u32x2 w; w.x = cvtpk(o[e][4 * r4] * rs * wv[0], o[e][4 * r4 + 1] * rs * wv[1]); w.y = cvtpk(o[e][4 * r4 + 2] * rs * wv[2], o[e][4 * r4 + 3] * rs * wv[3]);
                    *(u32x2*)(op + e * 32 + 8 * r4) = w; } }
    }
}
}
constexpr int NWAVES = 8;
#ifndef MK_N_LAUNCHES
#define MK_N_LAUNCHES 1
#endif
constexpr int N_PHASES = 7;
constexpr int BATCH = 8, SEQ = 2048, D = 2048, M = BATCH * SEQ, INC = 4608, DFF = 5632, NGU = 2 * DFF;
constexpr float RMS_EPS = 1e-5f;
constexpr float QSCALE2 = 0.125f * 1.4426950408889634f;
constexpr size_t MiB = 1u << 20;
constexpr size_t WS_PART1 = 1 * MiB, WS_PART2 = 3 * MiB;
constexpr size_t WS_WIN = 8 * MiB, WS_WOUT = 26 * MiB, WS_WGU = 34 * MiB, WS_WDN = 78 * MiB;
constexpr size_t WS_XN = 100 * MiB;
constexpr size_t WS_PROJ = 164 * MiB, WS_MIX = 308 * MiB;
constexpr size_t WS_H = 164 * MiB;
constexpr size_t WS_END = 372 * MiB;
static_assert(WS_H + (size_t)M * DFF * 2 <= WS_END && WS_MIX + (size_t)M * D * 2 <= WS_END && WS_PROJ + (size_t)M * INC * 2 <= WS_MIX, "ws map");
constexpr int RING_BYTES = 131072, LDS_BYTES = 147456;

#define LAS __attribute__((address_space(3)))
typedef unsigned short bf16;
typedef unsigned v4u __attribute__((ext_vector_type(4)));
typedef float f32x4 __attribute__((ext_vector_type(4)));
__device__ __forceinline__ unsigned pk2(float lo, float hi) { return pg8::cvt_pk_bf16(lo, hi); }
__device__ __forceinline__ float wave_sum(float v) {
#pragma unroll
    for (int o = 1; o < 64; o <<= 1) v += __shfl_xor(v, o);
    return v;
}
__device__ __forceinline__ void transpose_item(const float* __restrict__ W, int K, int N, bf16* __restrict__ WT, int dst_row0, const float* __restrict__ kscale, float cscale, LAS float* scr, int k0, int n0, int lane) {
    f32x4 v[16];
    const float* src = W + (size_t)(k0 + (lane >> 4)) * N + n0 + 4 * (lane & 15);
#pragma unroll
    for (int i = 0; i < 16; ++i) v[i] = *(const f32x4*)(src + (size_t)(4 * i) * N);
#pragma unroll
    for (int i = 0; i < 16; ++i) { const int kk = 4 * i + (lane >> 4); float sc = cscale; if (kscale) sc *= kscale[k0 + kk];
        LAS float* d = scr + kk * 65 + 4 * (lane & 15); d[0] = v[i].x * sc; d[1] = v[i].y * sc; d[2] = v[i].z * sc; d[3] = v[i].w * sc; }
    asm volatile("s_waitcnt lgkmcnt(0)" ::: "memory");
    const int c = lane & 7;
#pragma unroll
    for (int j = 0; j < 8; ++j) { const int n = (lane >> 3) + 8 * j; const LAS float* s = scr + (8 * c) * 65 + n;
        v4u o; o.x = pk2(s[0 * 65], s[1 * 65]); o.y = pk2(s[2 * 65], s[3 * 65]); o.z = pk2(s[4 * 65], s[5 * 65]); o.w = pk2(s[6 * 65], s[7 * 65]);
        *(v4u*)(WT + (size_t)(dst_row0 + n) * K + k0 + 8 * c) = o; }
    asm volatile("s_waitcnt lgkmcnt(0)" ::: "memory");
}

#define XB_TMO      128
#define XB_XCNT(j)  (256  + 64 * (j))
#define XB_XSUB(j)  (1280 + 64 * (j))
#define XB_XGEN(j)  (2304 + 64 * (j))
#define XB_TOP      3328
#define XB_TOPGEN   3392
#define XCD_BAR_WORDS 3456
#define XB_SPIN_CAP (1u << 18)

__device__ __forceinline__ unsigned xb_ld(unsigned* p)              { return __hip_atomic_load(p, __ATOMIC_RELAXED, __HIP_MEMORY_SCOPE_AGENT); }
__device__ __forceinline__ unsigned xb_add(unsigned* p, unsigned v) { return __hip_atomic_fetch_add(p, v, __ATOMIC_RELAXED, __HIP_MEMORY_SCOPE_AGENT); }
__device__ __forceinline__ unsigned xb_xcc_id() { return (unsigned)__builtin_amdgcn_s_getreg((3 << 11) | 20) & 0xFu; }
#define XB_SPIN(cond, bar) do { unsigned _sp = 0; while (cond) { __builtin_amdgcn_s_sleep(1); \
    if ((++_sp & 255u) == 0u) { if (xb_ld(&(bar)[XB_TMO])) break; if (_sp > XB_SPIN_CAP) { atomicAdd(&(bar)[XB_TMO], 1u); break; } } } } while (0)

struct XcdBarrier {
    unsigned* bar; unsigned x;
    volatile LAS unsigned* st;
};

__device__ __forceinline__ XcdBarrier xcd_barrier_post(unsigned* bar, volatile LAS unsigned* st) {
    XcdBarrier b; b.bar = bar; b.x = xb_xcc_id(); b.st = st;
    if (threadIdx.x == 0) (void)xb_add(&bar[XB_XCNT(b.x)], 1u);
    return b;
}
__device__ __forceinline__ void xcd_barrier_complete(unsigned* bar, unsigned x, unsigned& nloc, unsigned& nx) {
    const unsigned G = gridDim.x * gridDim.y * gridDim.z;
    unsigned sum, cnt, mine, sp = 0u;
    for (;;) {
        sum = 0u; cnt = 0u; mine = 0u;
#pragma unroll
        for (unsigned j = 0; j < 16; ++j) { const unsigned c = xb_ld(&bar[XB_XCNT(j)]); sum += c; cnt += (c > 0u) ? 1u : 0u; mine = (j == x) ? c : mine; }
        if (sum == G) break;
        __builtin_amdgcn_s_sleep(1);
        if ((++sp & 255u) == 0u) { if (xb_ld(&bar[XB_TMO])) break; if (sp > XB_SPIN_CAP) { atomicAdd(&bar[XB_TMO], 1u); break; } }
    }
    nloc = mine > 0u ? mine : 1u; nx = cnt > 0u ? cnt : 1u;
}

__device__ __forceinline__ void xcd_barrier(const XcdBarrier& b) {
    asm volatile("s_waitcnt vmcnt(0)" ::: "memory");
    __syncthreads();
    if (threadIdx.x == 0) {
        unsigned* bar = b.bar;
        __builtin_amdgcn_s_waitcnt(0);
        unsigned nloc = b.st[0], nx = b.st[1];
        if (nloc == 0u) { xcd_barrier_complete(bar, b.x, nloc, nx); b.st[0] = nloc; b.st[1] = nx; }
        const unsigned old = xb_add(&bar[XB_XSUB(b.x)], 1u);
        const unsigned gen = old / nloc;
        if (old + 1u == (gen + 1u) * nloc) {
            __builtin_amdgcn_fence(__ATOMIC_RELEASE, "agent");
            asm volatile("s_waitcnt vmcnt(0)" ::: "memory");
            const unsigned og = xb_add(&bar[XB_TOP], 1u);
            const unsigned tg = og / nx;
            if (og + 1u == (tg + 1u) * nx) xb_add(&bar[XB_TOPGEN], 1u);
            else XB_SPIN(xb_ld(&bar[XB_TOPGEN]) == tg, bar);
            __builtin_amdgcn_fence(__ATOMIC_ACQUIRE, "agent");
            xb_add(&bar[XB_XGEN(b.x)], 1u);
            asm volatile("s_waitcnt vmcnt(0)" ::: "memory");
        } else {
            XB_SPIN(xb_ld(&bar[XB_XGEN(b.x)]) == gen, bar);
            __builtin_amdgcn_fence(__ATOMIC_ACQUIRE, "agent");
            asm volatile("s_waitcnt vmcnt(0)" ::: "memory");
        }
    }
    __syncthreads();
}

struct TwiceOrder { pg8::StaticOrder S; __device__ bool next(int i, pg8::Unit& u) const { return S.next(i >> 1, u); } __device__ __forceinline__ void a_ready(const pg8::Unit&) const {} __device__ __forceinline__ void done(const pg8::Unit&) const {} };
struct Args { const float* in[15]; float* out; unsigned char* ws; int ph_lo, ph_hi; };
enum { I_X = 0, I_ANW, I_WIN, I_LQ1, I_LK1, I_LQ2, I_LK2, I_SUBLN, I_SINKS, I_WOUT, I_FNW, I_WG, I_WU, I_WD, I_FINW };

__device__ __forceinline__ void item_kn(int r, int nblk_n, int& k0, int& n0) { const int g8 = r >> 3, w = r & 7, hn = nblk_n >> 1; n0 = 64 * (2 * (g8 % hn) + (w & 1)); k0 = 64 * (4 * (g8 / hn) + (w >> 1)); }
#ifndef CV_SPLIT
#define CV_SPLIT 0
#endif
constexpr int CV_IN = (D / 64) * (INC / 64), CV_OUT = (D / 64) * (D / 64), CV_G = (D / 64) * (DFF / 64), CV_DN = (DFF / 64) * (D / 64), CV_ALL = CV_IN + CV_OUT + 2 * CV_G + CV_DN, CV_T0 = CV_IN + CV_OUT, CV_T1 = CV_T0 + CV_G;
__device__ __forceinline__ void convert_weights(const Args& args, unsigned char* ws, LAS float* scr, int first, int last, int skip0, int skip1, int widx, int nw, int lane) {
    bf16* Win_t = (bf16*)(ws + WS_WIN); bf16* Wout_t = (bf16*)(ws + WS_WOUT); bf16* Wgu_t = (bf16*)(ws + WS_WGU); bf16* Wdn_t = (bf16*)(ws + WS_WDN);
    for (int it = first + widx; it < last - (skip1 - skip0); it += nw) {
        int r = it; if (r >= skip0) r += skip1 - skip0;
        if (r < CV_IN) { int k0, n0; item_kn(r, INC / 64, k0, n0); const float cs = (n0 < 1024 || (n0 >= 3072 && n0 < 4096)) ? QSCALE2 : 1.f;
            transpose_item(args.in[I_WIN], D, INC, Win_t, n0, nullptr, cs, scr, k0, n0, lane); continue; } r -= CV_IN;
        if (r < CV_OUT) { int k0, n0; item_kn(r, D / 64, k0, n0); transpose_item(args.in[I_WOUT], D, D, Wout_t, n0, nullptr, 1.f, scr, k0, n0, lane); continue; } r -= CV_OUT;
        if (r < 2 * CV_G) { const int up = r >= CV_G; if (up) r -= CV_G; int k0, n0; item_kn(r, DFF / 64, k0, n0);
            transpose_item(args.in[up ? I_WU : I_WG], D, DFF, Wgu_t, 256 * (n0 / 128) + 128 * up + (n0 % 128), args.in[I_FNW], 1.f, scr, k0, n0, lane); continue; } r -= 2 * CV_G;
        { int k0, n0; item_kn(r, D / 64, k0, n0); transpose_item(args.in[I_WD], DFF, D, Wdn_t, n0, nullptr, 1.f, scr, k0, n0, lane); }
    }
}

__global__ void __launch_bounds__(NWAVES * 64, 2) hymba_fwd(Args args) {
    extern __shared__ __attribute__((aligned(16))) unsigned char lds_raw[];
    cg::grid_group grid = cg::this_grid();
    LAS unsigned char* lds = (LAS unsigned char*)lds_raw;
    const int tid = threadIdx.x, lane = tid & 63, wave = __builtin_amdgcn_readfirstlane(tid >> 6);
    const int G = gridDim.x, bx = blockIdx.x, vcu = (G % 8 == 0) ? (bx % 8) * (G / 8) + bx / 8 : bx;
    unsigned char* ws = args.ws;
    const float* x = args.in[I_X]; float* out = args.out;
    bf16* Win_t = (bf16*)(ws + WS_WIN); bf16* Wout_t = (bf16*)(ws + WS_WOUT); bf16* Wgu_t = (bf16*)(ws + WS_WGU); bf16* Wdn_t = (bf16*)(ws + WS_WDN);
    bf16* XN = (bf16*)(ws + WS_XN); bf16* PROJ = (bf16*)(ws + WS_PROJ); bf16* MIX = (bf16*)(ws + WS_MIX); bf16* HB = (bf16*)(ws + WS_H);
    float* part1 = (float*)(ws + WS_PART1); float* part2 = (float*)(ws + WS_PART2);
    const int lo = args.ph_lo, hi = args.ph_hi;
    volatile LAS unsigned* bst = (volatile LAS unsigned*)(lds + LDS_BYTES - 64);
    if (tid < 2) bst[tid] = 0u;
    __syncthreads();
    XcdBarrier gbar; gbar.bar = (unsigned*)ws; gbar.x = 0; gbar.st = bst;
    if (hi - lo > 1) gbar = xcd_barrier_post((unsigned*)ws, bst);
    if (hi > 1000) grid.sync();
#define IN(k) (lo <= (k) && (k) < hi)
#ifndef SYNC_REPEAT
#define SYNC_REPEAT 1
#endif
#define SEAM(k) do { if (IN(k) && IN((k) + 1)) { for (int sr_ = 0; sr_ < SYNC_REPEAT; ++sr_) xcd_barrier(gbar); } } while (0)
#ifndef PROBE_PHASE
#define PROBE_PHASE -1
#endif
#define REP(k) for (int rep_ = 0; rep_ < ((PROBE_PHASE == (k)) ? 2 : 1); ++rep_, ((PROBE_PHASE == (k)) && rep_ < 2 ? (xcd_barrier(gbar), 0) : 0))

    REP(0) if (IN(0)) {
        LAS float* scr = (LAS float*)(lds + wave * 16640);
        const int gw = vcu * NWAVES + wave, NGW = G * NWAVES;
#if defined(P0_TOUCH) && P0_TOUCH
        {
            const int widx[5] = {I_WIN, I_WOUT, I_WG, I_WU, I_WD}; const size_t wn4[5] = {(size_t)D * INC / 4, (size_t)D * D / 4, (size_t)D * DFF / 4, (size_t)D * DFF / 4, (size_t)DFF * D / 4};
            f32x4 acc4 = {0.f, 0.f, 0.f, 0.f};
#pragma unroll
            for (int w = 0; w < 5; ++w) { const f32x4* src = (const f32x4*)args.in[widx[w]];
                for (size_t i = (size_t)gw * 64 + lane; i < wn4[w]; i += (size_t)NGW * 64 * 4) {
                    f32x4 a = src[i], b = (i + (size_t)NGW * 64 < wn4[w]) ? src[i + (size_t)NGW * 64] : acc4, c = (i + (size_t)NGW * 128 < wn4[w]) ? src[i + (size_t)NGW * 128] : acc4, d = (i + (size_t)NGW * 192 < wn4[w]) ? src[i + (size_t)NGW * 192] : acc4;
                    acc4 = acc4 + a + b + c + d; } }
            if (acc4.x + acc4.y + acc4.z + acc4.w == 1.2345e38f) ((float*)(ws + WS_PART2))[gw * 64 + lane] = acc4.x;
        }
#endif
        convert_weights(args, ws, scr, 0, CV_ALL, CV_SPLIT ? CV_T0 : 0, CV_SPLIT ? CV_T1 : 0, gw, NGW, lane);
        const f32x4* wn = (const f32x4*)args.in[I_ANW] + lane;
        for (int rp_ = 0; rp_ < (PROBE_PHASE == 11 ? 2 : 1); ++rp_)
        for (int m = gw; m < M; m += NGW) {
            const f32x4* xr = (const f32x4*)(x + (size_t)m * D) + lane;
            f32x4 v[8]; float s = 0.f;
#pragma unroll
            for (int j = 0; j < 8; ++j) { v[j] = xr[64 * j]; s += (v[j].x * v[j].x + v[j].y * v[j].y) + (v[j].z * v[j].z + v[j].w * v[j].w); }
            const float rstd = rsqrtf(wave_sum(s) * (1.f / D) + RMS_EPS);
            unsigned long long* o8 = (unsigned long long*)(XN + (size_t)m * D) + lane;
#pragma unroll
            for (int j = 0; j < 8; ++j) { const f32x4 w = wn[64 * j]; o8[64 * j] = (unsigned long long)pk2(v[j].x * rstd * w.x, v[j].y * rstd * w.y) | ((unsigned long long)pk2(v[j].z * rstd * w.z, v[j].w * rstd * w.w) << 32); }
        }
        __syncthreads();
    }
    SEAM(0);
    REP(1) if (IN(1)) {
        pg8::Gemm g{XN, Win_t, M, INC, D}; pg8::StaticOrder S; S.init(M, INC, G, bx);
        pg8::EpiStore E{PROJ, INC};
#if PROBE_PHASE == 21
        { TwiceOrder S2{S}; pg8::gemm_phase<pg8::EpiStore, TwiceOrder, true, true>(lds, g, S2, E); }
#else
        pg8::gemm_phase<pg8::EpiStore, pg8::StaticOrder, true, true>(lds, g, S, E);
#endif
        { const int nwg = (M / 256) * (INC / 256), maxU = (nwg + G - 1) / G; int nIdle = G * maxU - nwg, idx = bx - (G - nIdle); if (nIdle == 0) { nIdle = G; idx = bx; }
          if (idx >= 0 && CV_SPLIT) convert_weights(args, ws, (LAS float*)(lds + wave * 16640), CV_T0, CV_T1, 0, 0, idx * NWAVES + wave, nIdle * NWAVES, lane); }
        __syncthreads();
    }
    SEAM(1);
    REP(2) if (IN(2)) {
        const float* lq1 = args.in[I_LQ1]; const float* lk1 = args.in[I_LK1]; const float* lq2 = args.in[I_LQ2]; const float* lk2 = args.in[I_LK2];
        const float s1 = wave_sum(lq1[lane] * lk1[lane]), s2 = wave_sum(lq2[lane] * lk2[lane]);
        const float lam = expf(s1) - expf(s2) + 0.2f;
        const int wq = wave & 3, gsel = wave >> 2;
        for (int i = vcu; i < 512; i += G) {
            const int bh = i >> 3, xq = i & 7, b = bh >> 3, h = bh & 7;
#pragma unroll 1
            for (int k = 0; k < 2; ++k) {
                const int qblk = k ? 15 - xq : xq;
                att::UnitP up; up.b = b; up.q0 = 128 * qblk; up.qcol = h * 128 + gsel * 64; up.kcol = 1024 + h * 128; up.vcol = 2048 + h * 128; up.kofs = gsel * 128;
                up.slope2 = exp2f(-(float)(h + 1)) * 1.4426950408889634f; up.m_init = -1e30f; up.l_init = 0.f;
                up.T0 = 0; up.T1 = 2 * qblk + 1; up.tlo = 0; up.thi = (up.q0 + 32 * wq) >> 6; up.window = 1 << 20; up.maskall = 0; up.ocol = h * 128;
                att::attn_unit<128, 128>((LAS char*)lds, PROJ, MIX, up, true, lam, args.in[I_SUBLN], tid);
            }
        }
        for (int i = vcu; i < 1024; i += G) {
            const int qblk = i & 15, pair = (i >> 4) & 1, hkv = (i >> 5) & 3, b = i >> 7, hq = hkv * 4 + pair * 2 + gsel, a = 2 * qblk;
            att::UnitP up; up.b = b; up.q0 = 128 * qblk; up.qcol = 3072 + hq * 64; up.kcol = 4096 + hkv * 64; up.vcol = 4352 + hkv * 64; up.kofs = 0;
            up.slope2 = exp2f(-0.5f * (float)(hq + 1)) * 1.4426950408889634f; up.m_init = args.in[I_SINKS][hq] * 1.4426950408889634f; up.l_init = 1.f;
            up.T0 = a - 2 < 0 ? 0 : a - 2; up.T1 = a + 1; up.tlo = a - 2 + (wq >> 1); up.thi = a + (wq >> 1); up.window = 128; up.maskall = 1; up.ocol = 1024 + hq * 64;
            att::attn_unit<64, 64>((LAS char*)lds, PROJ, MIX, up, false, 0.f, nullptr, tid);
        }
        __syncthreads();
    }
    SEAM(2);
    REP(3) if (IN(3)) {
        pg8::Gemm g{MIX, Wout_t, M, D, D}; pg8::StaticOrder S; S.init(M, D, G, bx);
        pg8::EpiResid<false> E{x, XN, part1, D};
        pg8::gemm_phase<pg8::EpiResid<false>, pg8::StaticOrder, true, true>(lds, g, S, E);
    }
    SEAM(3);
    REP(4) if (IN(4)) {
        pg8::Gemm g{XN, Wgu_t, M, NGU, D}; pg8::StaticOrder S; S.init(M, NGU, G, bx);
        pg8::EpiSwiGLU E{HB, DFF, part1, 1.f / D, RMS_EPS};
#if PROBE_PHASE == 24
        { TwiceOrder S2{S}; pg8::gemm_phase<pg8::EpiSwiGLU, TwiceOrder, true, true>(lds, g, S2, E); }
#else
        pg8::gemm_phase<pg8::EpiSwiGLU, pg8::StaticOrder, true, true>(lds, g, S, E);
#endif
    }
    SEAM(4);
    REP(5) if (IN(5)) {
        pg8::Gemm g{HB, Wdn_t, M, D, DFF}; pg8::StaticOrder S; S.init(M, D, G, bx);
        pg8::EpiResid<true> E{XN, XN, part2, D};
        pg8::gemm_phase<pg8::EpiResid<true>, pg8::StaticOrder, true, true>(lds, g, S, E);
    }
    SEAM(5);
    REP(6) if (IN(6)) {
        const int gw = vcu * NWAVES + wave, NGW = G * NWAVES;
        const f32x4* wn = (const f32x4*)args.in[I_FINW] + 2 * lane;
        for (int m = gw; m < M; m += NGW) {
            const float s = wave_sum(lane < 32 ? part2[(size_t)m * 32 + lane] : 0.f);
            const float rstd = rsqrtf(s * (1.f / D) + RMS_EPS);
            const v4u* xr = (const v4u*)(XN + (size_t)m * D) + lane; f32x4* orow = (f32x4*)(out + (size_t)m * D) + 2 * lane;
#pragma unroll
            for (int j = 0; j < 4; ++j) { const v4u w = xr[64 * j]; const f32x4 w0 = wn[128 * j], w1 = wn[128 * j + 1];
                const f32x4 a = {__uint_as_float(w.x << 16), __uint_as_float(w.x & 0xffff0000u), __uint_as_float(w.y << 16), __uint_as_float(w.y & 0xffff0000u)};
                const f32x4 b = {__uint_as_float(w.z << 16), __uint_as_float(w.z & 0xffff0000u), __uint_as_float(w.w << 16), __uint_as_float(w.w & 0xffff0000u)};
                __builtin_nontemporal_store(a * rstd * w0, orow + 128 * j); __builtin_nontemporal_store(b * rstd * w1, orow + 128 * j + 1); }
        }
    }
#undef IN
#undef SEAM
}

extern "C" void kernel_launch(void* const* d_in, const int* in_sizes, int n_in, void* d_out, int out_size, void* d_ws, size_t ws_size, hipStream_t stream) {
    static int grid = 0;
    if (grid == 0) {
        if (n_in != 15 || out_size != M * D || ws_size < WS_END) { fprintf(stderr, "kernel_launch: unexpected shapes (n_in %d out %d ws %zu)\n", n_in, out_size, ws_size); grid = -1; return; }
        int dev = 0, cus = 0, per_cu = 0;
        hipGetDevice(&dev); hipDeviceGetAttribute(&cus, hipDeviceAttributeMultiprocessorCount, dev);
        if (hipFuncSetAttribute((const void*)hymba_fwd, hipFuncAttributeMaxDynamicSharedMemorySize, LDS_BYTES) != hipSuccess) { fprintf(stderr, "kernel_launch: hipFuncSetAttribute failed\n"); grid = -1; return; }
        if (hipOccupancyMaxActiveBlocksPerMultiprocessor(&per_cu, (const void*)hymba_fwd, NWAVES * 64, LDS_BYTES) != hipSuccess || per_cu < 1) { fprintf(stderr, "kernel_launch: occupancy query says %d\n", per_cu); per_cu = 1; }
        (void)hipGetLastError();
        grid = cus * 1;
        fprintf(stderr, "kernel_launch: grid %d (cus %d, per_cu %d)\n", grid, cus, per_cu);
    }
    if (grid < 0) return;
    if (hipMemsetAsync(d_ws, 0, 16384, stream) != hipSuccess) { fprintf(stderr, "kernel_launch: memset failed\n"); return; }
    Args a{};
    for (int i = 0; i < 15; ++i) a.in[i] = (const float*)d_in[i];
    a.out = (float*)d_out; a.ws = (unsigned char*)d_ws;
#if MK_N_LAUNCHES == 1
    a.ph_lo = 0; a.ph_hi = N_PHASES;
    void* kargs[] = {&a};
    hipError_t e = hipLaunchCooperativeKernel((const void*)hymba_fwd, dim3(grid), dim3(NWAVES * 64), kargs, LDS_BYTES, stream);
    if (e != hipSuccess) fprintf(stderr, "kernel_launch: cooperative launch failed: %s\n", hipGetErrorString(e));
#else
    for (int p = 0; p < N_PHASES; ++p) { a.ph_lo = p; a.ph_hi = p + 1; hipLaunchKernelGGL(hymba_fwd, dim3(grid), dim3(NWAVES * 64), LDS_BYTES, stream, a); }
#endif
}
```

```cpp
#include <hip/hip_runtime.h>
#include <hip/hip_cooperative_groups.h>
#include <hip/hip_bf16.h>
#include <cstdio>
#include <cstdint>
#include <cmath>
namespace cg = cooperative_groups;
#define MK_N_LAUNCHES 1
#ifndef PG8_WGM
#define PG8_WGM 4
#endif
namespace pg8 {
#define PG8_LAS __attribute__((address_space(3)))
typedef unsigned short bf16_t;
typedef short bf16x8 __attribute__((ext_vector_type(8)));
typedef float f32x4 __attribute__((ext_vector_type(4)));
typedef unsigned u32x4 __attribute__((ext_vector_type(4)));
constexpr int BM = 256, BK = 64, HALF = 128, HTB = HALF * BK * 2  , STAGE_BYTES = 8 * HTB, NXCD = 8, WGM = PG8_WGM;

__host__ __device__ __forceinline__ int lds_byte(int r, int c) { const int st = (r >> 4) * 2 + (c >> 5), rr = r & 15, cc = c & 31, ob = rr * 64 + cc * 2; return st * 1024 + (ob ^ (((ob >> 9) & 1) << 5)); }
__host__ __device__ __forceinline__ void stage_rc(int b, int& R, int& C) { const int st = b / 1024, sb = b % 1024, swz = sb ^ (((sb >> 9) & 1) << 5); R = (st >> 1) * 16 + swz / 64; C = (st & 1) * 32 + (swz % 64) / 2; }
__host__ __device__ __forceinline__ int perm32(int rho) { const int n = rho >> 4, i = rho & 15; return 8 * (i >> 2) + 4 * n + (i & 3); }

struct Unit { int pm, pn; };
struct Gemm { const bf16_t* A; const bf16_t* Bt; int M, N, K; };

struct StaticOrder {
    int nM, nN, nwg, G, c, wgm;
    __host__ __device__ void init(int M, int N, int G_, int c_, int wgm_ = WGM) { nM = M / BM; nN = N / BM; nwg = nM * nN; G = G_; c = c_; wgm = wgm_; }
    __host__ __device__ bool next(int i, Unit& u) const {
        const long L = (long)i * G + c; if (L >= nwg) return false;
        int wgid = (int)L; { const int q = nwg / NXCD, r = nwg % NXCD, xcd = wgid % NXCD, off = wgid / NXCD; wgid = (xcd < r ? xcd * (q + 1) : r * (q + 1) + (xcd - r) * q) + off; }
        const int nig = wgm * nN, gid = wgid / nig, fm = gid * wgm, gsz = (nM - fm) < wgm ? (nM - fm) : wgm;
        u.pm = fm + ((wgid % nig) % gsz); u.pn = (wgid % nig) / gsz; return true;
    }
    __device__ __forceinline__ void a_ready(const Unit&) const {}
    __device__ __forceinline__ void done(const Unit&) const {}
};

__device__ __forceinline__ unsigned cvt_pk_bf16(float lo, float hi) { typedef float f2_t __attribute__((ext_vector_type(2))); typedef __bf16 b2_t __attribute__((ext_vector_type(2))); f2_t v = {lo, hi}; b2_t b = __builtin_convertvector(v, b2_t); return __builtin_bit_cast(unsigned, b); }
typedef unsigned u32x2 __attribute__((ext_vector_type(2)));
struct EpiStore {
    static constexpr bool PERM = true, AFTER_DRAIN = false;
    bf16_t* O; int ldc;
    __device__ __forceinline__ void operator()(const f32x4 (&acc)[2][2][4][2], const Unit& u, int wr, int wc, int fr, int fq) const {
        const int row0 = u.pm * BM + wr * 64 + fr, col0 = u.pn * BM + wc * 32 + 8 * fq;
#pragma unroll
        for (int ai = 0; ai < 2; ++ai)
#pragma unroll
            for (int m = 0; m < 4; ++m) { bf16_t* rowp = O + (size_t)(row0 + ai * HALF + m * 16) * ldc + col0;
#pragma unroll
                for (int bj = 0; bj < 2; ++bj) { const f32x4 v0 = acc[ai][bj][m][0], v1 = acc[ai][bj][m][1];
                    u32x4 w; w.x = cvt_pk_bf16(v0[0], v0[1]); w.y = cvt_pk_bf16(v0[2], v0[3]); w.z = cvt_pk_bf16(v1[0], v1[1]); w.w = cvt_pk_bf16(v1[2], v1[3]);
                    *(u32x4*)(rowp + bj * HALF) = w; } }
    }
};
template <bool BASE_BF16> struct EpiResid {
    static constexpr bool PERM = true, AFTER_DRAIN = false;
    const void* base; bf16_t* xo; float* part; int ldc;
    __device__ __forceinline__ void operator()(const f32x4 (&acc)[2][2][4][2], const Unit& u, int wr, int wc, int fr, int fq) const {
        const int row0 = u.pm * BM + wr * 64 + fr, col0 = u.pn * BM + wc * 32 + 8 * fq;
#pragma unroll
        for (int ai = 0; ai < 2; ++ai)
#pragma unroll
            for (int m = 0; m < 4; ++m) { const int r = row0 + ai * HALF + m * 16; const size_t off = (size_t)r * ldc + col0; float ss = 0.f;
#pragma unroll
                for (int bj = 0; bj < 2; ++bj) { f32x4 b0, b1;
                    if (BASE_BF16) { const u32x4 w = *(const u32x4*)((const bf16_t*)base + off + bj * HALF);
                        b0 = (f32x4){__uint_as_float(w.x << 16), __uint_as_float(w.x & 0xffff0000u), __uint_as_float(w.y << 16), __uint_as_float(w.y & 0xffff0000u)};
                        b1 = (f32x4){__uint_as_float(w.z << 16), __uint_as_float(w.z & 0xffff0000u), __uint_as_float(w.w << 16), __uint_as_float(w.w & 0xffff0000u)}; }
                    else { const float* bp = (const float*)base + off + bj * HALF; b0 = *(const f32x4*)bp; b1 = *(const f32x4*)(bp + 4); }
                    const f32x4 v0 = b0 + acc[ai][bj][m][0], v1 = b1 + acc[ai][bj][m][1];
                    ss += ((v0[0] * v0[0] + v0[1] * v0[1]) + (v0[2] * v0[2] + v0[3] * v0[3])) + ((v1[0] * v1[0] + v1[1] * v1[1]) + (v1[2] * v1[2] + v1[3] * v1[3]));
                    u32x4 w; w.x = cvt_pk_bf16(v0[0], v0[1]); w.y = cvt_pk_bf16(v0[2], v0[3]); w.z = cvt_pk_bf16(v1[0], v1[1]); w.w = cvt_pk_bf16(v1[2], v1[3]);
                    *(u32x4*)(xo + off + bj * HALF) = w; }
                ss += __shfl_xor(ss, 16); ss += __shfl_xor(ss, 32);
                if (fq == 0) part[(size_t)r * 32 + u.pn * 4 + wc] = ss; }
    }
};
struct EpiFinal {
    static constexpr bool PERM = true, AFTER_DRAIN = false;
    const bf16_t* xb; float* out; const float* wfin; float* xbuf; unsigned* cnt; PG8_LAS unsigned char* tab; int ldc; float inv_n, eps;
    __device__ __forceinline__ void operator()(f32x4 (&acc)[2][2][4][2], const Unit& u, int wr, int wc, int fr, int fq) const {
        const int lane = fq * 16 + fr, wid = wr * 4 + wc;
        PG8_LAS float* P = (PG8_LAS float*)tab;
        PG8_LAS float* S = (PG8_LAS float*)(tab + 4096);
        PG8_LAS unsigned* flag = (PG8_LAS unsigned*)(tab + 4096 + 1024);
        const int row0 = u.pm * BM + wr * 64 + fr, col0 = u.pn * BM + wc * 32 + 8 * fq;
#pragma unroll
        for (int ai = 0; ai < 2; ++ai)
#pragma unroll
            for (int m = 0; m < 4; ++m) { const int r = row0 + ai * HALF + m * 16; const size_t off = (size_t)r * ldc + col0; float ss = 0.f;
#pragma unroll
                for (int bj = 0; bj < 2; ++bj) { const u32x4 w = *(const u32x4*)(xb + off + bj * HALF);
                    const f32x4 b0 = {__uint_as_float(w.x << 16), __uint_as_float(w.x & 0xffff0000u), __uint_as_float(w.y << 16), __uint_as_float(w.y & 0xffff0000u)};
                    const f32x4 b1 = {__uint_as_float(w.z << 16), __uint_as_float(w.z & 0xffff0000u), __uint_as_float(w.w << 16), __uint_as_float(w.w & 0xffff0000u)};
                    const f32x4 v0 = b0 + acc[ai][bj][m][0], v1 = b1 + acc[ai][bj][m][1]; acc[ai][bj][m][0] = v0; acc[ai][bj][m][1] = v1;
                    ss += ((v0[0] * v0[0] + v0[1] * v0[1]) + (v0[2] * v0[2] + v0[3] * v0[3])) + ((v1[0] * v1[0] + v1[1] * v1[1]) + (v1[2] * v1[2] + v1[3] * v1[3])); }
                ss += __shfl_xor(ss, 16); ss += __shfl_xor(ss, 32);
                if (fq == 0) P[(ai * HALF + wr * 64 + m * 16 + fr) * 4 + wc] = ss; }
        asm volatile("s_waitcnt lgkmcnt(0)" ::: "memory"); __builtin_amdgcn_s_barrier(); asm volatile("" ::: "memory");
        const int row = wid * 32 + (lane & 31);
        if (lane < 32) { const f32x4 p4 = *(PG8_LAS const f32x4*)(P + row * 4);
            __hip_atomic_store(xbuf + ((size_t)(u.pm * BM + row) * 8 + u.pn), (p4[0] + p4[1]) + (p4[2] + p4[3]), __ATOMIC_RELAXED, __HIP_MEMORY_SCOPE_AGENT); }
        asm volatile("s_waitcnt vmcnt(0)" ::: "memory");
        if (lane == 0) __hip_atomic_fetch_add(cnt + 64 * u.pm, 1u, __ATOMIC_RELAXED, __HIP_MEMORY_SCOPE_AGENT);
        if (wid == 0) { bool dead = false; const unsigned long long t0 = __builtin_amdgcn_s_memrealtime();
            for (;;) { if ((unsigned)__builtin_amdgcn_readfirstlane(__hip_atomic_load(cnt + 64 * u.pm, __ATOMIC_RELAXED, __HIP_MEMORY_SCOPE_AGENT)) >= 64u) break;
                if (__builtin_amdgcn_s_memrealtime() - t0 > 2000000ull) { dead = true; break; }
                __builtin_amdgcn_s_sleep(2); }
            __builtin_amdgcn_fence(__ATOMIC_ACQUIRE, "agent");
            if (lane == 0) flag[0] = dead ? 1u : 0u; }
        asm volatile("s_waitcnt vmcnt(0) lgkmcnt(0)" ::: "memory"); __builtin_amdgcn_s_barrier(); asm volatile("" ::: "memory");
        const bool bad = flag[0] != 0u;
        if (lane < 32) { const float* slot = xbuf + (size_t)(u.pm * BM + row) * 8; float q = 0.f;
#pragma unroll
            for (int t = 0; t < 8; ++t) q += __hip_atomic_load(slot + t, __ATOMIC_RELAXED, __HIP_MEMORY_SCOPE_AGENT);
            S[row] = rsqrtf(q * inv_n + eps); }
        asm volatile("s_waitcnt vmcnt(0) lgkmcnt(0)" ::: "memory"); __builtin_amdgcn_s_barrier(); asm volatile("" ::: "memory");
        const float qnan = __builtin_nanf("");
        f32x4 wv[2][2];
#pragma unroll
        for (int bj = 0; bj < 2; ++bj) { wv[bj][0] = *(const f32x4*)(wfin + col0 + bj * HALF); wv[bj][1] = *(const f32x4*)(wfin + col0 + bj * HALF + 4); }
#pragma unroll
        for (int ai = 0; ai < 2; ++ai)
#pragma unroll
            for (int m = 0; m < 4; ++m) { const int rl = ai * HALF + wr * 64 + m * 16 + fr; const float rs = bad ? qnan : S[rl]; float* op = out + (size_t)(u.pm * BM + rl) * ldc + col0;
#pragma unroll
                for (int bj = 0; bj < 2; ++bj) { __builtin_nontemporal_store(acc[ai][bj][m][0] * rs * wv[bj][0], (f32x4*)(op + bj * HALF)); __builtin_nontemporal_store(acc[ai][bj][m][1] * rs * wv[bj][1], (f32x4*)(op + bj * HALF + 4)); } }
    }
};
struct EpiSwiGLU {
    static constexpr bool PERM = true, AFTER_DRAIN = false;
    bf16_t* H; int ldh; const float* part; float inv_n, eps;
    __device__ __forceinline__ static float silu_mul(float g, float uu) { const float e = __builtin_amdgcn_exp2f(g * -1.4426950408889634f); return g * uu * __builtin_amdgcn_rcpf(1.f + e); }
    __device__ __forceinline__ void operator()(const f32x4 (&acc)[2][2][4][2], const Unit& u, int wr, int wc, int fr, int fq) const {
        const int row0 = u.pm * BM + wr * 64 + fr, col0 = u.pn * HALF + wc * 32 + 8 * fq;
#pragma unroll
        for (int ai = 0; ai < 2; ++ai)
#pragma unroll
            for (int m = 0; m < 4; ++m) { const int r = row0 + ai * HALF + m * 16;
                const f32x4* pp = (const f32x4*)(part + (size_t)r * 32 + fq * 8); const f32x4 pa = pp[0], pb = pp[1];
                float s = ((pa[0] + pa[1]) + (pa[2] + pa[3])) + ((pb[0] + pb[1]) + (pb[2] + pb[3]));
                s += __shfl_xor(s, 16); s += __shfl_xor(s, 32);
                const float rstd = rsqrtf(s * inv_n + eps);
                const f32x4 g0 = acc[ai][0][m][0] * rstd, g1 = acc[ai][0][m][1] * rstd, u0 = acc[ai][1][m][0] * rstd, u1 = acc[ai][1][m][1] * rstd;
                u32x4 w; w.x = cvt_pk_bf16(silu_mul(g0[0], u0[0]), silu_mul(g0[1], u0[1])); w.y = cvt_pk_bf16(silu_mul(g0[2], u0[2]), silu_mul(g0[3], u0[3]));
                w.z = cvt_pk_bf16(silu_mul(g1[0], u1[0]), silu_mul(g1[1], u1[1])); w.w = cvt_pk_bf16(silu_mul(g1[2], u1[2]), silu_mul(g1[3], u1[3]));
                *(u32x4*)(H + (size_t)r * ldh + col0) = w; }
    }
};
template <class Epi, class Sched, bool ALIGN_EPI = false, bool SP2 = false>
__device__ __forceinline__ void gemm_phase(PG8_LAS unsigned char* lds, const Gemm g, const Sched& S, const Epi& E) {
    const int tid = threadIdx.x, wid = __builtin_amdgcn_readfirstlane(tid >> 6), lane = tid & 63, wr = wid >> 2, wc = wid & 3, fr = lane & 15, fq = lane >> 4;
    const int K = g.K, nt = K / BK;
    unsigned voffA[2], voffB[2];
#pragma unroll
    for (int i = 0; i < 2; ++i) { int R, C; stage_rc(tid * 16 + i * 8192, R, C); const int Rb = Epi::PERM ? ((R & ~31) + perm32(R & 31)) : R;
        voffA[i] = (unsigned)(R * K + C) * 2u; voffB[i] = (unsigned)(Rb * K + C) * 2u; }
    const size_t kstep = (size_t)(BK * 2);
    const size_t hstep = (size_t)HALF * K * 2;
    const size_t tstep = 2 * hstep;
    const unsigned ldsw = (unsigned)wid * 1024u;
    const int aoff = lds_byte(wr * 64 + fr, fq * 8), boff = lds_byte(wc * 32 + fr, fq * 8);
#define PG8_SA(b, h) (((b) * 2 + (h)) * HTB)
#define PG8_SB(b, h) ((4 + (b) * 2 + (h)) * HTB)
#define PG8_STAGE(bufoff, gbase, voff) do { _Pragma("unroll") for (int _i = 0; _i < 2; ++_i) \
        __builtin_amdgcn_global_load_lds((const unsigned*)((const char*)(gbase) + (voff)[_i]), (PG8_LAS unsigned*)(lds + (bufoff) + ldsw + _i * 8192), 16, 0, 0); } while (0)
#define PG8_LDA(dst, b, h) do { _Pragma("unroll") for (int m = 0; m < 4; ++m) _Pragma("unroll") for (int k = 0; k < 2; ++k) dst[m][k] = *(const PG8_LAS bf16x8*)(lds + PG8_SA(b, h) + aoff + m * 2048 + k * 1024); } while (0)
#define PG8_LDB(dst, b, h) do { _Pragma("unroll") for (int n = 0; n < 2; ++n) _Pragma("unroll") for (int k = 0; k < 2; ++k) dst[n][k] = *(const PG8_LAS bf16x8*)(lds + PG8_SB(b, h) + boff + n * 2048 + k * 1024); } while (0)
#define PG8_MMA(ai, bj, At, Bt) do { __builtin_amdgcn_s_setprio(1); _Pragma("unroll") for (int m = 0; m < 4; ++m) _Pragma("unroll") for (int n = 0; n < 2; ++n) _Pragma("unroll") for (int k = 0; k < 2; ++k) \
        acc[ai][bj][m][n] = __builtin_amdgcn_mfma_f32_16x16x32_bf16(Bt[n][k], At[m][k], acc[ai][bj][m][n], 0, 0, 0); __builtin_amdgcn_s_setprio(0); } while (0)
#define PG8_WAIT_V(n) asm volatile("s_waitcnt vmcnt(" #n ")" ::: "memory")
#define PG8_WAIT_L(n) asm volatile("s_waitcnt lgkmcnt(" #n ")" ::: "memory")
#define PG8_BAR __builtin_amdgcn_s_barrier()
#define PG8_SCHED __builtin_amdgcn_sched_barrier(0)
    Unit cur, nxt; int ui = 0;
    if (!S.next(0, cur)) return;
    f32x4 acc[2][2][4][2];
#pragma unroll
    for (int a = 0; a < 2; ++a)
#pragma unroll
        for (int b = 0; b < 2; ++b)
#pragma unroll
            for (int m = 0; m < 4; ++m)
#pragma unroll
                for (int n = 0; n < 2; ++n) acc[a][b][m][n] = (f32x4){0.f, 0.f, 0.f, 0.f};
    bf16x8 At[4][2], B0[2][2], B1[2][2];
    const char* cA = (const char*)g.A + (size_t)cur.pm * tstep; const char* cB = (const char*)g.Bt + (size_t)cur.pn * tstep;
    S.a_ready(cur);
    if constexpr (SP2) {
        PG8_STAGE(PG8_SB(0, 0), cB, voffB); PG8_STAGE(PG8_SB(0, 1), cB + hstep, voffB); PG8_STAGE(PG8_SA(0, 0), cA, voffA); PG8_STAGE(PG8_SA(0, 1), cA + hstep, voffA);
        if (wr == 1) PG8_BAR;
        PG8_WAIT_V(2); PG8_BAR;
        PG8_STAGE(PG8_SB(1, 0), cB + kstep, voffB); PG8_STAGE(PG8_SA(1, 0), cA + kstep, voffA); PG8_STAGE(PG8_SB(1, 1), cB + hstep + kstep, voffB);
        PG8_WAIT_V(6); PG8_BAR;
    } else {
        PG8_STAGE(PG8_SB(0, 0), cB, voffB); PG8_STAGE(PG8_SA(0, 0), cA, voffA); PG8_STAGE(PG8_SB(0, 1), cB + hstep, voffB); PG8_STAGE(PG8_SA(0, 1), cA + hstep, voffA);
        if (wr == 1) PG8_BAR;
        PG8_WAIT_V(4); PG8_BAR;
        PG8_STAGE(PG8_SB(1, 0), cB + kstep, voffB); PG8_STAGE(PG8_SA(1, 0), cA + kstep, voffA); PG8_STAGE(PG8_SB(1, 1), cB + hstep + kstep, voffB);
        PG8_WAIT_V(6); PG8_BAR;
    }
    for (;;) {
        const bool has_next = S.next(ui + 1, nxt);
        const char* nA = has_next ? (const char*)g.A + (size_t)nxt.pm * tstep : cA; const char* nB = has_next ? (const char*)g.Bt + (size_t)nxt.pn * tstep : cB;
        for (int t = 0; t < nt; t += 2) {
            const bool last = (t == nt - 2);
            const char* a1 = cA + (size_t)(t + 1) * kstep;
            const char* a2 = last ? nA : cA + (size_t)(t + 2) * kstep; const char* b2 = last ? nB : cB + (size_t)(t + 2) * kstep;
            const char* a3 = a2 + kstep; const char* b3 = b2 + kstep;
            if (last && has_next) S.a_ready(nxt);
            if constexpr (SP2) {
            PG8_LDB(B0, 0, 0); PG8_LDB(B1, 0, 1); PG8_SCHED; PG8_LDA(At, 0, 0); PG8_STAGE(PG8_SA(1, 1), a1 + hstep, voffA);
            PG8_WAIT_V(8); PG8_WAIT_L(0); PG8_BAR; PG8_MMA(0, 0, At, B0); PG8_MMA(0, 1, At, B1); PG8_BAR; PG8_SCHED;
            PG8_LDA(At, 0, 1); PG8_STAGE(PG8_SB(0, 0), b2, voffB); PG8_STAGE(PG8_SB(0, 1), b2 + hstep, voffB); PG8_STAGE(PG8_SA(0, 0), a2, voffA);
            PG8_WAIT_V(8); PG8_WAIT_L(0); PG8_BAR; PG8_MMA(1, 0, At, B0); PG8_MMA(1, 1, At, B1); PG8_BAR; PG8_SCHED;
            PG8_LDB(B0, 1, 0); PG8_LDB(B1, 1, 1); PG8_SCHED; PG8_LDA(At, 1, 0); PG8_STAGE(PG8_SA(0, 1), a2 + hstep, voffA);
            PG8_WAIT_V(8); PG8_WAIT_L(0); PG8_BAR; PG8_MMA(0, 0, At, B0); PG8_MMA(0, 1, At, B1); PG8_BAR; PG8_SCHED;
            PG8_LDA(At, 1, 1); PG8_STAGE(PG8_SB(1, 0), b3, voffB); PG8_STAGE(PG8_SB(1, 1), b3 + hstep, voffB); PG8_STAGE(PG8_SA(1, 0), a3, voffA);
            PG8_WAIT_V(8); PG8_WAIT_L(0); PG8_BAR; PG8_MMA(1, 0, At, B0); PG8_MMA(1, 1, At, B1); PG8_BAR; PG8_SCHED;
            } else {
            PG8_LDB(B0, 0, 0); PG8_SCHED; PG8_LDA(At, 0, 0); PG8_STAGE(PG8_SA(1, 1), a1 + hstep, voffA);
            PG8_WAIT_L(8); PG8_BAR; PG8_WAIT_L(0); PG8_MMA(0, 0, At, B0); PG8_BAR; PG8_SCHED;
            PG8_LDB(B1, 0, 1); PG8_STAGE(PG8_SB(0, 0), b2, voffB);
            PG8_BAR; PG8_WAIT_L(0); PG8_MMA(0, 1, At, B1); PG8_BAR;
            PG8_LDA(At, 0, 1); PG8_STAGE(PG8_SA(0, 0), a2, voffA);
            PG8_BAR; PG8_WAIT_L(0); PG8_MMA(1, 0, At, B0); PG8_BAR; PG8_SCHED;
            PG8_STAGE(PG8_SB(0, 1), b2 + hstep, voffB);
            PG8_WAIT_V(6); PG8_BAR; PG8_MMA(1, 1, At, B1); PG8_BAR;
            PG8_LDB(B0, 1, 0); PG8_SCHED; PG8_LDA(At, 1, 0); PG8_STAGE(PG8_SA(0, 1), a2 + hstep, voffA);
            PG8_WAIT_L(8); PG8_BAR; PG8_WAIT_L(0); PG8_MMA(0, 0, At, B0); PG8_BAR; PG8_SCHED;
            PG8_LDB(B1, 1, 1); PG8_STAGE(PG8_SB(1, 0), b3, voffB);
            PG8_BAR; PG8_WAIT_L(0); PG8_MMA(0, 1, At, B1); PG8_BAR;
            PG8_LDA(At, 1, 1); PG8_STAGE(PG8_SA(1, 0), a3, voffA);
            PG8_BAR; PG8_WAIT_L(0); PG8_MMA(1, 0, At, B0); PG8_BAR; PG8_SCHED;
            PG8_STAGE(PG8_SB(1, 1), b3 + hstep, voffB);
            PG8_WAIT_V(6); PG8_BAR; PG8_MMA(1, 1, At, B1); PG8_BAR;
            }
        }
        if constexpr (ALIGN_EPI) { if (wr == 0) PG8_BAR; }
        if constexpr (!Epi::AFTER_DRAIN) { E(acc, cur, wr, wc, fr, fq); S.done(cur); }
        if (!has_next) break;
#pragma unroll
        for (int a = 0; a < 2; ++a)
#pragma unroll
            for (int b = 0; b < 2; ++b)
#pragma unroll
                for (int m = 0; m < 4; ++m)
#pragma unroll
                    for (int n = 0; n < 2; ++n) acc[a][b][m][n] = (f32x4){0.f, 0.f, 0.f, 0.f};
        cur = nxt; cA = nA; cB = nB; ++ui;
        if constexpr (ALIGN_EPI) { if (wr == 1) PG8_BAR; }
    }
    PG8_WAIT_V(0);
    if constexpr (!ALIGN_EPI) { if (wr == 0) PG8_BAR; }
    PG8_BAR;
    if constexpr (Epi::AFTER_DRAIN) { E.fused(acc, cur, wr, wc, fr, fq, lds, wid, lane); S.done(cur); }
#undef PG8_SA
#undef PG8_SB
#undef PG8_STAGE
#undef PG8_LDA
#undef PG8_LDB
#undef PG8_MMA
#undef PG8_WAIT_V
#undef PG8_WAIT_L
#undef PG8_BAR
#undef PG8_SCHED
}
}
namespace att {
#define ATT_LAS __attribute__((address_space(3)))
typedef unsigned short bf16_t;
typedef short bf16x8 __attribute__((ext_vector_type(8)));
typedef short s16x4 __attribute__((ext_vector_type(4)));
typedef float f32x16 __attribute__((ext_vector_type(16)));
typedef float f32x4 __attribute__((ext_vector_type(4)));
typedef unsigned u32x4 __attribute__((ext_vector_type(4)));
typedef unsigned u32x2 __attribute__((ext_vector_type(2)));
constexpr int SEQ = 2048, PITCH = 4608, OPITCH = 2048;
__device__ __forceinline__ unsigned cvtpk(float lo, float hi) { typedef float f2_t __attribute__((ext_vector_type(2))); typedef __bf16 b2_t __attribute__((ext_vector_type(2))); f2_t v = {lo, hi}; b2_t b = __builtin_convertvector(v, b2_t); return __builtin_bit_cast(unsigned, b); }
__device__ __forceinline__ float swapmax(float m) { auto rr = __builtin_amdgcn_permlane32_swap(__float_as_uint(m), __float_as_uint(m), false, false); return fmaxf(__uint_as_float(rr[0]), __uint_as_float(rr[1])); }
__device__ __forceinline__ float swapsum(float m) { auto rr = __builtin_amdgcn_permlane32_swap(__float_as_uint(m), __float_as_uint(m), false, false); return __uint_as_float(rr[0]) + __uint_as_float(rr[1]); }
__device__ __forceinline__ s16x4 vtr(ATT_LAS const char* p) { return __builtin_bit_cast(s16x4, __builtin_amdgcn_ds_read_tr16_b64_v4i16((ATT_LAS s16x4*)p)); }

struct UnitP {
    int b, q0;
    int qcol, kcol, vcol;
    int kofs;
    float slope2;
    float m_init, l_init;
    int T0, T1;
    int tlo, thi;
    int window;
    int maskall;
    int ocol;
};

template <int DV, int KW>
__device__ __forceinline__ void attn_unit(ATT_LAS char* lds, const bf16_t* __restrict__ P, bf16_t* __restrict__ MIX, const UnitP up, bool diff, float lam, const float* __restrict__ subln_w, int tid,
                                          bool prefetched  , bool has_next, int nb, int nkcol, int nvcol, int nT0, int nT1  ) {
    static_assert(KW == DV && (KW == 128 || KW == 64), "tile geometry");
    constexpr int ROWB = KW * 2, CPR = ROWB / 16, RPP = 1024 / ROWB, NP = 64 / RPP / 8, TILEB = 64 * ROWB, STG = 2 * TILEB, NSTG = 4, NEB = DV / 32, NI = 2 * NP;
    constexpr bool WIDE = (KW == 128);
    const int lane = tid & 63, wid = __builtin_amdgcn_readfirstlane(tid >> 6), r32 = lane & 31, hi = lane >> 5, wq = wid & 3, g = wid >> 2;
    const int qw = up.q0 + 32 * wq, q = qw + r32;
    const size_t rowbase = (size_t)up.b * SEQ;
    __syncthreads();
    unsigned kso[NP], vso[NP];
#pragma unroll
    for (int i = 0; i < NP; ++i) { const int piece = wid + 8 * i, row = RPP * piece + lane / CPR, slot = lane % CPR;
        const int kch = WIDE ? (slot ^ (row & 15)) : (slot ^ ((row >> 1) & 7));
        const int vch = ((((slot >> 2) ^ (WIDE ? (row & 3) : ((row >> 1) & 1))) << 2) | (slot & 3));
        kso[i] = (unsigned)(row * PITCH + up.kcol + kch * 8); vso[i] = (unsigned)(row * PITCH + up.vcol + vch * 8); }
    const bf16_t* Pb = P + rowbase * PITCH;
#define ATT_DMA2(pb_, dk_, dv_, t, sg) do { const bf16_t* tb_ = (pb_) + (size_t)(t) * 64 * PITCH; \
    _Pragma("unroll") for (int i_ = 0; i_ < NP; ++i_) { \
        __builtin_amdgcn_global_load_lds((const unsigned*)(tb_ + (kso[i_] + (dk_))), (ATT_LAS unsigned*)(lds + (sg) * STG + (wid + 8 * i_) * 1024), 16, 0, 0); \
        __builtin_amdgcn_global_load_lds((const unsigned*)(tb_ + (vso[i_] + (dv_))), (ATT_LAS unsigned*)(lds + (sg) * STG + TILEB + (wid + 8 * i_) * 1024), 16, 0, 0); } } while (0)
#define ATT_DMA(t, sg) ATT_DMA2(Pb, 0u, 0u, t, sg)
    const int rot = prefetched ? 2 : 0;
    bf16x8 qr[4];
    { const bf16_t* qp = P + (rowbase + q) * PITCH + up.qcol + hi * 8;
#pragma unroll
      for (int d0 = 0; d0 < 4; ++d0) qr[d0] = *(const bf16x8*)(qp + d0 * 16); }
    if (!prefetched) {
#pragma unroll
        for (int j = 0; j < 2; ++j) if (up.T0 + j <= up.T1) ATT_DMA(up.T0 + j, j); }
    f32x16 o[NEB];
#pragma unroll
    for (int e = 0; e < NEB; ++e)
#pragma unroll
        for (int r = 0; r < 16; ++r) o[e][r] = 0.f;
    float mhat = up.l_init != 0.f ? up.m_init + up.slope2 * (float)q : 0.f, l = hi == 0 ? up.l_init : 0.f;
    float cb[16];
#pragma unroll
    for (int r = 0; r < 16; ++r) cb[r] = up.slope2 * (float)((r & 3) + 8 * (r >> 2));
    int kad[4];
#pragma unroll
    for (int d0 = 0; d0 < 4; ++d0) { const int c = (up.kofs >> 4) + 2 * d0 + hi; kad[d0] = r32 * ROWB + ((WIDE ? (c ^ (r32 & 15)) : (c ^ ((r32 >> 1) & 7))) << 4); }
    const int i16 = lane & 15, q4 = i16 >> 2, vsw = WIDE ? q4 : (q4 >> 1);
    const int vlane = TILEB + (4 * hi + q4) * ROWB + 32 * ((lane >> 4) & 1) + 8 * (i16 & 3);
    int vad[NEB];
#pragma unroll
    for (int e = 0; e < NEB; ++e) vad[e] = vlane + ((e ^ vsw) << 6);
    bf16x8 pa[4];
#define ATT_PV(sgi) do { ATT_LAS const char* Sv_ = lds + (sgi) * STG; \
    _Pragma("unroll") for (int e = 0; e < NEB; ++e) _Pragma("unroll") for (int ks = 0; ks < 4; ++ks) { \
        const s16x4 lo = vtr(Sv_ + vad[e] + ks * 16 * ROWB), hh = vtr(Sv_ + vad[e] + ks * 16 * ROWB + 8 * ROWB); \
        const bf16x8 vf = {lo[0], lo[1], lo[2], lo[3], hh[0], hh[1], hh[2], hh[3]}; \
        o[e] = __builtin_amdgcn_mfma_f32_32x32x16_bf16(vf, pa[ks], o[e], 0, 0, 0); } } while (0)
    for (int t = up.T0; t <= up.T1 + 1; ++t) {
        const int sg = (t - up.T0 + rot) & (NSTG - 1);
        if (t + 1 <= up.T1) { if (NI == 4) asm volatile("s_waitcnt vmcnt(4) lgkmcnt(0)" ::: "memory"); else asm volatile("s_waitcnt vmcnt(2) lgkmcnt(0)" ::: "memory"); }
        else asm volatile("s_waitcnt vmcnt(0) lgkmcnt(0)" ::: "memory");
        __builtin_amdgcn_s_barrier();
        asm volatile("" ::: "memory");
        if (t + 2 <= up.T1) ATT_DMA(t + 2, (sg + 2) & (NSTG - 1));
        if (g == 1 && t - 1 >= up.tlo && t - 1 <= up.thi && t - 1 >= up.T0) ATT_PV((sg + NSTG - 1) & (NSTG - 1));
        if (t >= up.tlo && t <= up.thi && t <= up.T1) {
            ATT_LAS const char* Sb = lds + sg * STG;
            f32x16 p0, p1;
            { const float base0 = up.slope2 * (float)(64 * t + 4 * hi) - mhat, base1 = base0 + 32.f * up.slope2;
#pragma unroll
              for (int r = 0; r < 16; ++r) { p0[r] = cb[r] + base0; p1[r] = cb[r] + base1; } }
#pragma unroll
            for (int d0 = 0; d0 < 4; ++d0) {
                const bf16x8 k0 = *(ATT_LAS const bf16x8*)(Sb + kad[d0]), k1 = *(ATT_LAS const bf16x8*)(Sb + kad[d0] + 32 * ROWB);
                p0 = __builtin_amdgcn_mfma_f32_32x32x16_bf16(k0, qr[d0], p0, 0, 0, 0);
                p1 = __builtin_amdgcn_mfma_f32_32x32x16_bf16(k1, qr[d0], p1, 0, 0, 0);
            }
            if (up.maskall || t == up.thi) {
                const int kvb = 64 * t + 4 * hi, qlo = q - up.window;
#pragma unroll
                for (int r = 0; r < 16; ++r) { const int kv = kvb + (r & 3) + 8 * (r >> 2);
                    if (kv > q || kv <= qlo) p0[r] = -INFINITY;
                    if (kv + 32 > q || kv + 32 <= qlo) p1[r] = -INFINITY; }
            }
            float ra = fmaxf(fmaxf(p0[0], p0[1]), p1[0]), rb = fmaxf(fmaxf(p0[2], p0[3]), p1[1]); ra = fmaxf(fmaxf(ra, p1[2]), p1[3]);
#pragma unroll
            for (int r = 4; r < 16; r += 4) { ra = fmaxf(fmaxf(ra, p0[r]), p0[r + 1]); rb = fmaxf(fmaxf(rb, p0[r + 2]), p0[r + 3]); ra = fmaxf(fmaxf(ra, p1[r]), p1[r + 1]); rb = fmaxf(fmaxf(rb, p1[r + 2]), p1[r + 3]); }
            const float rm = swapmax(fmaxf(ra, rb));
            if (__any(rm > 8.f)) {
                const float dl = fmaxf(rm, 0.f), alpha = __builtin_amdgcn_exp2f(-dl);
                mhat += dl; l *= alpha;
#pragma unroll
                for (int r = 0; r < 16; ++r) { p0[r] -= dl; p1[r] -= dl; }
#pragma unroll
                for (int e = 0; e < NEB; ++e)
#pragma unroll
                    for (int r = 0; r < 16; ++r) o[e][r] *= alpha;
            }
            float ps = 0.f;
#pragma unroll
            for (int r = 0; r < 16; ++r) { p0[r] = __builtin_amdgcn_exp2f(p0[r]); p1[r] = __builtin_amdgcn_exp2f(p1[r]); ps += p0[r] + p1[r]; }
            l += ps;
#pragma unroll
            for (int s = 0; s < 2; ++s) {
                u32x4 w0, w1;
                w0.x = cvtpk(p0[8 * s + 0], p0[8 * s + 1]); w0.y = cvtpk(p0[8 * s + 2], p0[8 * s + 3]); w0.z = cvtpk(p0[8 * s + 4], p0[8 * s + 5]); w0.w = cvtpk(p0[8 * s + 6], p0[8 * s + 7]);
                w1.x = cvtpk(p1[8 * s + 0], p1[8 * s + 1]); w1.y = cvtpk(p1[8 * s + 2], p1[8 * s + 3]); w1.z = cvtpk(p1[8 * s + 4], p1[8 * s + 5]); w1.w = cvtpk(p1[8 * s + 6], p1[8 * s + 7]);
                pa[s] = __builtin_bit_cast(bf16x8, w0); pa[2 + s] = __builtin_bit_cast(bf16x8, w1);
            }
            if (g == 0) ATT_PV(sg);
        }
    }
#undef ATT_PV
    asm volatile("s_waitcnt vmcnt(0) lgkmcnt(0)" ::: "memory");
    __builtin_amdgcn_s_barrier();
    asm volatile("" ::: "memory");
    if (has_next) {
        const bf16_t* Pn = P + (size_t)nb * SEQ * PITCH; const unsigned dk = (unsigned)(nkcol - up.kcol), dv = (unsigned)(nvcol - up.vcol);
#pragma unroll
        for (int j = 0; j < 2; ++j) if (nT0 + j <= nT1) ATT_DMA2(Pn, dk, dv, nT0 + j, 2 + j);
    }
#undef ATT_DMA
#undef ATT_DMA2
    const float lt = swapsum(l), inv = 1.f / lt;
    if (!diff) {
        bf16_t* op = MIX + (rowbase + q) * OPITCH + up.ocol + 4 * hi;
#pragma unroll
        for (int e = 0; e < NEB; ++e)
#pragma unroll
            for (int r4 = 0; r4 < 4; ++r4) { u32x2 w; w.x = cvtpk(o[e][4 * r4] * inv, o[e][4 * r4 + 1] * inv); w.y = cvtpk(o[e][4 * r4 + 2] * inv, o[e][4 * r4 + 3] * inv);
                *(u32x2*)(op + e * 32 + 8 * r4) = w; }
    } else {
        ATT_LAS float* xb = (ATT_LAS float*)(lds + wq * (NEB * 16 * 64 * 4)) + lane;
        if (g == 1) { const float sc = lam * inv;
#pragma unroll
            for (int e = 0; e < NEB; ++e)
#pragma unroll
                for (int r = 0; r < 16; ++r) xb[(e * 16 + r) * 64] = o[e][r] * sc; }
        __syncthreads();
        if (g == 0) { float ss = 0.f;
#pragma unroll
            for (int e = 0; e < NEB; ++e)
#pragma unroll
                for (int r = 0; r < 16; ++r) { const float d = o[e][r] * inv - xb[(e * 16 + r) * 64]; o[e][r] = d; ss += d * d; }
            ss = swapsum(ss);
            const float rs = rsqrtf(ss * (1.f / DV) + 1e-5f) * 0.8f;
            bf16_t* op = MIX + (rowbase + q) * OPITCH + up.ocol + 4 * hi;
#pragma unroll
            for (int e = 0; e < NEB; ++e)
#pragma unroll
                for (int r4 = 0; r4 < 4; ++r4) { const f32x4 wv = *(const f32x4*)(subln_w + e * 32 + 8 * r4 + 4 * hi);
                    u32x2 w; w.x = cvtpk(o[e][4 * r4] * rs * wv[0], o[e][4 * r4 + 1] * rs * wv[1]); w.y = cvtpk(o[e][4 * r4 + 2] * rs * wv[2], o[e][4 * r4 + 3] * rs * wv[3]);
                    *(u32x2*)(op + e * 32 + 8 * r4) = w; } }
    }
}
}
constexpr int NWAVES = 8;
#ifndef P4_ALIGN
#define P4_ALIGN true
#endif
#ifndef WGM_P1
#define WGM_P1 4
#endif
#ifndef WGM_P3
#define WGM_P3 4
#endif
#ifndef WGM_P4
#define WGM_P4 8
#endif
#ifndef WGM_P5
#define WGM_P5 4
#endif
#ifndef FUSE_FINAL
#define FUSE_FINAL 0
#endif
#ifndef GEMM_SP2
#define GEMM_SP2 true
#endif
#ifndef MK_N_LAUNCHES
#define MK_N_LAUNCHES 1
#endif
constexpr int N_PHASES = 7;
constexpr int BATCH = 8, SEQ = 2048, D = 2048, M = BATCH * SEQ, INC = 4608, DFF = 5632, NGU = 2 * DFF;
constexpr float RMS_EPS = 1e-5f;
constexpr float QSCALE2 = 0.125f * 1.4426950408889634f;
constexpr size_t MiB = 1u << 20;
constexpr size_t WS_PART1 = 1 * MiB, WS_PART2 = 3 * MiB;
constexpr size_t WS_WIN = 8 * MiB, WS_WOUT = 26 * MiB, WS_WGU = 34 * MiB, WS_WDN = 78 * MiB;
constexpr size_t WS_XN = 100 * MiB;
constexpr size_t WS_PROJ = 164 * MiB, WS_MIX = 308 * MiB;
constexpr size_t WS_H = 164 * MiB;
constexpr size_t WS_END = 372 * MiB;
static_assert(WS_H + (size_t)M * DFF * 2 <= WS_END && WS_MIX + (size_t)M * D * 2 <= WS_END && WS_PROJ + (size_t)M * INC * 2 <= WS_MIX, "ws map");
constexpr int RING_BYTES = 131072, LDS_BYTES = 147456;

#define LAS __attribute__((address_space(3)))
typedef unsigned short bf16;
typedef unsigned v4u __attribute__((ext_vector_type(4)));
typedef float f32x4 __attribute__((ext_vector_type(4)));
__device__ __forceinline__ unsigned pk2(float lo, float hi) { return pg8::cvt_pk_bf16(lo, hi); }
__device__ __forceinline__ float wave_sum(float v) {
#pragma unroll
    for (int o = 1; o < 64; o <<= 1) v += __shfl_xor(v, o);
    return v;
}
template <int NB> __device__ __forceinline__ void transpose_item(const float* __restrict__ W, int K, int N, bf16* __restrict__ WT, int dst_row0, const float* __restrict__ kscale, float cscale, LAS float* scr, int k0, int n0, int lane) {
    const float* src = W + (size_t)(k0 + (lane >> 4)) * N + n0 + 4 * (lane & 15);
#pragma unroll
    for (int b = 0; b < 16 / NB; ++b) {
        f32x4 v[NB];
#pragma unroll
        for (int i = 0; i < NB; ++i) v[i] = *(const f32x4*)(src + (size_t)(4 * (b * NB + i)) * N);
#pragma unroll
        for (int i = 0; i < NB; ++i) { const int kk = 4 * (b * NB + i) + (lane >> 4); float sc = cscale; if (kscale) sc *= kscale[k0 + kk];
            LAS float* d = scr + kk * 65 + 4 * (lane & 15); d[0] = v[i].x * sc; d[1] = v[i].y * sc; d[2] = v[i].z * sc; d[3] = v[i].w * sc; }
        if (NB < 16) asm volatile("" ::: "memory");
    }
    asm volatile("s_waitcnt lgkmcnt(0)" ::: "memory");
    const int c = lane & 7;
#pragma unroll
    for (int j = 0; j < 8; ++j) { const int n = (lane >> 3) + 8 * j; const LAS float* s = scr + (8 * c) * 65 + n;
        v4u o; o.x = pk2(s[0 * 65], s[1 * 65]); o.y = pk2(s[2 * 65], s[3 * 65]); o.z = pk2(s[4 * 65], s[5 * 65]); o.w = pk2(s[6 * 65], s[7 * 65]);
        *(v4u*)(WT + (size_t)(dst_row0 + n) * K + k0 + 8 * c) = o; }
    asm volatile("s_waitcnt lgkmcnt(0)" ::: "memory");
}

#define XB_TMO      128
#define XB_XCNT(j)  (256  + 64 * (j))
#define XB_XSUB(j)  (1280 + 64 * (j))
#define XB_XGEN(j)  (2304 + 64 * (j))
#define XB_TOP      3328
#define XB_TOPGEN   3392
#define XCD_BAR_WORDS 3456
#define XB_SPIN_CAP (1u << 18)

__device__ __forceinline__ unsigned xb_ld(unsigned* p)              { return __hip_atomic_load(p, __ATOMIC_RELAXED, __HIP_MEMORY_SCOPE_AGENT); }
__device__ __forceinline__ unsigned xb_add(unsigned* p, unsigned v) { return __hip_atomic_fetch_add(p, v, __ATOMIC_RELAXED, __HIP_MEMORY_SCOPE_AGENT); }
__device__ __forceinline__ unsigned xb_xcc_id() { return (unsigned)__builtin_amdgcn_s_getreg((3 << 11) | 20) & 0xFu; }
#define XB_SPIN(cond, bar) do { unsigned _sp = 0; while (cond) { __builtin_amdgcn_s_sleep(1); \
    if ((++_sp & 255u) == 0u) { if (xb_ld(&(bar)[XB_TMO])) break; if (_sp > XB_SPIN_CAP) { atomicAdd(&(bar)[XB_TMO], 1u); break; } } } } while (0)

struct XcdBarrier {
    unsigned* bar; unsigned x;
    volatile LAS unsigned* st;
};

__device__ __forceinline__ XcdBarrier xcd_barrier_post(unsigned* bar, volatile LAS unsigned* st) {
    XcdBarrier b; b.bar = bar; b.x = xb_xcc_id(); b.st = st;
    if (threadIdx.x == 0) (void)xb_add(&bar[XB_XCNT(b.x)], 1u);
    return b;
}
__device__ __forceinline__ void xcd_barrier_complete(unsigned* bar, unsigned x, unsigned& nloc, unsigned& nx) {
    const unsigned G = gridDim.x * gridDim.y * gridDim.z;
    unsigned sum, cnt, mine, sp = 0u;
    for (;;) {
        sum = 0u; cnt = 0u; mine = 0u;
#pragma unroll
        for (unsigned j = 0; j < 16; ++j) { const unsigned c = xb_ld(&bar[XB_XCNT(j)]); sum += c; cnt += (c > 0u) ? 1u : 0u; mine = (j == x) ? c : mine; }
        if (sum == G) break;
        __builtin_amdgcn_s_sleep(1);
        if ((++sp & 255u) == 0u) { if (xb_ld(&bar[XB_TMO])) break; if (sp > XB_SPIN_CAP) { atomicAdd(&bar[XB_TMO], 1u); break; } }
    }
    nloc = mine > 0u ? mine : 1u; nx = cnt > 0u ? cnt : 1u;
}

__device__ __forceinline__ void xcd_barrier(const XcdBarrier& b) {
    asm volatile("s_waitcnt vmcnt(0)" ::: "memory");
    __syncthreads();
    if (threadIdx.x == 0) {
        unsigned* bar = b.bar;
        __builtin_amdgcn_s_waitcnt(0);
        unsigned nloc = b.st[0], nx = b.st[1];
        if (nloc == 0u) { xcd_barrier_complete(bar, b.x, nloc, nx); b.st[0] = nloc; b.st[1] = nx; }
        const unsigned old = xb_add(&bar[XB_XSUB(b.x)], 1u);
        const unsigned gen = old / nloc;
        if (old + 1u == (gen + 1u) * nloc) {
            __builtin_amdgcn_fence(__ATOMIC_RELEASE, "agent");
            asm volatile("s_waitcnt vmcnt(0)" ::: "memory");
            const unsigned og = xb_add(&bar[XB_TOP], 1u);
            const unsigned tg = og / nx;
            if (og + 1u == (tg + 1u) * nx) xb_add(&bar[XB_TOPGEN], 1u);
            else XB_SPIN(xb_ld(&bar[XB_TOPGEN]) == tg, bar);
            __builtin_amdgcn_fence(__ATOMIC_ACQUIRE, "agent");
            xb_add(&bar[XB_XGEN(b.x)], 1u);
            asm volatile("s_waitcnt vmcnt(0)" ::: "memory");
        } else {
            XB_SPIN(xb_ld(&bar[XB_XGEN(b.x)]) == gen, bar);
            __builtin_amdgcn_fence(__ATOMIC_ACQUIRE, "agent");
            asm volatile("s_waitcnt vmcnt(0)" ::: "memory");
        }
    }
    __syncthreads();
}

struct PrefetchOrder {
    pg8::StaticOrder S; const char* base; unsigned row_bytes, tile_bytes; LAS unsigned char* dump;
    __device__ __forceinline__ bool next(int i, pg8::Unit& u) const { return S.next(i, u); }
    __device__ __forceinline__ void done(const pg8::Unit&) const {}
    __device__ __forceinline__ void a_ready(const pg8::Unit& u) const {
        const int tid = threadIdx.x, wid = __builtin_amdgcn_readfirstlane(tid >> 6); const unsigned lpr = tile_bytes >> 7, nline = 256u * lpr;
        const char* tb = base + (size_t)u.pm * 256 * row_bytes + (size_t)u.pn * tile_bytes;
        for (unsigned line = tid; line < nline; line += 512) { const unsigned r = line / lpr, l = line % lpr;
            __builtin_amdgcn_global_load_lds((const unsigned*)(tb + (size_t)r * row_bytes + l * 128), (LAS unsigned*)(dump + wid * 256), 4, 0, 0); }
    }
};
struct TwiceOrder { pg8::StaticOrder S; __device__ bool next(int i, pg8::Unit& u) const { return S.next(i >> 1, u); } __device__ __forceinline__ void a_ready(const pg8::Unit&) const {} __device__ __forceinline__ void done(const pg8::Unit&) const {} };
struct Args { const float* in[15]; float* out; unsigned char* ws; int ph_lo, ph_hi; };
enum { I_X = 0, I_ANW, I_WIN, I_LQ1, I_LK1, I_LQ2, I_LK2, I_SUBLN, I_SINKS, I_WOUT, I_FNW, I_WG, I_WU, I_WD, I_FINW };

__device__ __forceinline__ void item_kn(int r, int nblk_n, int& k0, int& n0) { const int g8 = r >> 3, w = r & 7, hn = nblk_n >> 1; n0 = 64 * (2 * (g8 % hn) + (w & 1)); k0 = 64 * (4 * (g8 / hn) + (w >> 1)); }
#ifndef CV_SPLIT
#define CV_SPLIT 0
#endif
#ifndef CV_SA
#define CV_SA 48
#endif
constexpr int CV_IN = (D / 64) * (INC / 64), CV_OUT = (D / 64) * (D / 64), CV_G = (D / 64) * (DFF / 64), CV_DN = (DFF / 64) * (D / 64), CV_ALL = CV_IN + CV_OUT + 2 * CV_G + CV_DN, CV_T0 = CV_IN + CV_OUT, CV_T1 = CV_T0 + CV_G;
template <int NB> __device__ __forceinline__ void convert_weights(const Args& args, unsigned char* ws, LAS float* scr, int first, int last, int skip0, int skip1, int widx, int nw, int lane) {
    bf16* Win_t = (bf16*)(ws + WS_WIN); bf16* Wout_t = (bf16*)(ws + WS_WOUT); bf16* Wgu_t = (bf16*)(ws + WS_WGU); bf16* Wdn_t = (bf16*)(ws + WS_WDN);
    for (int it = first + widx; it < last - (skip1 - skip0); it += nw) {
        int r = it; if (r >= skip0) r += skip1 - skip0;
        if (r < CV_IN) { int k0, n0; item_kn(r, INC / 64, k0, n0); const float cs = (n0 < 1024 || (n0 >= 3072 && n0 < 4096)) ? QSCALE2 : 1.f;
            transpose_item<NB>(args.in[I_WIN], D, INC, Win_t, n0, nullptr, cs, scr, k0, n0, lane); continue; } r -= CV_IN;
        if (r < CV_OUT) { int k0, n0; item_kn(r, D / 64, k0, n0); transpose_item<NB>(args.in[I_WOUT], D, D, Wout_t, n0, nullptr, 1.f, scr, k0, n0, lane); continue; } r -= CV_OUT;
        if (r < 2 * CV_G) { const int up = r >= CV_G; if (up) r -= CV_G; int k0, n0; item_kn(r, DFF / 64, k0, n0);
            transpose_item<NB>(args.in[up ? I_WU : I_WG], D, DFF, Wgu_t, 256 * (n0 / 128) + 128 * up + (n0 % 128), args.in[I_FNW], 1.f, scr, k0, n0, lane); continue; } r -= 2 * CV_G;
        { int k0, n0; item_kn(r, D / 64, k0, n0); transpose_item<NB>(args.in[I_WD], DFF, D, Wdn_t, n0, nullptr, 1.f, scr, k0, n0, lane); }
    }
}

struct CvItem { const float* src; bf16* dst; const float* kscale; float cscale; int N, K; };
__device__ __forceinline__ bool cv_decode(const Args& args, unsigned char* ws, int r, int last, int lane, CvItem& it) {
    if (r >= last) return false;
    bf16* Win_t = (bf16*)(ws + WS_WIN); bf16* Wout_t = (bf16*)(ws + WS_WOUT); bf16* Wgu_t = (bf16*)(ws + WS_WGU); bf16* Wdn_t = (bf16*)(ws + WS_WDN);
    int k0, n0, row0; const float* W; bf16* WT; it.kscale = nullptr; it.cscale = 1.f;
    if (r < CV_IN) { item_kn(r, INC / 64, k0, n0); W = args.in[I_WIN]; WT = Win_t; it.N = INC; it.K = D; row0 = n0; it.cscale = (n0 < 1024 || (n0 >= 3072 && n0 < 4096)) ? QSCALE2 : 1.f; }
    else if ((r -= CV_IN) < CV_OUT) { item_kn(r, D / 64, k0, n0); W = args.in[I_WOUT]; WT = Wout_t; it.N = D; it.K = D; row0 = n0; }
    else if ((r -= CV_OUT) < 2 * CV_G) { const int up = r >= CV_G; if (up) r -= CV_G; item_kn(r, DFF / 64, k0, n0); W = args.in[up ? I_WU : I_WG]; WT = Wgu_t; it.N = DFF; it.K = D; row0 = 256 * (n0 / 128) + 128 * up + (n0 % 128); it.kscale = args.in[I_FNW] + k0; }
    else { r -= 2 * CV_G; item_kn(r, D / 64, k0, n0); W = args.in[I_WD]; WT = Wdn_t; it.N = D; it.K = DFF; row0 = n0; }
    it.src = W + (size_t)(k0 + (lane >> 4)) * it.N + n0 + 4 * (lane & 15);
    it.dst = WT + (size_t)row0 * it.K + k0;
    return true;
}
__device__ __forceinline__ void cv_load(const CvItem& it, f32x4 (&v)[16]) {
#pragma unroll
    for (int i = 0; i < 16; ++i) v[i] = *(const f32x4*)(it.src + (size_t)(4 * i) * it.N);
}
__device__ __forceinline__ void cv_finish(const CvItem& it, const f32x4 (&v)[16], LAS float* scr, int lane) {
#pragma unroll
    for (int i = 0; i < 16; ++i) { const int kk = 4 * i + (lane >> 4); float sc = it.cscale; if (it.kscale) sc *= it.kscale[kk];
        LAS float* d = scr + kk * 65 + 4 * (lane & 15); d[0] = v[i].x * sc; d[1] = v[i].y * sc; d[2] = v[i].z * sc; d[3] = v[i].w * sc; }
    asm volatile("s_waitcnt lgkmcnt(0)" ::: "memory");
    const int c = lane & 7;
#pragma unroll
    for (int j = 0; j < 8; ++j) { const int n = (lane >> 3) + 8 * j; const LAS float* s = scr + (8 * c) * 65 + n;
        v4u o; o.x = pk2(s[0 * 65], s[1 * 65]); o.y = pk2(s[2 * 65], s[3 * 65]); o.z = pk2(s[4 * 65], s[5 * 65]); o.w = pk2(s[6 * 65], s[7 * 65]);
        *(v4u*)(it.dst + (size_t)n * it.K + 8 * c) = o; }
    asm volatile("s_waitcnt lgkmcnt(0)" ::: "memory");
}
__device__ __forceinline__ void convert_weights_pipe(const Args& args, unsigned char* ws, LAS float* scr, int first, int last, int widx, int nw, int lane) {
    CvItem ia, ib; f32x4 va[16], vb[16];
    int r = first + widx;
    bool ha = cv_decode(args, ws, r, last, lane, ia); if (ha) cv_load(ia, va);
    while (ha) {
        const bool hb = cv_decode(args, ws, r + nw, last, lane, ib); if (hb) cv_load(ib, vb);
        cv_finish(ia, va, scr, lane);
        if (!hb) break;
        r += 2 * nw;
        ha = cv_decode(args, ws, r, last, lane, ia); if (ha) cv_load(ia, va);
        cv_finish(ib, vb, scr, lane);
    }
}

__global__ void __launch_bounds__(NWAVES * 64, 2) hymba_fwd(Args args) {
    extern __shared__ __attribute__((aligned(16))) unsigned char lds_raw[];
    cg::grid_group grid = cg::this_grid();
    LAS unsigned char* lds = (LAS unsigned char*)lds_raw;
    const int tid = threadIdx.x, lane = tid & 63, wave = __builtin_amdgcn_readfirstlane(tid >> 6);
    const int G = gridDim.x, bx = blockIdx.x, vcu = (G % 8 == 0) ? (bx % 8) * (G / 8) + bx / 8 : bx;
    unsigned char* ws = args.ws;
    const float* x = args.in[I_X]; float* out = args.out;
    bf16* Win_t = (bf16*)(ws + WS_WIN); bf16* Wout_t = (bf16*)(ws + WS_WOUT); bf16* Wgu_t = (bf16*)(ws + WS_WGU); bf16* Wdn_t = (bf16*)(ws + WS_WDN);
    bf16* XN = (bf16*)(ws + WS_XN); bf16* PROJ = (bf16*)(ws + WS_PROJ); bf16* MIX = (bf16*)(ws + WS_MIX); bf16* HB = (bf16*)(ws + WS_H);
    float* part1 = (float*)(ws + WS_PART1); float* part2 = (float*)(ws + WS_PART2);
    const int lo = args.ph_lo, hi = args.ph_hi;
    volatile LAS unsigned* bst = (volatile LAS unsigned*)(lds + LDS_BYTES - 64);
    if (tid < 2) bst[tid] = 0u;
    if (tid == 0) { *(LAS unsigned long long*)(lds + LDS_BYTES - 32) = 0ull; }
    __syncthreads();
    XcdBarrier gbar; gbar.bar = (unsigned*)ws; gbar.x = 0; gbar.st = bst;
    if (hi - lo > 1) gbar = xcd_barrier_post((unsigned*)ws, bst);
    if (hi > 1000) grid.sync();
#define IN(k) (lo <= (k) && (k) < hi)
#ifndef SYNC_REPEAT
#define SYNC_REPEAT 1
#endif
#define SEAM(k) do { if (IN(k) && IN((k) + 1)) { for (int sr_ = 0; sr_ < SYNC_REPEAT; ++sr_) xcd_barrier(gbar); } } while (0)
#ifndef PROBE_PHASE
#define PROBE_PHASE -1
#endif
#ifndef STAMP_SEL
#define STAMP_SEL 1
#endif
#ifdef STAMP_PHASE
#define STAMP_BEGIN(k) do { if ((k) == STAMP_PHASE || ((k) == 2 && (STAMP_PHASE == 30 || STAMP_PHASE == 31))) st0_ = __builtin_amdgcn_s_memrealtime(); } while (0)
#define STAMP_END(k) do { if ((k) == STAMP_PHASE) st1_ = __builtin_amdgcn_s_memrealtime(); } while (0)
#else
#define STAMP_BEGIN(k) do {} while (0)
#define STAMP_END(k) do {} while (0)
#endif
    unsigned long long st0_ = 0, st1_ = 0; (void)st0_; (void)st1_;
#define REP(k) for (int rep_ = 0; rep_ < ((PROBE_PHASE == (k)) ? 2 : 1); ++rep_, ((PROBE_PHASE == (k)) && rep_ < 2 ? (xcd_barrier(gbar), 0) : 0))

    STAMP_BEGIN(0); STAMP_BEGIN(41);
    REP(0) if (IN(0)) {
        LAS float* scr = (LAS float*)(lds + wave * 16640);
        const int gw = vcu * NWAVES + wave, NGW = G * NWAVES;
#if defined(P0_TOUCH) && P0_TOUCH
        {
            const int widx[5] = {I_WIN, I_WOUT, I_WG, I_WU, I_WD}; const size_t wn4[5] = {(size_t)D * INC / 4, (size_t)D * D / 4, (size_t)D * DFF / 4, (size_t)D * DFF / 4, (size_t)DFF * D / 4};
            f32x4 acc4 = {0.f, 0.f, 0.f, 0.f};
#pragma unroll
            for (int w = 0; w < 5; ++w) { const f32x4* src = (const f32x4*)args.in[widx[w]];
                for (size_t i = (size_t)gw * 64 + lane; i < wn4[w]; i += (size_t)NGW * 64 * 4) {
                    f32x4 a = src[i], b = (i + (size_t)NGW * 64 < wn4[w]) ? src[i + (size_t)NGW * 64] : acc4, c = (i + (size_t)NGW * 128 < wn4[w]) ? src[i + (size_t)NGW * 128] : acc4, d = (i + (size_t)NGW * 192 < wn4[w]) ? src[i + (size_t)NGW * 192] : acc4;
                    acc4 = acc4 + a + b + c + d; } }
            if (acc4.x + acc4.y + acc4.z + acc4.w == 1.2345e38f) ((float*)(ws + WS_PART2))[gw * 64 + lane] = acc4.x;
        }
#endif
#if defined(CV_PIPE) && CV_PIPE
        convert_weights_pipe(args, ws, scr, 0, CV_SPLIT ? CV_IN : CV_ALL, gw, NGW, lane);
#else
        convert_weights<16>(args, ws, scr, 0, CV_SPLIT ? CV_ALL - 128 * CV_SA : CV_ALL, 0, 0, gw, NGW, lane);
#endif
        STAMP_BEGIN(40); __syncthreads(); STAMP_END(41);
        const f32x4* wn = (const f32x4*)args.in[I_ANW] + lane;
        for (int rp_ = 0; rp_ < (PROBE_PHASE == 11 ? 2 : 1); ++rp_)
        for (int m = gw; m < M; m += NGW) {
            const f32x4* xr = (const f32x4*)(x + (size_t)m * D) + lane;
            f32x4 v[8]; float s = 0.f;
#pragma unroll
            for (int j = 0; j < 8; ++j) { v[j] = xr[64 * j]; s += (v[j].x * v[j].x + v[j].y * v[j].y) + (v[j].z * v[j].z + v[j].w * v[j].w); }
            const float rstd = rsqrtf(wave_sum(s) * (1.f / D) + RMS_EPS);
            unsigned long long* o8 = (unsigned long long*)(XN + (size_t)m * D) + lane;
#pragma unroll
            for (int j = 0; j < 8; ++j) { const f32x4 w = wn[64 * j]; o8[64 * j] = (unsigned long long)pk2(v[j].x * rstd * w.x, v[j].y * rstd * w.y) | ((unsigned long long)pk2(v[j].z * rstd * w.z, v[j].w * rstd * w.w) << 32); }
        }
        __syncthreads();
    }
    SEAM(0);
    STAMP_END(0); STAMP_END(40);
    STAMP_BEGIN(1);
    REP(1) if (IN(1)) {
        pg8::Gemm g{XN, Win_t, M, INC, D}; pg8::StaticOrder S; S.init(M, INC, G, bx, WGM_P1);
        pg8::EpiStore E{PROJ, INC};
#if PROBE_PHASE == 21
        { TwiceOrder S2{S}; pg8::gemm_phase<pg8::EpiStore, TwiceOrder, true, true>(lds, g, S2, E); }
#else
        pg8::gemm_phase<pg8::EpiStore, pg8::StaticOrder, true, GEMM_SP2>(lds, g, S, E);
#endif
        if (CV_SPLIT) { const int nwg = (M / 256) * (INC / 256), maxU = (nwg + G - 1) / G, nIdle = G * maxU - nwg, idx = bx - (G - nIdle);
            const int nw_ = nIdle > 0 ? nIdle : G, id_ = nIdle > 0 ? idx : bx, per = (128 * CV_SA + nw_ - 1) / nw_, f0 = CV_ALL - 128 * CV_SA + id_ * per;
            if (id_ >= 0) convert_weights<8>(args, ws, (LAS float*)(lds + wave * 16640), f0, f0 + per < CV_ALL ? f0 + per : CV_ALL, 0, 0, wave, NWAVES, lane); }
        __syncthreads();
    }
    SEAM(1);
    STAMP_END(1);
    STAMP_BEGIN(2);
    REP(2) if (IN(2)) {
        const float* lq1 = args.in[I_LQ1]; const float* lk1 = args.in[I_LK1]; const float* lq2 = args.in[I_LQ2]; const float* lk2 = args.in[I_LK2];
        const float s1 = wave_sum(lq1[lane] * lk1[lane]), s2 = wave_sum(lq2[lane] * lk2[lane]);
        const float lam = expf(s1) - expf(s2) + 0.2f;
        const int wq = wave & 3, gsel = wave >> 2;
#ifdef ATT_PRIO
        if (gsel == 1) __builtin_amdgcn_s_setprio(1);
#endif
        STAMP_BEGIN(20);
        { const int np = vcu < 512 ? (512 - vcu + G - 1) / G : 0;
#define DIFF_UNIT(u_, up_) do { const int i_ = vcu + G * ((u_) >> 1), bh_ = (i_ >> 3) ^ (((u_) >> 1) & 1 ? 4 : 0)  , xq_ = i_ & 7, h_ = bh_ & 7, qblk_ = ((u_) & 1) ? 15 - xq_ : xq_; \
            up_.b = bh_ >> 3; up_.q0 = 128 * qblk_; up_.qcol = h_ * 128 + gsel * 64; up_.kcol = 1024 + h_ * 128; up_.vcol = 2048 + h_ * 128; up_.kofs = gsel * 128; \
            up_.slope2 = exp2f(-(float)(h_ + 1)) * 1.4426950408889634f; up_.m_init = 0.f; up_.l_init = 0.f; \
            up_.T0 = 0; up_.T1 = 2 * qblk_ + 1; up_.tlo = 0; up_.thi = (up_.q0 + 32 * wq) >> 6; up_.window = 1 << 20; up_.maskall = 0; up_.ocol = h_ * 128; } while (0)
#pragma unroll 1
          for (int u = 0; u < 2 * np; ++u) {
              att::UnitP up, nx; DIFF_UNIT(u, up); const bool hn = u + 1 < 2 * np; if (hn) DIFF_UNIT(u + 1, nx); else nx = up;
              att::attn_unit<128, 128>((LAS char*)lds, PROJ, MIX, up, true, lam, args.in[I_SUBLN], tid, u > 0, hn, nx.b, nx.kcol, nx.vcol, nx.T0, nx.T1);
          }
#undef DIFF_UNIT
        }
        STAMP_END(20); STAMP_BEGIN(21);
        { const int ns = vcu < 1024 ? (1024 - vcu + G - 1) / G : 0;
#define SWA_UNIT(u_, up_) do { const int i_ = vcu + G * (u_), qblk_ = i_ & 15, pair_ = (i_ >> 4) & 1, hkv_ = ((i_ >> 5) + (u_)) & 3, hq_ = hkv_ * 4 + pair_ * 2 + gsel, a_ = 2 * qblk_; \
            up_.b = i_ >> 7; up_.q0 = 128 * qblk_; up_.qcol = 3072 + hq_ * 64; up_.kcol = 4096 + hkv_ * 64; up_.vcol = 4352 + hkv_ * 64; up_.kofs = 0; \
            up_.slope2 = exp2f(-0.5f * (float)(hq_ + 1)) * 1.4426950408889634f; up_.m_init = args.in[I_SINKS][hq_] * 1.4426950408889634f; up_.l_init = 1.f; \
            up_.T0 = a_ - 2 < 0 ? 0 : a_ - 2; up_.T1 = a_ + 1; up_.tlo = a_ - 2 + (wq >> 1); up_.thi = a_ + (wq >> 1); up_.window = 128; up_.maskall = 1; up_.ocol = 1024 + hq_ * 64; } while (0)
#pragma unroll 1
          for (int u = 0; u < ns; ++u) {
              att::UnitP up, nx; SWA_UNIT(u, up); const bool hn = u + 1 < ns; if (hn) SWA_UNIT(u + 1, nx); else nx = up;
              att::attn_unit<64, 64>((LAS char*)lds, PROJ, MIX, up, false, 0.f, nullptr, tid, u > 0, hn, nx.b, nx.kcol, nx.vcol, nx.T0, nx.T1);
          }
#undef SWA_UNIT
        }
        STAMP_END(21);
#ifdef ATT_PRIO
        __builtin_amdgcn_s_setprio(0);
#endif
        __syncthreads();
#ifdef STAMP_PHASE
        if (STAMP_PHASE == 30 || STAMP_PHASE == 31) { if (tid == 0 && STAMP_SEL) { const unsigned d_ = (unsigned)(__builtin_amdgcn_s_memrealtime() - st0_);
            if (STAMP_PHASE == 30) __hip_atomic_fetch_max((unsigned*)ws + 3500, d_, __ATOMIC_RELAXED, __HIP_MEMORY_SCOPE_AGENT); else __hip_atomic_fetch_max((unsigned*)ws + 3500, ~d_, __ATOMIC_RELAXED, __HIP_MEMORY_SCOPE_AGENT) ; } }
#endif
    }
    SEAM(2);
#ifdef STAMP_PHASE
    if (STAMP_PHASE == 30 || STAMP_PHASE == 31) { const unsigned v_ = __hip_atomic_load((unsigned*)ws + 3500, __ATOMIC_RELAXED, __HIP_MEMORY_SCOPE_AGENT); st1_ = st0_ + (STAMP_PHASE == 30 ? v_ : ~v_); }
#endif
    STAMP_END(2);
    STAMP_BEGIN(3);
    REP(3) if (IN(3)) {
        pg8::Gemm g{MIX, Wout_t, M, D, D}; pg8::StaticOrder S; S.init(M, D, G, bx, WGM_P3);
        pg8::EpiResid<false> E{x, XN, part1, D};
        pg8::gemm_phase<pg8::EpiResid<false>, pg8::StaticOrder, true, GEMM_SP2>(lds, g, S, E);
    }
    SEAM(3);
    STAMP_END(3);
    STAMP_BEGIN(4);
    REP(4) if (IN(4)) {
        pg8::Gemm g{XN, Wgu_t, M, NGU, D}; pg8::StaticOrder S; S.init(M, NGU, G, bx, WGM_P4);
        pg8::EpiSwiGLU E{HB, DFF, part1, 1.f / D, RMS_EPS};
#if PROBE_PHASE == 24
        { TwiceOrder S2{S}; pg8::gemm_phase<pg8::EpiSwiGLU, TwiceOrder, true, true>(lds, g, S2, E); }
#else
        pg8::gemm_phase<pg8::EpiSwiGLU, pg8::StaticOrder, P4_ALIGN, GEMM_SP2>(lds, g, S, E);
#endif
    }
    SEAM(4);
    STAMP_END(4);
    STAMP_BEGIN(5);
    REP(5) if (IN(5)) {
        pg8::Gemm g{HB, Wdn_t, M, D, DFF}; pg8::StaticOrder S; S.init(M, D, G, bx, WGM_P5);
#if FUSE_FINAL
        pg8::EpiFinal E{XN, out, args.in[I_FINW], part2, (unsigned*)ws + 4096, lds + RING_BYTES, D, 1.f / D, RMS_EPS};
        pg8::gemm_phase<pg8::EpiFinal, pg8::StaticOrder, true, GEMM_SP2>(lds, g, S, E);
#else
        pg8::EpiResid<true> E{XN, XN, part2, D};
        pg8::gemm_phase<pg8::EpiResid<true>, pg8::StaticOrder, true, GEMM_SP2>(lds, g, S, E);
#endif
    }
#if !FUSE_FINAL
    SEAM(5);
#endif
    STAMP_END(5);
    STAMP_BEGIN(6);
    REP(6) if (IN(6) && !FUSE_FINAL) {
        const int gw = vcu * NWAVES + wave, NGW = G * NWAVES;
        const f32x4* wn = (const f32x4*)args.in[I_FINW] + 2 * lane;
        for (int m = gw; m < M; m += NGW) {
            const float s = wave_sum(lane < 32 ? part2[(size_t)m * 32 + lane] : 0.f);
            const float rstd = rsqrtf(s * (1.f / D) + RMS_EPS);
            const v4u* xr = (const v4u*)(XN + (size_t)m * D) + lane; f32x4* orow = (f32x4*)(out + (size_t)m * D) + 2 * lane;
#pragma unroll
            for (int j = 0; j < 4; ++j) { const v4u w = xr[64 * j]; const f32x4 w0 = wn[128 * j], w1 = wn[128 * j + 1];
                const f32x4 a = {__uint_as_float(w.x << 16), __uint_as_float(w.x & 0xffff0000u), __uint_as_float(w.y << 16), __uint_as_float(w.y & 0xffff0000u)};
                const f32x4 b = {__uint_as_float(w.z << 16), __uint_as_float(w.z & 0xffff0000u), __uint_as_float(w.w << 16), __uint_as_float(w.w & 0xffff0000u)};
                __builtin_nontemporal_store(a * rstd * w0, orow + 128 * j); __builtin_nontemporal_store(b * rstd * w1, orow + 128 * j + 1); }
        }
    }
#ifdef ATT_TIMER
    if (bx == 0) { __syncthreads(); if (tid == 0) { const unsigned long long dt = *(LAS unsigned long long*)(lds + LDS_BYTES - 32), te = __builtin_amdgcn_s_memtime(); while (__builtin_amdgcn_s_memtime() - te < dt) __builtin_amdgcn_s_sleep(32); } }
#endif
#ifdef STAMP_PHASE
    if (STAMP_PHASE == 6) { __syncthreads(); st1_ = __builtin_amdgcn_s_memrealtime(); }
    if (bx == 0 && tid == 0) { const unsigned long long te = __builtin_amdgcn_s_memrealtime(), dt = st1_ - st0_; while (__builtin_amdgcn_s_memrealtime() - te < dt) __builtin_amdgcn_s_sleep(32); }
#endif
#undef IN
#undef SEAM
}

extern "C" void kernel_launch(void* const* d_in, const int* in_sizes, int n_in, void* d_out, int out_size, void* d_ws, size_t ws_size, hipStream_t stream) {
    static int grid = 0;
    if (grid == 0) {
        if (n_in != 15 || out_size != M * D || ws_size < WS_END) { fprintf(stderr, "kernel_launch: unexpected shapes (n_in %d out %d ws %zu)\n", n_in, out_size, ws_size); grid = -1; return; }
        int dev = 0, cus = 0, per_cu = 0;
        hipGetDevice(&dev); hipDeviceGetAttribute(&cus, hipDeviceAttributeMultiprocessorCount, dev);
        if (hipFuncSetAttribute((const void*)hymba_fwd, hipFuncAttributeMaxDynamicSharedMemorySize, LDS_BYTES) != hipSuccess) { fprintf(stderr, "kernel_launch: hipFuncSetAttribute failed\n"); grid = -1; return; }
        if (hipOccupancyMaxActiveBlocksPerMultiprocessor(&per_cu, (const void*)hymba_fwd, NWAVES * 64, LDS_BYTES) != hipSuccess || per_cu < 1) { fprintf(stderr, "kernel_launch: occupancy query says %d\n", per_cu); per_cu = 1; }
        (void)hipGetLastError();
        grid = cus * 1;
        fprintf(stderr, "kernel_launch: grid %d (cus %d, per_cu %d)\n", grid, cus, per_cu);
    }
    if (grid < 0) return;
    if (hipMemsetAsync(d_ws, 0, 65536, stream) != hipSuccess) { fprintf(stderr, "kernel_launch: memset failed\n"); return; }
    Args a{};
    for (int i = 0; i < 15; ++i) a.in[i] = (const float*)d_in[i];
    a.out = (float*)d_out; a.ws = (unsigned char*)d_ws;
#if MK_N_LAUNCHES == 1
    a.ph_lo = 0; a.ph_hi = N_PHASES;
    void* kargs[] = {&a};
    hipError_t e = hipLaunchCooperativeKernel((const void*)hymba_fwd, dim3(grid), dim3(NWAVES * 64), kargs, LDS_BYTES, stream);
    if (e != hipSuccess) fprintf(stderr, "kernel_launch: cooperative launch failed: %s\n", hipGetErrorString(e));
#else
    for (int p = 0; p < N_PHASES; ++p) { a.ph_lo = p; a.ph_hi = p + 1; hipLaunchKernelGGL(hymba_fwd, dim3(grid), dim3(NWAVES * 64), LDS_BYTES, stream, a); }
#endif
}
```

```cpp
#include <hip/hip_runtime.h>
#include <hip/hip_cooperative_groups.h>
#include <hip/hip_bf16.h>
#include <cstdio>
#include <cstdint>
#include <cmath>
namespace cg = cooperative_groups;
#define MK_N_LAUNCHES 1
#ifndef PG8_WGM
#define PG8_WGM 4
#endif
namespace pg8 {
#define PG8_LAS __attribute__((address_space(3)))
typedef unsigned short bf16_t;
typedef short bf16x8 __attribute__((ext_vector_type(8)));
typedef float f32x4 __attribute__((ext_vector_type(4)));
typedef unsigned u32x4 __attribute__((ext_vector_type(4)));
constexpr int BM = 256, BK = 64, HALF = 128, HTB = HALF * BK * 2  , STAGE_BYTES = 8 * HTB, NXCD = 8, WGM = PG8_WGM;

__host__ __device__ __forceinline__ int lds_byte(int r, int c) { const int st = (r >> 4) * 2 + (c >> 5), rr = r & 15, cc = c & 31, ob = rr * 64 + cc * 2; return st * 1024 + (ob ^ (((ob >> 9) & 1) << 5)); }
__host__ __device__ __forceinline__ void stage_rc(int b, int& R, int& C) { const int st = b / 1024, sb = b % 1024, swz = sb ^ (((sb >> 9) & 1) << 5); R = (st >> 1) * 16 + swz / 64; C = (st & 1) * 32 + (swz % 64) / 2; }
__host__ __device__ __forceinline__ int perm32(int rho) { const int n = rho >> 4, i = rho & 15; return 8 * (i >> 2) + 4 * n + (i & 3); }

struct Unit { int pm, pn; };
struct Gemm { const bf16_t* A; const bf16_t* Bt; int M, N, K; };

struct StaticOrder {
    int nM, nN, nwg, G, c, wgm;
    __host__ __device__ void init(int M, int N, int G_, int c_, int wgm_ = WGM) { nM = M / BM; nN = N / BM; nwg = nM * nN; G = G_; c = c_; wgm = wgm_; }
    __host__ __device__ bool next(int i, Unit& u) const {
        const long L = (long)i * G + c; if (L >= nwg) return false;
        int wgid = (int)L; { const int q = nwg / NXCD, r = nwg % NXCD, xcd = wgid % NXCD, off = wgid / NXCD; wgid = (xcd < r ? xcd * (q + 1) : r * (q + 1) + (xcd - r) * q) + off; }
        const int nig = wgm * nN, gid = wgid / nig, fm = gid * wgm, gsz = (nM - fm) < wgm ? (nM - fm) : wgm;
        u.pm = fm + ((wgid % nig) % gsz); u.pn = (wgid % nig) / gsz; return true;
    }
    __device__ __forceinline__ void a_ready(const Unit&) const {}
    __device__ __forceinline__ void done(const Unit&) const {}
};

__device__ __forceinline__ unsigned cvt_pk_bf16(float lo, float hi) { typedef float f2_t __attribute__((ext_vector_type(2))); typedef __bf16 b2_t __attribute__((ext_vector_type(2))); f2_t v = {lo, hi}; b2_t b = __builtin_convertvector(v, b2_t); return __builtin_bit_cast(unsigned, b); }
typedef unsigned u32x2 __attribute__((ext_vector_type(2)));
struct EpiStore {
    static constexpr bool PERM = true, AFTER_DRAIN = false;
    bf16_t* O; int ldc;
    __device__ __forceinline__ void operator()(const f32x4 (&acc)[2][2][4][2], const Unit& u, int wr, int wc, int fr, int fq) const {
        const int row0 = u.pm * BM + wr * 64 + fr, col0 = u.pn * BM + wc * 32 + 8 * fq;
#pragma unroll
        for (int ai = 0; ai < 2; ++ai)
#pragma unroll
            for (int m = 0; m < 4; ++m) { bf16_t* rowp = O + (size_t)(row0 + ai * HALF + m * 16) * ldc + col0;
#pragma unroll
                for (int bj = 0; bj < 2; ++bj) { const f32x4 v0 = acc[ai][bj][m][0], v1 = acc[ai][bj][m][1];
                    u32x4 w; w.x = cvt_pk_bf16(v0[0], v0[1]); w.y = cvt_pk_bf16(v0[2], v0[3]); w.z = cvt_pk_bf16(v1[0], v1[1]); w.w = cvt_pk_bf16(v1[2], v1[3]);
                    *(u32x4*)(rowp + bj * HALF) = w; } }
    }
};
template <bool BASE_BF16> struct EpiResid {
    static constexpr bool PERM = true, AFTER_DRAIN = false;
    const void* base; bf16_t* xo; float* part; int ldc;
    __device__ __forceinline__ void operator()(const f32x4 (&acc)[2][2][4][2], const Unit& u, int wr, int wc, int fr, int fq) const {
        const int row0 = u.pm * BM + wr * 64 + fr, col0 = u.pn * BM + wc * 32 + 8 * fq;
#pragma unroll
        for (int ai = 0; ai < 2; ++ai)
#pragma unroll
            for (int m = 0; m < 4; ++m) { const int r = row0 + ai * HALF + m * 16; const size_t off = (size_t)r * ldc + col0; float ss = 0.f;
#pragma unroll
                for (int bj = 0; bj < 2; ++bj) { f32x4 b0, b1;
                    if (BASE_BF16) { const u32x4 w = *(const u32x4*)((const bf16_t*)base + off + bj * HALF);
                        b0 = (f32x4){__uint_as_float(w.x << 16), __uint_as_float(w.x & 0xffff0000u), __uint_as_float(w.y << 16), __uint_as_float(w.y & 0xffff0000u)};
                        b1 = (f32x4){__uint_as_float(w.z << 16), __uint_as_float(w.z & 0xffff0000u), __uint_as_float(w.w << 16), __uint_as_float(w.w & 0xffff0000u)}; }
                    else { const float* bp = (const float*)base + off + bj * HALF; b0 = __builtin_nontemporal_load((const f32x4*)bp); b1 = __builtin_nontemporal_load((const f32x4*)(bp + 4)); }
                    const f32x4 v0 = b0 + acc[ai][bj][m][0], v1 = b1 + acc[ai][bj][m][1];
                    ss += ((v0[0] * v0[0] + v0[1] * v0[1]) + (v0[2] * v0[2] + v0[3] * v0[3])) + ((v1[0] * v1[0] + v1[1] * v1[1]) + (v1[2] * v1[2] + v1[3] * v1[3]));
                    u32x4 w; w.x = cvt_pk_bf16(v0[0], v0[1]); w.y = cvt_pk_bf16(v0[2], v0[3]); w.z = cvt_pk_bf16(v1[0], v1[1]); w.w = cvt_pk_bf16(v1[2], v1[3]);
                    *(u32x4*)(xo + off + bj * HALF) = w; }
                ss += __shfl_xor(ss, 16); ss += __shfl_xor(ss, 32);
                if (fq == 0) part[(size_t)r * 32 + u.pn * 4 + wc] = ss; }
    }
};
struct EpiFinal {
    static constexpr bool PERM = true, AFTER_DRAIN = false;
    const bf16_t* xb; float* out; const float* wfin; float* xbuf; unsigned* cnt; PG8_LAS unsigned char* tab; int ldc; float inv_n, eps;
    __device__ __forceinline__ void operator()(f32x4 (&acc)[2][2][4][2], const Unit& u, int wr, int wc, int fr, int fq) const {
        const int lane = fq * 16 + fr, wid = wr * 4 + wc;
        PG8_LAS float* P = (PG8_LAS float*)tab;
        PG8_LAS float* S = (PG8_LAS float*)(tab + 4096);
        PG8_LAS unsigned* flag = (PG8_LAS unsigned*)(tab + 4096 + 1024);
        const int row0 = u.pm * BM + wr * 64 + fr, col0 = u.pn * BM + wc * 32 + 8 * fq;
#pragma unroll
        for (int ai = 0; ai < 2; ++ai)
#pragma unroll
            for (int m = 0; m < 4; ++m) { const int r = row0 + ai * HALF + m * 16; const size_t off = (size_t)r * ldc + col0; float ss = 0.f;
#pragma unroll
                for (int bj = 0; bj < 2; ++bj) { const u32x4 w = *(const u32x4*)(xb + off + bj * HALF);
                    const f32x4 b0 = {__uint_as_float(w.x << 16), __uint_as_float(w.x & 0xffff0000u), __uint_as_float(w.y << 16), __uint_as_float(w.y & 0xffff0000u)};
                    const f32x4 b1 = {__uint_as_float(w.z << 16), __uint_as_float(w.z & 0xffff0000u), __uint_as_float(w.w << 16), __uint_as_float(w.w & 0xffff0000u)};
                    const f32x4 v0 = b0 + acc[ai][bj][m][0], v1 = b1 + acc[ai][bj][m][1]; acc[ai][bj][m][0] = v0; acc[ai][bj][m][1] = v1;
                    ss += ((v0[0] * v0[0] + v0[1] * v0[1]) + (v0[2] * v0[2] + v0[3] * v0[3])) + ((v1[0] * v1[0] + v1[1] * v1[1]) + (v1[2] * v1[2] + v1[3] * v1[3])); }
                ss += __shfl_xor(ss, 16); ss += __shfl_xor(ss, 32);
                if (fq == 0) P[(ai * HALF + wr * 64 + m * 16 + fr) * 4 + wc] = ss; }
        asm volatile("s_waitcnt lgkmcnt(0)" ::: "memory"); __builtin_amdgcn_s_barrier(); asm volatile("" ::: "memory");
        const int row = wid * 32 + (lane & 31);
        if (lane < 32) { const f32x4 p4 = *(PG8_LAS const f32x4*)(P + row * 4);
            __hip_atomic_store(xbuf + ((size_t)(u.pm * BM + row) * 8 + u.pn), (p4[0] + p4[1]) + (p4[2] + p4[3]), __ATOMIC_RELAXED, __HIP_MEMORY_SCOPE_AGENT); }
        asm volatile("s_waitcnt vmcnt(0)" ::: "memory");
        if (lane == 0) __hip_atomic_fetch_add(cnt + 64 * u.pm, 1u, __ATOMIC_RELAXED, __HIP_MEMORY_SCOPE_AGENT);
        if (wid == 0) { bool dead = false; const unsigned long long t0 = __builtin_amdgcn_s_memrealtime();
            for (;;) { if ((unsigned)__builtin_amdgcn_readfirstlane(__hip_atomic_load(cnt + 64 * u.pm, __ATOMIC_RELAXED, __HIP_MEMORY_SCOPE_AGENT)) >= 64u) break;
                if (__builtin_amdgcn_s_memrealtime() - t0 > 2000000ull) { dead = true; break; }
                __builtin_amdgcn_s_sleep(2); }
            __builtin_amdgcn_fence(__ATOMIC_ACQUIRE, "agent");
            if (lane == 0) flag[0] = dead ? 1u : 0u; }
        asm volatile("s_waitcnt vmcnt(0) lgkmcnt(0)" ::: "memory"); __builtin_amdgcn_s_barrier(); asm volatile("" ::: "memory");
        const bool bad = flag[0] != 0u;
        if (lane < 32) { const float* slot = xbuf + (size_t)(u.pm * BM + row) * 8; float q = 0.f;
#pragma unroll
            for (int t = 0; t < 8; ++t) q += __hip_atomic_load(slot + t, __ATOMIC_RELAXED, __HIP_MEMORY_SCOPE_AGENT);
            S[row] = rsqrtf(q * inv_n + eps); }
        asm volatile("s_waitcnt vmcnt(0) lgkmcnt(0)" ::: "memory"); __builtin_amdgcn_s_barrier(); asm volatile("" ::: "memory");
        const float qnan = __builtin_nanf("");
        f32x4 wv[2][2];
#pragma unroll
        for (int bj = 0; bj < 2; ++bj) { wv[bj][0] = *(const f32x4*)(wfin + col0 + bj * HALF); wv[bj][1] = *(const f32x4*)(wfin + col0 + bj * HALF + 4); }
#pragma unroll
        for (int ai = 0; ai < 2; ++ai)
#pragma unroll
            for (int m = 0; m < 4; ++m) { const int rl = ai * HALF + wr * 64 + m * 16 + fr; const float rs = bad ? qnan : S[rl]; float* op = out + (size_t)(u.pm * BM + rl) * ldc + col0;
#pragma unroll
                for (int bj = 0; bj < 2; ++bj) { __builtin_nontemporal_store(acc[ai][bj][m][0] * rs * wv[bj][0], (f32x4*)(op + bj * HALF)); __builtin_nontemporal_store(acc[ai][bj][m][1] * rs * wv[bj][1], (f32x4*)(op + bj * HALF + 4)); } }
    }
};
struct EpiSwiGLU {
    static constexpr bool PERM = true, AFTER_DRAIN = false;
    bf16_t* H; int ldh; const float* part; float inv_n, eps;
    __device__ __forceinline__ static float silu_mul(float g, float uu) { const float e = __builtin_amdgcn_exp2f(g * -1.4426950408889634f); return g * uu * __builtin_amdgcn_rcpf(1.f + e); }
    __device__ __forceinline__ void operator()(const f32x4 (&acc)[2][2][4][2], const Unit& u, int wr, int wc, int fr, int fq) const {
        const int row0 = u.pm * BM + wr * 64 + fr, col0 = u.pn * HALF + wc * 32 + 8 * fq;
#pragma unroll
        for (int ai = 0; ai < 2; ++ai)
#pragma unroll
            for (int m = 0; m < 4; ++m) { const int r = row0 + ai * HALF + m * 16;
                const f32x4* pp = (const f32x4*)(part + (size_t)r * 32 + fq * 8); const f32x4 pa = pp[0], pb = pp[1];
                float s = ((pa[0] + pa[1]) + (pa[2] + pa[3])) + ((pb[0] + pb[1]) + (pb[2] + pb[3]));
                s += __shfl_xor(s, 16); s += __shfl_xor(s, 32);
                const float rstd = rsqrtf(s * inv_n + eps);
                const f32x4 g0 = acc[ai][0][m][0] * rstd, g1 = acc[ai][0][m][1] * rstd, u0 = acc[ai][1][m][0] * rstd, u1 = acc[ai][1][m][1] * rstd;
                u32x4 w; w.x = cvt_pk_bf16(silu_mul(g0[0], u0[0]), silu_mul(g0[1], u0[1])); w.y = cvt_pk_bf16(silu_mul(g0[2], u0[2]), silu_mul(g0[3], u0[3]));
                w.z = cvt_pk_bf16(silu_mul(g1[0], u1[0]), silu_mul(g1[1], u1[1])); w.w = cvt_pk_bf16(silu_mul(g1[2], u1[2]), silu_mul(g1[3], u1[3]));
                *(u32x4*)(H + (size_t)r * ldh + col0) = w; }
    }
};
template <class Epi, class Sched, bool ALIGN_EPI = false, bool SP2 = false>
__device__ __forceinline__ void gemm_phase(PG8_LAS unsigned char* lds, const Gemm g, const Sched& S, const Epi& E) {
    const int tid = threadIdx.x, wid = __builtin_amdgcn_readfirstlane(tid >> 6), lane = tid & 63, wr = wid >> 2, wc = wid & 3, fr = lane & 15, fq = lane >> 4;
    const int K = g.K, nt = K / BK;
    unsigned voffA[2], voffB[2];
#pragma unroll
    for (int i = 0; i < 2; ++i) { int R, C; stage_rc(tid * 16 + i * 8192, R, C); const int Rb = Epi::PERM ? ((R & ~31) + perm32(R & 31)) : R;
        voffA[i] = (unsigned)(R * K + C) * 2u; voffB[i] = (unsigned)(Rb * K + C) * 2u; }
    const size_t kstep = (size_t)(BK * 2);
    const size_t hstep = (size_t)HALF * K * 2;
    const size_t tstep = 2 * hstep;
    const unsigned ldsw = (unsigned)wid * 1024u;
    const int aoff = lds_byte(wr * 64 + fr, fq * 8), boff = lds_byte(wc * 32 + fr, fq * 8);
#define PG8_SA(b, h) (((b) * 2 + (h)) * HTB)
#define PG8_SB(b, h) ((4 + (b) * 2 + (h)) * HTB)
#define PG8_STAGE(bufoff, gbase, voff) do { _Pragma("unroll") for (int _i = 0; _i < 2; ++_i) \
        __builtin_amdgcn_global_load_lds((const unsigned*)((const char*)(gbase) + (voff)[_i]), (PG8_LAS unsigned*)(lds + (bufoff) + ldsw + _i * 8192), 16, 0, 0); } while (0)
#define PG8_LDA(dst, b, h) do { _Pragma("unroll") for (int m = 0; m < 4; ++m) _Pragma("unroll") for (int k = 0; k < 2; ++k) dst[m][k] = *(const PG8_LAS bf16x8*)(lds + PG8_SA(b, h) + aoff + m * 2048 + k * 1024); } while (0)
#define PG8_LDB(dst, b, h) do { _Pragma("unroll") for (int n = 0; n < 2; ++n) _Pragma("unroll") for (int k = 0; k < 2; ++k) dst[n][k] = *(const PG8_LAS bf16x8*)(lds + PG8_SB(b, h) + boff + n * 2048 + k * 1024); } while (0)
#define PG8_MMA(ai, bj, At, Bt) do { __builtin_amdgcn_s_setprio(1); _Pragma("unroll") for (int m = 0; m < 4; ++m) _Pragma("unroll") for (int n = 0; n < 2; ++n) _Pragma("unroll") for (int k = 0; k < 2; ++k) \
        acc[ai][bj][m][n] = __builtin_amdgcn_mfma_f32_16x16x32_bf16(Bt[n][k], At[m][k], acc[ai][bj][m][n], 0, 0, 0); __builtin_amdgcn_s_setprio(0); } while (0)
#define PG8_WAIT_V(n) asm volatile("s_waitcnt vmcnt(" #n ")" ::: "memory")
#define PG8_WAIT_L(n) asm volatile("s_waitcnt lgkmcnt(" #n ")" ::: "memory")
#define PG8_BAR __builtin_amdgcn_s_barrier()
#define PG8_SCHED __builtin_amdgcn_sched_barrier(0)
    Unit cur, nxt; int ui = 0;
    if (!S.next(0, cur)) return;
    f32x4 acc[2][2][4][2];
#pragma unroll
    for (int a = 0; a < 2; ++a)
#pragma unroll
        for (int b = 0; b < 2; ++b)
#pragma unroll
            for (int m = 0; m < 4; ++m)
#pragma unroll
                for (int n = 0; n < 2; ++n) acc[a][b][m][n] = (f32x4){0.f, 0.f, 0.f, 0.f};
    bf16x8 At[4][2], B0[2][2], B1[2][2];
    const char* cA = (const char*)g.A + (size_t)cur.pm * tstep; const char* cB = (const char*)g.Bt + (size_t)cur.pn * tstep;
    S.a_ready(cur);
    if constexpr (SP2) {
        PG8_STAGE(PG8_SB(0, 0), cB, voffB); PG8_STAGE(PG8_SB(0, 1), cB + hstep, voffB); PG8_STAGE(PG8_SA(0, 0), cA, voffA); PG8_STAGE(PG8_SA(0, 1), cA + hstep, voffA);
        if (wr == 1) PG8_BAR;
        PG8_WAIT_V(2); PG8_BAR;
        PG8_STAGE(PG8_SB(1, 0), cB + kstep, voffB); PG8_STAGE(PG8_SA(1, 0), cA + kstep, voffA); PG8_STAGE(PG8_SB(1, 1), cB + hstep + kstep, voffB);
        PG8_WAIT_V(6); PG8_BAR;
    } else {
        PG8_STAGE(PG8_SB(0, 0), cB, voffB); PG8_STAGE(PG8_SA(0, 0), cA, voffA); PG8_STAGE(PG8_SB(0, 1), cB + hstep, voffB); PG8_STAGE(PG8_SA(0, 1), cA + hstep, voffA);
        if (wr == 1) PG8_BAR;
        PG8_WAIT_V(4); PG8_BAR;
        PG8_STAGE(PG8_SB(1, 0), cB + kstep, voffB); PG8_STAGE(PG8_SA(1, 0), cA + kstep, voffA); PG8_STAGE(PG8_SB(1, 1), cB + hstep + kstep, voffB);
        PG8_WAIT_V(6); PG8_BAR;
    }
    for (;;) {
        const bool has_next = S.next(ui + 1, nxt);
        const char* nA = has_next ? (const char*)g.A + (size_t)nxt.pm * tstep : cA; const char* nB = has_next ? (const char*)g.Bt + (size_t)nxt.pn * tstep : cB;
        for (int t = 0; t < nt; t += 2) {
            const bool last = (t == nt - 2);
            const char* a1 = cA + (size_t)(t + 1) * kstep;
            const char* a2 = last ? nA : cA + (size_t)(t + 2) * kstep; const char* b2 = last ? nB : cB + (size_t)(t + 2) * kstep;
            const char* a3 = a2 + kstep; const char* b3 = b2 + kstep;
            if (last && has_next) S.a_ready(nxt);
            if constexpr (SP2) {
            PG8_LDB(B0, 0, 0); PG8_LDB(B1, 0, 1); PG8_SCHED; PG8_LDA(At, 0, 0); PG8_STAGE(PG8_SA(1, 1), a1 + hstep, voffA);
            PG8_WAIT_V(8); PG8_WAIT_L(0); PG8_BAR; PG8_MMA(0, 0, At, B0); PG8_MMA(0, 1, At, B1); PG8_BAR; PG8_SCHED;
            PG8_LDA(At, 0, 1); PG8_STAGE(PG8_SB(0, 0), b2, voffB); PG8_STAGE(PG8_SB(0, 1), b2 + hstep, voffB); PG8_STAGE(PG8_SA(0, 0), a2, voffA);
            PG8_WAIT_V(8); PG8_WAIT_L(0); PG8_BAR; PG8_MMA(1, 0, At, B0); PG8_MMA(1, 1, At, B1); PG8_BAR; PG8_SCHED;
            PG8_LDB(B0, 1, 0); PG8_LDB(B1, 1, 1); PG8_SCHED; PG8_LDA(At, 1, 0); PG8_STAGE(PG8_SA(0, 1), a2 + hstep, voffA);
            PG8_WAIT_V(8); PG8_WAIT_L(0); PG8_BAR; PG8_MMA(0, 0, At, B0); PG8_MMA(0, 1, At, B1); PG8_BAR; PG8_SCHED;
            PG8_LDA(At, 1, 1); PG8_STAGE(PG8_SB(1, 0), b3, voffB); PG8_STAGE(PG8_SB(1, 1), b3 + hstep, voffB); PG8_STAGE(PG8_SA(1, 0), a3, voffA);
            PG8_WAIT_V(8); PG8_WAIT_L(0); PG8_BAR; PG8_MMA(1, 0, At, B0); PG8_MMA(1, 1, At, B1); PG8_BAR; PG8_SCHED;
            } else {
            PG8_LDB(B0, 0, 0); PG8_SCHED; PG8_LDA(At, 0, 0); PG8_STAGE(PG8_SA(1, 1), a1 + hstep, voffA);
            PG8_WAIT_L(8); PG8_BAR; PG8_WAIT_L(0); PG8_MMA(0, 0, At, B0); PG8_BAR; PG8_SCHED;
            PG8_LDB(B1, 0, 1); PG8_STAGE(PG8_SB(0, 0), b2, voffB);
            PG8_BAR; PG8_WAIT_L(0); PG8_MMA(0, 1, At, B1); PG8_BAR;
            PG8_LDA(At, 0, 1); PG8_STAGE(PG8_SA(0, 0), a2, voffA);
            PG8_BAR; PG8_WAIT_L(0); PG8_MMA(1, 0, At, B0); PG8_BAR; PG8_SCHED;
            PG8_STAGE(PG8_SB(0, 1), b2 + hstep, voffB);
            PG8_WAIT_V(6); PG8_BAR; PG8_MMA(1, 1, At, B1); PG8_BAR;
            PG8_LDB(B0, 1, 0); PG8_SCHED; PG8_LDA(At, 1, 0); PG8_STAGE(PG8_SA(0, 1), a2 + hstep, voffA);
            PG8_WAIT_L(8); PG8_BAR; PG8_WAIT_L(0); PG8_MMA(0, 0, At, B0); PG8_BAR; PG8_SCHED;
            PG8_LDB(B1, 1, 1); PG8_STAGE(PG8_SB(1, 0), b3, voffB);
            PG8_BAR; PG8_WAIT_L(0); PG8_MMA(0, 1, At, B1); PG8_BAR;
            PG8_LDA(At, 1, 1); PG8_STAGE(PG8_SA(1, 0), a3, voffA);
            PG8_BAR; PG8_WAIT_L(0); PG8_MMA(1, 0, At, B0); PG8_BAR; PG8_SCHED;
            PG8_STAGE(PG8_SB(1, 1), b3 + hstep, voffB);
            PG8_WAIT_V(6); PG8_BAR; PG8_MMA(1, 1, At, B1); PG8_BAR;
            }
        }
        if constexpr (ALIGN_EPI) { if (wr == 0) PG8_BAR; }
        if constexpr (!Epi::AFTER_DRAIN) { E(acc, cur, wr, wc, fr, fq); S.done(cur); }
        if (!has_next) break;
#pragma unroll
        for (int a = 0; a < 2; ++a)
#pragma unroll
            for (int b = 0; b < 2; ++b)
#pragma unroll
                for (int m = 0; m < 4; ++m)
#pragma unroll
                    for (int n = 0; n < 2; ++n) acc[a][b][m][n] = (f32x4){0.f, 0.f, 0.f, 0.f};
        cur = nxt; cA = nA; cB = nB; ++ui;
        if constexpr (ALIGN_EPI) { if (wr == 1) PG8_BAR; }
    }
    PG8_WAIT_V(0);
    if constexpr (!ALIGN_EPI) { if (wr == 0) PG8_BAR; }
    PG8_BAR;
    if constexpr (Epi::AFTER_DRAIN) { E.fused(acc, cur, wr, wc, fr, fq, lds, wid, lane); S.done(cur); }
#undef PG8_SA
#undef PG8_SB
#undef PG8_STAGE
#undef PG8_LDA
#undef PG8_LDB
#undef PG8_MMA
#undef PG8_WAIT_V
#undef PG8_WAIT_L
#undef PG8_BAR
#undef PG8_SCHED
}
}
namespace att {
#define ATT_LAS __attribute__((address_space(3)))
typedef unsigned short bf16_t;
typedef short bf16x8 __attribute__((ext_vector_type(8)));
typedef short s16x4 __attribute__((ext_vector_type(4)));
typedef float f32x16 __attribute__((ext_vector_type(16)));
typedef float f32x4 __attribute__((ext_vector_type(4)));
typedef unsigned u32x4 __attribute__((ext_vector_type(4)));
typedef unsigned u32x2 __attribute__((ext_vector_type(2)));
constexpr int SEQ = 2048, PITCH = 4608, OPITCH = 2048;
__device__ __forceinline__ unsigned cvtpk(float lo, float hi) { typedef float f2_t __attribute__((ext_vector_type(2))); typedef __bf16 b2_t __attribute__((ext_vector_type(2))); f2_t v = {lo, hi}; b2_t b = __builtin_convertvector(v, b2_t); return __builtin_bit_cast(unsigned, b); }
__device__ __forceinline__ float swapmax(float m) { auto rr = __builtin_amdgcn_permlane32_swap(__float_as_uint(m), __float_as_uint(m), false, false); return fmaxf(__uint_as_float(rr[0]), __uint_as_float(rr[1])); }
__device__ __forceinline__ float swapsum(float m) { auto rr = __builtin_amdgcn_permlane32_swap(__float_as_uint(m), __float_as_uint(m), false, false); return __uint_as_float(rr[0]) + __uint_as_float(rr[1]); }
__device__ __forceinline__ s16x4 vtr(ATT_LAS const char* p) { return __builtin_bit_cast(s16x4, __builtin_amdgcn_ds_read_tr16_b64_v4i16((ATT_LAS s16x4*)p)); }

struct UnitP {
    int b, q0;
    int qcol, kcol, vcol;
    int kofs;
    float slope2;
    float m_init, l_init;
    int T0, T1;
    int tlo, thi;
    int window;
    int maskall;
    int ocol;
};

template <int DV, int KW>
__device__ __forceinline__ void attn_unit(ATT_LAS char* lds, const bf16_t* __restrict__ P, bf16_t* __restrict__ MIX, const UnitP up, bool diff, float lam, const float* __restrict__ subln_w, int tid,
                                          bool prefetched  , bool has_next, int nb, int nkcol, int nvcol, int nT0, int nT1  ) {
    static_assert(KW == DV && (KW == 128 || KW == 64), "tile geometry");
    constexpr int ROWB = KW * 2, CPR = ROWB / 16, RPP = 1024 / ROWB, NP = 64 / RPP / 8, TILEB = 64 * ROWB, STG = 2 * TILEB, NSTG = 4, NEB = DV / 32, NI = 2 * NP;
    constexpr bool WIDE = (KW == 128);
    const int lane = tid & 63, wid = __builtin_amdgcn_readfirstlane(tid >> 6), r32 = lane & 31, hi = lane >> 5, wq = wid & 3, g = wid >> 2;
    const int qw = up.q0 + 32 * wq, q = qw + r32;
    const size_t rowbase = (size_t)up.b * SEQ;
    __syncthreads();
    unsigned kso[NP], vso[NP];
#pragma unroll
    for (int i = 0; i < NP; ++i) { const int piece = wid + 8 * i, row = RPP * piece + lane / CPR, slot = lane % CPR;
        const int kch = WIDE ? (slot ^ (row & 15)) : (slot ^ ((row >> 1) & 7));
        const int vch = ((((slot >> 2) ^ (WIDE ? (row & 3) : ((row >> 1) & 1))) << 2) | (slot & 3));
        kso[i] = (unsigned)(row * PITCH + up.kcol + kch * 8); vso[i] = (unsigned)(row * PITCH + up.vcol + vch * 8); }
    const bf16_t* Pb = P + rowbase * PITCH;
#define ATT_DMA2(pb_, dk_, dv_, t, sg) do { const bf16_t* tb_ = (pb_) + (size_t)(t) * 64 * PITCH; \
    _Pragma("unroll") for (int i_ = 0; i_ < NP; ++i_) { \
        __builtin_amdgcn_global_load_lds((const unsigned*)(tb_ + (kso[i_] + (dk_))), (ATT_LAS unsigned*)(lds + (sg) * STG + (wid + 8 * i_) * 1024), 16, 0, 0); \
        __builtin_amdgcn_global_load_lds((const unsigned*)(tb_ + (vso[i_] + (dv_))), (ATT_LAS unsigned*)(lds + (sg) * STG + TILEB + (wid + 8 * i_) * 1024), 16, 0, 0); } } while (0)
#define ATT_DMA(t, sg) ATT_DMA2(Pb, 0u, 0u, t, sg)
    const int rot = prefetched ? 2 : 0;
    bf16x8 qr[4];
    { const bf16_t* qp = P + (rowbase + q) * PITCH + up.qcol + hi * 8;
#pragma unroll
      for (int d0 = 0; d0 < 4; ++d0) qr[d0] = *(const bf16x8*)(qp + d0 * 16); }
    if (!prefetched) {
#pragma unroll
        for (int j = 0; j < 2; ++j) if (up.T0 + j <= up.T1) ATT_DMA(up.T0 + j, j); }
    f32x16 o[NEB];
#pragma unroll
    for (int e = 0; e < NEB; ++e)
#pragma unroll
        for (int r = 0; r < 16; ++r) o[e][r] = 0.f;
    float mhat = up.l_init != 0.f ? up.m_init + up.slope2 * (float)q : 0.f, l = hi == 0 ? up.l_init : 0.f;
    float cb[16];
#pragma unroll
    for (int r = 0; r < 16; ++r) cb[r] = up.slope2 * (float)((r & 3) + 8 * (r >> 2));
    int kad[4];
#pragma unroll
    for (int d0 = 0; d0 < 4; ++d0) { const int c = (up.kofs >> 4) + 2 * d0 + hi; kad[d0] = r32 * ROWB + ((WIDE ? (c ^ (r32 & 15)) : (c ^ ((r32 >> 1) & 7))) << 4); }
    const int i16 = lane & 15, q4 = i16 >> 2, vsw = WIDE ? q4 : (q4 >> 1);
    const int vlane = TILEB + (4 * hi + q4) * ROWB + 32 * ((lane >> 4) & 1) + 8 * (i16 & 3);
    int vad[NEB];
#pragma unroll
    for (int e = 0; e < NEB; ++e) vad[e] = vlane + ((e ^ vsw) << 6);
    bf16x8 pa[4];
#define ATT_PV(sgi) do { ATT_LAS const char* Sv_ = lds + (sgi) * STG; \
    _Pragma("unroll") for (int e = 0; e < NEB; ++e) _Pragma("unroll") for (int ks = 0; ks < 4; ++ks) { \
        const s16x4 lo = vtr(Sv_ + vad[e] + ks * 16 * ROWB), hh = vtr(Sv_ + vad[e] + ks * 16 * ROWB + 8 * ROWB); \
        const bf16x8 vf = {lo[0], lo[1], lo[2], lo[3], hh[0], hh[1], hh[2], hh[3]}; \
        o[e] = __builtin_amdgcn_mfma_f32_32x32x16_bf16(vf, pa[ks], o[e], 0, 0, 0); } } while (0)
    for (int t = up.T0; t <= up.T1 + 1; ++t) {
        const int sg = (t - up.T0 + rot) & (NSTG - 1);
        if (t + 1 <= up.T1) { if (NI == 4) asm volatile("s_waitcnt vmcnt(4) lgkmcnt(0)" ::: "memory"); else asm volatile("s_waitcnt vmcnt(2) lgkmcnt(0)" ::: "memory"); }
        else asm volatile("s_waitcnt vmcnt(0) lgkmcnt(0)" ::: "memory");
        __builtin_amdgcn_s_barrier();
        asm volatile("" ::: "memory");
        if (t + 2 <= up.T1) ATT_DMA(t + 2, (sg + 2) & (NSTG - 1));
        if (g == 1 && t - 1 >= up.tlo && t - 1 <= up.thi && t - 1 >= up.T0) ATT_PV((sg + NSTG - 1) & (NSTG - 1));
        if (t >= up.tlo && t <= up.thi && t <= up.T1) {
            ATT_LAS const char* Sb = lds + sg * STG;
            f32x16 p0, p1;
            { const float base0 = up.slope2 * (float)(64 * t + 4 * hi) - mhat, base1 = base0 + 32.f * up.slope2;
#pragma unroll
              for (int r = 0; r < 16; ++r) { p0[r] = cb[r] + base0; p1[r] = cb[r] + base1; } }
#pragma unroll
            for (int d0 = 0; d0 < 4; ++d0) {
                const bf16x8 k0 = *(ATT_LAS const bf16x8*)(Sb + kad[d0]), k1 = *(ATT_LAS const bf16x8*)(Sb + kad[d0] + 32 * ROWB);
                p0 = __builtin_amdgcn_mfma_f32_32x32x16_bf16(k0, qr[d0], p0, 0, 0, 0);
                p1 = __builtin_amdgcn_mfma_f32_32x32x16_bf16(k1, qr[d0], p1, 0, 0, 0);
            }
            if (up.maskall || t == up.thi) {
                const int kvb = 64 * t + 4 * hi, qlo = q - up.window;
#pragma unroll
                for (int r = 0; r < 16; ++r) { const int kv = kvb + (r & 3) + 8 * (r >> 2);
                    if (kv > q || kv <= qlo) p0[r] = -INFINITY;
                    if (kv + 32 > q || kv + 32 <= qlo) p1[r] = -INFINITY; }
            }
            float ra = fmaxf(fmaxf(p0[0], p0[1]), p1[0]), rb = fmaxf(fmaxf(p0[2], p0[3]), p1[1]); ra = fmaxf(fmaxf(ra, p1[2]), p1[3]);
#pragma unroll
            for (int r = 4; r < 16; r += 4) { ra = fmaxf(fmaxf(ra, p0[r]), p0[r + 1]); rb = fmaxf(fmaxf(rb, p0[r + 2]), p0[r + 3]); ra = fmaxf(fmaxf(ra, p1[r]), p1[r + 1]); rb = fmaxf(fmaxf(rb, p1[r + 2]), p1[r + 3]); }
            const float rm = swapmax(fmaxf(ra, rb));
            if (__any(rm > 8.f)) {
                const float dl = fmaxf(rm, 0.f), alpha = __builtin_amdgcn_exp2f(-dl);
                mhat += dl; l *= alpha;
#pragma unroll
                for (int r = 0; r < 16; ++r) { p0[r] -= dl; p1[r] -= dl; }
#pragma unroll
                for (int e = 0; e < NEB; ++e)
#pragma unroll
                    for (int r = 0; r < 16; ++r) o[e][r] *= alpha;
            }
            float ps = 0.f;
#pragma unroll
            for (int r = 0; r < 16; ++r) { p0[r] = __builtin_amdgcn_exp2f(p0[r]); p1[r] = __builtin_amdgcn_exp2f(p1[r]); ps += p0[r] + p1[r]; }
            l += ps;
#pragma unroll
            for (int s = 0; s < 2; ++s) {
                u32x4 w0, w1;
                w0.x = cvtpk(p0[8 * s + 0], p0[8 * s + 1]); w0.y = cvtpk(p0[8 * s + 2], p0[8 * s + 3]); w0.z = cvtpk(p0[8 * s + 4], p0[8 * s + 5]); w0.w = cvtpk(p0[8 * s + 6], p0[8 * s + 7]);
                w1.x = cvtpk(p1[8 * s + 0], p1[8 * s + 1]); w1.y = cvtpk(p1[8 * s + 2], p1[8 * s + 3]); w1.z = cvtpk(p1[8 * s + 4], p1[8 * s + 5]); w1.w = cvtpk(p1[8 * s + 6], p1[8 * s + 7]);
                pa[s] = __builtin_bit_cast(bf16x8, w0); pa[2 + s] = __builtin_bit_cast(bf16x8, w1);
            }
            if (g == 0) ATT_PV(sg);
        }
    }
#undef ATT_PV
    asm volatile("s_waitcnt vmcnt(0) lgkmcnt(0)" ::: "memory");
    __builtin_amdgcn_s_barrier();
    asm volatile("" ::: "memory");
    if (has_next) {
        const bf16_t* Pn = P + (size_t)nb * SEQ * PITCH; const unsigned dk = (unsigned)(nkcol - up.kcol), dv = (unsigned)(nvcol - up.vcol);
#pragma unroll
        for (int j = 0; j < 2; ++j) if (nT0 + j <= nT1) ATT_DMA2(Pn, dk, dv, nT0 + j, 2 + j);
    }
#undef ATT_DMA
#undef ATT_DMA2
    const float lt = swapsum(l), inv = 1.f / lt;
    if (!diff) {
        bf16_t* op = MIX + (rowbase + q) * OPITCH + up.ocol + 4 * hi;
#pragma unroll
        for (int e = 0; e < NEB; ++e)
#pragma unroll
            for (int r4 = 0; r4 < 4; ++r4) { u32x2 w; w.x = cvtpk(o[e][4 * r4] * inv, o[e][4 * r4 + 1] * inv); w.y = cvtpk(o[e][4 * r4 + 2] * inv, o[e][4 * r4 + 3] * inv);
                *(u32x2*)(op + e * 32 + 8 * r4) = w; }
    } else {
        ATT_LAS float* xb = (ATT_LAS float*)(lds + wq * (NEB * 16 * 64 * 4)) + lane;
        if (g == 1) { const float sc = lam * inv;
#pragma unroll
            for (int e = 0; e < NEB; ++e)
#pragma unroll
                for (int r = 0; r < 16; ++r) xb[(e * 16 + r) * 64] = o[e][r] * sc; }
        __syncthreads();
        if (g == 0) { float ss = 0.f;
#pragma unroll
            for (int e = 0; e < NEB; ++e)
#pragma unroll
                for (int r = 0; r < 16; ++r) { const float d = o[e][r] * inv - xb[(e * 16 + r) * 64]; o[e][r] = d; ss += d * d; }
            ss = swapsum(ss);
            const float rs = rsqrtf(ss * (1.f / DV) + 1e-5f) * 0.8f;
            bf16_t* op = MIX + (rowbase + q) * OPITCH + up.ocol + 4 * hi;
#pragma unroll
            for (int e = 0; e < NEB; ++e)
#pragma unroll
                for (int r4 = 0; r4 < 4; ++r4) { const f32x4 wv = *(const f32x4*)(subln_w + e * 32 + 8 * r4 + 4 * hi);
                    u32x2 w; w.x = cvtpk(o[e][4 * r4] * rs * wv[0], o[e][4 * r4 + 1] * rs * wv[1]); w.y = cvtpk(o[e][4 * r4 + 2] * rs * wv[2], o[e][4 * r4 + 3] * rs * wv[3]);
                    *(u32x2*)(op + e * 32 + 8 * r4) = w; } }
    }
}
}
constexpr int NWAVES = 8;
#ifndef P4_ALIGN
#define P4_ALIGN true
#endif
#ifndef WGM_P1
#define WGM_P1 4
#endif
#ifndef WGM_P3
#define WGM_P3 4
#endif
#ifndef WGM_P4
#define WGM_P4 8
#endif
#ifndef WGM_P5
#define WGM_P5 4
#endif
#ifndef FUSE_FINAL
#define FUSE_FINAL 0
#endif
#ifndef GEMM_SP2
#define GEMM_SP2 true
#endif
#ifndef MK_N_LAUNCHES
#define MK_N_LAUNCHES 1
#endif
constexpr int N_PHASES = 7;
constexpr int BATCH = 8, SEQ = 2048, D = 2048, M = BATCH * SEQ, INC = 4608, DFF = 5632, NGU = 2 * DFF;
constexpr float RMS_EPS = 1e-5f;
constexpr float QSCALE2 = 0.125f * 1.4426950408889634f;
constexpr size_t MiB = 1u << 20;
constexpr size_t WS_PART1 = 1 * MiB, WS_PART2 = 3 * MiB;
constexpr size_t WS_WIN = 8 * MiB, WS_WOUT = 26 * MiB, WS_WGU = 34 * MiB, WS_WDN = 78 * MiB;
constexpr size_t WS_XN = 100 * MiB;
constexpr size_t WS_PROJ = 164 * MiB, WS_MIX = 308 * MiB;
constexpr size_t WS_H = 164 * MiB;
constexpr size_t WS_END = 372 * MiB;
static_assert(WS_H + (size_t)M * DFF * 2 <= WS_END && WS_MIX + (size_t)M * D * 2 <= WS_END && WS_PROJ + (size_t)M * INC * 2 <= WS_MIX, "ws map");
constexpr int RING_BYTES = 131072, LDS_BYTES = 147456;

#define LAS __attribute__((address_space(3)))
typedef unsigned short bf16;
typedef unsigned v4u __attribute__((ext_vector_type(4)));
typedef float f32x4 __attribute__((ext_vector_type(4)));
__device__ __forceinline__ unsigned pk2(float lo, float hi) { return pg8::cvt_pk_bf16(lo, hi); }
__device__ __forceinline__ float wave_sum(float v) {
#pragma unroll
    for (int o = 1; o < 64; o <<= 1) v += __shfl_xor(v, o);
    return v;
}
template <int NB> __device__ __forceinline__ void transpose_item(const float* __restrict__ W, int K, int N, bf16* __restrict__ WT, int dst_row0, const float* __restrict__ kscale, float cscale, LAS float* scr, int k0, int n0, int lane) {
    const float* src = W + (size_t)(k0 + (lane >> 4)) * N + n0 + 4 * (lane & 15);
#pragma unroll
    for (int b = 0; b < 16 / NB; ++b) {
        f32x4 v[NB];
#pragma unroll
        for (int i = 0; i < NB; ++i) v[i] = __builtin_nontemporal_load((const f32x4*)(src + (size_t)(4 * (b * NB + i)) * N));
#pragma unroll
        for (int i = 0; i < NB; ++i) { const int kk = 4 * (b * NB + i) + (lane >> 4); float sc = cscale; if (kscale) sc *= kscale[k0 + kk];
            LAS float* d = scr + kk * 65 + 4 * (lane & 15); d[0] = v[i].x * sc; d[1] = v[i].y * sc; d[2] = v[i].z * sc; d[3] = v[i].w * sc; }
        if (NB < 16) asm volatile("" ::: "memory");
    }
    asm volatile("s_waitcnt lgkmcnt(0)" ::: "memory");
    const int c = lane & 7;
#pragma unroll
    for (int j = 0; j < 8; ++j) { const int n = (lane >> 3) + 8 * j; const LAS float* s = scr + (8 * c) * 65 + n;
        v4u o; o.x = pk2(s[0 * 65], s[1 * 65]); o.y = pk2(s[2 * 65], s[3 * 65]); o.z = pk2(s[4 * 65], s[5 * 65]); o.w = pk2(s[6 * 65], s[7 * 65]);
        *(v4u*)(WT + (size_t)(dst_row0 + n) * K + k0 + 8 * c) = o; }
    asm volatile("s_waitcnt lgkmcnt(0)" ::: "memory");
}

#define XB_TMO      128
#define XB_XCNT(j)  (256  + 64 * (j))
#define XB_XSUB(j)  (1280 + 64 * (j))
#define XB_XGEN(j)  (2304 + 64 * (j))
#define XB_TOP      3328
#define XB_TOPGEN   3392
#define XCD_BAR_WORDS 3456
#define XB_SPIN_CAP (1u << 18)

__device__ __forceinline__ unsigned xb_ld(unsigned* p)              { return __hip_atomic_load(p, __ATOMIC_RELAXED, __HIP_MEMORY_SCOPE_AGENT); }
__device__ __forceinline__ unsigned xb_add(unsigned* p, unsigned v) { return __hip_atomic_fetch_add(p, v, __ATOMIC_RELAXED, __HIP_MEMORY_SCOPE_AGENT); }
__device__ __forceinline__ unsigned xb_xcc_id() { return (unsigned)__builtin_amdgcn_s_getreg((3 << 11) | 20) & 0xFu; }
#define XB_SPIN(cond, bar) do { unsigned _sp = 0; while (cond) { __builtin_amdgcn_s_sleep(1); \
    if ((++_sp & 255u) == 0u) { if (xb_ld(&(bar)[XB_TMO])) break; if (_sp > XB_SPIN_CAP) { atomicAdd(&(bar)[XB_TMO], 1u); break; } } } } while (0)

struct XcdBarrier {
    unsigned* bar; unsigned x;
    volatile LAS unsigned* st;
};

__device__ __forceinline__ XcdBarrier xcd_barrier_post(unsigned* bar, volatile LAS unsigned* st) {
    XcdBarrier b; b.bar = bar; b.x = xb_xcc_id(); b.st = st;
    if (threadIdx.x == 0) (void)xb_add(&bar[XB_XCNT(b.x)], 1u);
    return b;
}
__device__ __forceinline__ void xcd_barrier_complete(unsigned* bar, unsigned x, unsigned& nloc, unsigned& nx) {
    const unsigned G = gridDim.x * gridDim.y * gridDim.z;
    unsigned sum, cnt, mine, sp = 0u;
    for (;;) {
        sum = 0u; cnt = 0u; mine = 0u;
#pragma unroll
        for (unsigned j = 0; j < 16; ++j) { const unsigned c = xb_ld(&bar[XB_XCNT(j)]); sum += c; cnt += (c > 0u) ? 1u : 0u; mine = (j == x) ? c : mine; }
        if (sum == G) break;
        __builtin_amdgcn_s_sleep(1);
        if ((++sp & 255u) == 0u) { if (xb_ld(&bar[XB_TMO])) break; if (sp > XB_SPIN_CAP) { atomicAdd(&bar[XB_TMO], 1u); break; } }
    }
    nloc = mine > 0u ? mine : 1u; nx = cnt > 0u ? cnt : 1u;
}

__device__ __forceinline__ void xcd_barrier(const XcdBarrier& b) {
    asm volatile("s_waitcnt vmcnt(0)" ::: "memory");
    __syncthreads();
    if (threadIdx.x == 0) {
        unsigned* bar = b.bar;
        __builtin_amdgcn_s_waitcnt(0);
        unsigned nloc = b.st[0], nx = b.st[1];
        if (nloc == 0u) { xcd_barrier_complete(bar, b.x, nloc, nx); b.st[0] = nloc; b.st[1] = nx; }
        const unsigned old = xb_add(&bar[XB_XSUB(b.x)], 1u);
        const unsigned gen = old / nloc;
        if (old + 1u == (gen + 1u) * nloc) {
            __builtin_amdgcn_fence(__ATOMIC_RELEASE, "agent");
            asm volatile("s_waitcnt vmcnt(0)" ::: "memory");
            const unsigned og = xb_add(&bar[XB_TOP], 1u);
            const unsigned tg = og / nx;
            if (og + 1u == (tg + 1u) * nx) xb_add(&bar[XB_TOPGEN], 1u);
            else XB_SPIN(xb_ld(&bar[XB_TOPGEN]) == tg, bar);
            __builtin_amdgcn_fence(__ATOMIC_ACQUIRE, "agent");
            xb_add(&bar[XB_XGEN(b.x)], 1u);
            asm volatile("s_waitcnt vmcnt(0)" ::: "memory");
        } else {
            XB_SPIN(xb_ld(&bar[XB_XGEN(b.x)]) == gen, bar);
            __builtin_amdgcn_fence(__ATOMIC_ACQUIRE, "agent");
            asm volatile("s_waitcnt vmcnt(0)" ::: "memory");
        }
    }
    __syncthreads();
}

struct PrefetchOrder {
    pg8::StaticOrder S; const char* base; unsigned row_bytes, tile_bytes; LAS unsigned char* dump;
    __device__ __forceinline__ bool next(int i, pg8::Unit& u) const { return S.next(i, u); }
    __device__ __forceinline__ void done(const pg8::Unit&) const {}
    __device__ __forceinline__ void a_ready(const pg8::Unit& u) const {
        const int tid = threadIdx.x, wid = __builtin_amdgcn_readfirstlane(tid >> 6); const unsigned lpr = tile_bytes >> 7, nline = 256u * lpr;
        const char* tb = base + (size_t)u.pm * 256 * row_bytes + (size_t)u.pn * tile_bytes;
        for (unsigned line = tid; line < nline; line += 512) { const unsigned r = line / lpr, l = line % lpr;
            __builtin_amdgcn_global_load_lds((const unsigned*)(tb + (size_t)r * row_bytes + l * 128), (LAS unsigned*)(dump + wid * 256), 4, 0, 0); }
    }
};
struct TwiceOrder { pg8::StaticOrder S; __device__ bool next(int i, pg8::Unit& u) const { return S.next(i >> 1, u); } __device__ __forceinline__ void a_ready(const pg8::Unit&) const {} __device__ __forceinline__ void done(const pg8::Unit&) const {} };
struct Args { const float* in[15]; float* out; unsigned char* ws; int ph_lo, ph_hi; };
enum { I_X = 0, I_ANW, I_WIN, I_LQ1, I_LK1, I_LQ2, I_LK2, I_SUBLN, I_SINKS, I_WOUT, I_FNW, I_WG, I_WU, I_WD, I_FINW };

__device__ __forceinline__ void item_kn(int r, int nblk_n, int& k0, int& n0) { const int g8 = r >> 3, w = r & 7, hn = nblk_n >> 1; n0 = 64 * (2 * (g8 % hn) + (w & 1)); k0 = 64 * (4 * (g8 / hn) + (w >> 1)); }
#ifndef CV_SPLIT
#define CV_SPLIT 0
#endif
#ifndef CV_SA
#define CV_SA 48
#endif
constexpr int CV_IN = (D / 64) * (INC / 64), CV_OUT = (D / 64) * (D / 64), CV_G = (D / 64) * (DFF / 64), CV_DN = (DFF / 64) * (D / 64), CV_ALL = CV_IN + CV_OUT + 2 * CV_G + CV_DN, CV_T0 = CV_IN + CV_OUT, CV_T1 = CV_T0 + CV_G;
template <int NB> __device__ __forceinline__ void convert_weights(const Args& args, unsigned char* ws, LAS float* scr, int first, int last, int skip0, int skip1, int widx, int nw, int lane) {
    bf16* Win_t = (bf16*)(ws + WS_WIN); bf16* Wout_t = (bf16*)(ws + WS_WOUT); bf16* Wgu_t = (bf16*)(ws + WS_WGU); bf16* Wdn_t = (bf16*)(ws + WS_WDN);
    for (int it = first + widx; it < last - (skip1 - skip0); it += nw) {
        int r = it; if (r >= skip0) r += skip1 - skip0;
        if (r < CV_IN) { int k0, n0; item_kn(r, INC / 64, k0, n0); const float cs = (n0 < 1024 || (n0 >= 3072 && n0 < 4096)) ? QSCALE2 : 1.f;
            transpose_item<NB>(args.in[I_WIN], D, INC, Win_t, n0, nullptr, cs, scr, k0, n0, lane); continue; } r -= CV_IN;
        if (r < CV_OUT) { int k0, n0; item_kn(r, D / 64, k0, n0); transpose_item<NB>(args.in[I_WOUT], D, D, Wout_t, n0, nullptr, 1.f, scr, k0, n0, lane); continue; } r -= CV_OUT;
        if (r < 2 * CV_G) { const int up = r >= CV_G; if (up) r -= CV_G; int k0, n0; item_kn(r, DFF / 64, k0, n0);
            transpose_item<NB>(args.in[up ? I_WU : I_WG], D, DFF, Wgu_t, 256 * (n0 / 128) + 128 * up + (n0 % 128), args.in[I_FNW], 1.f, scr, k0, n0, lane); continue; } r -= 2 * CV_G;
        { int k0, n0; item_kn(r, D / 64, k0, n0); transpose_item<NB>(args.in[I_WD], DFF, D, Wdn_t, n0, nullptr, 1.f, scr, k0, n0, lane); }
    }
}

struct CvItem { const float* src; bf16* dst; const float* kscale; float cscale; int N, K; };
__device__ __forceinline__ bool cv_decode(const Args& args, unsigned char* ws, int r, int last, int lane, CvItem& it) {
    if (r >= last) return false;
    bf16* Win_t = (bf16*)(ws + WS_WIN); bf16* Wout_t = (bf16*)(ws + WS_WOUT); bf16* Wgu_t = (bf16*)(ws + WS_WGU); bf16* Wdn_t = (bf16*)(ws + WS_WDN);
    int k0, n0, row0; const float* W; bf16* WT; it.kscale = nullptr; it.cscale = 1.f;
    if (r < CV_IN) { item_kn(r, INC / 64, k0, n0); W = args.in[I_WIN]; WT = Win_t; it.N = INC; it.K = D; row0 = n0; it.cscale = (n0 < 1024 || (n0 >= 3072 && n0 < 4096)) ? QSCALE2 : 1.f; }
    else if ((r -= CV_IN) < CV_OUT) { item_kn(r, D / 64, k0, n0); W = args.in[I_WOUT]; WT = Wout_t; it.N = D; it.K = D; row0 = n0; }
    else if ((r -= CV_OUT) < 2 * CV_G) { const int up = r >= CV_G; if (up) r -= CV_G; item_kn(r, DFF / 64, k0, n0); W = args.in[up ? I_WU : I_WG]; WT = Wgu_t; it.N = DFF; it.K = D; row0 = 256 * (n0 / 128) + 128 * up + (n0 % 128); it.kscale = args.in[I_FNW] + k0; }
    else { r -= 2 * CV_G; item_kn(r, D / 64, k0, n0); W = args.in[I_WD]; WT = Wdn_t; it.N = D; it.K = DFF; row0 = n0; }
    it.src = W + (size_t)(k0 + (lane >> 4)) * it.N + n0 + 4 * (lane & 15);
    it.dst = WT + (size_t)row0 * it.K + k0;
    return true;
}
__device__ __forceinline__ void cv_load(const CvItem& it, f32x4 (&v)[16]) {
#pragma unroll
    for (int i = 0; i < 16; ++i) v[i] = *(const f32x4*)(it.src + (size_t)(4 * i) * it.N);
}
__device__ __forceinline__ void cv_finish(const CvItem& it, const f32x4 (&v)[16], LAS float* scr, int lane) {
#pragma unroll
    for (int i = 0; i < 16; ++i) { const int kk = 4 * i + (lane >> 4); float sc = it.cscale; if (it.kscale) sc *= it.kscale[kk];
        LAS float* d = scr + kk * 65 + 4 * (lane & 15); d[0] = v[i].x * sc; d[1] = v[i].y * sc; d[2] = v[i].z * sc; d[3] = v[i].w * sc; }
    asm volatile("s_waitcnt lgkmcnt(0)" ::: "memory");
    const int c = lane & 7;
#pragma unroll
    for (int j = 0; j < 8; ++j) { const int n = (lane >> 3) + 8 * j; const LAS float* s = scr + (8 * c) * 65 + n;
        v4u o; o.x = pk2(s[0 * 65], s[1 * 65]); o.y = pk2(s[2 * 65], s[3 * 65]); o.z = pk2(s[4 * 65], s[5 * 65]); o.w = pk2(s[6 * 65], s[7 * 65]);
        *(v4u*)(it.dst + (size_t)n * it.K + 8 * c) = o; }
    asm volatile("s_waitcnt lgkmcnt(0)" ::: "memory");
}
__device__ __forceinline__ void convert_weights_pipe(const Args& args, unsigned char* ws, LAS float* scr, int first, int last, int widx, int nw, int lane) {
    CvItem ia, ib; f32x4 va[16], vb[16];
    int r = first + widx;
    bool ha = cv_decode(args, ws, r, last, lane, ia); if (ha) cv_load(ia, va);
    while (ha) {
        const bool hb = cv_decode(args, ws, r + nw, last, lane, ib); if (hb) cv_load(ib, vb);
        cv_finish(ia, va, scr, lane);
        if (!hb) break;
        r += 2 * nw;
        ha = cv_decode(args, ws, r, last, lane, ia); if (ha) cv_load(ia, va);
        cv_finish(ib, vb, scr, lane);
    }
}

__global__ void __launch_bounds__(NWAVES * 64, 2) hymba_fwd(Args args) {
    extern __shared__ __attribute__((aligned(16))) unsigned char lds_raw[];
    cg::grid_group grid = cg::this_grid();
    LAS unsigned char* lds = (LAS unsigned char*)lds_raw;
    const int tid = threadIdx.x, lane = tid & 63, wave = __builtin_amdgcn_readfirstlane(tid >> 6);
    const int G = gridDim.x, bx = blockIdx.x, vcu = (G % 8 == 0) ? (bx % 8) * (G / 8) + bx / 8 : bx;
    unsigned char* ws = args.ws;
    const float* x = args.in[I_X]; float* out = args.out;
    bf16* Win_t = (bf16*)(ws + WS_WIN); bf16* Wout_t = (bf16*)(ws + WS_WOUT); bf16* Wgu_t = (bf16*)(ws + WS_WGU); bf16* Wdn_t = (bf16*)(ws + WS_WDN);
    bf16* XN = (bf16*)(ws + WS_XN); bf16* PROJ = (bf16*)(ws + WS_PROJ); bf16* MIX = (bf16*)(ws + WS_MIX); bf16* HB = (bf16*)(ws + WS_H);
    float* part1 = (float*)(ws + WS_PART1); float* part2 = (float*)(ws + WS_PART2);
    const int lo = args.ph_lo, hi = args.ph_hi;
    volatile LAS unsigned* bst = (volatile LAS unsigned*)(lds + LDS_BYTES - 64);
    if (tid < 2) bst[tid] = 0u;
    if (tid == 0) { *(LAS unsigned long long*)(lds + LDS_BYTES - 32) = 0ull; }
    __syncthreads();
    XcdBarrier gbar; gbar.bar = (unsigned*)ws; gbar.x = 0; gbar.st = bst;
    if (hi - lo > 1) gbar = xcd_barrier_post((unsigned*)ws, bst);
    if (hi > 1000) grid.sync();
#define IN(k) (lo <= (k) && (k) < hi)
#ifndef SYNC_REPEAT
#define SYNC_REPEAT 1
#endif
#define SEAM(k) do { if (IN(k) && IN((k) + 1)) { for (int sr_ = 0; sr_ < SYNC_REPEAT; ++sr_) xcd_barrier(gbar); } } while (0)
#ifndef PROBE_PHASE
#define PROBE_PHASE -1
#endif
#ifndef STAMP_SEL
#define STAMP_SEL 1
#endif
#ifdef STAMP_PHASE
#define STAMP_BEGIN(k) do { if ((k) == STAMP_PHASE || ((k) == 2 && (STAMP_PHASE == 30 || STAMP_PHASE == 31))) st0_ = __builtin_amdgcn_s_memrealtime(); } while (0)
#define STAMP_END(k) do { if ((k) == STAMP_PHASE) st1_ = __builtin_amdgcn_s_memrealtime(); } while (0)
#else
#define STAMP_BEGIN(k) do {} while (0)
#define STAMP_END(k) do {} while (0)
#endif
    unsigned long long st0_ = 0, st1_ = 0; (void)st0_; (void)st1_;
#define REP(k) for (int rep_ = 0; rep_ < ((PROBE_PHASE == (k)) ? 2 : 1); ++rep_, ((PROBE_PHASE == (k)) && rep_ < 2 ? (xcd_barrier(gbar), 0) : 0))

    STAMP_BEGIN(0); STAMP_BEGIN(41);
    REP(0) if (IN(0)) {
        LAS float* scr = (LAS float*)(lds + wave * 16640);
        const int gw = vcu * NWAVES + wave, NGW = G * NWAVES;
#if defined(P0_TOUCH) && P0_TOUCH
        {
            const int widx[5] = {I_WIN, I_WOUT, I_WG, I_WU, I_WD}; const size_t wn4[5] = {(size_t)D * INC / 4, (size_t)D * D / 4, (size_t)D * DFF / 4, (size_t)D * DFF / 4, (size_t)DFF * D / 4};
            f32x4 acc4 = {0.f, 0.f, 0.f, 0.f};
#pragma unroll
            for (int w = 0; w < 5; ++w) { const f32x4* src = (const f32x4*)args.in[widx[w]];
                for (size_t i = (size_t)gw * 64 + lane; i < wn4[w]; i += (size_t)NGW * 64 * 4) {
                    f32x4 a = src[i], b = (i + (size_t)NGW * 64 < wn4[w]) ? src[i + (size_t)NGW * 64] : acc4, c = (i + (size_t)NGW * 128 < wn4[w]) ? src[i + (size_t)NGW * 128] : acc4, d = (i + (size_t)NGW * 192 < wn4[w]) ? src[i + (size_t)NGW * 192] : acc4;
                    acc4 = acc4 + a + b + c + d; } }
            if (acc4.x + acc4.y + acc4.z + acc4.w == 1.2345e38f) ((float*)(ws + WS_PART2))[gw * 64 + lane] = acc4.x;
        }
#endif
#if defined(CV_PIPE) && CV_PIPE
        convert_weights_pipe(args, ws, scr, 0, CV_SPLIT ? CV_IN : CV_ALL, gw, NGW, lane);
#else
        convert_weights<16>(args, ws, scr, 0, CV_SPLIT ? CV_ALL - 128 * CV_SA : CV_ALL, 0, 0, gw, NGW, lane);
#endif
        STAMP_BEGIN(40); __syncthreads(); STAMP_END(41);
        const f32x4* wn = (const f32x4*)args.in[I_ANW] + lane;
        for (int rp_ = 0; rp_ < (PROBE_PHASE == 11 ? 2 : 1); ++rp_)
        for (int m = gw; m < M; m += NGW) {
            const f32x4* xr = (const f32x4*)(x + (size_t)m * D) + lane;
            f32x4 v[8]; float s = 0.f;
#pragma unroll
            for (int j = 0; j < 8; ++j) { v[j] = __builtin_nontemporal_load(xr + 64 * j); s += (v[j].x * v[j].x + v[j].y * v[j].y) + (v[j].z * v[j].z + v[j].w * v[j].w); }
            const float rstd = rsqrtf(wave_sum(s) * (1.f / D) + RMS_EPS);
            unsigned long long* o8 = (unsigned long long*)(XN + (size_t)m * D) + lane;
#pragma unroll
            for (int j = 0; j < 8; ++j) { const f32x4 w = wn[64 * j]; o8[64 * j] = (unsigned long long)pk2(v[j].x * rstd * w.x, v[j].y * rstd * w.y) | ((unsigned long long)pk2(v[j].z * rstd * w.z, v[j].w * rstd * w.w) << 32); }
        }
        __syncthreads();
    }
    SEAM(0);
    STAMP_END(0); STAMP_END(40);
    STAMP_BEGIN(1);
    REP(1) if (IN(1)) {
        pg8::Gemm g{XN, Win_t, M, INC, D}; pg8::StaticOrder S; S.init(M, INC, G, bx, WGM_P1);
        pg8::EpiStore E{PROJ, INC};
#if PROBE_PHASE == 21
        { TwiceOrder S2{S}; pg8::gemm_phase<pg8::EpiStore, TwiceOrder, true, true>(lds, g, S2, E); }
#else
        pg8::gemm_phase<pg8::EpiStore, pg8::StaticOrder, true, GEMM_SP2>(lds, g, S, E);
#endif
        if (CV_SPLIT) { const int nwg = (M / 256) * (INC / 256), maxU = (nwg + G - 1) / G, nIdle = G * maxU - nwg, idx = bx - (G - nIdle);
            const int nw_ = nIdle > 0 ? nIdle : G, id_ = nIdle > 0 ? idx : bx, per = (128 * CV_SA + nw_ - 1) / nw_, f0 = CV_ALL - 128 * CV_SA + id_ * per;
            if (id_ >= 0) convert_weights<8>(args, ws, (LAS float*)(lds + wave * 16640), f0, f0 + per < CV_ALL ? f0 + per : CV_ALL, 0, 0, wave, NWAVES, lane); }
        __syncthreads();
    }
    SEAM(1);
    STAMP_END(1);
    STAMP_BEGIN(2);
    REP(2) if (IN(2)) {
        const float* lq1 = args.in[I_LQ1]; const float* lk1 = args.in[I_LK1]; const float* lq2 = args.in[I_LQ2]; const float* lk2 = args.in[I_LK2];
        const float s1 = wave_sum(lq1[lane] * lk1[lane]), s2 = wave_sum(lq2[lane] * lk2[lane]);
        const float lam = expf(s1) - expf(s2) + 0.2f;
        const int wq = wave & 3, gsel = wave >> 2;
#ifdef ATT_PRIO
        if (gsel == 1) __builtin_amdgcn_s_setprio(1);
#endif
        STAMP_BEGIN(20);
        { const int np = vcu < 512 ? (512 - vcu + G - 1) / G : 0;
#define DIFF_UNIT(u_, up_) do { const int i_ = vcu + G * ((u_) >> 1), bh_ = (i_ >> 3) ^ (((u_) >> 1) & 1 ? 4 : 0)  , xq_ = i_ & 7, h_ = bh_ & 7, qblk_ = ((u_) & 1) ? 15 - xq_ : xq_; \
            up_.b = bh_ >> 3; up_.q0 = 128 * qblk_; up_.qcol = h_ * 128 + gsel * 64; up_.kcol = 1024 + h_ * 128; up_.vcol = 2048 + h_ * 128; up_.kofs = gsel * 128; \
            up_.slope2 = exp2f(-(float)(h_ + 1)) * 1.4426950408889634f; up_.m_init = 0.f; up_.l_init = 0.f; \
            up_.T0 = 0; up_.T1 = 2 * qblk_ + 1; up_.tlo = 0; up_.thi = (up_.q0 + 32 * wq) >> 6; up_.window = 1 << 20; up_.maskall = 0; up_.ocol = h_ * 128; } while (0)
#pragma unroll 1
          for (int u = 0; u < 2 * np; ++u) {
              att::UnitP up, nx; DIFF_UNIT(u, up); const bool hn = u + 1 < 2 * np; if (hn) DIFF_UNIT(u + 1, nx); else nx = up;
              att::attn_unit<128, 128>((LAS char*)lds, PROJ, MIX, up, true, lam, args.in[I_SUBLN], tid, u > 0, hn, nx.b, nx.kcol, nx.vcol, nx.T0, nx.T1);
          }
#undef DIFF_UNIT
        }
        STAMP_END(20); STAMP_BEGIN(21);
        { const int ns = vcu < 1024 ? (1024 - vcu + G - 1) / G : 0;
#define SWA_UNIT(u_, up_) do { const int i_ = vcu + G * (u_), qblk_ = i_ & 15, pair_ = (i_ >> 4) & 1, hkv_ = ((i_ >> 5) + (u_)) & 3, hq_ = hkv_ * 4 + pair_ * 2 + gsel, a_ = 2 * qblk_; \
            up_.b = i_ >> 7; up_.q0 = 128 * qblk_; up_.qcol = 3072 + hq_ * 64; up_.kcol = 4096 + hkv_ * 64; up_.vcol = 4352 + hkv_ * 64; up_.kofs = 0; \
            up_.slope2 = exp2f(-0.5f * (float)(hq_ + 1)) * 1.4426950408889634f; up_.m_init = args.in[I_SINKS][hq_] * 1.4426950408889634f; up_.l_init = 1.f; \
            up_.T0 = a_ - 2 < 0 ? 0 : a_ - 2; up_.T1 = a_ + 1; up_.tlo = a_ - 2 + (wq >> 1); up_.thi = a_ + (wq >> 1); up_.window = 128; up_.maskall = 1; up_.ocol = 1024 + hq_ * 64; } while (0)
#pragma unroll 1
          for (int u = 0; u < ns; ++u) {
              att::UnitP up, nx; SWA_UNIT(u, up); const bool hn = u + 1 < ns; if (hn) SWA_UNIT(u + 1, nx); else nx = up;
              att::attn_unit<64, 64>((LAS char*)lds, PROJ, MIX, up, false, 0.f, nullptr, tid, u > 0, hn, nx.b, nx.kcol, nx.vcol, nx.T0, nx.T1);
          }
#undef SWA_UNIT
        }
        STAMP_END(21);
#ifdef ATT_PRIO
        __builtin_amdgcn_s_setprio(0);
#endif
        __syncthreads();
#ifdef STAMP_PHASE
        if (STAMP_PHASE == 30 || STAMP_PHASE == 31) { if (tid == 0 && STAMP_SEL) { const unsigned d_ = (unsigned)(__builtin_amdgcn_s_memrealtime() - st0_);
            if (STAMP_PHASE == 30) __hip_atomic_fetch_max((unsigned*)ws + 3500, d_, __ATOMIC_RELAXED, __HIP_MEMORY_SCOPE_AGENT); else __hip_atomic_fetch_max((unsigned*)ws + 3500, ~d_, __ATOMIC_RELAXED, __HIP_MEMORY_SCOPE_AGENT) ; } }
#endif
    }
    SEAM(2);
#ifdef STAMP_PHASE
    if (STAMP_PHASE == 30 || STAMP_PHASE == 31) { const unsigned v_ = __hip_atomic_load((unsigned*)ws + 3500, __ATOMIC_RELAXED, __HIP_MEMORY_SCOPE_AGENT); st1_ = st0_ + (STAMP_PHASE == 30 ? v_ : ~v_); }
#endif
    STAMP_END(2);
    STAMP_BEGIN(3);
    REP(3) if (IN(3)) {
        pg8::Gemm g{MIX, Wout_t, M, D, D}; pg8::StaticOrder S; S.init(M, D, G, bx, WGM_P3);
        pg8::EpiResid<false> E{x, XN, part1, D};
        pg8::gemm_phase<pg8::EpiResid<false>, pg8::StaticOrder, true, GEMM_SP2>(lds, g, S, E);
    }
    SEAM(3);
    STAMP_END(3);
    STAMP_BEGIN(4);
    REP(4) if (IN(4)) {
        pg8::Gemm g{XN, Wgu_t, M, NGU, D}; pg8::StaticOrder S; S.init(M, NGU, G, bx, WGM_P4);
        pg8::EpiSwiGLU E{HB, DFF, part1, 1.f / D, RMS_EPS};
#if PROBE_PHASE == 24
        { TwiceOrder S2{S}; pg8::gemm_phase<pg8::EpiSwiGLU, TwiceOrder, true, true>(lds, g, S2, E); }
#else
        pg8::gemm_phase<pg8::EpiSwiGLU, pg8::StaticOrder, P4_ALIGN, GEMM_SP2>(lds, g, S, E);
#endif
    }
    SEAM(4);
    STAMP_END(4);
    STAMP_BEGIN(5);
    REP(5) if (IN(5)) {
        pg8::Gemm g{HB, Wdn_t, M, D, DFF}; pg8::StaticOrder S; S.init(M, D, G, bx, WGM_P5);
#if FUSE_FINAL
        pg8::EpiFinal E{XN, out, args.in[I_FINW], part2, (unsigned*)ws + 4096, lds + RING_BYTES, D, 1.f / D, RMS_EPS};
        pg8::gemm_phase<pg8::EpiFinal, pg8::StaticOrder, true, GEMM_SP2>(lds, g, S, E);
#else
        pg8::EpiResid<true> E{XN, XN, part2, D};
        pg8::gemm_phase<pg8::EpiResid<true>, pg8::StaticOrder, true, GEMM_SP2>(lds, g, S, E);
#endif
    }
#if !FUSE_FINAL
    SEAM(5);
#endif
    STAMP_END(5);
    STAMP_BEGIN(6);
    REP(6) if (IN(6) && !FUSE_FINAL) {
        const int gw = vcu * NWAVES + wave, NGW = G * NWAVES;
        const f32x4* wn = (const f32x4*)args.in[I_FINW] + 2 * lane;
        for (int m = gw; m < M; m += NGW) {
            const float s = wave_sum(lane < 32 ? part2[(size_t)m * 32 + lane] : 0.f);
            const float rstd = rsqrtf(s * (1.f / D) + RMS_EPS);
            const v4u* xr = (const v4u*)(XN + (size_t)m * D) + lane; f32x4* orow = (f32x4*)(out + (size_t)m * D) + 2 * lane;
#pragma unroll
            for (int j = 0; j < 4; ++j) { const v4u w = __builtin_nontemporal_load(xr + 64 * j); const f32x4 w0 = wn[128 * j], w1 = wn[128 * j + 1];
                const f32x4 a = {__uint_as_float(w.x << 16), __uint_as_float(w.x & 0xffff0000u), __uint_as_float(w.y << 16), __uint_as_float(w.y & 0xffff0000u)};
                const f32x4 b = {__uint_as_float(w.z << 16), __uint_as_float(w.z & 0xffff0000u), __uint_as_float(w.w << 16), __uint_as_float(w.w & 0xffff0000u)};
                __builtin_nontemporal_store(a * rstd * w0, orow + 128 * j); __builtin_nontemporal_store(b * rstd * w1, orow + 128 * j + 1); }
        }
    }
#ifdef ATT_TIMER
    if (bx == 0) { __syncthreads(); if (tid == 0) { const unsigned long long dt = *(LAS unsigned long long*)(lds + LDS_BYTES - 32), te = __builtin_amdgcn_s_memtime(); while (__builtin_amdgcn_s_memtime() - te < dt) __builtin_amdgcn_s_sleep(32); } }
#endif
#ifdef STAMP_PHASE
    if (STAMP_PHASE == 6) { __syncthreads(); st1_ = __builtin_amdgcn_s_memrealtime(); }
    if (bx == 0 && tid == 0) { const unsigned long long te = __builtin_amdgcn_s_memrealtime(), dt = st1_ - st0_; while (__builtin_amdgcn_s_memrealtime() - te < dt) __builtin_amdgcn_s_sleep(32); }
#endif
#undef IN
#undef SEAM
}

extern "C" void kernel_launch(void* const* d_in, const int* in_sizes, int n_in, void* d_out, int out_size, void* d_ws, size_t ws_size, hipStream_t stream) {
    static int grid = 0;
    if (grid == 0) {
        if (n_in != 15 || out_size != M * D || ws_size < WS_END) { fprintf(stderr, "kernel_launch: unexpected shapes (n_in %d out %d ws %zu)\n", n_in, out_size, ws_size); grid = -1; return; }
        int dev = 0, cus = 0, per_cu = 0;
        hipGetDevice(&dev); hipDeviceGetAttribute(&cus, hipDeviceAttributeMultiprocessorCount, dev);
        if (hipFuncSetAttribute((const void*)hymba_fwd, hipFuncAttributeMaxDynamicSharedMemorySize, LDS_BYTES) != hipSuccess) { fprintf(stderr, "kernel_launch: hipFuncSetAttribute failed\n"); grid = -1; return; }
        if (hipOccupancyMaxActiveBlocksPerMultiprocessor(&per_cu, (const void*)hymba_fwd, NWAVES * 64, LDS_BYTES) != hipSuccess || per_cu < 1) { fprintf(stderr, "kernel_launch: occupancy query says %d\n", per_cu); per_cu = 1; }
        (void)hipGetLastError();
        grid = cus * 1;
        fprintf(stderr, "kernel_launch: grid %d (cus %d, per_cu %d)\n", grid, cus, per_cu);
    }
    if (grid < 0) return;
    if (hipMemsetAsync(d_ws, 0, 65536, stream) != hipSuccess) { fprintf(stderr, "kernel_launch: memset failed\n"); return; }
    Args a{};
    for (int i = 0; i < 15; ++i) a.in[i] = (const float*)d_in[i];
    a.out = (float*)d_out; a.ws = (unsigned char*)d_ws;
#if MK_N_LAUNCHES == 1
    a.ph_lo = 0; a.ph_hi = N_PHASES;
    void* kargs[] = {&a};
    hipError_t e = hipLaunchCooperativeKernel((const void*)hymba_fwd, dim3(grid), dim3(NWAVES * 64), kargs, LDS_BYTES, stream);
    if (e != hipSuccess) fprintf(stderr, "kernel_launch: cooperative launch failed: %s\n", hipGetErrorString(e));
#else
    for (int p = 0; p < N_PHASES; ++p) { a.ph_lo = p; a.ph_hi = p + 1; hipLaunchKernelGGL(hymba_fwd, dim3(grid), dim3(NWAVES * 64), LDS_BYTES, stream, a); }
#endif
}
```

```cpp
#include <hip/hip_runtime.h>
#include <hip/hip_cooperative_groups.h>
#include <hip/hip_bf16.h>
#include <cstdio>
#include <cstdint>
#include <cmath>
namespace cg = cooperative_groups;
#define MK_N_LAUNCHES 1
#ifndef PG8_WGM
#define PG8_WGM 4
#endif
namespace pg8 {
#define PG8_LAS __attribute__((address_space(3)))
typedef unsigned short bf16_t;
typedef short bf16x8 __attribute__((ext_vector_type(8)));
typedef float f32x4 __attribute__((ext_vector_type(4)));
typedef unsigned u32x4 __attribute__((ext_vector_type(4)));
constexpr int BM = 256, BK = 64, HALF = 128, HTB = HALF * BK * 2  , STAGE_BYTES = 8 * HTB, NXCD = 8, WGM = PG8_WGM;

__host__ __device__ __forceinline__ int lds_byte(int r, int c) { const int st = (r >> 4) * 2 + (c >> 5), rr = r & 15, cc = c & 31, ob = rr * 64 + cc * 2; return st * 1024 + (ob ^ (((ob >> 9) & 1) << 5)); }
__host__ __device__ __forceinline__ void stage_rc(int b, int& R, int& C) { const int st = b / 1024, sb = b % 1024, swz = sb ^ (((sb >> 9) & 1) << 5); R = (st >> 1) * 16 + swz / 64; C = (st & 1) * 32 + (swz % 64) / 2; }
__host__ __device__ __forceinline__ int perm32(int rho) { const int n = rho >> 4, i = rho & 15; return 8 * (i >> 2) + 4 * n + (i & 3); }

struct Unit { int pm, pn; };
struct Gemm { const bf16_t* A; const bf16_t* Bt; int M, N, K; };

struct StaticOrder {
    int nM, nN, nwg, G, c, wgm;
    __host__ __device__ void init(int M, int N, int G_, int c_, int wgm_ = WGM) { nM = M / BM; nN = N / BM; nwg = nM * nN; G = G_; c = c_; wgm = wgm_; }
    __host__ __device__ bool next(int i, Unit& u) const {
        const long L = (long)i * G + c; if (L >= nwg) return false;
        int wgid = (int)L; { const int q = nwg / NXCD, r = nwg % NXCD, xcd = wgid % NXCD, off = wgid / NXCD; wgid = (xcd < r ? xcd * (q + 1) : r * (q + 1) + (xcd - r) * q) + off; }
        const int nig = wgm * nN, gid = wgid / nig, fm = gid * wgm, gsz = (nM - fm) < wgm ? (nM - fm) : wgm;
        u.pm = fm + ((wgid % nig) % gsz); u.pn = (wgid % nig) / gsz; return true;
    }
    __device__ __forceinline__ void a_ready(const Unit&) const {}
    __device__ __forceinline__ void done(const Unit&) const {}
};

__device__ __forceinline__ unsigned cvt_pk_bf16(float lo, float hi) { typedef float f2_t __attribute__((ext_vector_type(2))); typedef __bf16 b2_t __attribute__((ext_vector_type(2))); f2_t v = {lo, hi}; b2_t b = __builtin_convertvector(v, b2_t); return __builtin_bit_cast(unsigned, b); }
typedef unsigned u32x2 __attribute__((ext_vector_type(2)));
#ifndef EPI_NT_H
#define EPI_NT_H 0
#endif
#ifndef EPI_NT_PROJ
#define EPI_NT_PROJ 0
#endif
struct EpiStore {
    static constexpr bool PERM = true, AFTER_DRAIN = false;
    bf16_t* O; int ldc;
    __device__ __forceinline__ void operator()(const f32x4 (&acc)[2][2][4][2], const Unit& u, int wr, int wc, int fr, int fq) const {
        const int row0 = u.pm * BM + wr * 64 + fr, col0 = u.pn * BM + wc * 32 + 8 * fq;
#pragma unroll
        for (int ai = 0; ai < 2; ++ai)
#pragma unroll
            for (int m = 0; m < 4; ++m) { bf16_t* rowp = O + (size_t)(row0 + ai * HALF + m * 16) * ldc + col0;
#pragma unroll
                for (int bj = 0; bj < 2; ++bj) { const f32x4 v0 = acc[ai][bj][m][0], v1 = acc[ai][bj][m][1];
                    u32x4 w; w.x = cvt_pk_bf16(v0[0], v0[1]); w.y = cvt_pk_bf16(v0[2], v0[3]); w.z = cvt_pk_bf16(v1[0], v1[1]); w.w = cvt_pk_bf16(v1[2], v1[3]);
                    if (EPI_NT_PROJ) __builtin_nontemporal_store(w, (u32x4*)(rowp + bj * HALF)); else *(u32x4*)(rowp + bj * HALF) = w; } }
    }
};
template <bool BASE_BF16> struct EpiResid {
    static constexpr bool PERM = true, AFTER_DRAIN = false;
    const void* base; bf16_t* xo; float* part; int ldc;
    __device__ __forceinline__ void operator()(const f32x4 (&acc)[2][2][4][2], const Unit& u, int wr, int wc, int fr, int fq) const {
        const int row0 = u.pm * BM + wr * 64 + fr, col0 = u.pn * BM + wc * 32 + 8 * fq;
#pragma unroll
        for (int ai = 0; ai < 2; ++ai)
#pragma unroll
            for (int m = 0; m < 4; ++m) { const int r = row0 + ai * HALF + m * 16; const size_t off = (size_t)r * ldc + col0; float ss = 0.f;
#pragma unroll
                for (int bj = 0; bj < 2; ++bj) { f32x4 b0, b1;
                    if (BASE_BF16) { const u32x4 w = *(const u32x4*)((const bf16_t*)base + off + bj * HALF);
                        b0 = (f32x4){__uint_as_float(w.x << 16), __uint_as_float(w.x & 0xffff0000u), __uint_as_float(w.y << 16), __uint_as_float(w.y & 0xffff0000u)};
                        b1 = (f32x4){__uint_as_float(w.z << 16), __uint_as_float(w.z & 0xffff0000u), __uint_as_float(w.w << 16), __uint_as_float(w.w & 0xffff0000u)}; }
                    else { const float* bp = (const float*)base + off + bj * HALF; b0 = __builtin_nontemporal_load((const f32x4*)bp); b1 = __builtin_nontemporal_load((const f32x4*)(bp + 4)); }
                    const f32x4 v0 = b0 + acc[ai][bj][m][0], v1 = b1 + acc[ai][bj][m][1];
                    ss += ((v0[0] * v0[0] + v0[1] * v0[1]) + (v0[2] * v0[2] + v0[3] * v0[3])) + ((v1[0] * v1[0] + v1[1] * v1[1]) + (v1[2] * v1[2] + v1[3] * v1[3]));
                    u32x4 w; w.x = cvt_pk_bf16(v0[0], v0[1]); w.y = cvt_pk_bf16(v0[2], v0[3]); w.z = cvt_pk_bf16(v1[0], v1[1]); w.w = cvt_pk_bf16(v1[2], v1[3]);
                    *(u32x4*)(xo + off + bj * HALF) = w; }
                ss += __shfl_xor(ss, 16); ss += __shfl_xor(ss, 32);
                if (fq == 0) part[(size_t)r * 32 + u.pn * 4 + wc] = ss; }
    }
};
struct EpiFinal {
    static constexpr bool PERM = true, AFTER_DRAIN = false;
    const bf16_t* xb; float* out; const float* wfin; float* xbuf; unsigned* cnt; PG8_LAS unsigned char* tab; int ldc; float inv_n, eps;
    __device__ __forceinline__ void operator()(f32x4 (&acc)[2][2][4][2], const Unit& u, int wr, int wc, int fr, int fq) const {
        const int lane = fq * 16 + fr, wid = wr * 4 + wc;
        PG8_LAS float* P = (PG8_LAS float*)tab;
        PG8_LAS float* S = (PG8_LAS float*)(tab + 4096);
        PG8_LAS unsigned* flag = (PG8_LAS unsigned*)(tab + 4096 + 1024);
        const int row0 = u.pm * BM + wr * 64 + fr, col0 = u.pn * BM + wc * 32 + 8 * fq;
#pragma unroll
        for (int ai = 0; ai < 2; ++ai)
#pragma unroll
            for (int m = 0; m < 4; ++m) { const int r = row0 + ai * HALF + m * 16; const size_t off = (size_t)r * ldc + col0; float ss = 0.f;
#pragma unroll
                for (int bj = 0; bj < 2; ++bj) { const u32x4 w = *(const u32x4*)(xb + off + bj * HALF);
                    const f32x4 b0 = {__uint_as_float(w.x << 16), __uint_as_float(w.x & 0xffff0000u), __uint_as_float(w.y << 16), __uint_as_float(w.y & 0xffff0000u)};
                    const f32x4 b1 = {__uint_as_float(w.z << 16), __uint_as_float(w.z & 0xffff0000u), __uint_as_float(w.w << 16), __uint_as_float(w.w & 0xffff0000u)};
                    const f32x4 v0 = b0 + acc[ai][bj][m][0], v1 = b1 + acc[ai][bj][m][1]; acc[ai][bj][m][0] = v0; acc[ai][bj][m][1] = v1;
                    ss += ((v0[0] * v0[0] + v0[1] * v0[1]) + (v0[2] * v0[2] + v0[3] * v0[3])) + ((v1[0] * v1[0] + v1[1] * v1[1]) + (v1[2] * v1[2] + v1[3] * v1[3])); }
                ss += __shfl_xor(ss, 16); ss += __shfl_xor(ss, 32);
                if (fq == 0) P[(ai * HALF + wr * 64 + m * 16 + fr) * 4 + wc] = ss; }
        asm volatile("s_waitcnt lgkmcnt(0)" ::: "memory"); __builtin_amdgcn_s_barrier(); asm volatile("" ::: "memory");
        const int row = wid * 32 + (lane & 31);
        if (lane < 32) { const f32x4 p4 = *(PG8_LAS const f32x4*)(P + row * 4);
            __hip_atomic_store(xbuf + ((size_t)(u.pm * BM + row) * 8 + u.pn), (p4[0] + p4[1]) + (p4[2] + p4[3]), __ATOMIC_RELAXED, __HIP_MEMORY_SCOPE_AGENT); }
        asm volatile("s_waitcnt vmcnt(0)" ::: "memory");
        if (lane == 0) __hip_atomic_fetch_add(cnt + 64 * u.pm, 1u, __ATOMIC_RELAXED, __HIP_MEMORY_SCOPE_AGENT);
        if (wid == 0) { bool dead = false; const unsigned long long t0 = __builtin_amdgcn_s_memrealtime();
            for (;;) { if ((unsigned)__builtin_amdgcn_readfirstlane(__hip_atomic_load(cnt + 64 * u.pm, __ATOMIC_RELAXED, __HIP_MEMORY_SCOPE_AGENT)) >= 64u) break;
                if (__builtin_amdgcn_s_memrealtime() - t0 > 2000000ull) { dead = true; break; }
                __builtin_amdgcn_s_sleep(2); }
            __builtin_amdgcn_fence(__ATOMIC_ACQUIRE, "agent");
            if (lane == 0) flag[0] = dead ? 1u : 0u; }
        asm volatile("s_waitcnt vmcnt(0) lgkmcnt(0)" ::: "memory"); __builtin_amdgcn_s_barrier(); asm volatile("" ::: "memory");
        const bool bad = flag[0] != 0u;
        if (lane < 32) { const float* slot = xbuf + (size_t)(u.pm * BM + row) * 8; float q = 0.f;
#pragma unroll
            for (int t = 0; t < 8; ++t) q += __hip_atomic_load(slot + t, __ATOMIC_RELAXED, __HIP_MEMORY_SCOPE_AGENT);
            S[row] = rsqrtf(q * inv_n + eps); }
        asm volatile("s_waitcnt vmcnt(0) lgkmcnt(0)" ::: "memory"); __builtin_amdgcn_s_barrier(); asm volatile("" ::: "memory");
        const float qnan = __builtin_nanf("");
        f32x4 wv[2][2];
#pragma unroll
        for (int bj = 0; bj < 2; ++bj) { wv[bj][0] = *(const f32x4*)(wfin + col0 + bj * HALF); wv[bj][1] = *(const f32x4*)(wfin + col0 + bj * HALF + 4); }
#pragma unroll
        for (int ai = 0; ai < 2; ++ai)
#pragma unroll
            for (int m = 0; m < 4; ++m) { const int rl = ai * HALF + wr * 64 + m * 16 + fr; const float rs = bad ? qnan : S[rl]; float* op = out + (size_t)(u.pm * BM + rl) * ldc + col0;
#pragma unroll
                for (int bj = 0; bj < 2; ++bj) { __builtin_nontemporal_store(acc[ai][bj][m][0] * rs * wv[bj][0], (f32x4*)(op + bj * HALF)); __builtin_nontemporal_store(acc[ai][bj][m][1] * rs * wv[bj][1], (f32x4*)(op + bj * HALF + 4)); } }
    }
};
struct EpiSwiGLU {
    static constexpr bool PERM = true, AFTER_DRAIN = false;
    bf16_t* H; int ldh; const float* part; float inv_n, eps;
    __device__ __forceinline__ static float silu_mul(float g, float uu) { const float e = __builtin_amdgcn_exp2f(g * -1.4426950408889634f); return g * uu * __builtin_amdgcn_rcpf(1.f + e); }
    __device__ __forceinline__ void operator()(const f32x4 (&acc)[2][2][4][2], const Unit& u, int wr, int wc, int fr, int fq) const {
        const int row0 = u.pm * BM + wr * 64 + fr, col0 = u.pn * HALF + wc * 32 + 8 * fq;
#pragma unroll
        for (int ai = 0; ai < 2; ++ai)
#pragma unroll
            for (int m = 0; m < 4; ++m) { const int r = row0 + ai * HALF + m * 16;
                const f32x4* pp = (const f32x4*)(part + (size_t)r * 32 + fq * 8); const f32x4 pa = pp[0], pb = pp[1];
                float s = ((pa[0] + pa[1]) + (pa[2] + pa[3])) + ((pb[0] + pb[1]) + (pb[2] + pb[3]));
                s += __shfl_xor(s, 16); s += __shfl_xor(s, 32);
                const float rstd = rsqrtf(s * inv_n + eps);
                const f32x4 g0 = acc[ai][0][m][0] * rstd, g1 = acc[ai][0][m][1] * rstd, u0 = acc[ai][1][m][0] * rstd, u1 = acc[ai][1][m][1] * rstd;
                u32x4 w; w.x = cvt_pk_bf16(silu_mul(g0[0], u0[0]), silu_mul(g0[1], u0[1])); w.y = cvt_pk_bf16(silu_mul(g0[2], u0[2]), silu_mul(g0[3], u0[3]));
                w.z = cvt_pk_bf16(silu_mul(g1[0], u1[0]), silu_mul(g1[1], u1[1])); w.w = cvt_pk_bf16(silu_mul(g1[2], u1[2]), silu_mul(g1[3], u1[3]));
                if (EPI_NT_H) __builtin_nontemporal_store(w, (u32x4*)(H + (size_t)r * ldh + col0)); else *(u32x4*)(H + (size_t)r * ldh + col0) = w; }
    }
};
template <class Epi, class Sched, bool ALIGN_EPI = false, bool SP2 = false>
__device__ __forceinline__ void gemm_phase(PG8_LAS unsigned char* lds, const Gemm g, const Sched& S, const Epi& E) {
    const int tid = threadIdx.x, wid = __builtin_amdgcn_readfirstlane(tid >> 6), lane = tid & 63, wr = wid >> 2, wc = wid & 3, fr = lane & 15, fq = lane >> 4;
    const int K = g.K, nt = K / BK;
    unsigned voffA[2], voffB[2];
#pragma unroll
    for (int i = 0; i < 2; ++i) { int R, C; stage_rc(tid * 16 + i * 8192, R, C); const int Rb = Epi::PERM ? ((R & ~31) + perm32(R & 31)) : R;
        voffA[i] = (unsigned)(R * K + C) * 2u; voffB[i] = (unsigned)(Rb * K + C) * 2u; }
    const size_t kstep = (size_t)(BK * 2);
    const size_t hstep = (size_t)HALF * K * 2;
    const size_t tstep = 2 * hstep;
    const unsigned ldsw = (unsigned)wid * 1024u;
    const int aoff = lds_byte(wr * 64 + fr, fq * 8), boff = lds_byte(wc * 32 + fr, fq * 8);
#define PG8_SA(b, h) (((b) * 2 + (h)) * HTB)
#define PG8_SB(b, h) ((4 + (b) * 2 + (h)) * HTB)
#define PG8_STAGE(bufoff, gbase, voff) do { _Pragma("unroll") for (int _i = 0; _i < 2; ++_i) \
        __builtin_amdgcn_global_load_lds((const unsigned*)((const char*)(gbase) + (voff)[_i]), (PG8_LAS unsigned*)(lds + (bufoff) + ldsw + _i * 8192), 16, 0, 0); } while (0)
#define PG8_LDA(dst, b, h) do { _Pragma("unroll") for (int m = 0; m < 4; ++m) _Pragma("unroll") for (int k = 0; k < 2; ++k) dst[m][k] = *(const PG8_LAS bf16x8*)(lds + PG8_SA(b, h) + aoff + m * 2048 + k * 1024); } while (0)
#define PG8_LDB(dst, b, h) do { _Pragma("unroll") for (int n = 0; n < 2; ++n) _Pragma("unroll") for (int k = 0; k < 2; ++k) dst[n][k] = *(const PG8_LAS bf16x8*)(lds + PG8_SB(b, h) + boff + n * 2048 + k * 1024); } while (0)
#define PG8_MMA(ai, bj, At, Bt) do { __builtin_amdgcn_s_setprio(1); _Pragma("unroll") for (int m = 0; m < 4; ++m) _Pragma("unroll") for (int n = 0; n < 2; ++n) _Pragma("unroll") for (int k = 0; k < 2; ++k) \
        acc[ai][bj][m][n] = __builtin_amdgcn_mfma_f32_16x16x32_bf16(Bt[n][k], At[m][k], acc[ai][bj][m][n], 0, 0, 0); __builtin_amdgcn_s_setprio(0); } while (0)
#define PG8_WAIT_V(n) asm volatile("s_waitcnt vmcnt(" #n ")" ::: "memory")
#define PG8_WAIT_L(n) asm volatile("s_waitcnt lgkmcnt(" #n ")" ::: "memory")
#define PG8_BAR __builtin_amdgcn_s_barrier()
#define PG8_SCHED __builtin_amdgcn_sched_barrier(0)
    Unit cur, nxt; int ui = 0;
    if (!S.next(0, cur)) return;
    f32x4 acc[2][2][4][2];
#pragma unroll
    for (int a = 0; a < 2; ++a)
#pragma unroll
        for (int b = 0; b < 2; ++b)
#pragma unroll
            for (int m = 0; m < 4; ++m)
#pragma unroll
                for (int n = 0; n < 2; ++n) acc[a][b][m][n] = (f32x4){0.f, 0.f, 0.f, 0.f};
    bf16x8 At[4][2], B0[2][2], B1[2][2];
    const char* cA = (const char*)g.A + (size_t)cur.pm * tstep; const char* cB = (const char*)g.Bt + (size_t)cur.pn * tstep;
    S.a_ready(cur);
    if constexpr (SP2) {
        PG8_STAGE(PG8_SB(0, 0), cB, voffB); PG8_STAGE(PG8_SB(0, 1), cB + hstep, voffB); PG8_STAGE(PG8_SA(0, 0), cA, voffA); PG8_STAGE(PG8_SA(0, 1), cA + hstep, voffA);
        if (wr == 1) PG8_BAR;
        PG8_WAIT_V(2); PG8_BAR;
        PG8_STAGE(PG8_SB(1, 0), cB + kstep, voffB); PG8_STAGE(PG8_SA(1, 0), cA + kstep, voffA); PG8_STAGE(PG8_SB(1, 1), cB + hstep + kstep, voffB);
        PG8_WAIT_V(6); PG8_BAR;
    } else {
        PG8_STAGE(PG8_SB(0, 0), cB, voffB); PG8_STAGE(PG8_SA(0, 0), cA, voffA); PG8_STAGE(PG8_SB(0, 1), cB + hstep, voffB); PG8_STAGE(PG8_SA(0, 1), cA + hstep, voffA);
        if (wr == 1) PG8_BAR;
        PG8_WAIT_V(4); PG8_BAR;
        PG8_STAGE(PG8_SB(1, 0), cB + kstep, voffB); PG8_STAGE(PG8_SA(1, 0), cA + kstep, voffA); PG8_STAGE(PG8_SB(1, 1), cB + hstep + kstep, voffB);
        PG8_WAIT_V(6); PG8_BAR;
    }
    for (;;) {
        const bool has_next = S.next(ui + 1, nxt);
        const char* nA = has_next ? (const char*)g.A + (size_t)nxt.pm * tstep : cA; const char* nB = has_next ? (const char*)g.Bt + (size_t)nxt.pn * tstep : cB;
        for (int t = 0; t < nt; t += 2) {
            const bool last = (t == nt - 2);
            const char* a1 = cA + (size_t)(t + 1) * kstep;
            const char* a2 = last ? nA : cA + (size_t)(t + 2) * kstep; const char* b2 = last ? nB : cB + (size_t)(t + 2) * kstep;
            const char* a3 = a2 + kstep; const char* b3 = b2 + kstep;
            if (last && has_next) S.a_ready(nxt);
            if constexpr (SP2) {
            PG8_LDB(B0, 0, 0); PG8_LDB(B1, 0, 1); PG8_SCHED; PG8_LDA(At, 0, 0); PG8_STAGE(PG8_SA(1, 1), a1 + hstep, voffA);
            PG8_WAIT_V(8); PG8_WAIT_L(0); PG8_BAR; PG8_MMA(0, 0, At, B0); PG8_MMA(0, 1, At, B1); PG8_BAR; PG8_SCHED;
            PG8_LDA(At, 0, 1); PG8_STAGE(PG8_SB(0, 0), b2, voffB); PG8_STAGE(PG8_SB(0, 1), b2 + hstep, voffB); PG8_STAGE(PG8_SA(0, 0), a2, voffA);
            PG8_WAIT_V(8); PG8_WAIT_L(0); PG8_BAR; PG8_MMA(1, 0, At, B0); PG8_MMA(1, 1, At, B1); PG8_BAR; PG8_SCHED;
            PG8_LDB(B0, 1, 0); PG8_LDB(B1, 1, 1); PG8_SCHED; PG8_LDA(At, 1, 0); PG8_STAGE(PG8_SA(0, 1), a2 + hstep, voffA);
            PG8_WAIT_V(8); PG8_WAIT_L(0); PG8_BAR; PG8_MMA(0, 0, At, B0); PG8_MMA(0, 1, At, B1); PG8_BAR; PG8_SCHED;
            PG8_LDA(At, 1, 1); PG8_STAGE(PG8_SB(1, 0), b3, voffB); PG8_STAGE(PG8_SB(1, 1), b3 + hstep, voffB); PG8_STAGE(PG8_SA(1, 0), a3, voffA);
            PG8_WAIT_V(8); PG8_WAIT_L(0); PG8_BAR; PG8_MMA(1, 0, At, B0); PG8_MMA(1, 1, At, B1); PG8_BAR; PG8_SCHED;
            } else {
            PG8_LDB(B0, 0, 0); PG8_SCHED; PG8_LDA(At, 0, 0); PG8_STAGE(PG8_SA(1, 1), a1 + hstep, voffA);
            PG8_WAIT_L(8); PG8_BAR; PG8_WAIT_L(0); PG8_MMA(0, 0, At, B0); PG8_BAR; PG8_SCHED;
            PG8_LDB(B1, 0, 1); PG8_STAGE(PG8_SB(0, 0), b2, voffB);
            PG8_BAR; PG8_WAIT_L(0); PG8_MMA(0, 1, At, B1); PG8_BAR;
            PG8_LDA(At, 0, 1); PG8_STAGE(PG8_SA(0, 0), a2, voffA);
            PG8_BAR; PG8_WAIT_L(0); PG8_MMA(1, 0, At, B0); PG8_BAR; PG8_SCHED;
            PG8_STAGE(PG8_SB(0, 1), b2 + hstep, voffB);
            PG8_WAIT_V(6); PG8_BAR; PG8_MMA(1, 1, At, B1); PG8_BAR;
            PG8_LDB(B0, 1, 0); PG8_SCHED; PG8_LDA(At, 1, 0); PG8_STAGE(PG8_SA(0, 1), a2 + hstep, voffA);
            PG8_WAIT_L(8); PG8_BAR; PG8_WAIT_L(0); PG8_MMA(0, 0, At, B0); PG8_BAR; PG8_SCHED;
            PG8_LDB(B1, 1, 1); PG8_STAGE(PG8_SB(1, 0), b3, voffB);
            PG8_BAR; PG8_WAIT_L(0); PG8_MMA(0, 1, At, B1); PG8_BAR;
            PG8_LDA(At, 1, 1); PG8_STAGE(PG8_SA(1, 0), a3, voffA);
            PG8_BAR; PG8_WAIT_L(0); PG8_MMA(1, 0, At, B0); PG8_BAR; PG8_SCHED;
            PG8_STAGE(PG8_SB(1, 1), b3 + hstep, voffB);
            PG8_WAIT_V(6); PG8_BAR; PG8_MMA(1, 1, At, B1); PG8_BAR;
            }
        }
        if constexpr (ALIGN_EPI) { if (wr == 0) PG8_BAR; }
        if constexpr (!Epi::AFTER_DRAIN) { E(acc, cur, wr, wc, fr, fq); S.done(cur); }
        if (!has_next) break;
#pragma unroll
        for (int a = 0; a < 2; ++a)
#pragma unroll
            for (int b = 0; b < 2; ++b)
#pragma unroll
                for (int m = 0; m < 4; ++m)
#pragma unroll
                    for (int n = 0; n < 2; ++n) acc[a][b][m][n] = (f32x4){0.f, 0.f, 0.f, 0.f};
        cur = nxt; cA = nA; cB = nB; ++ui;
        if constexpr (ALIGN_EPI) { if (wr == 1) PG8_BAR; }
    }
    PG8_WAIT_V(0);
    if constexpr (!ALIGN_EPI) { if (wr == 0) PG8_BAR; }
    PG8_BAR;
    if constexpr (Epi::AFTER_DRAIN) { E.fused(acc, cur, wr, wc, fr, fq, lds, wid, lane); S.done(cur); }
#undef PG8_SA
#undef PG8_SB
#undef PG8_STAGE
#undef PG8_LDA
#undef PG8_LDB
#undef PG8_MMA
#undef PG8_WAIT_V
#undef PG8_WAIT_L
#undef PG8_BAR
#undef PG8_SCHED
}
}
namespace att {
#ifndef ATT_NT_OUT
#define ATT_NT_OUT 0
#endif
#define ATT_LAS __attribute__((address_space(3)))
typedef unsigned short bf16_t;
typedef short bf16x8 __attribute__((ext_vector_type(8)));
typedef short s16x4 __attribute__((ext_vector_type(4)));
typedef float f32x16 __attribute__((ext_vector_type(16)));
typedef float f32x4 __attribute__((ext_vector_type(4)));
typedef unsigned u32x4 __attribute__((ext_vector_type(4)));
typedef unsigned u32x2 __attribute__((ext_vector_type(2)));
constexpr int SEQ = 2048, PITCH = 4608, OPITCH = 2048;
__device__ __forceinline__ unsigned cvtpk(float lo, float hi) { typedef float f2_t __attribute__((ext_vector_type(2))); typedef __bf16 b2_t __attribute__((ext_vector_type(2))); f2_t v = {lo, hi}; b2_t b = __builtin_convertvector(v, b2_t); return __builtin_bit_cast(unsigned, b); }
__device__ __forceinline__ float swapmax(float m) { auto rr = __builtin_amdgcn_permlane32_swap(__float_as_uint(m), __float_as_uint(m), false, false); return fmaxf(__uint_as_float(rr[0]), __uint_as_float(rr[1])); }
__device__ __forceinline__ float swapsum(float m) { auto rr = __builtin_amdgcn_permlane32_swap(__float_as_uint(m), __float_as_uint(m), false, false); return __uint_as_float(rr[0]) + __uint_as_float(rr[1]); }
__device__ __forceinline__ s16x4 vtr(ATT_LAS const char* p) { return __builtin_bit_cast(s16x4, __builtin_amdgcn_ds_read_tr16_b64_v4i16((ATT_LAS s16x4*)p)); }

struct UnitP {
    int b, q0;
    int qcol, kcol, vcol;
    int kofs;
    float slope2;
    float m_init, l_init;
    int T0, T1;
    int tlo, thi;
    int window;
    int maskall;
    int ocol;
};

template <int DV, int KW>
__device__ __forceinline__ void attn_unit(ATT_LAS char* lds, const bf16_t* __restrict__ P, bf16_t* __restrict__ MIX, const UnitP up, bool diff, float lam, const float* __restrict__ subln_w, int tid,
                                          bool prefetched  , bool has_next, int nb, int nkcol, int nvcol, int nT0, int nT1  ) {
    static_assert(KW == DV && (KW == 128 || KW == 64), "tile geometry");
    constexpr int ROWB = KW * 2, CPR = ROWB / 16, RPP = 1024 / ROWB, NP = 64 / RPP / 8, TILEB = 64 * ROWB, STG = 2 * TILEB, NSTG = 4, NEB = DV / 32, NI = 2 * NP;
    constexpr bool WIDE = (KW == 128);
    const int lane = tid & 63, wid = __builtin_amdgcn_readfirstlane(tid >> 6), r32 = lane & 31, hi = lane >> 5, wq = wid & 3, g = wid >> 2;
    const int qw = up.q0 + 32 * wq, q = qw + r32;
    const size_t rowbase = (size_t)up.b * SEQ;
    __syncthreads();
    unsigned kso[NP], vso[NP];
#pragma unroll
    for (int i = 0; i < NP; ++i) { const int piece = wid + 8 * i, row = RPP * piece + lane / CPR, slot = lane % CPR;
        const int kch = WIDE ? (slot ^ (row & 15)) : (slot ^ ((row >> 1) & 7));
        const int vch = ((((slot >> 2) ^ (WIDE ? (row & 3) : ((row >> 1) & 1))) << 2) | (slot & 3));
        kso[i] = (unsigned)(row * PITCH + up.kcol + kch * 8); vso[i] = (unsigned)(row * PITCH + up.vcol + vch * 8); }
    const bf16_t* Pb = P + rowbase * PITCH;
#define ATT_DMA2(pb_, dk_, dv_, t, sg) do { const bf16_t* tb_ = (pb_) + (size_t)(t) * 64 * PITCH; \
    _Pragma("unroll") for (int i_ = 0; i_ < NP; ++i_) { \
        __builtin_amdgcn_global_load_lds((const unsigned*)(tb_ + (kso[i_] + (dk_))), (ATT_LAS unsigned*)(lds + (sg) * STG + (wid + 8 * i_) * 1024), 16, 0, 0); \
        __builtin_amdgcn_global_load_lds((const unsigned*)(tb_ + (vso[i_] + (dv_))), (ATT_LAS unsigned*)(lds + (sg) * STG + TILEB + (wid + 8 * i_) * 1024), 16, 0, 0); } } while (0)
#define ATT_DMA(t, sg) ATT_DMA2(Pb, 0u, 0u, t, sg)
    const int rot = prefetched ? 2 : 0;
    bf16x8 qr[4];
    { const bf16_t* qp = P + (rowbase + q) * PITCH + up.qcol + hi * 8;
#pragma unroll
      for (int d0 = 0; d0 < 4; ++d0) qr[d0] = *(const bf16x8*)(qp + d0 * 16); }
    if (!prefetched) {
#pragma unroll
        for (int j = 0; j < 2; ++j) if (up.T0 + j <= up.T1) ATT_DMA(up.T0 + j, j); }
    f32x16 o[NEB];
#pragma unroll
    for (int e = 0; e < NEB; ++e)
#pragma unroll
        for (int r = 0; r < 16; ++r) o[e][r] = 0.f;
    float mhat = up.l_init != 0.f ? up.m_init + up.slope2 * (float)q : 0.f, l = hi == 0 ? up.l_init : 0.f;
    float cb[16];
#pragma unroll
    for (int r = 0; r < 16; ++r) cb[r] = up.slope2 * (float)((r & 3) + 8 * (r >> 2));
    int kad[4];
#pragma unroll
    for (int d0 = 0; d0 < 4; ++d0) { const int c = (up.kofs >> 4) + 2 * d0 + hi; kad[d0] = r32 * ROWB + ((WIDE ? (c ^ (r32 & 15)) : (c ^ ((r32 >> 1) & 7))) << 4); }
    const int i16 = lane & 15, q4 = i16 >> 2, vsw = WIDE ? q4 : (q4 >> 1);
    const int vlane = TILEB + (4 * hi + q4) * ROWB + 32 * ((lane >> 4) & 1) + 8 * (i16 & 3);
    int vad[NEB];
#pragma unroll
    for (int e = 0; e < NEB; ++e) vad[e] = vlane + ((e ^ vsw) << 6);
    bf16x8 pa[4];
#define ATT_PV(sgi) do { ATT_LAS const char* Sv_ = lds + (sgi) * STG; \
    _Pragma("unroll") for (int e = 0; e < NEB; ++e) _Pragma("unroll") for (int ks = 0; ks < 4; ++ks) { \
        const s16x4 lo = vtr(Sv_ + vad[e] + ks * 16 * ROWB), hh = vtr(Sv_ + vad[e] + ks * 16 * ROWB + 8 * ROWB); \
        const bf16x8 vf = {lo[0], lo[1], lo[2], lo[3], hh[0], hh[1], hh[2], hh[3]}; \
        o[e] = __builtin_amdgcn_mfma_f32_32x32x16_bf16(vf, pa[ks], o[e], 0, 0, 0); } } while (0)
    for (int t = up.T0; t <= up.T1 + 1; ++t) {
        const int sg = (t - up.T0 + rot) & (NSTG - 1);
        if (t + 1 <= up.T1) { if (NI == 4) asm volatile("s_waitcnt vmcnt(4) lgkmcnt(0)" ::: "memory"); else asm volatile("s_waitcnt vmcnt(2) lgkmcnt(0)" ::: "memory"); }
        else asm volatile("s_waitcnt vmcnt(0) lgkmcnt(0)" ::: "memory");
        __builtin_amdgcn_s_barrier();
        asm volatile("" ::: "memory");
        if (t + 2 <= up.T1) ATT_DMA(t + 2, (sg + 2) & (NSTG - 1));
        if (g == 1 && t - 1 >= up.tlo && t - 1 <= up.thi && t - 1 >= up.T0) ATT_PV((sg + NSTG - 1) & (NSTG - 1));
        if (t >= up.tlo && t <= up.thi && t <= up.T1) {
            ATT_LAS const char* Sb = lds + sg * STG;
            f32x16 p0, p1;
            { const float base0 = up.slope2 * (float)(64 * t + 4 * hi) - mhat, base1 = base0 + 32.f * up.slope2;
#pragma unroll
              for (int r = 0; r < 16; ++r) { p0[r] = cb[r] + base0; p1[r] = cb[r] + base1; } }
#pragma unroll
            for (int d0 = 0; d0 < 4; ++d0) {
                const bf16x8 k0 = *(ATT_LAS const bf16x8*)(Sb + kad[d0]), k1 = *(ATT_LAS const bf16x8*)(Sb + kad[d0] + 32 * ROWB);
                p0 = __builtin_amdgcn_mfma_f32_32x32x16_bf16(k0, qr[d0], p0, 0, 0, 0);
                p1 = __builtin_amdgcn_mfma_f32_32x32x16_bf16(k1, qr[d0], p1, 0, 0, 0);
            }
            if (up.maskall || t == up.thi) {
                const int kvb = 64 * t + 4 * hi, qlo = q - up.window;
#pragma unroll
                for (int r = 0; r < 16; ++r) { const int kv = kvb + (r & 3) + 8 * (r >> 2);
                    if (kv > q || kv <= qlo) p0[r] = -INFINITY;
                    if (kv + 32 > q || kv + 32 <= qlo) p1[r] = -INFINITY; }
            }
            float ra = fmaxf(fmaxf(p0[0], p0[1]), p1[0]), rb = fmaxf(fmaxf(p0[2], p0[3]), p1[1]); ra = fmaxf(fmaxf(ra, p1[2]), p1[3]);
#pragma unroll
            for (int r = 4; r < 16; r += 4) { ra = fmaxf(fmaxf(ra, p0[r]), p0[r + 1]); rb = fmaxf(fmaxf(rb, p0[r + 2]), p0[r + 3]); ra = fmaxf(fmaxf(ra, p1[r]), p1[r + 1]); rb = fmaxf(fmaxf(rb, p1[r + 2]), p1[r + 3]); }
            const float rm = swapmax(fmaxf(ra, rb));
            if (__any(rm > 8.f)) {
                const float dl = fmaxf(rm, 0.f), alpha = __builtin_amdgcn_exp2f(-dl);
                mhat += dl; l *= alpha;
#pragma unroll
                for (int r = 0; r < 16; ++r) { p0[r] -= dl; p1[r] -= dl; }
#pragma unroll
                for (int e = 0; e < NEB; ++e)
#pragma unroll
                    for (int r = 0; r < 16; ++r) o[e][r] *= alpha;
            }
            float ps = 0.f;
#pragma unroll
            for (int r = 0; r < 16; ++r) { p0[r] = __builtin_amdgcn_exp2f(p0[r]); p1[r] = __builtin_amdgcn_exp2f(p1[r]); ps += p0[r] + p1[r]; }
            l += ps;
#pragma unroll
            for (int s = 0; s < 2; ++s) {
                u32x4 w0, w1;
                w0.x = cvtpk(p0[8 * s + 0], p0[8 * s + 1]); w0.y = cvtpk(p0[8 * s + 2], p0[8 * s + 3]); w0.z = cvtpk(p0[8 * s + 4], p0[8 * s + 5]); w0.w = cvtpk(p0[8 * s + 6], p0[8 * s + 7]);
                w1.x = cvtpk(p1[8 * s + 0], p1[8 * s + 1]); w1.y = cvtpk(p1[8 * s + 2], p1[8 * s + 3]); w1.z = cvtpk(p1[8 * s + 4], p1[8 * s + 5]); w1.w = cvtpk(p1[8 * s + 6], p1[8 * s + 7]);
                pa[s] = __builtin_bit_cast(bf16x8, w0); pa[2 + s] = __builtin_bit_cast(bf16x8, w1);
            }
            if (g == 0) ATT_PV(sg);
        }
    }
#undef ATT_PV
    asm volatile("s_waitcnt vmcnt(0) lgkmcnt(0)" ::: "memory");
    __builtin_amdgcn_s_barrier();
    asm volatile("" ::: "memory");
    if (has_next) {
        const bf16_t* Pn = P + (size_t)nb * SEQ * PITCH; const unsigned dk = (unsigned)(nkcol - up.kcol), dv = (unsigned)(nvcol - up.vcol);
#pragma unroll
        for (int j = 0; j < 2; ++j) if (nT0 + j <= nT1) ATT_DMA2(Pn, dk, dv, nT0 + j, 2 + j);
    }
#undef ATT_DMA
#undef ATT_DMA2
    const float lt = swapsum(l), inv = 1.f / lt;
    constexpr int ORS = DV * 2 + 16, OCH = DV / 8, ORPI = 64 / OCH  ;
    if (!diff) {
        ATT_LAS char* ot = lds + 4 * STG + wid * (32 * ORS);
#pragma unroll
        for (int e = 0; e < NEB; ++e)
#pragma unroll
            for (int r4 = 0; r4 < 4; ++r4) { u32x2 w; w.x = cvtpk(o[e][4 * r4] * inv, o[e][4 * r4 + 1] * inv); w.y = cvtpk(o[e][4 * r4 + 2] * inv, o[e][4 * r4 + 3] * inv);
                *(ATT_LAS u32x2*)(ot + r32 * ORS + (e * 32 + 8 * r4 + 4 * hi) * 2) = w; }
        bf16_t* ob = MIX + (rowbase + qw) * OPITCH + up.ocol;
#pragma unroll
        for (int j = 0; j < 32 / ORPI; ++j) { const int row = j * ORPI + lane / OCH, ch = lane % OCH; const u32x4 v = *(ATT_LAS const u32x4*)(ot + row * ORS + ch * 16); *(u32x4*)(ob + (size_t)row * OPITCH + ch * 8) = v; }
    } else {
        ATT_LAS float* xb = (ATT_LAS float*)(lds + wq * (NEB * 16 * 64 * 4)) + lane;
        if (g == 1) { const float sc = lam * inv;
#pragma unroll
            for (int e = 0; e < NEB; ++e)
#pragma unroll
                for (int r = 0; r < 16; ++r) xb[(e * 16 + r) * 64] = o[e][r] * sc; }
        __syncthreads();
        if (g == 0) { float ss = 0.f;
#pragma unroll
            for (int e = 0; e < NEB; ++e)
#pragma unroll
                for (int r = 0; r < 16; ++r) { const float d = o[e][r] * inv - xb[(e * 16 + r) * 64]; o[e][r] = d; ss += d * d; }
            ss = swapsum(ss);
            const float rs = rsqrtf(ss * (1.f / DV) + 1e-5f) * 0.8f;
            ATT_LAS char* ot = lds + wq * (NEB * 16 * 64 * 4);
            asm volatile("s_waitcnt lgkmcnt(0)" ::: "memory");
#pragma unroll
            for (int e = 0; e < NEB; ++e)
#pragma unroll
                for (int r4 = 0; r4 < 4; ++r4) { const f32x4 wv = *(const f32x4*)(subln_w + e * 32 + 8 * r4 + 4 * hi);
                    u32x2 w; w.x = cvtpk(o[e][4 * r4] * rs * wv[0], o[e][4 * r4 + 1] * rs * wv[1]); w.y = cvtpk(o[e][4 * r4 + 2] * rs * wv[2], o[e][4 * r4 + 3] * rs * wv[3]);
                    *(ATT_LAS u32x2*)(ot + r32 * ORS + (e * 32 + 8 * r4 + 4 * hi) * 2) = w; }
            bf16_t* ob = MIX + (rowbase + qw) * OPITCH + up.ocol;
#pragma unroll
            for (int j = 0; j < 32 / ORPI; ++j) { const int row = j * ORPI + lane / OCH, ch = lane % OCH; const u32x4 v = *(ATT_LAS const u32x4*)(ot + row * ORS + ch * 16); *(u32x4*)(ob + (size_t)row * OPITCH + ch * 8) = v; } }
    }
}
}
constexpr int NWAVES = 8;
#ifndef CV_ROT
#define CV_ROT 0
#endif
#ifndef CV_NTS
#define CV_NTS false
#endif
#ifndef P4_ALIGN
#define P4_ALIGN true
#endif
#ifndef WGM_P1
#define WGM_P1 4
#endif
#ifndef WGM_P3
#define WGM_P3 4
#endif
#ifndef WGM_P4
#define WGM_P4 8
#endif
#ifndef WGM_P5
#define WGM_P5 4
#endif
#ifndef FUSE_FINAL
#define FUSE_FINAL 0
#endif
#ifndef GEMM_SP2
#define GEMM_SP2 true
#endif
#ifndef MK_N_LAUNCHES
#define MK_N_LAUNCHES 1
#endif
constexpr int N_PHASES = 7;
constexpr int BATCH = 8, SEQ = 2048, D = 2048, M = BATCH * SEQ, INC = 4608, DFF = 5632, NGU = 2 * DFF;
constexpr float RMS_EPS = 1e-5f;
constexpr float QSCALE2 = 0.125f * 1.4426950408889634f;
constexpr size_t MiB = 1u << 20;
constexpr size_t WS_PART1 = 1 * MiB, WS_PART2 = 3 * MiB;
constexpr size_t WS_WIN = 8 * MiB, WS_WOUT = 26 * MiB, WS_WGU = 34 * MiB, WS_WDN = 78 * MiB;
constexpr size_t WS_XN = 100 * MiB;
constexpr size_t WS_PROJ = 164 * MiB, WS_MIX = 308 * MiB;
constexpr size_t WS_H = 164 * MiB;
constexpr size_t WS_END = 372 * MiB;
static_assert(WS_H + (size_t)M * DFF * 2 <= WS_END && WS_MIX + (size_t)M * D * 2 <= WS_END && WS_PROJ + (size_t)M * INC * 2 <= WS_MIX, "ws map");
constexpr int RING_BYTES = 131072, LDS_BYTES = 147456;

#define LAS __attribute__((address_space(3)))
typedef unsigned short bf16;
typedef unsigned v4u __attribute__((ext_vector_type(4)));
typedef float f32x4 __attribute__((ext_vector_type(4)));
__device__ __forceinline__ unsigned pk2(float lo, float hi) { return pg8::cvt_pk_bf16(lo, hi); }
__device__ __forceinline__ float wave_sum(float v) {
#pragma unroll
    for (int o = 1; o < 64; o <<= 1) v += __shfl_xor(v, o);
    return v;
}
template <int NB> __device__ __forceinline__ void transpose_item(const float* __restrict__ W, int K, int N, bf16* __restrict__ WT, int dst_row0, const float* __restrict__ kscale, float cscale, LAS float* scr, int k0, int n0, int lane, bool nts = false) {
    const float* src = W + (size_t)(k0 + (lane >> 4)) * N + n0 + 4 * (lane & 15);
#pragma unroll
    for (int b = 0; b < 16 / NB; ++b) {
        f32x4 v[NB];
#pragma unroll
        for (int i = 0; i < NB; ++i) v[i] = __builtin_nontemporal_load((const f32x4*)(src + (size_t)(4 * (b * NB + i)) * N));
#pragma unroll
        for (int i = 0; i < NB; ++i) { const int kk = 4 * (b * NB + i) + (lane >> 4); float sc = cscale; if (kscale) sc *= kscale[k0 + kk];
            LAS float* d = scr + kk * 65 + 4 * (lane & 15); d[0] = v[i].x * sc; d[1] = v[i].y * sc; d[2] = v[i].z * sc; d[3] = v[i].w * sc; }
        if (NB < 16) asm volatile("" ::: "memory");
    }
    asm volatile("s_waitcnt lgkmcnt(0)" ::: "memory");
    const int c = lane & 7;
#pragma unroll
    for (int j = 0; j < 8; ++j) { const int n = (lane >> 3) + 8 * j; const LAS float* s = scr + (8 * c) * 65 + n;
        v4u o; o.x = pk2(s[0 * 65], s[1 * 65]); o.y = pk2(s[2 * 65], s[3 * 65]); o.z = pk2(s[4 * 65], s[5 * 65]); o.w = pk2(s[6 * 65], s[7 * 65]);
        v4u* dp = (v4u*)(WT + (size_t)(dst_row0 + n) * K + k0 + 8 * c); if (nts) __builtin_nontemporal_store(o, dp); else *dp = o; }
    asm volatile("s_waitcnt lgkmcnt(0)" ::: "memory");
}

#define XB_TMO      128
#define XB_XCNT(j)  (256  + 64 * (j))
#define XB_XSUB(j)  (1280 + 64 * (j))
#define XB_XGEN(j)  (2304 + 64 * (j))
#define XB_TOP      3328
#define XB_TOPGEN   3392
#define XCD_BAR_WORDS 3456
#define XB_SPIN_CAP (1u << 18)

__device__ __forceinline__ unsigned xb_ld(unsigned* p)              { return __hip_atomic_load(p, __ATOMIC_RELAXED, __HIP_MEMORY_SCOPE_AGENT); }
__device__ __forceinline__ unsigned xb_add(unsigned* p, unsigned v) { return __hip_atomic_fetch_add(p, v, __ATOMIC_RELAXED, __HIP_MEMORY_SCOPE_AGENT); }
__device__ __forceinline__ unsigned xb_xcc_id() { return (unsigned)__builtin_amdgcn_s_getreg((3 << 11) | 20) & 0xFu; }
#define XB_SPIN(cond, bar) do { unsigned _sp = 0; while (cond) { __builtin_amdgcn_s_sleep(1); \
    if ((++_sp & 255u) == 0u) { if (xb_ld(&(bar)[XB_TMO])) break; if (_sp > XB_SPIN_CAP) { atomicAdd(&(bar)[XB_TMO], 1u); break; } } } } while (0)

struct XcdBarrier {
    unsigned* bar; unsigned x;
    volatile LAS unsigned* st;
};

__device__ __forceinline__ XcdBarrier xcd_barrier_post(unsigned* bar, volatile LAS unsigned* st) {
    XcdBarrier b; b.bar = bar; b.x = xb_xcc_id(); b.st = st;
    if (threadIdx.x == 0) (void)xb_add(&bar[XB_XCNT(b.x)], 1u);
    return b;
}
__device__ __forceinline__ void xcd_barrier_complete(unsigned* bar, unsigned x, unsigned& nloc, unsigned& nx) {
    const unsigned G = gridDim.x * gridDim.y * gridDim.z;
    unsigned sum, cnt, mine, sp = 0u;
    for (;;) {
        sum = 0u; cnt = 0u; mine = 0u;
#pragma unroll
        for (unsigned j = 0; j < 16; ++j) { const unsigned c = xb_ld(&bar[XB_XCNT(j)]); sum += c; cnt += (c > 0u) ? 1u : 0u; mine = (j == x) ? c : mine; }
        if (sum == G) break;
        __builtin_amdgcn_s_sleep(1);
        if ((++sp & 255u) == 0u) { if (xb_ld(&bar[XB_TMO])) break; if (sp > XB_SPIN_CAP) { atomicAdd(&bar[XB_TMO], 1u); break; } }
    }
    nloc = mine > 0u ? mine : 1u; nx = cnt > 0u ? cnt : 1u;
}

__device__ __forceinline__ void xcd_barrier(const XcdBarrier& b) {
    asm volatile("s_waitcnt vmcnt(0)" ::: "memory");
    __syncthreads();
    if (threadIdx.x == 0) {
        unsigned* bar = b.bar;
        __builtin_amdgcn_s_waitcnt(0);
        unsigned nloc = b.st[0], nx = b.st[1];
        if (nloc == 0u) { xcd_barrier_complete(bar, b.x, nloc, nx); b.st[0] = nloc; b.st[1] = nx; }
        const unsigned old = xb_add(&bar[XB_XSUB(b.x)], 1u);
        const unsigned gen = old / nloc;
        if (old + 1u == (gen + 1u) * nloc) {
            __builtin_amdgcn_fence(__ATOMIC_RELEASE, "agent");
            asm volatile("s_waitcnt vmcnt(0)" ::: "memory");
            const unsigned og = xb_add(&bar[XB_TOP], 1u);
            const unsigned tg = og / nx;
            if (og + 1u == (tg + 1u) * nx) xb_add(&bar[XB_TOPGEN], 1u);
            else XB_SPIN(xb_ld(&bar[XB_TOPGEN]) == tg, bar);
            __builtin_amdgcn_fence(__ATOMIC_ACQUIRE, "agent");
            xb_add(&bar[XB_XGEN(b.x)], 1u);
            asm volatile("s_waitcnt vmcnt(0)" ::: "memory");
        } else {
            XB_SPIN(xb_ld(&bar[XB_XGEN(b.x)]) == gen, bar);
            __builtin_amdgcn_fence(__ATOMIC_ACQUIRE, "agent");
            asm volatile("s_waitcnt vmcnt(0)" ::: "memory");
        }
    }
    __syncthreads();
}

struct PrefetchOrder {
    pg8::StaticOrder S; const char* base; unsigned row_bytes, tile_bytes; LAS unsigned char* dump;
    __device__ __forceinline__ bool next(int i, pg8::Unit& u) const { return S.next(i, u); }
    __device__ __forceinline__ void done(const pg8::Unit&) const {}
    __device__ __forceinline__ void a_ready(const pg8::Unit& u) const {
        const int tid = threadIdx.x, wid = __builtin_amdgcn_readfirstlane(tid >> 6); const unsigned lpr = tile_bytes >> 7, nline = 256u * lpr;
        const char* tb = base + (size_t)u.pm * 256 * row_bytes + (size_t)u.pn * tile_bytes;
        for (unsigned line = tid; line < nline; line += 512) { const unsigned r = line / lpr, l = line % lpr;
            __builtin_amdgcn_global_load_lds((const unsigned*)(tb + (size_t)r * row_bytes + l * 128), (LAS unsigned*)(dump + wid * 256), 4, 0, 0); }
    }
};
struct TwiceOrder { pg8::StaticOrder S; __device__ bool next(int i, pg8::Unit& u) const { return S.next(i >> 1, u); } __device__ __forceinline__ void a_ready(const pg8::Unit&) const {} __device__ __forceinline__ void done(const pg8::Unit&) const {} };
struct Args { const float* in[15]; float* out; unsigned char* ws; int ph_lo, ph_hi; };
enum { I_X = 0, I_ANW, I_WIN, I_LQ1, I_LK1, I_LQ2, I_LK2, I_SUBLN, I_SINKS, I_WOUT, I_FNW, I_WG, I_WU, I_WD, I_FINW };

__device__ __forceinline__ void item_kn(int r, int nblk_n, int& k0, int& n0) { const int g8 = r >> 3, w = r & 7, hn = nblk_n >> 1; n0 = 64 * (2 * (g8 % hn) + (w & 1)); k0 = 64 * (4 * (g8 / hn) + (w >> 1)); }
#ifndef CV_SPLIT
#define CV_SPLIT 0
#endif
#ifndef CV_SA
#define CV_SA 48
#endif
constexpr int CV_IN = (D / 64) * (INC / 64), CV_OUT = (D / 64) * (D / 64), CV_G = (D / 64) * (DFF / 64), CV_DN = (DFF / 64) * (D / 64), CV_ALL = CV_IN + CV_OUT + 2 * CV_G + CV_DN, CV_T0 = CV_IN + CV_OUT, CV_T1 = CV_T0 + CV_G;
template <int NB> __device__ __forceinline__ void convert_weights(const Args& args, unsigned char* ws, LAS float* scr, int first, int last, int skip0, int skip1, int widx, int nw, int lane) {
    bf16* Win_t = (bf16*)(ws + WS_WIN); bf16* Wout_t = (bf16*)(ws + WS_WOUT); bf16* Wgu_t = (bf16*)(ws + WS_WGU); bf16* Wdn_t = (bf16*)(ws + WS_WDN);
    for (int it = first + widx; it < last - (skip1 - skip0); it += nw) {
        int r = it; if (r >= skip0) r += skip1 - skip0;
        if (CV_ROT && first == 0 && last == CV_ALL) { r += CV_IN; if (r >= CV_ALL) r -= CV_ALL; }
        if (r < CV_IN) { int k0, n0; item_kn(r, INC / 64, k0, n0); const float cs = (n0 < 1024 || (n0 >= 3072 && n0 < 4096)) ? QSCALE2 : 1.f;
            transpose_item<NB>(args.in[I_WIN], D, INC, Win_t, n0, nullptr, cs, scr, k0, n0, lane); continue; } r -= CV_IN;
        if (r < CV_OUT) { int k0, n0; item_kn(r, D / 64, k0, n0); transpose_item<NB>(args.in[I_WOUT], D, D, Wout_t, n0, nullptr, 1.f, scr, k0, n0, lane, CV_NTS); continue; } r -= CV_OUT;
        if (r < 2 * CV_G) { const int up = r >= CV_G; if (up) r -= CV_G; int k0, n0; item_kn(r, DFF / 64, k0, n0);
            transpose_item<NB>(args.in[up ? I_WU : I_WG], D, DFF, Wgu_t, 256 * (n0 / 128) + 128 * up + (n0 % 128), args.in[I_FNW], 1.f, scr, k0, n0, lane, CV_NTS); continue; } r -= 2 * CV_G;
        { int k0, n0; item_kn(r, D / 64, k0, n0); transpose_item<NB>(args.in[I_WD], DFF, D, Wdn_t, n0, nullptr, 1.f, scr, k0, n0, lane, CV_NTS); }
    }
}

struct CvItem { const float* src; bf16* dst; const float* kscale; float cscale; int N, K; };
__device__ __forceinline__ bool cv_decode(const Args& args, unsigned char* ws, int r, int last, int lane, CvItem& it) {
    if (r >= last) return false;
    bf16* Win_t = (bf16*)(ws + WS_WIN); bf16* Wout_t = (bf16*)(ws + WS_WOUT); bf16* Wgu_t = (bf16*)(ws + WS_WGU); bf16* Wdn_t = (bf16*)(ws + WS_WDN);
    int k0, n0, row0; const float* W; bf16* WT; it.kscale = nullptr; it.cscale = 1.f;
    if (r < CV_IN) { item_kn(r, INC / 64, k0, n0); W = args.in[I_WIN]; WT = Win_t; it.N = INC; it.K = D; row0 = n0; it.cscale = (n0 < 1024 || (n0 >= 3072 && n0 < 4096)) ? QSCALE2 : 1.f; }
    else if ((r -= CV_IN) < CV_OUT) { item_kn(r, D / 64, k0, n0); W = args.in[I_WOUT]; WT = Wout_t; it.N = D; it.K = D; row0 = n0; }
    else if ((r -= CV_OUT) < 2 * CV_G) { const int up = r >= CV_G; if (up) r -= CV_G; item_kn(r, DFF / 64, k0, n0); W = args.in[up ? I_WU : I_WG]; WT = Wgu_t; it.N = DFF; it.K = D; row0 = 256 * (n0 / 128) + 128 * up + (n0 % 128); it.kscale = args.in[I_FNW] + k0; }
    else { r -= 2 * CV_G; item_kn(r, D / 64, k0, n0); W = args.in[I_WD]; WT = Wdn_t; it.N = D; it.K = DFF; row0 = n0; }
    it.src = W + (size_t)(k0 + (lane >> 4)) * it.N + n0 + 4 * (lane & 15);
    it.dst = WT + (size_t)row0 * it.K + k0;
    return true;
}
__device__ __forceinline__ void cv_load(const CvItem& it, f32x4 (&v)[16]) {
#pragma unroll
    for (int i = 0; i < 16; ++i) v[i] = *(const f32x4*)(it.src + (size_t)(4 * i) * it.N);
}
__device__ __forceinline__ void cv_finish(const CvItem& it, const f32x4 (&v)[16], LAS float* scr, int lane) {
#pragma unroll
    for (int i = 0; i < 16; ++i) { const int kk = 4 * i + (lane >> 4); float sc = it.cscale; if (it.kscale) sc *= it.kscale[kk];
        LAS float* d = scr + kk * 65 + 4 * (lane & 15); d[0] = v[i].x * sc; d[1] = v[i].y * sc; d[2] = v[i].z * sc; d[3] = v[i].w * sc; }
    asm volatile("s_waitcnt lgkmcnt(0)" ::: "memory");
    const int c = lane & 7;
#pragma unroll
    for (int j = 0; j < 8; ++j) { const int n = (lane >> 3) + 8 * j; const LAS float* s = scr + (8 * c) * 65 + n;
        v4u o; o.x = pk2(s[0 * 65], s[1 * 65]); o.y = pk2(s[2 * 65], s[3 * 65]); o.z = pk2(s[4 * 65], s[5 * 65]); o.w = pk2(s[6 * 65], s[7 * 65]);
        *(v4u*)(it.dst + (size_t)n * it.K + 8 * c) = o; }
    asm volatile("s_waitcnt lgkmcnt(0)" ::: "memory");
}
__device__ __forceinline__ void convert_weights_pipe(const Args& args, unsigned char* ws, LAS float* scr, int first, int last, int widx, int nw, int lane) {
    CvItem ia, ib; f32x4 va[16], vb[16];
    int r = first + widx;
    bool ha = cv_decode(args, ws, r, last, lane, ia); if (ha) cv_load(ia, va);
    while (ha) {
        const bool hb = cv_decode(args, ws, r + nw, last, lane, ib); if (hb) cv_load(ib, vb);
        cv_finish(ia, va, scr, lane);
        if (!hb) break;
        r += 2 * nw;
        ha = cv_decode(args, ws, r, last, lane, ia); if (ha) cv_load(ia, va);
        cv_finish(ib, vb, scr, lane);
    }
}

__global__ void __launch_bounds__(NWAVES * 64, 2) hymba_fwd(Args args) {
    extern __shared__ __attribute__((aligned(16))) unsigned char lds_raw[];
    cg::grid_group grid = cg::this_grid();
    LAS unsigned char* lds = (LAS unsigned char*)lds_raw;
    const int tid = threadIdx.x, lane = tid & 63, wave = __builtin_amdgcn_readfirstlane(tid >> 6);
    const int G = gridDim.x, bx = blockIdx.x, vcu = (G % 8 == 0) ? (bx % 8) * (G / 8) + bx / 8 : bx;
    unsigned char* ws = args.ws;
    const float* x = args.in[I_X]; float* out = args.out;
    bf16* Win_t = (bf16*)(ws + WS_WIN); bf16* Wout_t = (bf16*)(ws + WS_WOUT); bf16* Wgu_t = (bf16*)(ws + WS_WGU); bf16* Wdn_t = (bf16*)(ws + WS_WDN);
    bf16* XN = (bf16*)(ws + WS_XN); bf16* PROJ = (bf16*)(ws + WS_PROJ); bf16* MIX = (bf16*)(ws + WS_MIX); bf16* HB = (bf16*)(ws + WS_H);
    float* part1 = (float*)(ws + WS_PART1); float* part2 = (float*)(ws + WS_PART2);
    const int lo = args.ph_lo, hi = args.ph_hi;
    volatile LAS unsigned* bst = (volatile LAS unsigned*)(lds + LDS_BYTES - 64);
    if (tid < 2) bst[tid] = 0u;
    if (tid == 0) { *(LAS unsigned long long*)(lds + LDS_BYTES - 32) = 0ull; }
    __syncthreads();
    XcdBarrier gbar; gbar.bar = (unsigned*)ws; gbar.x = 0; gbar.st = bst;
    if (hi - lo > 1) gbar = xcd_barrier_post((unsigned*)ws, bst);
    if (hi > 1000) grid.sync();
#define IN(k) (lo <= (k) && (k) < hi)
#ifndef SYNC_REPEAT
#define SYNC_REPEAT 1
#endif
#define SEAM(k) do { if (IN(k) && IN((k) + 1)) { for (int sr_ = 0; sr_ < SYNC_REPEAT; ++sr_) xcd_barrier(gbar); } } while (0)
#ifndef PROBE_PHASE
#define PROBE_PHASE -1
#endif
#ifndef STAMP_SEL
#define STAMP_SEL 1
#endif
#ifdef STAMP_PHASE
#define STAMP_BEGIN(k) do { if ((k) == STAMP_PHASE || ((k) == 2 && (STAMP_PHASE == 30 || STAMP_PHASE == 31))) st0_ = __builtin_amdgcn_s_memrealtime(); } while (0)
#define STAMP_END(k) do { if ((k) == STAMP_PHASE) st1_ = __builtin_amdgcn_s_memrealtime(); } while (0)
#else
#define STAMP_BEGIN(k) do {} while (0)
#define STAMP_END(k) do {} while (0)
#endif
    unsigned long long st0_ = 0, st1_ = 0; (void)st0_; (void)st1_;
#define REP(k) for (int rep_ = 0; rep_ < ((PROBE_PHASE == (k)) ? 2 : 1); ++rep_, ((PROBE_PHASE == (k)) && rep_ < 2 ? (xcd_barrier(gbar), 0) : 0))

    STAMP_BEGIN(0); STAMP_BEGIN(41);
    REP(0) if (IN(0)) {
        LAS float* scr = (LAS float*)(lds + wave * 16640);
        const int gw = vcu * NWAVES + wave, NGW = G * NWAVES;
#if defined(P0_TOUCH) && P0_TOUCH
        {
            const int widx[5] = {I_WIN, I_WOUT, I_WG, I_WU, I_WD}; const size_t wn4[5] = {(size_t)D * INC / 4, (size_t)D * D / 4, (size_t)D * DFF / 4, (size_t)D * DFF / 4, (size_t)DFF * D / 4};
            f32x4 acc4 = {0.f, 0.f, 0.f, 0.f};
#pragma unroll
            for (int w = 0; w < 5; ++w) { const f32x4* src = (const f32x4*)args.in[widx[w]];
                for (size_t i = (size_t)gw * 64 + lane; i < wn4[w]; i += (size_t)NGW * 64 * 4) {
                    f32x4 a = src[i], b = (i + (size_t)NGW * 64 < wn4[w]) ? src[i + (size_t)NGW * 64] : acc4, c = (i + (size_t)NGW * 128 < wn4[w]) ? src[i + (size_t)NGW * 128] : acc4, d = (i + (size_t)NGW * 192 < wn4[w]) ? src[i + (size_t)NGW * 192] : acc4;
                    acc4 = acc4 + a + b + c + d; } }
            if (acc4.x + acc4.y + acc4.z + acc4.w == 1.2345e38f) ((float*)(ws + WS_PART2))[gw * 64 + lane] = acc4.x;
        }
#endif
#if defined(CV_PIPE) && CV_PIPE
        convert_weights_pipe(args, ws, scr, 0, CV_SPLIT ? CV_IN : CV_ALL, gw, NGW, lane);
#else
        convert_weights<16>(args, ws, scr, 0, CV_SPLIT ? CV_ALL - 128 * CV_SA : CV_ALL, 0, 0, gw, NGW, lane);
#endif
        STAMP_BEGIN(40); __syncthreads(); STAMP_END(41);
        const f32x4* wn = (const f32x4*)args.in[I_ANW] + lane;
        for (int rp_ = 0; rp_ < (PROBE_PHASE == 11 ? 2 : 1); ++rp_)
        for (int m = gw; m < M; m += NGW) {
            const f32x4* xr = (const f32x4*)(x + (size_t)m * D) + lane;
            f32x4 v[8]; float s = 0.f;
#pragma unroll
            for (int j = 0; j < 8; ++j) { v[j] = __builtin_nontemporal_load(xr + 64 * j); s += (v[j].x * v[j].x + v[j].y * v[j].y) + (v[j].z * v[j].z + v[j].w * v[j].w); }
            const float rstd = rsqrtf(wave_sum(s) * (1.f / D) + RMS_EPS);
            unsigned long long* o8 = (unsigned long long*)(XN + (size_t)m * D) + lane;
#pragma unroll
            for (int j = 0; j < 8; ++j) { const f32x4 w = wn[64 * j]; o8[64 * j] = (unsigned long long)pk2(v[j].x * rstd * w.x, v[j].y * rstd * w.y) | ((unsigned long long)pk2(v[j].z * rstd * w.z, v[j].w * rstd * w.w) << 32); }
        }
        __syncthreads();
    }
    SEAM(0);
    STAMP_END(0); STAMP_END(40);
    STAMP_BEGIN(1);
    REP(1) if (IN(1)) {
        pg8::Gemm g{XN, Win_t, M, INC, D}; pg8::StaticOrder S; S.init(M, INC, G, bx, WGM_P1);
        pg8::EpiStore E{PROJ, INC};
#if PROBE_PHASE == 21
        { TwiceOrder S2{S}; pg8::gemm_phase<pg8::EpiStore, TwiceOrder, true, true>(lds, g, S2, E); }
#else
        pg8::gemm_phase<pg8::EpiStore, pg8::StaticOrder, true, GEMM_SP2>(lds, g, S, E);
#endif
        if (CV_SPLIT) { const int nwg = (M / 256) * (INC / 256), maxU = (nwg + G - 1) / G, nIdle = G * maxU - nwg, idx = bx - (G - nIdle);
            const int nw_ = nIdle > 0 ? nIdle : G, id_ = nIdle > 0 ? idx : bx, per = (128 * CV_SA + nw_ - 1) / nw_, f0 = CV_ALL - 128 * CV_SA + id_ * per;
            if (id_ >= 0) convert_weights<8>(args, ws, (LAS float*)(lds + wave * 16640), f0, f0 + per < CV_ALL ? f0 + per : CV_ALL, 0, 0, wave, NWAVES, lane); }
        __syncthreads();
    }
    SEAM(1);
    STAMP_END(1);
    STAMP_BEGIN(2);
    REP(2) if (IN(2)) {
        const float* lq1 = args.in[I_LQ1]; const float* lk1 = args.in[I_LK1]; const float* lq2 = args.in[I_LQ2]; const float* lk2 = args.in[I_LK2];
        const float s1 = wave_sum(lq1[lane] * lk1[lane]), s2 = wave_sum(lq2[lane] * lk2[lane]);
        const float lam = expf(s1) - expf(s2) + 0.2f;
        const int wq = wave & 3, gsel = wave >> 2;
#ifdef ATT_PRIO
        if (gsel == 1) __builtin_amdgcn_s_setprio(1);
#endif
        STAMP_BEGIN(20);
        { const int np = vcu < 512 ? (512 - vcu + G - 1) / G : 0;
#define DIFF_UNIT(u_, up_) do { const int i_ = vcu + G * ((u_) >> 1), bh_ = (i_ >> 3) ^ (((u_) >> 1) & 1 ? 4 : 0)  , xq_ = i_ & 7, h_ = bh_ & 7, qblk_ = ((u_) & 1) ? 15 - xq_ : xq_; \
            up_.b = bh_ >> 3; up_.q0 = 128 * qblk_; up_.qcol = h_ * 128 + gsel * 64; up_.kcol = 1024 + h_ * 128; up_.vcol = 2048 + h_ * 128; up_.kofs = gsel * 128; \
            up_.slope2 = exp2f(-(float)(h_ + 1)) * 1.4426950408889634f; up_.m_init = 0.f; up_.l_init = 0.f; \
            up_.T0 = 0; up_.T1 = 2 * qblk_ + 1; up_.tlo = 0; up_.thi = (up_.q0 + 32 * wq) >> 6; up_.window = 1 << 20; up_.maskall = 0; up_.ocol = h_ * 128; } while (0)
#pragma unroll 1
          for (int u = 0; u < 2 * np; ++u) {
              att::UnitP up, nx; DIFF_UNIT(u, up); const bool hn = u + 1 < 2 * np; if (hn) DIFF_UNIT(u + 1, nx); else nx = up;
              att::attn_unit<128, 128>((LAS char*)lds, PROJ, MIX, up, true, lam, args.in[I_SUBLN], tid, u > 0, hn, nx.b, nx.kcol, nx.vcol, nx.T0, nx.T1);
          }
#undef DIFF_UNIT
        }
        STAMP_END(20); STAMP_BEGIN(21);
        { const int ns = vcu < 1024 ? (1024 - vcu + G - 1) / G : 0;
#define SWA_UNIT(u_, up_) do { const int i_ = vcu + G * (u_), qblk_ = i_ & 15, pair_ = (i_ >> 4) & 1, hkv_ = ((i_ >> 5) + (u_)) & 3, hq_ = hkv_ * 4 + pair_ * 2 + gsel, a_ = 2 * qblk_; \
            up_.b = i_ >> 7; up_.q0 = 128 * qblk_; up_.qcol = 3072 + hq_ * 64; up_.kcol = 4096 + hkv_ * 64; up_.vcol = 4352 + hkv_ * 64; up_.kofs = 0; \
            up_.slope2 = exp2f(-0.5f * (float)(hq_ + 1)) * 1.4426950408889634f; up_.m_init = args.in[I_SINKS][hq_] * 1.4426950408889634f; up_.l_init = 1.f; \
            up_.T0 = a_ - 2 < 0 ? 0 : a_ - 2; up_.T1 = a_ + 1; up_.tlo = a_ - 2 + (wq >> 1); up_.thi = a_ + (wq >> 1); up_.window = 128; up_.maskall = 1; up_.ocol = 1024 + hq_ * 64; } while (0)
#pragma unroll 1
          for (int u = 0; u < ns; ++u) {
              att::UnitP up, nx; SWA_UNIT(u, up); const bool hn = u + 1 < ns; if (hn) SWA_UNIT(u + 1, nx); else nx = up;
              att::attn_unit<64, 64>((LAS char*)lds, PROJ, MIX, up, false, 0.f, nullptr, tid, u > 0, hn, nx.b, nx.kcol, nx.vcol, nx.T0, nx.T1);
          }
#undef SWA_UNIT
        }
        STAMP_END(21);
#ifdef ATT_PRIO
        __builtin_amdgcn_s_setprio(0);
#endif
        __syncthreads();
#ifdef STAMP_PHASE
        if (STAMP_PHASE == 30 || STAMP_PHASE == 31) { if (tid == 0 && STAMP_SEL) { const unsigned d_ = (unsigned)(__builtin_amdgcn_s_memrealtime() - st0_);
            if (STAMP_PHASE == 30) __hip_atomic_fetch_max((unsigned*)ws + 3500, d_, __ATOMIC_RELAXED, __HIP_MEMORY_SCOPE_AGENT); else __hip_atomic_fetch_max((unsigned*)ws + 3500, ~d_, __ATOMIC_RELAXED, __HIP_MEMORY_SCOPE_AGENT) ; } }
#endif
    }
    SEAM(2);
#ifdef STAMP_PHASE
    if (STAMP_PHASE == 30 || STAMP_PHASE == 31) { const unsigned v_ = __hip_atomic_load((unsigned*)ws + 3500, __ATOMIC_RELAXED, __HIP_MEMORY_SCOPE_AGENT); st1_ = st0_ + (STAMP_PHASE == 30 ? v_ : ~v_); }
#endif
    STAMP_END(2);
    STAMP_BEGIN(3);
    REP(3) if (IN(3)) {
        pg8::Gemm g{MIX, Wout_t, M, D, D}; pg8::StaticOrder S; S.init(M, D, G, bx, WGM_P3);
        pg8::EpiResid<false> E{x, XN, part1, D};
        pg8::gemm_phase<pg8::EpiResid<false>, pg8::StaticOrder, true, GEMM_SP2>(lds, g, S, E);
    }
    SEAM(3);
    STAMP_END(3);
    STAMP_BEGIN(4);
    REP(4) if (IN(4)) {
        pg8::Gemm g{XN, Wgu_t, M, NGU, D}; pg8::StaticOrder S; S.init(M, NGU, G, bx, WGM_P4);
        pg8::EpiSwiGLU E{HB, DFF, part1, 1.f / D, RMS_EPS};
#if PROBE_PHASE == 24
        { TwiceOrder S2{S}; pg8::gemm_phase<pg8::EpiSwiGLU, TwiceOrder, true, true>(lds, g, S2, E); }
#else
        pg8::gemm_phase<pg8::EpiSwiGLU, pg8::StaticOrder, P4_ALIGN, GEMM_SP2>(lds, g, S, E);
#endif
    }
    SEAM(4);
    STAMP_END(4);
    STAMP_BEGIN(5);
    REP(5) if (IN(5)) {
        pg8::Gemm g{HB, Wdn_t, M, D, DFF}; pg8::StaticOrder S; S.init(M, D, G, bx, WGM_P5);
#if FUSE_FINAL
        pg8::EpiFinal E{XN, out, args.in[I_FINW], part2, (unsigned*)ws + 4096, lds + RING_BYTES, D, 1.f / D, RMS_EPS};
        pg8::gemm_phase<pg8::EpiFinal, pg8::StaticOrder, true, GEMM_SP2>(lds, g, S, E);
#else
        pg8::EpiResid<true> E{XN, XN, part2, D};
        pg8::gemm_phase<pg8::EpiResid<true>, pg8::StaticOrder, true, GEMM_SP2>(lds, g, S, E);
#endif
    }
#if !FUSE_FINAL
    SEAM(5);
#endif
    STAMP_END(5);
    STAMP_BEGIN(6);
    REP(6) if (IN(6) && !FUSE_FINAL) {
        const int gw = vcu * NWAVES + wave, NGW = G * NWAVES;
        const f32x4* wn = (const f32x4*)args.in[I_FINW] + 2 * lane;
        for (int m = gw; m < M; m += NGW) {
            const float s = wave_sum(lane < 32 ? part2[(size_t)m * 32 + lane] : 0.f);
            const float rstd = rsqrtf(s * (1.f / D) + RMS_EPS);
            const v4u* xr = (const v4u*)(XN + (size_t)m * D) + lane; f32x4* orow = (f32x4*)(out + (size_t)m * D) + 2 * lane;
#pragma unroll
            for (int j = 0; j < 4; ++j) { const v4u w = __builtin_nontemporal_load(xr + 64 * j); const f32x4 w0 = wn[128 * j], w1 = wn[128 * j + 1];
                const f32x4 a = {__uint_as_float(w.x << 16), __uint_as_float(w.x & 0xffff0000u), __uint_as_float(w.y << 16), __uint_as_float(w.y & 0xffff0000u)};
                const f32x4 b = {__uint_as_float(w.z << 16), __uint_as_float(w.z & 0xffff0000u), __uint_as_float(w.w << 16), __uint_as_float(w.w & 0xffff0000u)};
                __builtin_nontemporal_store(a * rstd * w0, orow + 128 * j); __builtin_nontemporal_store(b * rstd * w1, orow + 128 * j + 1); }
        }
    }
#ifdef ATT_TIMER
    if (bx == 0) { __syncthreads(); if (tid == 0) { const unsigned long long dt = *(LAS unsigned long long*)(lds + LDS_BYTES - 32), te = __builtin_amdgcn_s_memtime(); while (__builtin_amdgcn_s_memtime() - te < dt) __builtin_amdgcn_s_sleep(32); } }
#endif
#ifdef STAMP_PHASE
    if (STAMP_PHASE == 6) { __syncthreads(); st1_ = __builtin_amdgcn_s_memrealtime(); }
    if (bx == 0 && tid == 0) { const unsigned long long te = __builtin_amdgcn_s_memrealtime(), dt = st1_ - st0_; while (__builtin_amdgcn_s_memrealtime() - te < dt) __builtin_amdgcn_s_sleep(32); }
#endif
#undef IN
#undef SEAM
}

extern "C" void kernel_launch(void* const* d_in, const int* in_sizes, int n_in, void* d_out, int out_size, void* d_ws, size_t ws_size, hipStream_t stream) {
    static int grid = 0;
    if (grid == 0) {
        if (n_in != 15 || out_size != M * D || ws_size < WS_END) { fprintf(stderr, "kernel_launch: unexpected shapes (n_in %d out %d ws %zu)\n", n_in, out_size, ws_size); grid = -1; return; }
        int dev = 0, cus = 0, per_cu = 0;
        hipGetDevice(&dev); hipDeviceGetAttribute(&cus, hipDeviceAttributeMultiprocessorCount, dev);
        if (hipFuncSetAttribute((const void*)hymba_fwd, hipFuncAttributeMaxDynamicSharedMemorySize, LDS_BYTES) != hipSuccess) { fprintf(stderr, "kernel_launch: hipFuncSetAttribute failed\n"); grid = -1; return; }
        if (hipOccupancyMaxActiveBlocksPerMultiprocessor(&per_cu, (const void*)hymba_fwd, NWAVES * 64, LDS_BYTES) != hipSuccess || per_cu < 1) { fprintf(stderr, "kernel_launch: occupancy query says %d\n", per_cu); per_cu = 1; }
        (void)hipGetLastError();
        grid = cus * 1;
        fprintf(stderr, "kernel_launch: grid %d (cus %d, per_cu %d)\n", grid, cus, per_cu);
    }
    if (grid < 0) return;
    if (hipMemsetAsync(d_ws, 0, 65536, stream) != hipSuccess) { fprintf(stderr, "kernel_launch: memset failed\n"); return; }
    Args a{};
    for (int i = 0; i < 15; ++i) a.in[i] = (const float*)d_in[i];
    a.out = (float*)d_out; a.ws = (unsigned char*)d_ws;
#if MK_N_LAUNCHES == 1
    a.ph_lo = 0; a.ph_hi = N_PHASES;
    void* kargs[] = {&a};
    hipError_t e = hipLaunchCooperativeKernel((const void*)hymba_fwd, dim3(grid), dim3(NWAVES * 64), kargs, LDS_BYTES, stream);
    if (e != hipSuccess) fprintf(stderr, "kernel_launch: cooperative launch failed: %s\n", hipGetErrorString(e));
#else
    for (int p = 0; p < N_PHASES; ++p) { a.ph_lo = p; a.ph_hi = p + 1; hipLaunchKernelGGL(hymba_fwd, dim3(grid), dim3(NWAVES * 64), LDS_BYTES, stream, a); }
#endif
}
```

```cpp
#include <hip/hip_runtime.h>
#include <hip/hip_cooperative_groups.h>
#include <hip/hip_bf16.h>
#include <cstdio>
#include <cstdint>
#include <cmath>
namespace cg = cooperative_groups;
#define MK_N_LAUNCHES 1
#ifndef PG8_WGM
#define PG8_WGM 4
#endif
namespace pg8 {
#define PG8_LAS __attribute__((address_space(3)))
typedef unsigned short bf16_t;
typedef short bf16x8 __attribute__((ext_vector_type(8)));
typedef float f32x4 __attribute__((ext_vector_type(4)));
typedef unsigned u32x4 __attribute__((ext_vector_type(4)));
constexpr int BM = 256, BK = 64, HALF = 128, HTB = HALF * BK * 2  , STAGE_BYTES = 8 * HTB, NXCD = 8, WGM = PG8_WGM;

__host__ __device__ __forceinline__ int lds_byte(int r, int c) { const int st = (r >> 4) * 2 + (c >> 5), rr = r & 15, cc = c & 31, ob = rr * 64 + cc * 2; return st * 1024 + (ob ^ (((ob >> 9) & 1) << 5)); }
__host__ __device__ __forceinline__ void stage_rc(int b, int& R, int& C) { const int st = b / 1024, sb = b % 1024, swz = sb ^ (((sb >> 9) & 1) << 5); R = (st >> 1) * 16 + swz / 64; C = (st & 1) * 32 + (swz % 64) / 2; }
__host__ __device__ __forceinline__ int perm32(int rho) { const int n = rho >> 4, i = rho & 15; return 8 * (i >> 2) + 4 * n + (i & 3); }

struct Unit { int pm, pn; };
struct Gemm { const bf16_t* A; const bf16_t* Bt; int M, N, K; };

struct StaticOrder {
    int nM, nN, nwg, G, c, wgm;
    __host__ __device__ void init(int M, int N, int G_, int c_, int wgm_ = WGM) { nM = M / BM; nN = N / BM; nwg = nM * nN; G = G_; c = c_; wgm = wgm_; }
    __host__ __device__ bool next(int i, Unit& u) const {
        const long L = (long)i * G + c; if (L >= nwg) return false;
        int wgid = (int)L; { const int q = nwg / NXCD, r = nwg % NXCD, xcd = wgid % NXCD, off = wgid / NXCD; wgid = (xcd < r ? xcd * (q + 1) : r * (q + 1) + (xcd - r) * q) + off; }
        const int nig = wgm * nN, gid = wgid / nig, fm = gid * wgm, gsz = (nM - fm) < wgm ? (nM - fm) : wgm;
        u.pm = fm + ((wgid % nig) % gsz); u.pn = (wgid % nig) / gsz; return true;
    }
    __device__ __forceinline__ void a_ready(const Unit&) const {}
    __device__ __forceinline__ void done(const Unit&) const {}
};

__device__ __forceinline__ unsigned cvt_pk_bf16(float lo, float hi) { typedef float f2_t __attribute__((ext_vector_type(2))); typedef __bf16 b2_t __attribute__((ext_vector_type(2))); f2_t v = {lo, hi}; b2_t b = __builtin_convertvector(v, b2_t); return __builtin_bit_cast(unsigned, b); }
typedef unsigned u32x2 __attribute__((ext_vector_type(2)));
#ifndef P5_NT_A
#define P5_NT_A 0
#endif
#ifndef EPI_NT_H
#define EPI_NT_H 0
#endif
#ifndef EPI_NT_PROJ
#define EPI_NT_PROJ 0
#endif
struct EpiStore {
    static constexpr bool PERM = true, AFTER_DRAIN = false; static constexpr int AUX_A = 0, AUX_B = 0;
    bf16_t* O; int ldc;
    __device__ __forceinline__ void operator()(const f32x4 (&acc)[2][2][4][2], const Unit& u, int wr, int wc, int fr, int fq) const {
        const int row0 = u.pm * BM + wr * 64 + fr, col0 = u.pn * BM + wc * 32 + 8 * fq;
#pragma unroll
        for (int ai = 0; ai < 2; ++ai)
#pragma unroll
            for (int m = 0; m < 4; ++m) { bf16_t* rowp = O + (size_t)(row0 + ai * HALF + m * 16) * ldc + col0;
#pragma unroll
                for (int bj = 0; bj < 2; ++bj) { const f32x4 v0 = acc[ai][bj][m][0], v1 = acc[ai][bj][m][1];
                    u32x4 w; w.x = cvt_pk_bf16(v0[0], v0[1]); w.y = cvt_pk_bf16(v0[2], v0[3]); w.z = cvt_pk_bf16(v1[0], v1[1]); w.w = cvt_pk_bf16(v1[2], v1[3]);
                    if (EPI_NT_PROJ) __builtin_nontemporal_store(w, (u32x4*)(rowp + bj * HALF)); else *(u32x4*)(rowp + bj * HALF) = w; } }
    }
};
template <bool BASE_BF16> struct EpiResid {
    static constexpr bool PERM = true, AFTER_DRAIN = false; static constexpr int AUX_A = (BASE_BF16 && P5_NT_A) ? 2 : 0, AUX_B = 0;
    const void* base; bf16_t* xo; float* part; int ldc;
    __device__ __forceinline__ void operator()(const f32x4 (&acc)[2][2][4][2], const Unit& u, int wr, int wc, int fr, int fq) const {
        const int row0 = u.pm * BM + wr * 64 + fr, col0 = u.pn * BM + wc * 32 + 8 * fq;
#pragma unroll
        for (int ai = 0; ai < 2; ++ai)
#pragma unroll
            for (int m = 0; m < 4; ++m) { const int r = row0 + ai * HALF + m * 16; const size_t off = (size_t)r * ldc + col0; float ss = 0.f;
#pragma unroll
                for (int bj = 0; bj < 2; ++bj) { f32x4 b0, b1;
                    if (BASE_BF16) { const u32x4 w = *(const u32x4*)((const bf16_t*)base + off + bj * HALF);
                        b0 = (f32x4){__uint_as_float(w.x << 16), __uint_as_float(w.x & 0xffff0000u), __uint_as_float(w.y << 16), __uint_as_float(w.y & 0xffff0000u)};
                        b1 = (f32x4){__uint_as_float(w.z << 16), __uint_as_float(w.z & 0xffff0000u), __uint_as_float(w.w << 16), __uint_as_float(w.w & 0xffff0000u)}; }
                    else { const float* bp = (const float*)base + off + bj * HALF; b0 = __builtin_nontemporal_load((const f32x4*)bp); b1 = __builtin_nontemporal_load((const f32x4*)(bp + 4)); }
                    const f32x4 v0 = b0 + acc[ai][bj][m][0], v1 = b1 + acc[ai][bj][m][1];
                    ss += ((v0[0] * v0[0] + v0[1] * v0[1]) + (v0[2] * v0[2] + v0[3] * v0[3])) + ((v1[0] * v1[0] + v1[1] * v1[1]) + (v1[2] * v1[2] + v1[3] * v1[3]));
                    u32x4 w; w.x = cvt_pk_bf16(v0[0], v0[1]); w.y = cvt_pk_bf16(v0[2], v0[3]); w.z = cvt_pk_bf16(v1[0], v1[1]); w.w = cvt_pk_bf16(v1[2], v1[3]);
                    *(u32x4*)(xo + off + bj * HALF) = w; }
                ss += __shfl_xor(ss, 16); ss += __shfl_xor(ss, 32);
                if (fq == 0) part[(size_t)r * 32 + u.pn * 4 + wc] = ss; }
    }
};
struct EpiFinal {
    static constexpr bool PERM = true, AFTER_DRAIN = false; static constexpr int AUX_A = 0, AUX_B = 0;
    const bf16_t* xb; float* out; const float* wfin; float* xbuf; unsigned* cnt; PG8_LAS unsigned char* tab; int ldc; float inv_n, eps;
    __device__ __forceinline__ void operator()(f32x4 (&acc)[2][2][4][2], const Unit& u, int wr, int wc, int fr, int fq) const {
        const int lane = fq * 16 + fr, wid = wr * 4 + wc;
        PG8_LAS float* P = (PG8_LAS float*)tab;
        PG8_LAS float* S = (PG8_LAS float*)(tab + 4096);
        PG8_LAS unsigned* flag = (PG8_LAS unsigned*)(tab + 4096 + 1024);
        const int row0 = u.pm * BM + wr * 64 + fr, col0 = u.pn * BM + wc * 32 + 8 * fq;
#pragma unroll
        for (int ai = 0; ai < 2; ++ai)
#pragma unroll
            for (int m = 0; m < 4; ++m) { const int r = row0 + ai * HALF + m * 16; const size_t off = (size_t)r * ldc + col0; float ss = 0.f;
#pragma unroll
                for (int bj = 0; bj < 2; ++bj) { const u32x4 w = *(const u32x4*)(xb + off + bj * HALF);
                    const f32x4 b0 = {__uint_as_float(w.x << 16), __uint_as_float(w.x & 0xffff0000u), __uint_as_float(w.y << 16), __uint_as_float(w.y & 0xffff0000u)};
                    const f32x4 b1 = {__uint_as_float(w.z << 16), __uint_as_float(w.z & 0xffff0000u), __uint_as_float(w.w << 16), __uint_as_float(w.w & 0xffff0000u)};
                    const f32x4 v0 = b0 + acc[ai][bj][m][0], v1 = b1 + acc[ai][bj][m][1]; acc[ai][bj][m][0] = v0; acc[ai][bj][m][1] = v1;
                    ss += ((v0[0] * v0[0] + v0[1] * v0[1]) + (v0[2] * v0[2] + v0[3] * v0[3])) + ((v1[0] * v1[0] + v1[1] * v1[1]) + (v1[2] * v1[2] + v1[3] * v1[3])); }
                ss += __shfl_xor(ss, 16); ss += __shfl_xor(ss, 32);
                if (fq == 0) P[(ai * HALF + wr * 64 + m * 16 + fr) * 4 + wc] = ss; }
        asm volatile("s_waitcnt lgkmcnt(0)" ::: "memory"); __builtin_amdgcn_s_barrier(); asm volatile("" ::: "memory");
        const int row = wid * 32 + (lane & 31);
        if (lane < 32) { const f32x4 p4 = *(PG8_LAS const f32x4*)(P + row * 4);
            __hip_atomic_store(xbuf + ((size_t)(u.pm * BM + row) * 8 + u.pn), (p4[0] + p4[1]) + (p4[2] + p4[3]), __ATOMIC_RELAXED, __HIP_MEMORY_SCOPE_AGENT); }
        asm volatile("s_waitcnt vmcnt(0)" ::: "memory");
        if (lane == 0) __hip_atomic_fetch_add(cnt + 64 * u.pm, 1u, __ATOMIC_RELAXED, __HIP_MEMORY_SCOPE_AGENT);
        if (wid == 0) { bool dead = false; const unsigned long long t0 = __builtin_amdgcn_s_memrealtime();
            for (;;) { if ((unsigned)__builtin_amdgcn_readfirstlane(__hip_atomic_load(cnt + 64 * u.pm, __ATOMIC_RELAXED, __HIP_MEMORY_SCOPE_AGENT)) >= 64u) break;
                if (__builtin_amdgcn_s_memrealtime() - t0 > 2000000ull) { dead = true; break; }
                __builtin_amdgcn_s_sleep(2); }
            __builtin_amdgcn_fence(__ATOMIC_ACQUIRE, "agent");
            if (lane == 0) flag[0] = dead ? 1u : 0u; }
        asm volatile("s_waitcnt vmcnt(0) lgkmcnt(0)" ::: "memory"); __builtin_amdgcn_s_barrier(); asm volatile("" ::: "memory");
        const bool bad = flag[0] != 0u;
        if (lane < 32) { const float* slot = xbuf + (size_t)(u.pm * BM + row) * 8; float q = 0.f;
#pragma unroll
            for (int t = 0; t < 8; ++t) q += __hip_atomic_load(slot + t, __ATOMIC_RELAXED, __HIP_MEMORY_SCOPE_AGENT);
            S[row] = rsqrtf(q * inv_n + eps); }
        asm volatile("s_waitcnt vmcnt(0) lgkmcnt(0)" ::: "memory"); __builtin_amdgcn_s_barrier(); asm volatile("" ::: "memory");
        const float qnan = __builtin_nanf("");
        f32x4 wv[2][2];
#pragma unroll
        for (int bj = 0; bj < 2; ++bj) { wv[bj][0] = *(const f32x4*)(wfin + col0 + bj * HALF); wv[bj][1] = *(const f32x4*)(wfin + col0 + bj * HALF + 4); }
#pragma unroll
        for (int ai = 0; ai < 2; ++ai)
#pragma unroll
            for (int m = 0; m < 4; ++m) { const int rl = ai * HALF + wr * 64 + m * 16 + fr; const float rs = bad ? qnan : S[rl]; float* op = out + (size_t)(u.pm * BM + rl) * ldc + col0;
#pragma unroll
                for (int bj = 0; bj < 2; ++bj) { __builtin_nontemporal_store(acc[ai][bj][m][0] * rs * wv[bj][0], (f32x4*)(op + bj * HALF)); __builtin_nontemporal_store(acc[ai][bj][m][1] * rs * wv[bj][1], (f32x4*)(op + bj * HALF + 4)); } }
    }
};
struct EpiSwiGLU {
    static constexpr bool PERM = true, AFTER_DRAIN = false; static constexpr int AUX_A = 0, AUX_B = 0;
    bf16_t* H; int ldh; const float* part; float inv_n, eps;
    __device__ __forceinline__ static float silu_mul(float g, float uu) { const float e = __builtin_amdgcn_exp2f(g * -1.4426950408889634f); return g * uu * __builtin_amdgcn_rcpf(1.f + e); }
    __device__ __forceinline__ void operator()(const f32x4 (&acc)[2][2][4][2], const Unit& u, int wr, int wc, int fr, int fq) const {
        const int row0 = u.pm * BM + wr * 64 + fr, col0 = u.pn * HALF + wc * 32 + 8 * fq;
#pragma unroll
        for (int ai = 0; ai < 2; ++ai)
#pragma unroll
            for (int m = 0; m < 4; ++m) { const int r = row0 + ai * HALF + m * 16;
                const f32x4* pp = (const f32x4*)(part + (size_t)r * 32 + fq * 8); const f32x4 pa = pp[0], pb = pp[1];
                float s = ((pa[0] + pa[1]) + (pa[2] + pa[3])) + ((pb[0] + pb[1]) + (pb[2] + pb[3]));
                s += __shfl_xor(s, 16); s += __shfl_xor(s, 32);
                const float rstd = rsqrtf(s * inv_n + eps);
                const f32x4 g0 = acc[ai][0][m][0] * rstd, g1 = acc[ai][0][m][1] * rstd, u0 = acc[ai][1][m][0] * rstd, u1 = acc[ai][1][m][1] * rstd;
                u32x4 w; w.x = cvt_pk_bf16(silu_mul(g0[0], u0[0]), silu_mul(g0[1], u0[1])); w.y = cvt_pk_bf16(silu_mul(g0[2], u0[2]), silu_mul(g0[3], u0[3]));
                w.z = cvt_pk_bf16(silu_mul(g1[0], u1[0]), silu_mul(g1[1], u1[1])); w.w = cvt_pk_bf16(silu_mul(g1[2], u1[2]), silu_mul(g1[3], u1[3]));
                if (EPI_NT_H) __builtin_nontemporal_store(w, (u32x4*)(H + (size_t)r * ldh + col0)); else *(u32x4*)(H + (size_t)r * ldh + col0) = w; }
    }
};
template <class Epi, class Sched, bool ALIGN_EPI = false, bool SP2 = false>
__device__ __forceinline__ void gemm_phase(PG8_LAS unsigned char* lds, const Gemm g, const Sched& S, const Epi& E) {
    const int tid = threadIdx.x, wid = __builtin_amdgcn_readfirstlane(tid >> 6), lane = tid & 63, wr = wid >> 2, wc = wid & 3, fr = lane & 15, fq = lane >> 4;
    const int K = g.K, nt = K / BK;
    constexpr int AUXA = Epi::AUX_A, AUXB = Epi::AUX_B;
    unsigned voffA[2], voffB[2];
#pragma unroll
    for (int i = 0; i < 2; ++i) { int R, C; stage_rc(tid * 16 + i * 8192, R, C); const int Rb = Epi::PERM ? ((R & ~31) + perm32(R & 31)) : R;
        voffA[i] = (unsigned)(R * K + C) * 2u; voffB[i] = (unsigned)(Rb * K + C) * 2u; }
    const size_t kstep = (size_t)(BK * 2);
    const size_t hstep = (size_t)HALF * K * 2;
    const size_t tstep = 2 * hstep;
    const unsigned ldsw = (unsigned)wid * 1024u;
    const int aoff = lds_byte(wr * 64 + fr, fq * 8), boff = lds_byte(wc * 32 + fr, fq * 8);
#define PG8_SA(b, h) (((b) * 2 + (h)) * HTB)
#define PG8_SB(b, h) ((4 + (b) * 2 + (h)) * HTB)
#define PG8_STAGE_X(bufoff, gbase, voff, aux_) do { _Pragma("unroll") for (int _i = 0; _i < 2; ++_i) \
        __builtin_amdgcn_global_load_lds((const unsigned*)((const char*)(gbase) + (voff)[_i]), (PG8_LAS unsigned*)(lds + (bufoff) + ldsw + _i * 8192), 16, 0, aux_); } while (0)
#define PG8_LDA(dst, b, h) do { _Pragma("unroll") for (int m = 0; m < 4; ++m) _Pragma("unroll") for (int k = 0; k < 2; ++k) dst[m][k] = *(const PG8_LAS bf16x8*)(lds + PG8_SA(b, h) + aoff + m * 2048 + k * 1024); } while (0)
#define PG8_LDB(dst, b, h) do { _Pragma("unroll") for (int n = 0; n < 2; ++n) _Pragma("unroll") for (int k = 0; k < 2; ++k) dst[n][k] = *(const PG8_LAS bf16x8*)(lds + PG8_SB(b, h) + boff + n * 2048 + k * 1024); } while (0)
#define PG8_MMA(ai, bj, At, Bt) do { __builtin_amdgcn_s_setprio(1); _Pragma("unroll") for (int m = 0; m < 4; ++m) _Pragma("unroll") for (int n = 0; n < 2; ++n) _Pragma("unroll") for (int k = 0; k < 2; ++k) \
        acc[ai][bj][m][n] = __builtin_amdgcn_mfma_f32_16x16x32_bf16(Bt[n][k], At[m][k], acc[ai][bj][m][n], 0, 0, 0); __builtin_amdgcn_s_setprio(0); } while (0)
#define PG8_WAIT_V(n) asm volatile("s_waitcnt vmcnt(" #n ")" ::: "memory")
#define PG8_WAIT_L(n) asm volatile("s_waitcnt lgkmcnt(" #n ")" ::: "memory")
#define PG8_BAR __builtin_amdgcn_s_barrier()
#define PG8_SCHED __builtin_amdgcn_sched_barrier(0)
    Unit cur, nxt; int ui = 0;
    if (!S.next(0, cur)) return;
    f32x4 acc[2][2][4][2];
#pragma unroll
    for (int a = 0; a < 2; ++a)
#pragma unroll
        for (int b = 0; b < 2; ++b)
#pragma unroll
            for (int m = 0; m < 4; ++m)
#pragma unroll
                for (int n = 0; n < 2; ++n) acc[a][b][m][n] = (f32x4){0.f, 0.f, 0.f, 0.f};
    bf16x8 At[4][2], B0[2][2], B1[2][2];
    const char* cA = (const char*)g.A + (size_t)cur.pm * tstep; const char* cB = (const char*)g.Bt + (size_t)cur.pn * tstep;
    S.a_ready(cur);
    if constexpr (SP2) {
        PG8_STAGE_X(PG8_SB(0, 0), cB, voffB, AUXB); PG8_STAGE_X(PG8_SB(0, 1), cB + hstep, voffB, AUXB); PG8_STAGE_X(PG8_SA(0, 0), cA, voffA, AUXA); PG8_STAGE_X(PG8_SA(0, 1), cA + hstep, voffA, AUXA);
        if (wr == 1) PG8_BAR;
        PG8_WAIT_V(2); PG8_BAR;
        PG8_STAGE_X(PG8_SB(1, 0), cB + kstep, voffB, AUXB); PG8_STAGE_X(PG8_SA(1, 0), cA + kstep, voffA, AUXA); PG8_STAGE_X(PG8_SB(1, 1), cB + hstep + kstep, voffB, AUXB);
        PG8_WAIT_V(6); PG8_BAR;
    } else {
        PG8_STAGE_X(PG8_SB(0, 0), cB, voffB, AUXB); PG8_STAGE_X(PG8_SA(0, 0), cA, voffA, AUXA); PG8_STAGE_X(PG8_SB(0, 1), cB + hstep, voffB, AUXB); PG8_STAGE_X(PG8_SA(0, 1), cA + hstep, voffA, AUXA);
        if (wr == 1) PG8_BAR;
        PG8_WAIT_V(4); PG8_BAR;
        PG8_STAGE_X(PG8_SB(1, 0), cB + kstep, voffB, AUXB); PG8_STAGE_X(PG8_SA(1, 0), cA + kstep, voffA, AUXA); PG8_STAGE_X(PG8_SB(1, 1), cB + hstep + kstep, voffB, AUXB);
        PG8_WAIT_V(6); PG8_BAR;
    }
    for (;;) {
        const bool has_next = S.next(ui + 1, nxt);
        const char* nA = has_next ? (const char*)g.A + (size_t)nxt.pm * tstep : cA; const char* nB = has_next ? (const char*)g.Bt + (size_t)nxt.pn * tstep : cB;
        for (int t = 0; t < nt; t += 2) {
            const bool last = (t == nt - 2);
            const char* a1 = cA + (size_t)(t + 1) * kstep;
            const char* a2 = last ? nA : cA + (size_t)(t + 2) * kstep; const char* b2 = last ? nB : cB + (size_t)(t + 2) * kstep;
            const char* a3 = a2 + kstep; const char* b3 = b2 + kstep;
            if (last && has_next) S.a_ready(nxt);
            if constexpr (SP2) {
            PG8_LDB(B0, 0, 0); PG8_LDB(B1, 0, 1); PG8_SCHED; PG8_LDA(At, 0, 0); PG8_STAGE_X(PG8_SA(1, 1), a1 + hstep, voffA, AUXA);
            PG8_WAIT_V(8); PG8_WAIT_L(0); PG8_BAR; PG8_MMA(0, 0, At, B0); PG8_MMA(0, 1, At, B1); PG8_BAR; PG8_SCHED;
            PG8_LDA(At, 0, 1); PG8_STAGE_X(PG8_SB(0, 0), b2, voffB, AUXB); PG8_STAGE_X(PG8_SB(0, 1), b2 + hstep, voffB, AUXB); PG8_STAGE_X(PG8_SA(0, 0), a2, voffA, AUXA);
            PG8_WAIT_V(8); PG8_WAIT_L(0); PG8_BAR; PG8_MMA(1, 0, At, B0); PG8_MMA(1, 1, At, B1); PG8_BAR; PG8_SCHED;
            PG8_LDB(B0, 1, 0); PG8_LDB(B1, 1, 1); PG8_SCHED; PG8_LDA(At, 1, 0); PG8_STAGE_X(PG8_SA(0, 1), a2 + hstep, voffA, AUXA);
            PG8_WAIT_V(8); PG8_WAIT_L(0); PG8_BAR; PG8_MMA(0, 0, At, B0); PG8_MMA(0, 1, At, B1); PG8_BAR; PG8_SCHED;
            PG8_LDA(At, 1, 1); PG8_STAGE_X(PG8_SB(1, 0), b3, voffB, AUXB); PG8_STAGE_X(PG8_SB(1, 1), b3 + hstep, voffB, AUXB); PG8_STAGE_X(PG8_SA(1, 0), a3, voffA, AUXA);
            PG8_WAIT_V(8); PG8_WAIT_L(0); PG8_BAR; PG8_MMA(1, 0, At, B0); PG8_MMA(1, 1, At, B1); PG8_BAR; PG8_SCHED;
            } else {
            PG8_LDB(B0, 0, 0); PG8_SCHED; PG8_LDA(At, 0, 0); PG8_STAGE_X(PG8_SA(1, 1), a1 + hstep, voffA, AUXA);
            PG8_WAIT_L(8); PG8_BAR; PG8_WAIT_L(0); PG8_MMA(0, 0, At, B0); PG8_BAR; PG8_SCHED;
            PG8_LDB(B1, 0, 1); PG8_STAGE_X(PG8_SB(0, 0), b2, voffB, AUXB);
            PG8_BAR; PG8_WAIT_L(0); PG8_MMA(0, 1, At, B1); PG8_BAR;
            PG8_LDA(At, 0, 1); PG8_STAGE_X(PG8_SA(0, 0), a2, voffA, AUXA);
            PG8_BAR; PG8_WAIT_L(0); PG8_MMA(1, 0, At, B0); PG8_BAR; PG8_SCHED;
            PG8_STAGE_X(PG8_SB(0, 1), b2 + hstep, voffB, AUXB);
            PG8_WAIT_V(6); PG8_BAR; PG8_MMA(1, 1, At, B1); PG8_BAR;
            PG8_LDB(B0, 1, 0); PG8_SCHED; PG8_LDA(At, 1, 0); PG8_STAGE_X(PG8_SA(0, 1), a2 + hstep, voffA, AUXA);
            PG8_WAIT_L(8); PG8_BAR; PG8_WAIT_L(0); PG8_MMA(0, 0, At, B0); PG8_BAR; PG8_SCHED;
            PG8_LDB(B1, 1, 1); PG8_STAGE_X(PG8_SB(1, 0), b3, voffB, AUXB);
            PG8_BAR; PG8_WAIT_L(0); PG8_MMA(0, 1, At, B1); PG8_BAR;
            PG8_LDA(At, 1, 1); PG8_STAGE_X(PG8_SA(1, 0), a3, voffA, AUXA);
            PG8_BAR; PG8_WAIT_L(0); PG8_MMA(1, 0, At, B0); PG8_BAR; PG8_SCHED;
            PG8_STAGE_X(PG8_SB(1, 1), b3 + hstep, voffB, AUXB);
            PG8_WAIT_V(6); PG8_BAR; PG8_MMA(1, 1, At, B1); PG8_BAR;
            }
        }
        if constexpr (ALIGN_EPI) { if (wr == 0) PG8_BAR; }
        if constexpr (!Epi::AFTER_DRAIN) { E(acc, cur, wr, wc, fr, fq); S.done(cur); }
        if (!has_next) break;
#pragma unroll
        for (int a = 0; a < 2; ++a)
#pragma unroll
            for (int b = 0; b < 2; ++b)
#pragma unroll
                for (int m = 0; m < 4; ++m)
#pragma unroll
                    for (int n = 0; n < 2; ++n) acc[a][b][m][n] = (f32x4){0.f, 0.f, 0.f, 0.f};
        cur = nxt; cA = nA; cB = nB; ++ui;
        if constexpr (ALIGN_EPI) { if (wr == 1) PG8_BAR; }
    }
    PG8_WAIT_V(0);
    if constexpr (!ALIGN_EPI) { if (wr == 0) PG8_BAR; }
    PG8_BAR;
    if constexpr (Epi::AFTER_DRAIN) { E.fused(acc, cur, wr, wc, fr, fq, lds, wid, lane); S.done(cur); }
#undef PG8_SA
#undef PG8_SB
#undef PG8_STAGE_X
#undef PG8_LDA
#undef PG8_LDB
#undef PG8_MMA
#undef PG8_WAIT_V
#undef PG8_WAIT_L
#undef PG8_BAR
#undef PG8_SCHED
}
}
namespace att {
#ifndef ATT_NT_OUT
#define ATT_NT_OUT 0
#endif
#define ATT_LAS __attribute__((address_space(3)))
typedef unsigned short bf16_t;
typedef short bf16x8 __attribute__((ext_vector_type(8)));
typedef short s16x4 __attribute__((ext_vector_type(4)));
typedef float f32x16 __attribute__((ext_vector_type(16)));
typedef float f32x4 __attribute__((ext_vector_type(4)));
typedef unsigned u32x4 __attribute__((ext_vector_type(4)));
typedef unsigned u32x2 __attribute__((ext_vector_type(2)));
constexpr int SEQ = 2048, PITCH = 4608, OPITCH = 2048;
__device__ __forceinline__ unsigned cvtpk(float lo, float hi) { typedef float f2_t __attribute__((ext_vector_type(2))); typedef __bf16 b2_t __attribute__((ext_vector_type(2))); f2_t v = {lo, hi}; b2_t b = __builtin_convertvector(v, b2_t); return __builtin_bit_cast(unsigned, b); }
__device__ __forceinline__ float swapmax(float m) { auto rr = __builtin_amdgcn_permlane32_swap(__float_as_uint(m), __float_as_uint(m), false, false); return fmaxf(__uint_as_float(rr[0]), __uint_as_float(rr[1])); }
__device__ __forceinline__ float swapsum(float m) { auto rr = __builtin_amdgcn_permlane32_swap(__float_as_uint(m), __float_as_uint(m), false, false); return __uint_as_float(rr[0]) + __uint_as_float(rr[1]); }
__device__ __forceinline__ s16x4 vtr(ATT_LAS const char* p) { return __builtin_bit_cast(s16x4, __builtin_amdgcn_ds_read_tr16_b64_v4i16((ATT_LAS s16x4*)p)); }

struct UnitP {
    int b, q0;
    int qcol, kcol, vcol;
    int kofs;
    float slope2;
    float m_init, l_init;
    int T0, T1;
    int tlo, thi;
    int window;
    int maskall;
    int ocol;
};

template <int DV, int KW>
__device__ __forceinline__ void attn_unit(ATT_LAS char* lds, const bf16_t* __restrict__ P, bf16_t* __restrict__ MIX, const UnitP up, bool diff, float lam, const float* __restrict__ subln_w, int tid,
                                          bool prefetched  , bool has_next, int nb, int nkcol, int nvcol, int nT0, int nT1  ) {
    static_assert(KW == DV && (KW == 128 || KW == 64), "tile geometry");
    constexpr int ROWB = KW * 2, CPR = ROWB / 16, RPP = 1024 / ROWB, NP = 64 / RPP / 8, TILEB = 64 * ROWB, STG = 2 * TILEB, NSTG = 4, NEB = DV / 32, NI = 2 * NP;
    constexpr bool WIDE = (KW == 128);
    const int lane = tid & 63, wid = __builtin_amdgcn_readfirstlane(tid >> 6), r32 = lane & 31, hi = lane >> 5, wq = wid & 3, g = wid >> 2;
    const int qw = up.q0 + 32 * wq, q = qw + r32;
    const size_t rowbase = (size_t)up.b * SEQ;
    __syncthreads();
    unsigned kso[NP], vso[NP];
#pragma unroll
    for (int i = 0; i < NP; ++i) { const int piece = wid + 8 * i, row = RPP * piece + lane / CPR, slot = lane % CPR;
        const int kch = WIDE ? (slot ^ (row & 15)) : (slot ^ ((row >> 1) & 7));
        const int vch = ((((slot >> 2) ^ (WIDE ? (row & 3) : ((row >> 1) & 1))) << 2) | (slot & 3));
        kso[i] = (unsigned)(row * PITCH + up.kcol + kch * 8); vso[i] = (unsigned)(row * PITCH + up.vcol + vch * 8); }
    const bf16_t* Pb = P + rowbase * PITCH;
#define ATT_DMA2(pb_, dk_, dv_, t, sg) do { const bf16_t* tb_ = (pb_) + (size_t)(t) * 64 * PITCH; \
    _Pragma("unroll") for (int i_ = 0; i_ < NP; ++i_) { \
        __builtin_amdgcn_global_load_lds((const unsigned*)(tb_ + (kso[i_] + (dk_))), (ATT_LAS unsigned*)(lds + (sg) * STG + (wid + 8 * i_) * 1024), 16, 0, 0); \
        __builtin_amdgcn_global_load_lds((const unsigned*)(tb_ + (vso[i_] + (dv_))), (ATT_LAS unsigned*)(lds + (sg) * STG + TILEB + (wid + 8 * i_) * 1024), 16, 0, 0); } } while (0)
#define ATT_DMA(t, sg) ATT_DMA2(Pb, 0u, 0u, t, sg)
    const int rot = prefetched ? 2 : 0;
    bf16x8 qr[4];
    { const bf16_t* qp = P + (rowbase + q) * PITCH + up.qcol + hi * 8;
#pragma unroll
      for (int d0 = 0; d0 < 4; ++d0) qr[d0] = *(const bf16x8*)(qp + d0 * 16); }
    if (!prefetched) {
#pragma unroll
        for (int j = 0; j < 2; ++j) if (up.T0 + j <= up.T1) ATT_DMA(up.T0 + j, j); }
    f32x16 o[NEB];
#pragma unroll
    for (int e = 0; e < NEB; ++e)
#pragma unroll
        for (int r = 0; r < 16; ++r) o[e][r] = 0.f;
    float mhat = up.l_init != 0.f ? up.m_init + up.slope2 * (float)q : 0.f, l = hi == 0 ? up.l_init : 0.f;
    float cb[16];
#pragma unroll
    for (int r = 0; r < 16; ++r) cb[r] = up.slope2 * (float)((r & 3) + 8 * (r >> 2));
    int kad[4];
#pragma unroll
    for (int d0 = 0; d0 < 4; ++d0) { const int c = (up.kofs >> 4) + 2 * d0 + hi; kad[d0] = r32 * ROWB + ((WIDE ? (c ^ (r32 & 15)) : (c ^ ((r32 >> 1) & 7))) << 4); }
    const int i16 = lane & 15, q4 = i16 >> 2, vsw = WIDE ? q4 : (q4 >> 1);
    const int vlane = TILEB + (4 * hi + q4) * ROWB + 32 * ((lane >> 4) & 1) + 8 * (i16 & 3);
    int vad[NEB];
#pragma unroll
    for (int e = 0; e < NEB; ++e) vad[e] = vlane + ((e ^ vsw) << 6);
    bf16x8 pa[4];
#define ATT_PV(sgi) do { ATT_LAS const char* Sv_ = lds + (sgi) * STG; __builtin_amdgcn_s_setprio(1); \
    _Pragma("unroll") for (int e = 0; e < NEB; ++e) _Pragma("unroll") for (int ks = 0; ks < 4; ++ks) { \
        const s16x4 lo = vtr(Sv_ + vad[e] + ks * 16 * ROWB), hh = vtr(Sv_ + vad[e] + ks * 16 * ROWB + 8 * ROWB); \
        const bf16x8 vf = {lo[0], lo[1], lo[2], lo[3], hh[0], hh[1], hh[2], hh[3]}; \
        o[e] = __builtin_amdgcn_mfma_f32_32x32x16_bf16(vf, pa[ks], o[e], 0, 0, 0); } __builtin_amdgcn_s_setprio(0); } while (0)
    for (int t = up.T0; t <= up.T1 + 1; ++t) {
        const int sg = (t - up.T0 + rot) & (NSTG - 1);
        if (t + 1 <= up.T1) { if (NI == 4) asm volatile("s_waitcnt vmcnt(4) lgkmcnt(0)" ::: "memory"); else asm volatile("s_waitcnt vmcnt(2) lgkmcnt(0)" ::: "memory"); }
        else asm volatile("s_waitcnt vmcnt(0) lgkmcnt(0)" ::: "memory");
        __builtin_amdgcn_s_barrier();
        asm volatile("" ::: "memory");
        if (t + 2 <= up.T1) ATT_DMA(t + 2, (sg + 2) & (NSTG - 1));
        if (g == 1 && t - 1 >= up.tlo && t - 1 <= up.thi && t - 1 >= up.T0) ATT_PV((sg + NSTG - 1) & (NSTG - 1));
        if (t >= up.tlo && t <= up.thi && t <= up.T1) {
            ATT_LAS const char* Sb = lds + sg * STG;
            f32x16 p0, p1;
            { const float base0 = up.slope2 * (float)(64 * t + 4 * hi) - mhat, base1 = base0 + 32.f * up.slope2;
#pragma unroll
              for (int r = 0; r < 16; ++r) { p0[r] = cb[r] + base0; p1[r] = cb[r] + base1; } }
            __builtin_amdgcn_s_setprio(1);
#pragma unroll
            for (int d0 = 0; d0 < 4; ++d0) {
                const bf16x8 k0 = *(ATT_LAS const bf16x8*)(Sb + kad[d0]), k1 = *(ATT_LAS const bf16x8*)(Sb + kad[d0] + 32 * ROWB);
                p0 = __builtin_amdgcn_mfma_f32_32x32x16_bf16(k0, qr[d0], p0, 0, 0, 0);
                p1 = __builtin_amdgcn_mfma_f32_32x32x16_bf16(k1, qr[d0], p1, 0, 0, 0);
            }
            __builtin_amdgcn_s_setprio(0);
            if (up.maskall || t == up.thi) {
                const int kvb = 64 * t + 4 * hi, qlo = q - up.window;
#pragma unroll
                for (int r = 0; r < 16; ++r) { const int kv = kvb + (r & 3) + 8 * (r >> 2);
                    if (kv > q || kv <= qlo) p0[r] = -INFINITY;
                    if (kv + 32 > q || kv + 32 <= qlo) p1[r] = -INFINITY; }
            }
            float ra = fmaxf(fmaxf(p0[0], p0[1]), p1[0]), rb = fmaxf(fmaxf(p0[2], p0[3]), p1[1]); ra = fmaxf(fmaxf(ra, p1[2]), p1[3]);
#pragma unroll
            for (int r = 4; r < 16; r += 4) { ra = fmaxf(fmaxf(ra, p0[r]), p0[r + 1]); rb = fmaxf(fmaxf(rb, p0[r + 2]), p0[r + 3]); ra = fmaxf(fmaxf(ra, p1[r]), p1[r + 1]); rb = fmaxf(fmaxf(rb, p1[r + 2]), p1[r + 3]); }
            const float rm = swapmax(fmaxf(ra, rb));
            if (__any(rm > 8.f)) {
                const float dl = fmaxf(rm, 0.f), alpha = __builtin_amdgcn_exp2f(-dl);
                mhat += dl; l *= alpha;
#pragma unroll
                for (int r = 0; r < 16; ++r) { p0[r] -= dl; p1[r] -= dl; }
#pragma unroll
                for (int e = 0; e < NEB; ++e)
#pragma unroll
                    for (int r = 0; r < 16; ++r) o[e][r] *= alpha;
            }
            float ps = 0.f;
#pragma unroll
            for (int r = 0; r < 16; ++r) { p0[r] = __builtin_amdgcn_exp2f(p0[r]); p1[r] = __builtin_amdgcn_exp2f(p1[r]); ps += p0[r] + p1[r]; }
            l += ps;
#pragma unroll
            for (int s = 0; s < 2; ++s) {
                u32x4 w0, w1;
                w0.x = cvtpk(p0[8 * s + 0], p0[8 * s + 1]); w0.y = cvtpk(p0[8 * s + 2], p0[8 * s + 3]); w0.z = cvtpk(p0[8 * s + 4], p0[8 * s + 5]); w0.w = cvtpk(p0[8 * s + 6], p0[8 * s + 7]);
                w1.x = cvtpk(p1[8 * s + 0], p1[8 * s + 1]); w1.y = cvtpk(p1[8 * s + 2], p1[8 * s + 3]); w1.z = cvtpk(p1[8 * s + 4], p1[8 * s + 5]); w1.w = cvtpk(p1[8 * s + 6], p1[8 * s + 7]);
                pa[s] = __builtin_bit_cast(bf16x8, w0); pa[2 + s] = __builtin_bit_cast(bf16x8, w1);
            }
            if (g == 0) ATT_PV(sg);
        }
    }
#undef ATT_PV
    asm volatile("s_waitcnt vmcnt(0) lgkmcnt(0)" ::: "memory");
    __builtin_amdgcn_s_barrier();
    asm volatile("" ::: "memory");
    if (has_next) {
        const bf16_t* Pn = P + (size_t)nb * SEQ * PITCH; const unsigned dk = (unsigned)(nkcol - up.kcol), dv = (unsigned)(nvcol - up.vcol);
#pragma unroll
        for (int j = 0; j < 2; ++j) if (nT0 + j <= nT1) ATT_DMA2(Pn, dk, dv, nT0 + j, 2 + j);
    }
#undef ATT_DMA
#undef ATT_DMA2
    const float lt = swapsum(l), inv = 1.f / lt;
    constexpr int ORS = DV * 2 + 16, OCH = DV / 8, ORPI = 64 / OCH  ;
    if (!diff) {
        ATT_LAS char* ot = lds + 4 * STG + wid * (32 * ORS);
#pragma unroll
        for (int e = 0; e < NEB; ++e)
#pragma unroll
            for (int r4 = 0; r4 < 4; ++r4) { u32x2 w; w.x = cvtpk(o[e][4 * r4] * inv, o[e][4 * r4 + 1] * inv); w.y = cvtpk(o[e][4 * r4 + 2] * inv, o[e][4 * r4 + 3] * inv);
                *(ATT_LAS u32x2*)(ot + r32 * ORS + (e * 32 + 8 * r4 + 4 * hi) * 2) = w; }
        bf16_t* ob = MIX + (rowbase + qw) * OPITCH + up.ocol;
#pragma unroll
        for (int j = 0; j < 32 / ORPI; ++j) { const int row = j * ORPI + lane / OCH, ch = lane % OCH; const u32x4 v = *(ATT_LAS const u32x4*)(ot + row * ORS + ch * 16); *(u32x4*)(ob + (size_t)row * OPITCH + ch * 8) = v; }
    } else {
        ATT_LAS float* xb = (ATT_LAS float*)(lds + wq * (NEB * 16 * 64 * 4)) + lane;
        if (g == 1) { const float sc = lam * inv;
#pragma unroll
            for (int e = 0; e < NEB; ++e)
#pragma unroll
                for (int r = 0; r < 16; ++r) xb[(e * 16 + r) * 64] = o[e][r] * sc; }
        __syncthreads();
        if (g == 0) { float ss = 0.f;
#pragma unroll
            for (int e = 0; e < NEB; ++e)
#pragma unroll
                for (int r = 0; r < 16; ++r) { const float d = o[e][r] * inv - xb[(e * 16 + r) * 64]; o[e][r] = d; ss += d * d; }
            ss = swapsum(ss);
            const float rs = rsqrtf(ss * (1.f / DV) + 1e-5f) * 0.8f;
            ATT_LAS char* ot = lds + wq * (NEB * 16 * 64 * 4);
            asm volatile("s_waitcnt lgkmcnt(0)" ::: "memory");
#pragma unroll
            for (int e = 0; e < NEB; ++e)
#pragma unroll
                for (int r4 = 0; r4 < 4; ++r4) { const f32x4 wv = *(const f32x4*)(subln_w + e * 32 + 8 * r4 + 4 * hi);
                    u32x2 w; w.x = cvtpk(o[e][4 * r4] * rs * wv[0], o[e][4 * r4 + 1] * rs * wv[1]); w.y = cvtpk(o[e][4 * r4 + 2] * rs * wv[2], o[e][4 * r4 + 3] * rs * wv[3]);
                    *(ATT_LAS u32x2*)(ot + r32 * ORS + (e * 32 + 8 * r4 + 4 * hi) * 2) = w; }
            bf16_t* ob = MIX + (rowbase + qw) * OPITCH + up.ocol;
#pragma unroll
            for (int j = 0; j < 32 / ORPI; ++j) { const int row = j * ORPI + lane / OCH, ch = lane % OCH; const u32x4 v = *(ATT_LAS const u32x4*)(ot + row * ORS + ch * 16); *(u32x4*)(ob + (size_t)row * OPITCH + ch * 8) = v; } }
    }
}
}
constexpr int NWAVES = 8;
#ifndef CV_ROT
#define CV_ROT 0
#endif
#ifndef CV_NTS
#define CV_NTS false
#endif
#ifndef P4_ALIGN
#define P4_ALIGN true
#endif
#ifndef WGM_P1
#define WGM_P1 4
#endif
#ifndef WGM_P3
#define WGM_P3 4
#endif
#ifndef WGM_P4
#define WGM_P4 8
#endif
#ifndef WGM_P5
#define WGM_P5 4
#endif
#ifndef FUSE_FINAL
#define FUSE_FINAL 0
#endif
#ifndef GEMM_SP2
#define GEMM_SP2 true
#endif
#ifndef MK_N_LAUNCHES
#define MK_N_LAUNCHES 1
#endif
constexpr int N_PHASES = 7;
constexpr int BATCH = 8, SEQ = 2048, D = 2048, M = BATCH * SEQ, INC = 4608, DFF = 5632, NGU = 2 * DFF;
constexpr float RMS_EPS = 1e-5f;
constexpr float QSCALE2 = 0.125f * 1.4426950408889634f;
constexpr size_t MiB = 1u << 20;
constexpr size_t WS_PART1 = 1 * MiB, WS_PART2 = 3 * MiB;
constexpr size_t WS_WIN = 8 * MiB, WS_WOUT = 26 * MiB, WS_WGU = 34 * MiB, WS_WDN = 78 * MiB;
constexpr size_t WS_XN = 100 * MiB;
constexpr size_t WS_PROJ = 164 * MiB, WS_MIX = 308 * MiB;
constexpr size_t WS_H = 164 * MiB;
constexpr size_t WS_END = 372 * MiB;
static_assert(WS_H + (size_t)M * DFF * 2 <= WS_END && WS_MIX + (size_t)M * D * 2 <= WS_END && WS_PROJ + (size_t)M * INC * 2 <= WS_MIX, "ws map");
constexpr int RING_BYTES = 131072, LDS_BYTES = 147456;

#define LAS __attribute__((address_space(3)))
typedef unsigned short bf16;
typedef unsigned v4u __attribute__((ext_vector_type(4)));
typedef float f32x4 __attribute__((ext_vector_type(4)));
__device__ __forceinline__ unsigned pk2(float lo, float hi) { return pg8::cvt_pk_bf16(lo, hi); }
__device__ __forceinline__ float wave_sum(float v) {
#pragma unroll
    for (int o = 1; o < 64; o <<= 1) v += __shfl_xor(v, o);
    return v;
}
template <int NB> __device__ __forceinline__ void transpose_item(const float* __restrict__ W, int K, int N, bf16* __restrict__ WT, int dst_row0, const float* __restrict__ kscale, float cscale, LAS float* scr, int k0, int n0, int lane, bool nts = false) {
    const float* src = W + (size_t)(k0 + (lane >> 4)) * N + n0 + 4 * (lane & 15);
#pragma unroll
    for (int b = 0; b < 16 / NB; ++b) {
        f32x4 v[NB];
#pragma unroll
        for (int i = 0; i < NB; ++i) v[i] = __builtin_nontemporal_load((const f32x4*)(src + (size_t)(4 * (b * NB + i)) * N));
#pragma unroll
        for (int i = 0; i < NB; ++i) { const int kk = 4 * (b * NB + i) + (lane >> 4); float sc = cscale; if (kscale) sc *= kscale[k0 + kk];
            LAS float* d = scr + kk * 65 + 4 * (lane & 15); d[0] = v[i].x * sc; d[1] = v[i].y * sc; d[2] = v[i].z * sc; d[3] = v[i].w * sc; }
        if (NB < 16) asm volatile("" ::: "memory");
    }
    asm volatile("s_waitcnt lgkmcnt(0)" ::: "memory");
    const int c = lane & 7;
#pragma unroll
    for (int j = 0; j < 8; ++j) { const int n = (lane >> 3) + 8 * j; const LAS float* s = scr + (8 * c) * 65 + n;
        v4u o; o.x = pk2(s[0 * 65], s[1 * 65]); o.y = pk2(s[2 * 65], s[3 * 65]); o.z = pk2(s[4 * 65], s[5 * 65]); o.w = pk2(s[6 * 65], s[7 * 65]);
        v4u* dp = (v4u*)(WT + (size_t)(dst_row0 + n) * K + k0 + 8 * c); if (nts) __builtin_nontemporal_store(o, dp); else *dp = o; }
    asm volatile("s_waitcnt lgkmcnt(0)" ::: "memory");
}

#define XB_TMO      128
#define XB_XCNT(j)  (256  + 64 * (j))
#define XB_XSUB(j)  (1280 + 64 * (j))
#define XB_XGEN(j)  (2304 + 64 * (j))
#define XB_TOP      3328
#define XB_TOPGEN   3392
#define XCD_BAR_WORDS 3456
#define XB_SPIN_CAP (1u << 18)

__device__ __forceinline__ unsigned xb_ld(unsigned* p)              { return __hip_atomic_load(p, __ATOMIC_RELAXED, __HIP_MEMORY_SCOPE_AGENT); }
__device__ __forceinline__ unsigned xb_add(unsigned* p, unsigned v) { return __hip_atomic_fetch_add(p, v, __ATOMIC_RELAXED, __HIP_MEMORY_SCOPE_AGENT); }
__device__ __forceinline__ unsigned xb_xcc_id() { return (unsigned)__builtin_amdgcn_s_getreg((3 << 11) | 20) & 0xFu; }
#define XB_SPIN(cond, bar) do { unsigned _sp = 0; while (cond) { __builtin_amdgcn_s_sleep(1); \
    if ((++_sp & 255u) == 0u) { if (xb_ld(&(bar)[XB_TMO])) break; if (_sp > XB_SPIN_CAP) { atomicAdd(&(bar)[XB_TMO], 1u); break; } } } } while (0)

struct XcdBarrier {
    unsigned* bar; unsigned x;
    volatile LAS unsigned* st;
};

__device__ __forceinline__ XcdBarrier xcd_barrier_post(unsigned* bar, volatile LAS unsigned* st) {
    XcdBarrier b; b.bar = bar; b.x = xb_xcc_id(); b.st = st;
    if (threadIdx.x == 0) (void)xb_add(&bar[XB_XCNT(b.x)], 1u);
    return b;
}
__device__ __forceinline__ void xcd_barrier_complete(unsigned* bar, unsigned x, unsigned& nloc, unsigned& nx) {
    const unsigned G = gridDim.x * gridDim.y * gridDim.z;
    unsigned sum, cnt, mine, sp = 0u;
    for (;;) {
        sum = 0u; cnt = 0u; mine = 0u;
#pragma unroll
        for (unsigned j = 0; j < 16; ++j) { const unsigned c = xb_ld(&bar[XB_XCNT(j)]); sum += c; cnt += (c > 0u) ? 1u : 0u; mine = (j == x) ? c : mine; }
        if (sum == G) break;
        __builtin_amdgcn_s_sleep(1);
        if ((++sp & 255u) == 0u) { if (xb_ld(&bar[XB_TMO])) break; if (sp > XB_SPIN_CAP) { atomicAdd(&bar[XB_TMO], 1u); break; } }
    }
    nloc = mine > 0u ? mine : 1u; nx = cnt > 0u ? cnt : 1u;
}

__device__ __forceinline__ void xcd_barrier(const XcdBarrier& b) {
    asm volatile("s_waitcnt vmcnt(0)" ::: "memory");
    __syncthreads();
    if (threadIdx.x == 0) {
        unsigned* bar = b.bar;
        __builtin_amdgcn_s_waitcnt(0);
        unsigned nloc = b.st[0], nx = b.st[1];
        if (nloc == 0u) { xcd_barrier_complete(bar, b.x, nloc, nx); b.st[0] = nloc; b.st[1] = nx; }
        const unsigned old = xb_add(&bar[XB_XSUB(b.x)], 1u);
        const unsigned gen = old / nloc;
        if (old + 1u == (gen + 1u) * nloc) {
            __builtin_amdgcn_fence(__ATOMIC_RELEASE, "agent");
            asm volatile("s_waitcnt vmcnt(0)" ::: "memory");
            const unsigned og = xb_add(&bar[XB_TOP], 1u);
            const unsigned tg = og / nx;
            if (og + 1u == (tg + 1u) * nx) xb_add(&bar[XB_TOPGEN], 1u);
            else XB_SPIN(xb_ld(&bar[XB_TOPGEN]) == tg, bar);
            __builtin_amdgcn_fence(__ATOMIC_ACQUIRE, "agent");
            xb_add(&bar[XB_XGEN(b.x)], 1u);
            asm volatile("s_waitcnt vmcnt(0)" ::: "memory");
        } else {
            XB_SPIN(xb_ld(&bar[XB_XGEN(b.x)]) == gen, bar);
            __builtin_amdgcn_fence(__ATOMIC_ACQUIRE, "agent");
            asm volatile("s_waitcnt vmcnt(0)" ::: "memory");
        }
    }
    __syncthreads();
}

struct PrefetchOrder {
    pg8::StaticOrder S; const char* base; unsigned row_bytes, tile_bytes; LAS unsigned char* dump;
    __device__ __forceinline__ bool next(int i, pg8::Unit& u) const { return S.next(i, u); }
    __device__ __forceinline__ void done(const pg8::Unit&) const {}
    __device__ __forceinline__ void a_ready(const pg8::Unit& u) const {
        const int tid = threadIdx.x, wid = __builtin_amdgcn_readfirstlane(tid >> 6); const unsigned lpr = tile_bytes >> 7, nline = 256u * lpr;
        const char* tb = base + (size_t)u.pm * 256 * row_bytes + (size_t)u.pn * tile_bytes;
        for (unsigned line = tid; line < nline; line += 512) { const unsigned r = line / lpr, l = line % lpr;
            __builtin_amdgcn_global_load_lds((const unsigned*)(tb + (size_t)r * row_bytes + l * 128), (LAS unsigned*)(dump + wid * 256), 4, 0, 0); }
    }
};
struct TwiceOrder { pg8::StaticOrder S; __device__ bool next(int i, pg8::Unit& u) const { return S.next(i >> 1, u); } __device__ __forceinline__ void a_ready(const pg8::Unit&) const {} __device__ __forceinline__ void done(const pg8::Unit&) const {} };
struct Args { const float* in[15]; float* out; unsigned char* ws; int ph_lo, ph_hi; };
enum { I_X = 0, I_ANW, I_WIN, I_LQ1, I_LK1, I_LQ2, I_LK2, I_SUBLN, I_SINKS, I_WOUT, I_FNW, I_WG, I_WU, I_WD, I_FINW };

__device__ __forceinline__ void item_kn(int r, int nblk_n, int& k0, int& n0) { const int g8 = r >> 3, w = r & 7, hn = nblk_n >> 1; n0 = 64 * (2 * (g8 % hn) + (w & 1)); k0 = 64 * (4 * (g8 / hn) + (w >> 1)); }
#ifndef CV_SPLIT
#define CV_SPLIT 0
#endif
#ifndef CV_SA
#define CV_SA 48
#endif
constexpr int CV_IN = (D / 64) * (INC / 64), CV_OUT = (D / 64) * (D / 64), CV_G = (D / 64) * (DFF / 64), CV_DN = (DFF / 64) * (D / 64), CV_ALL = CV_IN + CV_OUT + 2 * CV_G + CV_DN, CV_T0 = CV_IN + CV_OUT, CV_T1 = CV_T0 + CV_G;
template <int NB> __device__ __forceinline__ void convert_weights(const Args& args, unsigned char* ws, LAS float* scr, int first, int last, int skip0, int skip1, int widx, int nw, int lane) {
    bf16* Win_t = (bf16*)(ws + WS_WIN); bf16* Wout_t = (bf16*)(ws + WS_WOUT); bf16* Wgu_t = (bf16*)(ws + WS_WGU); bf16* Wdn_t = (bf16*)(ws + WS_WDN);
    for (int it = first + widx; it < last - (skip1 - skip0); it += nw) {
        int r = it; if (r >= skip0) r += skip1 - skip0;
        if (CV_ROT && first == 0 && last == CV_ALL) { r += CV_IN; if (r >= CV_ALL) r -= CV_ALL; }
        if (r < CV_IN) { int k0, n0; item_kn(r, INC / 64, k0, n0); const float cs = (n0 < 1024 || (n0 >= 3072 && n0 < 4096)) ? QSCALE2 : 1.f;
            transpose_item<NB>(args.in[I_WIN], D, INC, Win_t, n0, nullptr, cs, scr, k0, n0, lane); continue; } r -= CV_IN;
        if (r < CV_OUT) { int k0, n0; item_kn(r, D / 64, k0, n0); transpose_item<NB>(args.in[I_WOUT], D, D, Wout_t, n0, nullptr, 1.f, scr, k0, n0, lane, CV_NTS); continue; } r -= CV_OUT;
        if (r < 2 * CV_G) { const int up = r >= CV_G; if (up) r -= CV_G; int k0, n0; item_kn(r, DFF / 64, k0, n0);
            transpose_item<NB>(args.in[up ? I_WU : I_WG], D, DFF, Wgu_t, 256 * (n0 / 128) + 128 * up + (n0 % 128), args.in[I_FNW], 1.f, scr, k0, n0, lane, CV_NTS); continue; } r -= 2 * CV_G;
        { int k0, n0; item_kn(r, D / 64, k0, n0); transpose_item<NB>(args.in[I_WD], DFF, D, Wdn_t, n0, nullptr, 1.f, scr, k0, n0, lane, CV_NTS); }
    }
}

struct CvItem { const float* src; bf16* dst; const float* kscale; float cscale; int N, K; };
__device__ __forceinline__ bool cv_decode(const Args& args, unsigned char* ws, int r, int last, int lane, CvItem& it) {
    if (r >= last) return false;
    bf16* Win_t = (bf16*)(ws + WS_WIN); bf16* Wout_t = (bf16*)(ws + WS_WOUT); bf16* Wgu_t = (bf16*)(ws + WS_WGU); bf16* Wdn_t = (bf16*)(ws + WS_WDN);
    int k0, n0, row0; const float* W; bf16* WT; it.kscale = nullptr; it.cscale = 1.f;
    if (r < CV_IN) { item_kn(r, INC / 64, k0, n0); W = args.in[I_WIN]; WT = Win_t; it.N = INC; it.K = D; row0 = n0; it.cscale = (n0 < 1024 || (n0 >= 3072 && n0 < 4096)) ? QSCALE2 : 1.f; }
    else if ((r -= CV_IN) < CV_OUT) { item_kn(r, D / 64, k0, n0); W = args.in[I_WOUT]; WT = Wout_t; it.N = D; it.K = D; row0 = n0; }
    else if ((r -= CV_OUT) < 2 * CV_G) { const int up = r >= CV_G; if (up) r -= CV_G; item_kn(r, DFF / 64, k0, n0); W = args.in[up ? I_WU : I_WG]; WT = Wgu_t; it.N = DFF; it.K = D; row0 = 256 * (n0 / 128) + 128 * up + (n0 % 128); it.kscale = args.in[I_FNW] + k0; }
    else { r -= 2 * CV_G; item_kn(r, D / 64, k0, n0); W = args.in[I_WD]; WT = Wdn_t; it.N = D; it.K = DFF; row0 = n0; }
    it.src = W + (size_t)(k0 + (lane >> 4)) * it.N + n0 + 4 * (lane & 15);
    it.dst = WT + (size_t)row0 * it.K + k0;
    return true;
}
__device__ __forceinline__ void cv_load(const CvItem& it, f32x4 (&v)[16]) {
#pragma unroll
    for (int i = 0; i < 16; ++i) v[i] = *(const f32x4*)(it.src + (size_t)(4 * i) * it.N);
}
__device__ __forceinline__ void cv_finish(const CvItem& it, const f32x4 (&v)[16], LAS float* scr, int lane) {
#pragma unroll
    for (int i = 0; i < 16; ++i) { const int kk = 4 * i + (lane >> 4); float sc = it.cscale; if (it.kscale) sc *= it.kscale[kk];
        LAS float* d = scr + kk * 65 + 4 * (lane & 15); d[0] = v[i].x * sc; d[1] = v[i].y * sc; d[2] = v[i].z * sc; d[3] = v[i].w * sc; }
    asm volatile("s_waitcnt lgkmcnt(0)" ::: "memory");
    const int c = lane & 7;
#pragma unroll
    for (int j = 0; j < 8; ++j) { const int n = (lane >> 3) + 8 * j; const LAS float* s = scr + (8 * c) * 65 + n;
        v4u o; o.x = pk2(s[0 * 65], s[1 * 65]); o.y = pk2(s[2 * 65], s[3 * 65]); o.z = pk2(s[4 * 65], s[5 * 65]); o.w = pk2(s[6 * 65], s[7 * 65]);
        *(v4u*)(it.dst + (size_t)n * it.K + 8 * c) = o; }
    asm volatile("s_waitcnt lgkmcnt(0)" ::: "memory");
}
__device__ __forceinline__ void convert_weights_pipe(const Args& args, unsigned char* ws, LAS float* scr, int first, int last, int widx, int nw, int lane) {
    CvItem ia, ib; f32x4 va[16], vb[16];
    int r = first + widx;
    bool ha = cv_decode(args, ws, r, last, lane, ia); if (ha) cv_load(ia, va);
    while (ha) {
        const bool hb = cv_decode(args, ws, r + nw, last, lane, ib); if (hb) cv_load(ib, vb);
        cv_finish(ia, va, scr, lane);
        if (!hb) break;
        r += 2 * nw;
        ha = cv_decode(args, ws, r, last, lane, ia); if (ha) cv_load(ia, va);
        cv_finish(ib, vb, scr, lane);
    }
}

__global__ void __launch_bounds__(NWAVES * 64, 2) hymba_fwd(Args args) {
    extern __shared__ __attribute__((aligned(16))) unsigned char lds_raw[];
    cg::grid_group grid = cg::this_grid();
    LAS unsigned char* lds = (LAS unsigned char*)lds_raw;
    const int tid = threadIdx.x, lane = tid & 63, wave = __builtin_amdgcn_readfirstlane(tid >> 6);
    const int G = gridDim.x, bx = blockIdx.x, vcu = (G % 8 == 0) ? (bx % 8) * (G / 8) + bx / 8 : bx;
    unsigned char* ws = args.ws;
    const float* x = args.in[I_X]; float* out = args.out;
    bf16* Win_t = (bf16*)(ws + WS_WIN); bf16* Wout_t = (bf16*)(ws + WS_WOUT); bf16* Wgu_t = (bf16*)(ws + WS_WGU); bf16* Wdn_t = (bf16*)(ws + WS_WDN);
    bf16* XN = (bf16*)(ws + WS_XN); bf16* PROJ = (bf16*)(ws + WS_PROJ); bf16* MIX = (bf16*)(ws + WS_MIX); bf16* HB = (bf16*)(ws + WS_H);
    float* part1 = (float*)(ws + WS_PART1); float* part2 = (float*)(ws + WS_PART2);
    const int lo = args.ph_lo, hi = args.ph_hi;
    volatile LAS unsigned* bst = (volatile LAS unsigned*)(lds + LDS_BYTES - 64);
    if (tid < 2) bst[tid] = 0u;
    if (tid == 0) { *(LAS unsigned long long*)(lds + LDS_BYTES - 32) = 0ull; }
    __syncthreads();
    XcdBarrier gbar; gbar.bar = (unsigned*)ws; gbar.x = 0; gbar.st = bst;
    if (hi - lo > 1) gbar = xcd_barrier_post((unsigned*)ws, bst);
    if (hi > 1000) grid.sync();
#define IN(k) (lo <= (k) && (k) < hi)
#ifndef SYNC_REPEAT
#define SYNC_REPEAT 1
#endif
#define SEAM(k) do { if (IN(k) && IN((k) + 1)) { for (int sr_ = 0; sr_ < SYNC_REPEAT; ++sr_) xcd_barrier(gbar); } } while (0)
#ifndef PROBE_PHASE
#define PROBE_PHASE -1
#endif
#ifndef STAMP_SEL
#define STAMP_SEL 1
#endif
#ifdef STAMP_PHASE
#define STAMP_BEGIN(k) do { if ((k) == STAMP_PHASE || ((k) == 2 && (STAMP_PHASE == 30 || STAMP_PHASE == 31))) st0_ = __builtin_amdgcn_s_memrealtime(); } while (0)
#define STAMP_END(k) do { if ((k) == STAMP_PHASE) st1_ = __builtin_amdgcn_s_memrealtime(); } while (0)
#else
#define STAMP_BEGIN(k) do {} while (0)
#define STAMP_END(k) do {} while (0)
#endif
    unsigned long long st0_ = 0, st1_ = 0; (void)st0_; (void)st1_;
#define REP(k) for (int rep_ = 0; rep_ < ((PROBE_PHASE == (k)) ? 2 : 1); ++rep_, ((PROBE_PHASE == (k)) && rep_ < 2 ? (xcd_barrier(gbar), 0) : 0))

    STAMP_BEGIN(0); STAMP_BEGIN(41);
    REP(0) if (IN(0)) {
        LAS float* scr = (LAS float*)(lds + wave * 16640);
        const int gw = vcu * NWAVES + wave, NGW = G * NWAVES;
#if defined(P0_TOUCH) && P0_TOUCH
        {
            const int widx[5] = {I_WIN, I_WOUT, I_WG, I_WU, I_WD}; const size_t wn4[5] = {(size_t)D * INC / 4, (size_t)D * D / 4, (size_t)D * DFF / 4, (size_t)D * DFF / 4, (size_t)DFF * D / 4};
            f32x4 acc4 = {0.f, 0.f, 0.f, 0.f};
#pragma unroll
            for (int w = 0; w < 5; ++w) { const f32x4* src = (const f32x4*)args.in[widx[w]];
                for (size_t i = (size_t)gw * 64 + lane; i < wn4[w]; i += (size_t)NGW * 64 * 4) {
                    f32x4 a = src[i], b = (i + (size_t)NGW * 64 < wn4[w]) ? src[i + (size_t)NGW * 64] : acc4, c = (i + (size_t)NGW * 128 < wn4[w]) ? src[i + (size_t)NGW * 128] : acc4, d = (i + (size_t)NGW * 192 < wn4[w]) ? src[i + (size_t)NGW * 192] : acc4;
                    acc4 = acc4 + a + b + c + d; } }
            if (acc4.x + acc4.y + acc4.z + acc4.w == 1.2345e38f) ((float*)(ws + WS_PART2))[gw * 64 + lane] = acc4.x;
        }
#endif
#if defined(CV_PIPE) && CV_PIPE
        convert_weights_pipe(args, ws, scr, 0, CV_SPLIT ? CV_IN : CV_ALL, gw, NGW, lane);
#else
        convert_weights<16>(args, ws, scr, 0, CV_SPLIT ? CV_ALL - 128 * CV_SA : CV_ALL, 0, 0, gw, NGW, lane);
#endif
        STAMP_BEGIN(40); __syncthreads(); STAMP_END(41);
        const f32x4* wn = (const f32x4*)args.in[I_ANW] + lane;
        for (int rp_ = 0; rp_ < (PROBE_PHASE == 11 ? 2 : 1); ++rp_)
        for (int m = gw; m < M; m += NGW) {
            const f32x4* xr = (const f32x4*)(x + (size_t)m * D) + lane;
            f32x4 v[8]; float s = 0.f;
#pragma unroll
            for (int j = 0; j < 8; ++j) { v[j] = __builtin_nontemporal_load(xr + 64 * j); s += (v[j].x * v[j].x + v[j].y * v[j].y) + (v[j].z * v[j].z + v[j].w * v[j].w); }
            const float rstd = rsqrtf(wave_sum(s) * (1.f / D) + RMS_EPS);
            unsigned long long* o8 = (unsigned long long*)(XN + (size_t)m * D) + lane;
#pragma unroll
            for (int j = 0; j < 8; ++j) { const f32x4 w = wn[64 * j]; o8[64 * j] = (unsigned long long)pk2(v[j].x * rstd * w.x, v[j].y * rstd * w.y) | ((unsigned long long)pk2(v[j].z * rstd * w.z, v[j].w * rstd * w.w) << 32); }
        }
        __syncthreads();
    }
    SEAM(0);
    STAMP_END(0); STAMP_END(40);
    STAMP_BEGIN(1);
    REP(1) if (IN(1)) {
        pg8::Gemm g{XN, Win_t, M, INC, D}; pg8::StaticOrder S; S.init(M, INC, G, bx, WGM_P1);
        pg8::EpiStore E{PROJ, INC};
#if PROBE_PHASE == 21
        { TwiceOrder S2{S}; pg8::gemm_phase<pg8::EpiStore, TwiceOrder, true, true>(lds, g, S2, E); }
#else
        pg8::gemm_phase<pg8::EpiStore, pg8::StaticOrder, true, GEMM_SP2>(lds, g, S, E);
#endif
        if (CV_SPLIT) { const int nwg = (M / 256) * (INC / 256), maxU = (nwg + G - 1) / G, nIdle = G * maxU - nwg, idx = bx - (G - nIdle);
            const int nw_ = nIdle > 0 ? nIdle : G, id_ = nIdle > 0 ? idx : bx, per = (128 * CV_SA + nw_ - 1) / nw_, f0 = CV_ALL - 128 * CV_SA + id_ * per;
            if (id_ >= 0) convert_weights<8>(args, ws, (LAS float*)(lds + wave * 16640), f0, f0 + per < CV_ALL ? f0 + per : CV_ALL, 0, 0, wave, NWAVES, lane); }
        __syncthreads();
    }
    SEAM(1);
    STAMP_END(1);
    STAMP_BEGIN(2);
    REP(2) if (IN(2)) {
        const float* lq1 = args.in[I_LQ1]; const float* lk1 = args.in[I_LK1]; const float* lq2 = args.in[I_LQ2]; const float* lk2 = args.in[I_LK2];
        const float s1 = wave_sum(lq1[lane] * lk1[lane]), s2 = wave_sum(lq2[lane] * lk2[lane]);
        const float lam = expf(s1) - expf(s2) + 0.2f;
        const int wq = wave & 3, gsel = wave >> 2;
#ifdef ATT_PRIO
        if (gsel == 1) __builtin_amdgcn_s_setprio(1);
#endif
        STAMP_BEGIN(20);
        { const int np = vcu < 512 ? (512 - vcu + G - 1) / G : 0;
#define DIFF_UNIT(u_, up_) do { const int i_ = vcu + G * ((u_) >> 1), bh_ = (i_ >> 3) ^ (((u_) >> 1) & 1 ? 4 : 0)  , xq_ = i_ & 7, h_ = bh_ & 7, qblk_ = ((u_) & 1) ? 15 - xq_ : xq_; \
            up_.b = bh_ >> 3; up_.q0 = 128 * qblk_; up_.qcol = h_ * 128 + gsel * 64; up_.kcol = 1024 + h_ * 128; up_.vcol = 2048 + h_ * 128; up_.kofs = gsel * 128; \
            up_.slope2 = exp2f(-(float)(h_ + 1)) * 1.4426950408889634f; up_.m_init = 0.f; up_.l_init = 0.f; \
            up_.T0 = 0; up_.T1 = 2 * qblk_ + 1; up_.tlo = 0; up_.thi = (up_.q0 + 32 * wq) >> 6; up_.window = 1 << 20; up_.maskall = 0; up_.ocol = h_ * 128; } while (0)
#pragma unroll 1
          for (int u = 0; u < 2 * np; ++u) {
              att::UnitP up, nx; DIFF_UNIT(u, up); const bool hn = u + 1 < 2 * np; if (hn) DIFF_UNIT(u + 1, nx); else nx = up;
              att::attn_unit<128, 128>((LAS char*)lds, PROJ, MIX, up, true, lam, args.in[I_SUBLN], tid, u > 0, hn, nx.b, nx.kcol, nx.vcol, nx.T0, nx.T1);
          }
#undef DIFF_UNIT
        }
        STAMP_END(20); STAMP_BEGIN(21);
        { const int ns = vcu < 1024 ? (1024 - vcu + G - 1) / G : 0;
#define SWA_UNIT(u_, up_) do { const int i_ = vcu + G * (u_), qblk_ = i_ & 15, pair_ = (i_ >> 4) & 1, hkv_ = ((i_ >> 5) + (u_)) & 3, hq_ = hkv_ * 4 + pair_ * 2 + gsel, a_ = 2 * qblk_; \
            up_.b = i_ >> 7; up_.q0 = 128 * qblk_; up_.qcol = 3072 + hq_ * 64; up_.kcol = 4096 + hkv_ * 64; up_.vcol = 4352 + hkv_ * 64; up_.kofs = 0; \
            up_.slope2 = exp2f(-0.5f * (float)(hq_ + 1)) * 1.4426950408889634f; up_.m_init = args.in[I_SINKS][hq_] * 1.4426950408889634f; up_.l_init = 1.f; \
            up_.T0 = a_ - 2 < 0 ? 0 : a_ - 2; up_.T1 = a_ + 1; up_.tlo = a_ - 2 + (wq >> 1); up_.thi = a_ + (wq >> 1); up_.window = 128; up_.maskall = 1; up_.ocol = 1024 + hq_ * 64; } while (0)
#pragma unroll 1
          for (int u = 0; u < ns; ++u) {
              att::UnitP up, nx; SWA_UNIT(u, up); const bool hn = u + 1 < ns; if (hn) SWA_UNIT(u + 1, nx); else nx = up;
              att::attn_unit<64, 64>((LAS char*)lds, PROJ, MIX, up, false, 0.f, nullptr, tid, u > 0, hn, nx.b, nx.kcol, nx.vcol, nx.T0, nx.T1);
          }
#undef SWA_UNIT
        }
        STAMP_END(21);
#ifdef ATT_PRIO
        __builtin_amdgcn_s_setprio(0);
#endif
#if defined(P3_PREFETCH_X) && P3_PREFETCH_X
        {
            pg8::StaticOrder S3; S3.init(M, D, G, bx, WGM_P3); pg8::Unit u3; float pacc = 0.f;
            for (int i = 0; S3.next(i, u3); ++i) {
                const float* tb = x + (size_t)u3.pm * 256 * D + (size_t)u3.pn * 256;
#pragma unroll
                for (int k = 0; k < 4; ++k) { const int line = tid + 512 * k; pacc += tb[(size_t)(line >> 3) * D + (line & 7) * 32]; }
            }
            if (pacc == 1.2345e38f) part2[tid] = pacc;
        }
#endif
        __syncthreads();
#ifdef STAMP_PHASE
        if (STAMP_PHASE == 30 || STAMP_PHASE == 31) { if (tid == 0 && STAMP_SEL) { const unsigned d_ = (unsigned)(__builtin_amdgcn_s_memrealtime() - st0_);
            if (STAMP_PHASE == 30) __hip_atomic_fetch_max((unsigned*)ws + 3500, d_, __ATOMIC_RELAXED, __HIP_MEMORY_SCOPE_AGENT); else __hip_atomic_fetch_max((unsigned*)ws + 3500, ~d_, __ATOMIC_RELAXED, __HIP_MEMORY_SCOPE_AGENT) ; } }
#endif
    }
    SEAM(2);
#ifdef STAMP_PHASE
    if (STAMP_PHASE == 30 || STAMP_PHASE == 31) { const unsigned v_ = __hip_atomic_load((unsigned*)ws + 3500, __ATOMIC_RELAXED, __HIP_MEMORY_SCOPE_AGENT); st1_ = st0_ + (STAMP_PHASE == 30 ? v_ : ~v_); }
#endif
    STAMP_END(2);
    STAMP_BEGIN(3);
    REP(3) if (IN(3)) {
        pg8::Gemm g{MIX, Wout_t, M, D, D}; pg8::StaticOrder S; S.init(M, D, G, bx, WGM_P3);
        pg8::EpiResid<false> E{x, XN, part1, D};
        pg8::gemm_phase<pg8::EpiResid<false>, pg8::StaticOrder, true, GEMM_SP2>(lds, g, S, E);
    }
    SEAM(3);
    STAMP_END(3);
    STAMP_BEGIN(4);
    REP(4) if (IN(4)) {
        pg8::Gemm g{XN, Wgu_t, M, NGU, D}; pg8::StaticOrder S; S.init(M, NGU, G, bx, WGM_P4);
        pg8::EpiSwiGLU E{HB, DFF, part1, 1.f / D, RMS_EPS};
#if PROBE_PHASE == 24
        { TwiceOrder S2{S}; pg8::gemm_phase<pg8::EpiSwiGLU, TwiceOrder, true, true>(lds, g, S2, E); }
#else
        pg8::gemm_phase<pg8::EpiSwiGLU, pg8::StaticOrder, P4_ALIGN, GEMM_SP2>(lds, g, S, E);
#endif
    }
    SEAM(4);
    STAMP_END(4);
    STAMP_BEGIN(5);
    REP(5) if (IN(5)) {
        pg8::Gemm g{HB, Wdn_t, M, D, DFF}; pg8::StaticOrder S; S.init(M, D, G, bx, WGM_P5);
#if FUSE_FINAL
        pg8::EpiFinal E{XN, out, args.in[I_FINW], part2, (unsigned*)ws + 4096, lds + RING_BYTES, D, 1.f / D, RMS_EPS};
        pg8::gemm_phase<pg8::EpiFinal, pg8::StaticOrder, true, GEMM_SP2>(lds, g, S, E);
#else
        pg8::EpiResid<true> E{XN, XN, part2, D};
        pg8::gemm_phase<pg8::EpiResid<true>, pg8::StaticOrder, true, GEMM_SP2>(lds, g, S, E);
#endif
    }
#if !FUSE_FINAL
    SEAM(5);
#endif
    STAMP_END(5);
    STAMP_BEGIN(6);
    REP(6) if (IN(6) && !FUSE_FINAL) {
        const int gw = vcu * NWAVES + wave, NGW = G * NWAVES;
        const f32x4* wn = (const f32x4*)args.in[I_FINW] + 2 * lane;
        for (int m = gw; m < M; m += NGW) {
            const float s = wave_sum(lane < 32 ? part2[(size_t)m * 32 + lane] : 0.f);
            const float rstd = rsqrtf(s * (1.f / D) + RMS_EPS);
            const v4u* xr = (const v4u*)(XN + (size_t)m * D) + lane; f32x4* orow = (f32x4*)(out + (size_t)m * D) + 2 * lane;
#pragma unroll
            for (int j = 0; j < 4; ++j) { const v4u w = __builtin_nontemporal_load(xr + 64 * j); const f32x4 w0 = wn[128 * j], w1 = wn[128 * j + 1];
                const f32x4 a = {__uint_as_float(w.x << 16), __uint_as_float(w.x & 0xffff0000u), __uint_as_float(w.y << 16), __uint_as_float(w.y & 0xffff0000u)};
                const f32x4 b = {__uint_as_float(w.z << 16), __uint_as_float(w.z & 0xffff0000u), __uint_as_float(w.w << 16), __uint_as_float(w.w & 0xffff0000u)};
                __builtin_nontemporal_store(a * rstd * w0, orow + 128 * j); __builtin_nontemporal_store(b * rstd * w1, orow + 128 * j + 1); }
        }
    }
#ifdef ATT_TIMER
    if (bx == 0) { __syncthreads(); if (tid == 0) { const unsigned long long dt = *(LAS unsigned long long*)(lds + LDS_BYTES - 32), te = __builtin_amdgcn_s_memtime(); while (__builtin_amdgcn_s_memtime() - te < dt) __builtin_amdgcn_s_sleep(32); } }
#endif
#ifdef STAMP_PHASE
    if (STAMP_PHASE == 6) { __syncthreads(); st1_ = __builtin_amdgcn_s_memrealtime(); }
    if (bx == 0 && tid == 0) { const unsigned long long te = __builtin_amdgcn_s_memrealtime(), dt = st1_ - st0_; while (__builtin_amdgcn_s_memrealtime() - te < dt) __builtin_amdgcn_s_sleep(32); }
#endif
#undef IN
#undef SEAM
}

extern "C" void kernel_launch(void* const* d_in, const int* in_sizes, int n_in, void* d_out, int out_size, void* d_ws, size_t ws_size, hipStream_t stream) {
    static int grid = 0;
    if (grid == 0) {
        if (n_in != 15 || out_size != M * D || ws_size < WS_END) { fprintf(stderr, "kernel_launch: unexpected shapes (n_in %d out %d ws %zu)\n", n_in, out_size, ws_size); grid = -1; return; }
        int dev = 0, cus = 0, per_cu = 0;
        hipGetDevice(&dev); hipDeviceGetAttribute(&cus, hipDeviceAttributeMultiprocessorCount, dev);
        if (hipFuncSetAttribute((const void*)hymba_fwd, hipFuncAttributeMaxDynamicSharedMemorySize, LDS_BYTES) != hipSuccess) { fprintf(stderr, "kernel_launch: hipFuncSetAttribute failed\n"); grid = -1; return; }
        if (hipOccupancyMaxActiveBlocksPerMultiprocessor(&per_cu, (const void*)hymba_fwd, NWAVES * 64, LDS_BYTES) != hipSuccess || per_cu < 1) { fprintf(stderr, "kernel_launch: occupancy query says %d\n", per_cu); per_cu = 1; }
        (void)hipGetLastError();
        grid = cus * 1;
        fprintf(stderr, "kernel_launch: grid %d (cus %d, per_cu %d)\n", grid, cus, per_cu);
    }
    if (grid < 0) return;
    if (hipMemsetAsync(d_ws, 0, 65536, stream) != hipSuccess) { fprintf(stderr, "kernel_launch: memset failed\n"); return; }
    Args a{};
    for (int i = 0; i < 15; ++i) a.in[i] = (const float*)d_in[i];
    a.out = (float*)d_out; a.ws = (unsigned char*)d_ws;
#if MK_N_LAUNCHES == 1
    a.ph_lo = 0; a.ph_hi = N_PHASES;
    void* kargs[] = {&a};
    hipError_t e = hipLaunchCooperativeKernel((const void*)hymba_fwd, dim3(grid), dim3(NWAVES * 64), kargs, LDS_BYTES, stream);
    if (e != hipSuccess) fprintf(stderr, "kernel_launch: cooperative launch failed: %s\n", hipGetErrorString(e));
#else
    for (int p = 0; p < N_PHASES; ++p) { a.ph_lo = p; a.ph_hi = p + 1; hipLaunchKernelGGL(hymba_fwd, dim3(grid), dim3(NWAVES * 64), LDS_BYTES, stream, a); }
#endif
}
```

```cpp
#include <hip/hip_runtime.h>
#include <hip/hip_cooperative_groups.h>
#include <hip/hip_bf16.h>
#include <cstdio>
#include <cstdint>
#include <cmath>
namespace cg = cooperative_groups;
#define MK_N_LAUNCHES 1
#ifndef PG8_WGM
#define PG8_WGM 4
#endif
namespace pg8 {
#define PG8_LAS __attribute__((address_space(3)))
typedef unsigned short bf16_t;
typedef short bf16x8 __attribute__((ext_vector_type(8)));
typedef float f32x4 __attribute__((ext_vector_type(4)));
typedef unsigned u32x4 __attribute__((ext_vector_type(4)));
constexpr int BM = 256, BK = 64, HALF = 128, HTB = HALF * BK * 2  , STAGE_BYTES = 8 * HTB, NXCD = 8, WGM = PG8_WGM;

__host__ __device__ __forceinline__ int lds_byte(int r, int c) { const int st = (r >> 4) * 2 + (c >> 5), rr = r & 15, cc = c & 31, ob = rr * 64 + cc * 2; return st * 1024 + (ob ^ (((ob >> 9) & 1) << 5)); }
__host__ __device__ __forceinline__ void stage_rc(int b, int& R, int& C) { const int st = b / 1024, sb = b % 1024, swz = sb ^ (((sb >> 9) & 1) << 5); R = (st >> 1) * 16 + swz / 64; C = (st & 1) * 32 + (swz % 64) / 2; }
__host__ __device__ __forceinline__ int perm32(int rho) { const int n = rho >> 4, i = rho & 15; return 8 * (i >> 2) + 4 * n + (i & 3); }

struct Unit { int pm, pn; };
struct Gemm { const bf16_t* A; const bf16_t* Bt; int M, N, K; };

struct StaticOrder {
    int nM, nN, nwg, G, c, wgm;
    __host__ __device__ void init(int M, int N, int G_, int c_, int wgm_ = WGM) { nM = M / BM; nN = N / BM; nwg = nM * nN; G = G_; c = c_; wgm = wgm_; }
    __host__ __device__ bool next(int i, Unit& u) const {
        const long L = (long)i * G + c; if (L >= nwg) return false;
        int wgid = (int)L; { const int q = nwg / NXCD, r = nwg % NXCD, xcd = wgid % NXCD, off = wgid / NXCD; wgid = (xcd < r ? xcd * (q + 1) : r * (q + 1) + (xcd - r) * q) + off; }
        const int nig = wgm * nN, gid = wgid / nig, fm = gid * wgm, gsz = (nM - fm) < wgm ? (nM - fm) : wgm;
        u.pm = fm + ((wgid % nig) % gsz); u.pn = (wgid % nig) / gsz; return true;
    }
    __device__ __forceinline__ void a_ready(const Unit&) const {}
    __device__ __forceinline__ void done(const Unit&) const {}
};

__device__ __forceinline__ unsigned cvt_pk_bf16(float lo, float hi) { typedef float f2_t __attribute__((ext_vector_type(2))); typedef __bf16 b2_t __attribute__((ext_vector_type(2))); f2_t v = {lo, hi}; b2_t b = __builtin_convertvector(v, b2_t); return __builtin_bit_cast(unsigned, b); }
typedef unsigned u32x2 __attribute__((ext_vector_type(2)));
#ifndef P5_NT_A
#define P5_NT_A 0
#endif
#ifndef EPI_NT_H
#define EPI_NT_H 0
#endif
#ifndef EPI_NT_PROJ
#define EPI_NT_PROJ 0
#endif
struct EpiStore {
    static constexpr bool PERM = true, AFTER_DRAIN = false; static constexpr int AUX_A = 0, AUX_B = 0;
    bf16_t* O; int ldc;
    __device__ __forceinline__ void operator()(const f32x4 (&acc)[2][2][4][2], const Unit& u, int wr, int wc, int fr, int fq) const {
        const int row0 = u.pm * BM + wr * 64 + fr, col0 = u.pn * BM + wc * 32 + 8 * fq;
#pragma unroll
        for (int ai = 0; ai < 2; ++ai)
#pragma unroll
            for (int m = 0; m < 4; ++m) { bf16_t* rowp = O + (size_t)(row0 + ai * HALF + m * 16) * ldc + col0;
#pragma unroll
                for (int bj = 0; bj < 2; ++bj) { const f32x4 v0 = acc[ai][bj][m][0], v1 = acc[ai][bj][m][1];
                    u32x4 w; w.x = cvt_pk_bf16(v0[0], v0[1]); w.y = cvt_pk_bf16(v0[2], v0[3]); w.z = cvt_pk_bf16(v1[0], v1[1]); w.w = cvt_pk_bf16(v1[2], v1[3]);
                    if (EPI_NT_PROJ) __builtin_nontemporal_store(w, (u32x4*)(rowp + bj * HALF)); else *(u32x4*)(rowp + bj * HALF) = w; } }
    }
};
template <bool BASE_BF16> struct EpiResid {
    static constexpr bool PERM = true, AFTER_DRAIN = false; static constexpr int AUX_A = (BASE_BF16 && P5_NT_A) ? 2 : 0, AUX_B = 0;
    const void* base; bf16_t* xo; float* part; int ldc;
    __device__ __forceinline__ void operator()(const f32x4 (&acc)[2][2][4][2], const Unit& u, int wr, int wc, int fr, int fq) const {
        const int row0 = u.pm * BM + wr * 64 + fr, col0 = u.pn * BM + wc * 32 + 8 * fq;
#pragma unroll
        for (int ai = 0; ai < 2; ++ai)
#pragma unroll
            for (int m = 0; m < 4; ++m) { const int r = row0 + ai * HALF + m * 16; const size_t off = (size_t)r * ldc + col0; float ss = 0.f;
#pragma unroll
                for (int bj = 0; bj < 2; ++bj) { f32x4 b0, b1;
                    if (BASE_BF16) { const u32x4 w = *(const u32x4*)((const bf16_t*)base + off + bj * HALF);
                        b0 = (f32x4){__uint_as_float(w.x << 16), __uint_as_float(w.x & 0xffff0000u), __uint_as_float(w.y << 16), __uint_as_float(w.y & 0xffff0000u)};
                        b1 = (f32x4){__uint_as_float(w.z << 16), __uint_as_float(w.z & 0xffff0000u), __uint_as_float(w.w << 16), __uint_as_float(w.w & 0xffff0000u)}; }
                    else { const float* bp = (const float*)base + off + bj * HALF; b0 = __builtin_nontemporal_load((const f32x4*)bp); b1 = __builtin_nontemporal_load((const f32x4*)(bp + 4)); }
                    const f32x4 v0 = b0 + acc[ai][bj][m][0], v1 = b1 + acc[ai][bj][m][1];
                    ss += ((v0[0] * v0[0] + v0[1] * v0[1]) + (v0[2] * v0[2] + v0[3] * v0[3])) + ((v1[0] * v1[0] + v1[1] * v1[1]) + (v1[2] * v1[2] + v1[3] * v1[3]));
                    u32x4 w; w.x = cvt_pk_bf16(v0[0], v0[1]); w.y = cvt_pk_bf16(v0[2], v0[3]); w.z = cvt_pk_bf16(v1[0], v1[1]); w.w = cvt_pk_bf16(v1[2], v1[3]);
                    *(u32x4*)(xo + off + bj * HALF) = w; }
                ss += __shfl_xor(ss, 16); ss += __shfl_xor(ss, 32);
                if (fq == 0) part[(size_t)r * 32 + u.pn * 4 + wc] = ss; }
    }
};
struct EpiFinal {
    static constexpr bool PERM = true, AFTER_DRAIN = false; static constexpr int AUX_A = 0, AUX_B = 0;
    const bf16_t* xb; float* out; const float* wfin; float* xbuf; unsigned* cnt; PG8_LAS unsigned char* tab; int ldc; float inv_n, eps;
    __device__ __forceinline__ void operator()(f32x4 (&acc)[2][2][4][2], const Unit& u, int wr, int wc, int fr, int fq) const {
        const int lane = fq * 16 + fr, wid = wr * 4 + wc;
        PG8_LAS float* P = (PG8_LAS float*)tab;
        PG8_LAS float* S = (PG8_LAS float*)(tab + 4096);
        PG8_LAS unsigned* flag = (PG8_LAS unsigned*)(tab + 4096 + 1024);
        const int row0 = u.pm * BM + wr * 64 + fr, col0 = u.pn * BM + wc * 32 + 8 * fq;
#pragma unroll
        for (int ai = 0; ai < 2; ++ai)
#pragma unroll
            for (int m = 0; m < 4; ++m) { const int r = row0 + ai * HALF + m * 16; const size_t off = (size_t)r * ldc + col0; float ss = 0.f;
#pragma unroll
                for (int bj = 0; bj < 2; ++bj) { const u32x4 w = *(const u32x4*)(xb + off + bj * HALF);
                    const f32x4 b0 = {__uint_as_float(w.x << 16), __uint_as_float(w.x & 0xffff0000u), __uint_as_float(w.y << 16), __uint_as_float(w.y & 0xffff0000u)};
                    const f32x4 b1 = {__uint_as_float(w.z << 16), __uint_as_float(w.z & 0xffff0000u), __uint_as_float(w.w << 16), __uint_as_float(w.w & 0xffff0000u)};
                    const f32x4 v0 = b0 + acc[ai][bj][m][0], v1 = b1 + acc[ai][bj][m][1]; acc[ai][bj][m][0] = v0; acc[ai][bj][m][1] = v1;
                    ss += ((v0[0] * v0[0] + v0[1] * v0[1]) + (v0[2] * v0[2] + v0[3] * v0[3])) + ((v1[0] * v1[0] + v1[1] * v1[1]) + (v1[2] * v1[2] + v1[3] * v1[3])); }
                ss += __shfl_xor(ss, 16); ss += __shfl_xor(ss, 32);
                if (fq == 0) P[(ai * HALF + wr * 64 + m * 16 + fr) * 4 + wc] = ss; }
        asm volatile("s_waitcnt lgkmcnt(0)" ::: "memory"); __builtin_amdgcn_s_barrier(); asm volatile("" ::: "memory");
        const int row = wid * 32 + (lane & 31);
        if (lane < 32) { const f32x4 p4 = *(PG8_LAS const f32x4*)(P + row * 4);
            __hip_atomic_store(xbuf + ((size_t)(u.pm * BM + row) * 8 + u.pn), (p4[0] + p4[1]) + (p4[2] + p4[3]), __ATOMIC_RELAXED, __HIP_MEMORY_SCOPE_AGENT); }
        asm volatile("s_waitcnt vmcnt(0)" ::: "memory");
        if (lane == 0) __hip_atomic_fetch_add(cnt + 64 * u.pm, 1u, __ATOMIC_RELAXED, __HIP_MEMORY_SCOPE_AGENT);
        if (wid == 0) { bool dead = false; const unsigned long long t0 = __builtin_amdgcn_s_memrealtime();
            for (;;) { if ((unsigned)__builtin_amdgcn_readfirstlane(__hip_atomic_load(cnt + 64 * u.pm, __ATOMIC_RELAXED, __HIP_MEMORY_SCOPE_AGENT)) >= 64u) break;
                if (__builtin_amdgcn_s_memrealtime() - t0 > 2000000ull) { dead = true; break; }
                __builtin_amdgcn_s_sleep(2); }
            __builtin_amdgcn_fence(__ATOMIC_ACQUIRE, "agent");
            if (lane == 0) flag[0] = dead ? 1u : 0u; }
        asm volatile("s_waitcnt vmcnt(0) lgkmcnt(0)" ::: "memory"); __builtin_amdgcn_s_barrier(); asm volatile("" ::: "memory");
        const bool bad = flag[0] != 0u;
        if (lane < 32) { const float* slot = xbuf + (size_t)(u.pm * BM + row) * 8; float q = 0.f;
#pragma unroll
            for (int t = 0; t < 8; ++t) q += __hip_atomic_load(slot + t, __ATOMIC_RELAXED, __HIP_MEMORY_SCOPE_AGENT);
            S[row] = rsqrtf(q * inv_n + eps); }
        asm volatile("s_waitcnt vmcnt(0) lgkmcnt(0)" ::: "memory"); __builtin_amdgcn_s_barrier(); asm volatile("" ::: "memory");
        const float qnan = __builtin_nanf("");
        f32x4 wv[2][2];
#pragma unroll
        for (int bj = 0; bj < 2; ++bj) { wv[bj][0] = *(const f32x4*)(wfin + col0 + bj * HALF); wv[bj][1] = *(const f32x4*)(wfin + col0 + bj * HALF + 4); }
#pragma unroll
        for (int ai = 0; ai < 2; ++ai)
#pragma unroll
            for (int m = 0; m < 4; ++m) { const int rl = ai * HALF + wr * 64 + m * 16 + fr; const float rs = bad ? qnan : S[rl]; float* op = out + (size_t)(u.pm * BM + rl) * ldc + col0;
#pragma unroll
                for (int bj = 0; bj < 2; ++bj) { __builtin_nontemporal_store(acc[ai][bj][m][0] * rs * wv[bj][0], (f32x4*)(op + bj * HALF)); __builtin_nontemporal_store(acc[ai][bj][m][1] * rs * wv[bj][1], (f32x4*)(op + bj * HALF + 4)); } }
    }
};
struct EpiSwiGLU {
    static constexpr bool PERM = true, AFTER_DRAIN = false; static constexpr int AUX_A = 0, AUX_B = 0;
    bf16_t* H; int ldh; const float* part; float inv_n, eps; PG8_LAS const float* rtab; int rtab_pm;
    __device__ __forceinline__ static float silu_mul(float g, float uu) { const float e = __builtin_amdgcn_exp2f(g * -1.4426950408889634f); return g * uu * __builtin_amdgcn_rcpf(1.f + e); }
    __device__ __forceinline__ void operator()(const f32x4 (&acc)[2][2][4][2], const Unit& u, int wr, int wc, int fr, int fq) const {
        const int row0 = u.pm * BM + wr * 64 + fr, col0 = u.pn * HALF + wc * 32 + 8 * fq;
#pragma unroll
        for (int ai = 0; ai < 2; ++ai)
#pragma unroll
            for (int m = 0; m < 4; ++m) { const int r = row0 + ai * HALF + m * 16;
                float rstd;
                if (u.pm == rtab_pm) rstd = rtab[ai * HALF + wr * 64 + m * 16 + fr];
                else { const f32x4* pp = (const f32x4*)(part + (size_t)r * 32 + fq * 8); const f32x4 pa = pp[0], pb = pp[1];
                    float s = ((pa[0] + pa[1]) + (pa[2] + pa[3])) + ((pb[0] + pb[1]) + (pb[2] + pb[3]));
                    s += __shfl_xor(s, 16); s += __shfl_xor(s, 32);
                    rstd = rsqrtf(s * inv_n + eps); }
                const f32x4 g0 = acc[ai][0][m][0] * rstd, g1 = acc[ai][0][m][1] * rstd, u0 = acc[ai][1][m][0] * rstd, u1 = acc[ai][1][m][1] * rstd;
                u32x4 w; w.x = cvt_pk_bf16(silu_mul(g0[0], u0[0]), silu_mul(g0[1], u0[1])); w.y = cvt_pk_bf16(silu_mul(g0[2], u0[2]), silu_mul(g0[3], u0[3]));
                w.z = cvt_pk_bf16(silu_mul(g1[0], u1[0]), silu_mul(g1[1], u1[1])); w.w = cvt_pk_bf16(silu_mul(g1[2], u1[2]), silu_mul(g1[3], u1[3]));
                if (EPI_NT_H) __builtin_nontemporal_store(w, (u32x4*)(H + (size_t)r * ldh + col0)); else *(u32x4*)(H + (size_t)r * ldh + col0) = w; }
    }
};
template <class Epi, class Sched, bool ALIGN_EPI = false, bool SP2 = false>
__device__ __forceinline__ void gemm_phase(PG8_LAS unsigned char* lds, const Gemm g, const Sched& S, const Epi& E) {
    const int tid = threadIdx.x, wid = __builtin_amdgcn_readfirstlane(tid >> 6), lane = tid & 63, wr = wid >> 2, wc = wid & 3, fr = lane & 15, fq = lane >> 4;
    const int K = g.K, nt = K / BK;
    constexpr int AUXA = Epi::AUX_A, AUXB = Epi::AUX_B;
    unsigned voffA[2], voffB[2];
#pragma unroll
    for (int i = 0; i < 2; ++i) { int R, C; stage_rc(tid * 16 + i * 8192, R, C); const int Rb = Epi::PERM ? ((R & ~31) + perm32(R & 31)) : R;
        voffA[i] = (unsigned)(R * K + C) * 2u; voffB[i] = (unsigned)(Rb * K + C) * 2u; }
    const size_t kstep = (size_t)(BK * 2);
    const size_t hstep = (size_t)HALF * K * 2;
    const size_t tstep = 2 * hstep;
    const unsigned ldsw = (unsigned)wid * 1024u;
    const int aoff = lds_byte(wr * 64 + fr, fq * 8), boff = lds_byte(wc * 32 + fr, fq * 8);
#define PG8_SA(b, h) (((b) * 2 + (h)) * HTB)
#define PG8_SB(b, h) ((4 + (b) * 2 + (h)) * HTB)
#define PG8_STAGE_X(bufoff, gbase, voff, aux_) do { _Pragma("unroll") for (int _i = 0; _i < 2; ++_i) \
        __builtin_amdgcn_global_load_lds((const unsigned*)((const char*)(gbase) + (voff)[_i]), (PG8_LAS unsigned*)(lds + (bufoff) + ldsw + _i * 8192), 16, 0, aux_); } while (0)
#define PG8_LDA(dst, b, h) do { _Pragma("unroll") for (int m = 0; m < 4; ++m) _Pragma("unroll") for (int k = 0; k < 2; ++k) dst[m][k] = *(const PG8_LAS bf16x8*)(lds + PG8_SA(b, h) + aoff + m * 2048 + k * 1024); } while (0)
#define PG8_LDB(dst, b, h) do { _Pragma("unroll") for (int n = 0; n < 2; ++n) _Pragma("unroll") for (int k = 0; k < 2; ++k) dst[n][k] = *(const PG8_LAS bf16x8*)(lds + PG8_SB(b, h) + boff + n * 2048 + k * 1024); } while (0)
#define PG8_MMA(ai, bj, At, Bt) do { __builtin_amdgcn_s_setprio(1); _Pragma("unroll") for (int m = 0; m < 4; ++m) _Pragma("unroll") for (int n = 0; n < 2; ++n) _Pragma("unroll") for (int k = 0; k < 2; ++k) \
        acc[ai][bj][m][n] = __builtin_amdgcn_mfma_f32_16x16x32_bf16(Bt[n][k], At[m][k], acc[ai][bj][m][n], 0, 0, 0); __builtin_amdgcn_s_setprio(0); } while (0)
#define PG8_WAIT_V(n) asm volatile("s_waitcnt vmcnt(" #n ")" ::: "memory")
#define PG8_WAIT_L(n) asm volatile("s_waitcnt lgkmcnt(" #n ")" ::: "memory")
#define PG8_BAR __builtin_amdgcn_s_barrier()
#define PG8_SCHED __builtin_amdgcn_sched_barrier(0)
    Unit cur, nxt; int ui = 0;
    if (!S.next(0, cur)) return;
    f32x4 acc[2][2][4][2];
#pragma unroll
    for (int a = 0; a < 2; ++a)
#pragma unroll
        for (int b = 0; b < 2; ++b)
#pragma unroll
            for (int m = 0; m < 4; ++m)
#pragma unroll
                for (int n = 0; n < 2; ++n) acc[a][b][m][n] = (f32x4){0.f, 0.f, 0.f, 0.f};
    bf16x8 At[4][2], B0[2][2], B1[2][2];
    const char* cA = (const char*)g.A + (size_t)cur.pm * tstep; const char* cB = (const char*)g.Bt + (size_t)cur.pn * tstep;
    S.a_ready(cur);
    if constexpr (SP2) {
        PG8_STAGE_X(PG8_SB(0, 0), cB, voffB, AUXB); PG8_STAGE_X(PG8_SB(0, 1), cB + hstep, voffB, AUXB); PG8_STAGE_X(PG8_SA(0, 0), cA, voffA, AUXA); PG8_STAGE_X(PG8_SA(0, 1), cA + hstep, voffA, AUXA);
        if (wr == 1) PG8_BAR;
        PG8_WAIT_V(2); PG8_BAR;
        PG8_STAGE_X(PG8_SB(1, 0), cB + kstep, voffB, AUXB); PG8_STAGE_X(PG8_SA(1, 0), cA + kstep, voffA, AUXA); PG8_STAGE_X(PG8_SB(1, 1), cB + hstep + kstep, voffB, AUXB);
        PG8_WAIT_V(6); PG8_BAR;
    } else {
        PG8_STAGE_X(PG8_SB(0, 0), cB, voffB, AUXB); PG8_STAGE_X(PG8_SA(0, 0), cA, voffA, AUXA); PG8_STAGE_X(PG8_SB(0, 1), cB + hstep, voffB, AUXB); PG8_STAGE_X(PG8_SA(0, 1), cA + hstep, voffA, AUXA);
        if (wr == 1) PG8_BAR;
        PG8_WAIT_V(4); PG8_BAR;
        PG8_STAGE_X(PG8_SB(1, 0), cB + kstep, voffB, AUXB); PG8_STAGE_X(PG8_SA(1, 0), cA + kstep, voffA, AUXA); PG8_STAGE_X(PG8_SB(1, 1), cB + hstep + kstep, voffB, AUXB);
        PG8_WAIT_V(6); PG8_BAR;
    }
    for (;;) {
        const bool has_next = S.next(ui + 1, nxt);
        const char* nA = has_next ? (const char*)g.A + (size_t)nxt.pm * tstep : cA; const char* nB = has_next ? (const char*)g.Bt + (size_t)nxt.pn * tstep : cB;
        for (int t = 0; t < nt; t += 2) {
            const bool last = (t == nt - 2);
            const char* a1 = cA + (size_t)(t + 1) * kstep;
            const char* a2 = last ? nA : cA + (size_t)(t + 2) * kstep; const char* b2 = last ? nB : cB + (size_t)(t + 2) * kstep;
            const char* a3 = a2 + kstep; const char* b3 = b2 + kstep;
            if (last && has_next) S.a_ready(nxt);
            if constexpr (SP2) {
            PG8_LDB(B0, 0, 0); PG8_LDB(B1, 0, 1); PG8_SCHED; PG8_LDA(At, 0, 0); PG8_STAGE_X(PG8_SA(1, 1), a1 + hstep, voffA, AUXA);
            PG8_WAIT_V(8); PG8_WAIT_L(0); PG8_BAR; PG8_MMA(0, 0, At, B0); PG8_MMA(0, 1, At, B1); PG8_BAR; PG8_SCHED;
            PG8_LDA(At, 0, 1); PG8_STAGE_X(PG8_SB(0, 0), b2, voffB, AUXB); PG8_STAGE_X(PG8_SB(0, 1), b2 + hstep, voffB, AUXB); PG8_STAGE_X(PG8_SA(0, 0), a2, voffA, AUXA);
            PG8_WAIT_V(8); PG8_WAIT_L(0); PG8_BAR; PG8_MMA(1, 0, At, B0); PG8_MMA(1, 1, At, B1); PG8_BAR; PG8_SCHED;
            PG8_LDB(B0, 1, 0); PG8_LDB(B1, 1, 1); PG8_SCHED; PG8_LDA(At, 1, 0); PG8_STAGE_X(PG8_SA(0, 1), a2 + hstep, voffA, AUXA);
            PG8_WAIT_V(8); PG8_WAIT_L(0); PG8_BAR; PG8_MMA(0, 0, At, B0); PG8_MMA(0, 1, At, B1); PG8_BAR; PG8_SCHED;
            PG8_LDA(At, 1, 1); PG8_STAGE_X(PG8_SB(1, 0), b3, voffB, AUXB); PG8_STAGE_X(PG8_SB(1, 1), b3 + hstep, voffB, AUXB); PG8_STAGE_X(PG8_SA(1, 0), a3, voffA, AUXA);
            PG8_WAIT_V(8); PG8_WAIT_L(0); PG8_BAR; PG8_MMA(1, 0, At, B0); PG8_MMA(1, 1, At, B1); PG8_BAR; PG8_SCHED;
            } else {
            PG8_LDB(B0, 0, 0); PG8_SCHED; PG8_LDA(At, 0, 0); PG8_STAGE_X(PG8_SA(1, 1), a1 + hstep, voffA, AUXA);
            PG8_WAIT_L(8); PG8_BAR; PG8_WAIT_L(0); PG8_MMA(0, 0, At, B0); PG8_BAR; PG8_SCHED;
            PG8_LDB(B1, 0, 1); PG8_STAGE_X(PG8_SB(0, 0), b2, voffB, AUXB);
            PG8_BAR; PG8_WAIT_L(0); PG8_MMA(0, 1, At, B1); PG8_BAR;
            PG8_LDA(At, 0, 1); PG8_STAGE_X(PG8_SA(0, 0), a2, voffA, AUXA);
            PG8_BAR; PG8_WAIT_L(0); PG8_MMA(1, 0, At, B0); PG8_BAR; PG8_SCHED;
            PG8_STAGE_X(PG8_SB(0, 1), b2 + hstep, voffB, AUXB);
            PG8_WAIT_V(6); PG8_BAR; PG8_MMA(1, 1, At, B1); PG8_BAR;
            PG8_LDB(B0, 1, 0); PG8_SCHED; PG8_LDA(At, 1, 0); PG8_STAGE_X(PG8_SA(0, 1), a2 + hstep, voffA, AUXA);
            PG8_WAIT_L(8); PG8_BAR; PG8_WAIT_L(0); PG8_MMA(0, 0, At, B0); PG8_BAR; PG8_SCHED;
            PG8_LDB(B1, 1, 1); PG8_STAGE_X(PG8_SB(1, 0), b3, voffB, AUXB);
            PG8_BAR; PG8_WAIT_L(0); PG8_MMA(0, 1, At, B1); PG8_BAR;
            PG8_LDA(At, 1, 1); PG8_STAGE_X(PG8_SA(1, 0), a3, voffA, AUXA);
            PG8_BAR; PG8_WAIT_L(0); PG8_MMA(1, 0, At, B0); PG8_BAR; PG8_SCHED;
            PG8_STAGE_X(PG8_SB(1, 1), b3 + hstep, voffB, AUXB);
            PG8_WAIT_V(6); PG8_BAR; PG8_MMA(1, 1, At, B1); PG8_BAR;
            }
        }
        if constexpr (ALIGN_EPI) { if (wr == 0) PG8_BAR; }
        if constexpr (!Epi::AFTER_DRAIN) { E(acc, cur, wr, wc, fr, fq); S.done(cur); }
        if (!has_next) break;
#pragma unroll
        for (int a = 0; a < 2; ++a)
#pragma unroll
            for (int b = 0; b < 2; ++b)
#pragma unroll
                for (int m = 0; m < 4; ++m)
#pragma unroll
                    for (int n = 0; n < 2; ++n) acc[a][b][m][n] = (f32x4){0.f, 0.f, 0.f, 0.f};
        cur = nxt; cA = nA; cB = nB; ++ui;
        if constexpr (ALIGN_EPI) { if (wr == 1) PG8_BAR; }
    }
    PG8_WAIT_V(0);
    if constexpr (!ALIGN_EPI) { if (wr == 0) PG8_BAR; }
    PG8_BAR;
    if constexpr (Epi::AFTER_DRAIN) { E.fused(acc, cur, wr, wc, fr, fq, lds, wid, lane); S.done(cur); }
#undef PG8_SA
#undef PG8_SB
#undef PG8_STAGE_X
#undef PG8_LDA
#undef PG8_LDB
#undef PG8_MMA
#undef PG8_WAIT_V
#undef PG8_WAIT_L
#undef PG8_BAR
#undef PG8_SCHED
}
}
namespace att {
#ifndef ATT_NT_OUT
#define ATT_NT_OUT 0
#endif
#define ATT_LAS __attribute__((address_space(3)))
typedef unsigned short bf16_t;
typedef short bf16x8 __attribute__((ext_vector_type(8)));
typedef short s16x4 __attribute__((ext_vector_type(4)));
typedef float f32x16 __attribute__((ext_vector_type(16)));
typedef float f32x4 __attribute__((ext_vector_type(4)));
typedef unsigned u32x4 __attribute__((ext_vector_type(4)));
typedef unsigned u32x2 __attribute__((ext_vector_type(2)));
constexpr int SEQ = 2048, PITCH = 4608, OPITCH = 2048;
__device__ __forceinline__ unsigned cvtpk(float lo, float hi) { typedef float f2_t __attribute__((ext_vector_type(2))); typedef __bf16 b2_t __attribute__((ext_vector_type(2))); f2_t v = {lo, hi}; b2_t b = __builtin_convertvector(v, b2_t); return __builtin_bit_cast(unsigned, b); }
__device__ __forceinline__ float swapmax(float m) { auto rr = __builtin_amdgcn_permlane32_swap(__float_as_uint(m), __float_as_uint(m), false, false); return fmaxf(__uint_as_float(rr[0]), __uint_as_float(rr[1])); }
__device__ __forceinline__ float swapsum(float m) { auto rr = __builtin_amdgcn_permlane32_swap(__float_as_uint(m), __float_as_uint(m), false, false); return __uint_as_float(rr[0]) + __uint_as_float(rr[1]); }
__device__ __forceinline__ s16x4 vtr(ATT_LAS const char* p) { return __builtin_bit_cast(s16x4, __builtin_amdgcn_ds_read_tr16_b64_v4i16((ATT_LAS s16x4*)p)); }

struct UnitP {
    int b, q0;
    int qcol, kcol, vcol;
    int kofs;
    float slope2;
    float m_init, l_init;
    int T0, T1;
    int tlo, thi;
    int window;
    int maskall;
    int ocol;
};

template <int DV, int KW>
__device__ __forceinline__ void attn_unit(ATT_LAS char* lds, const bf16_t* __restrict__ P, bf16_t* __restrict__ MIX, const UnitP up, bool diff, float lam, const float* __restrict__ subln_w, int tid,
                                          bool prefetched  , bool has_next, int nb, int nkcol, int nvcol, int nT0, int nT1  ) {
    static_assert(KW == DV && (KW == 128 || KW == 64), "tile geometry");
    constexpr int ROWB = KW * 2, CPR = ROWB / 16, RPP = 1024 / ROWB, NP = 64 / RPP / 8, TILEB = 64 * ROWB, STG = 2 * TILEB, NSTG = 4, NEB = DV / 32, NI = 2 * NP;
    constexpr bool WIDE = (KW == 128);
    const int lane = tid & 63, wid = __builtin_amdgcn_readfirstlane(tid >> 6), r32 = lane & 31, hi = lane >> 5, wq = wid & 3, g = wid >> 2;
    const int qw = up.q0 + 32 * wq, q = qw + r32;
    const size_t rowbase = (size_t)up.b * SEQ;
    __syncthreads();
    unsigned kso[NP], vso[NP];
#pragma unroll
    for (int i = 0; i < NP; ++i) { const int piece = wid + 8 * i, row = RPP * piece + lane / CPR, slot = lane % CPR;
        const int kch = WIDE ? (slot ^ (row & 15)) : (slot ^ ((row >> 1) & 7));
        const int vch = ((((slot >> 2) ^ (WIDE ? (row & 3) : ((row >> 1) & 1))) << 2) | (slot & 3));
        kso[i] = (unsigned)(row * PITCH + up.kcol + kch * 8); vso[i] = (unsigned)(row * PITCH + up.vcol + vch * 8); }
    const bf16_t* Pb = P + rowbase * PITCH;
#define ATT_DMA2(pb_, dk_, dv_, t, sg) do { const bf16_t* tb_ = (pb_) + (size_t)(t) * 64 * PITCH; \
    _Pragma("unroll") for (int i_ = 0; i_ < NP; ++i_) { \
        __builtin_amdgcn_global_load_lds((const unsigned*)(tb_ + (kso[i_] + (dk_))), (ATT_LAS unsigned*)(lds + (sg) * STG + (wid + 8 * i_) * 1024), 16, 0, 0); \
        __builtin_amdgcn_global_load_lds((const unsigned*)(tb_ + (vso[i_] + (dv_))), (ATT_LAS unsigned*)(lds + (sg) * STG + TILEB + (wid + 8 * i_) * 1024), 16, 0, 0); } } while (0)
#define ATT_DMA(t, sg) ATT_DMA2(Pb, 0u, 0u, t, sg)
    const int rot = prefetched ? 2 : 0;
    bf16x8 qr[4];
    { const bf16_t* qp = P + (rowbase + q) * PITCH + up.qcol + hi * 8;
#pragma unroll
      for (int d0 = 0; d0 < 4; ++d0) qr[d0] = *(const bf16x8*)(qp + d0 * 16); }
    if (!prefetched) {
#pragma unroll
        for (int j = 0; j < 2; ++j) if (up.T0 + j <= up.T1) ATT_DMA(up.T0 + j, j); }
    f32x16 o[NEB];
#pragma unroll
    for (int e = 0; e < NEB; ++e)
#pragma unroll
        for (int r = 0; r < 16; ++r) o[e][r] = 0.f;
    float mhat = up.l_init != 0.f ? up.m_init + up.slope2 * (float)q : 0.f, l = hi == 0 ? up.l_init : 0.f;
    float cb[16];
#pragma unroll
    for (int r = 0; r < 16; ++r) cb[r] = up.slope2 * (float)((r & 3) + 8 * (r >> 2));
    int kad[4];
#pragma unroll
    for (int d0 = 0; d0 < 4; ++d0) { const int c = (up.kofs >> 4) + 2 * d0 + hi; kad[d0] = r32 * ROWB + ((WIDE ? (c ^ (r32 & 15)) : (c ^ ((r32 >> 1) & 7))) << 4); }
    const int i16 = lane & 15, q4 = i16 >> 2, vsw = WIDE ? q4 : (q4 >> 1);
    const int vlane = TILEB + (4 * hi + q4) * ROWB + 32 * ((lane >> 4) & 1) + 8 * (i16 & 3);
    int vad[NEB];
#pragma unroll
    for (int e = 0; e < NEB; ++e) vad[e] = vlane + ((e ^ vsw) << 6);
    bf16x8 pa[4];
#define ATT_PV(sgi) do { ATT_LAS const char* Sv_ = lds + (sgi) * STG; __builtin_amdgcn_s_setprio(1); \
    _Pragma("unroll") for (int e = 0; e < NEB; ++e) _Pragma("unroll") for (int ks = 0; ks < 4; ++ks) { \
        const s16x4 lo = vtr(Sv_ + vad[e] + ks * 16 * ROWB), hh = vtr(Sv_ + vad[e] + ks * 16 * ROWB + 8 * ROWB); \
        const bf16x8 vf = {lo[0], lo[1], lo[2], lo[3], hh[0], hh[1], hh[2], hh[3]}; \
        o[e] = __builtin_amdgcn_mfma_f32_32x32x16_bf16(vf, pa[ks], o[e], 0, 0, 0); } __builtin_amdgcn_s_setprio(0); } while (0)
    for (int t = up.T0; t <= up.T1 + 1; ++t) {
        const int sg = (t - up.T0 + rot) & (NSTG - 1);
        if (t + 1 <= up.T1) { if (NI == 4) asm volatile("s_waitcnt vmcnt(4) lgkmcnt(0)" ::: "memory"); else asm volatile("s_waitcnt vmcnt(2) lgkmcnt(0)" ::: "memory"); }
        else asm volatile("s_waitcnt vmcnt(0) lgkmcnt(0)" ::: "memory");
        __builtin_amdgcn_s_barrier();
        asm volatile("" ::: "memory");
        if (t + 2 <= up.T1) ATT_DMA(t + 2, (sg + 2) & (NSTG - 1));
        if (g == 1 && t - 1 >= up.tlo && t - 1 <= up.thi && t - 1 >= up.T0) ATT_PV((sg + NSTG - 1) & (NSTG - 1));
        if (t >= up.tlo && t <= up.thi && t <= up.T1) {
            ATT_LAS const char* Sb = lds + sg * STG;
            f32x16 p0, p1;
            { const float base0 = up.slope2 * (float)(64 * t + 4 * hi) - mhat, base1 = base0 + 32.f * up.slope2;
#pragma unroll
              for (int r = 0; r < 16; ++r) { p0[r] = cb[r] + base0; p1[r] = cb[r] + base1; } }
            __builtin_amdgcn_s_setprio(1);
#pragma unroll
            for (int d0 = 0; d0 < 4; ++d0) {
                const bf16x8 k0 = *(ATT_LAS const bf16x8*)(Sb + kad[d0]), k1 = *(ATT_LAS const bf16x8*)(Sb + kad[d0] + 32 * ROWB);
                p0 = __builtin_amdgcn_mfma_f32_32x32x16_bf16(k0, qr[d0], p0, 0, 0, 0);
                p1 = __builtin_amdgcn_mfma_f32_32x32x16_bf16(k1, qr[d0], p1, 0, 0, 0);
            }
            __builtin_amdgcn_s_setprio(0);
            if (up.maskall || t == up.thi) {
                const int kvb = 64 * t + 4 * hi, qlo = q - up.window;
#pragma unroll
                for (int r = 0; r < 16; ++r) { const int kv = kvb + (r & 3) + 8 * (r >> 2);
                    if (kv > q || kv <= qlo) p0[r] = -INFINITY;
                    if (kv + 32 > q || kv + 32 <= qlo) p1[r] = -INFINITY; }
            }
            float ra = fmaxf(fmaxf(p0[0], p0[1]), p1[0]), rb = fmaxf(fmaxf(p0[2], p0[3]), p1[1]); ra = fmaxf(fmaxf(ra, p1[2]), p1[3]);
#pragma unroll
            for (int r = 4; r < 16; r += 4) { ra = fmaxf(fmaxf(ra, p0[r]), p0[r + 1]); rb = fmaxf(fmaxf(rb, p0[r + 2]), p0[r + 3]); ra = fmaxf(fmaxf(ra, p1[r]), p1[r + 1]); rb = fmaxf(fmaxf(rb, p1[r + 2]), p1[r + 3]); }
            const float rm = swapmax(fmaxf(ra, rb));
            if (__any(rm > 8.f)) {
                const float dl = fmaxf(rm, 0.f), alpha = __builtin_amdgcn_exp2f(-dl);
                mhat += dl; l *= alpha;
#pragma unroll
                for (int r = 0; r < 16; ++r) { p0[r] -= dl; p1[r] -= dl; }
#pragma unroll
                for (int e = 0; e < NEB; ++e)
#pragma unroll
                    for (int r = 0; r < 16; ++r) o[e][r] *= alpha;
            }
            float ps = 0.f;
#pragma unroll
            for (int r = 0; r < 16; ++r) { p0[r] = __builtin_amdgcn_exp2f(p0[r]); p1[r] = __builtin_amdgcn_exp2f(p1[r]); ps += p0[r] + p1[r]; }
            l += ps;
#pragma unroll
            for (int s = 0; s < 2; ++s) {
                u32x4 w0, w1;
                w0.x = cvtpk(p0[8 * s + 0], p0[8 * s + 1]); w0.y = cvtpk(p0[8 * s + 2], p0[8 * s + 3]); w0.z = cvtpk(p0[8 * s + 4], p0[8 * s + 5]); w0.w = cvtpk(p0[8 * s + 6], p0[8 * s + 7]);
                w1.x = cvtpk(p1[8 * s + 0], p1[8 * s + 1]); w1.y = cvtpk(p1[8 * s + 2], p1[8 * s + 3]); w1.z = cvtpk(p1[8 * s + 4], p1[8 * s + 5]); w1.w = cvtpk(p1[8 * s + 6], p1[8 * s + 7]);
                pa[s] = __builtin_bit_cast(bf16x8, w0); pa[2 + s] = __builtin_bit_cast(bf16x8, w1);
            }
            if (g == 0) ATT_PV(sg);
        }
    }
#undef ATT_PV
    asm volatile("s_waitcnt vmcnt(0) lgkmcnt(0)" ::: "memory");
    __builtin_amdgcn_s_barrier();
    asm volatile("" ::: "memory");
    if (has_next) {
        const bf16_t* Pn = P + (size_t)nb * SEQ * PITCH; const unsigned dk = (unsigned)(nkcol - up.kcol), dv = (unsigned)(nvcol - up.vcol);
#pragma unroll
        for (int j = 0; j < 2; ++j) if (nT0 + j <= nT1) ATT_DMA2(Pn, dk, dv, nT0 + j, 2 + j);
    }
#undef ATT_DMA
#undef ATT_DMA2
    const float lt = swapsum(l), inv = 1.f / lt;
    constexpr int ORS = DV * 2 + 16, OCH = DV / 8, ORPI = 64 / OCH  ;
    if (!diff) {
        ATT_LAS char* ot = lds + 4 * STG + wid * (32 * ORS);
#pragma unroll
        for (int e = 0; e < NEB; ++e)
#pragma unroll
            for (int r4 = 0; r4 < 4; ++r4) { u32x2 w; w.x = cvtpk(o[e][4 * r4] * inv, o[e][4 * r4 + 1] * inv); w.y = cvtpk(o[e][4 * r4 + 2] * inv, o[e][4 * r4 + 3] * inv);
                *(ATT_LAS u32x2*)(ot + r32 * ORS + (e * 32 + 8 * r4 + 4 * hi) * 2) = w; }
        bf16_t* ob = MIX + (rowbase + qw) * OPITCH + up.ocol;
#pragma unroll
        for (int j = 0; j < 32 / ORPI; ++j) { const int row = j * ORPI + lane / OCH, ch = lane % OCH; const u32x4 v = *(ATT_LAS const u32x4*)(ot + row * ORS + ch * 16); *(u32x4*)(ob + (size_t)row * OPITCH + ch * 8) = v; }
    } else {
        ATT_LAS float* xb = (ATT_LAS float*)(lds + wq * (NEB * 16 * 64 * 4)) + lane;
        if (g == 1) { const float sc = lam * inv;
#pragma unroll
            for (int e = 0; e < NEB; ++e)
#pragma unroll
                for (int r = 0; r < 16; ++r) xb[(e * 16 + r) * 64] = o[e][r] * sc; }
        __syncthreads();
        if (g == 0) { float ss = 0.f;
#pragma unroll
            for (int e = 0; e < NEB; ++e)
#pragma unroll
                for (int r = 0; r < 16; ++r) { const float d = o[e][r] * inv - xb[(e * 16 + r) * 64]; o[e][r] = d; ss += d * d; }
            ss = swapsum(ss);
            const float rs = rsqrtf(ss * (1.f / DV) + 1e-5f) * 0.8f;
            ATT_LAS char* ot = lds + wq * (NEB * 16 * 64 * 4);
            asm volatile("s_waitcnt lgkmcnt(0)" ::: "memory");
#pragma unroll
            for (int e = 0; e < NEB; ++e)
#pragma unroll
                for (int r4 = 0; r4 < 4; ++r4) { const f32x4 wv = *(const f32x4*)(subln_w + e * 32 + 8 * r4 + 4 * hi);
                    u32x2 w; w.x = cvtpk(o[e][4 * r4] * rs * wv[0], o[e][4 * r4 + 1] * rs * wv[1]); w.y = cvtpk(o[e][4 * r4 + 2] * rs * wv[2], o[e][4 * r4 + 3] * rs * wv[3]);
                    *(ATT_LAS u32x2*)(ot + r32 * ORS + (e * 32 + 8 * r4 + 4 * hi) * 2) = w; }
            bf16_t* ob = MIX + (rowbase + qw) * OPITCH + up.ocol;
#pragma unroll
            for (int j = 0; j < 32 / ORPI; ++j) { const int row = j * ORPI + lane / OCH, ch = lane % OCH; const u32x4 v = *(ATT_LAS const u32x4*)(ot + row * ORS + ch * 16); *(u32x4*)(ob + (size_t)row * OPITCH + ch * 8) = v; } }
    }
}
}
constexpr int NWAVES = 8;
#ifndef CV_ROT
#define CV_ROT 0
#endif
#ifndef CV_NTS
#define CV_NTS false
#endif
#ifndef P4_ALIGN
#define P4_ALIGN true
#endif
#ifndef WGM_P1
#define WGM_P1 4
#endif
#ifndef WGM_P3
#define WGM_P3 4
#endif
#ifndef WGM_P4
#define WGM_P4 8
#endif
#ifndef WGM_P5
#define WGM_P5 4
#endif
#ifndef FUSE_FINAL
#define FUSE_FINAL 0
#endif
#ifndef GEMM_SP2
#define GEMM_SP2 true
#endif
#ifndef MK_N_LAUNCHES
#define MK_N_LAUNCHES 1
#endif
constexpr int N_PHASES = 7;
constexpr int BATCH = 8, SEQ = 2048, D = 2048, M = BATCH * SEQ, INC = 4608, DFF = 5632, NGU = 2 * DFF;
constexpr float RMS_EPS = 1e-5f;
constexpr float QSCALE2 = 0.125f * 1.4426950408889634f;
constexpr size_t MiB = 1u << 20;
constexpr size_t WS_PART1 = 1 * MiB, WS_PART2 = 3 * MiB;
constexpr size_t WS_WIN = 8 * MiB, WS_WOUT = 26 * MiB, WS_WGU = 34 * MiB, WS_WDN = 78 * MiB;
constexpr size_t WS_XN = 100 * MiB;
constexpr size_t WS_PROJ = 164 * MiB, WS_MIX = 308 * MiB;
constexpr size_t WS_H = 164 * MiB;
constexpr size_t WS_END = 372 * MiB;
static_assert(WS_H + (size_t)M * DFF * 2 <= WS_END && WS_MIX + (size_t)M * D * 2 <= WS_END && WS_PROJ + (size_t)M * INC * 2 <= WS_MIX, "ws map");
constexpr int RING_BYTES = 131072, LDS_BYTES = 147456;

#define LAS __attribute__((address_space(3)))
typedef unsigned short bf16;
typedef unsigned v4u __attribute__((ext_vector_type(4)));
typedef float f32x4 __attribute__((ext_vector_type(4)));
__device__ __forceinline__ unsigned pk2(float lo, float hi) { return pg8::cvt_pk_bf16(lo, hi); }
__device__ __forceinline__ float wave_sum(float v) {
#pragma unroll
    for (int o = 1; o < 64; o <<= 1) v += __shfl_xor(v, o);
    return v;
}
template <int NB> __device__ __forceinline__ void transpose_item(const float* __restrict__ W, int K, int N, bf16* __restrict__ WT, int dst_row0, const float* __restrict__ kscale, float cscale, LAS float* scr, int k0, int n0, int lane, bool nts = false) {
    const float* src = W + (size_t)(k0 + (lane >> 4)) * N + n0 + 4 * (lane & 15);
#pragma unroll
    for (int b = 0; b < 16 / NB; ++b) {
        f32x4 v[NB];
#pragma unroll
        for (int i = 0; i < NB; ++i) v[i] = __builtin_nontemporal_load((const f32x4*)(src + (size_t)(4 * (b * NB + i)) * N));
#pragma unroll
        for (int i = 0; i < NB; ++i) { const int kk = 4 * (b * NB + i) + (lane >> 4); float sc = cscale; if (kscale) sc *= kscale[k0 + kk];
            LAS float* d = scr + kk * 65 + 4 * (lane & 15); d[0] = v[i].x * sc; d[1] = v[i].y * sc; d[2] = v[i].z * sc; d[3] = v[i].w * sc; }
        if (NB < 16) asm volatile("" ::: "memory");
    }
    asm volatile("s_waitcnt lgkmcnt(0)" ::: "memory");
    const int c = lane & 7;
#pragma unroll
    for (int j = 0; j < 8; ++j) { const int n = (lane >> 3) + 8 * j; const LAS float* s = scr + (8 * c) * 65 + n;
        v4u o; o.x = pk2(s[0 * 65], s[1 * 65]); o.y = pk2(s[2 * 65], s[3 * 65]); o.z = pk2(s[4 * 65], s[5 * 65]); o.w = pk2(s[6 * 65], s[7 * 65]);
        v4u* dp = (v4u*)(WT + (size_t)(dst_row0 + n) * K + k0 + 8 * c); if (nts) __builtin_nontemporal_store(o, dp); else *dp = o; }
    asm volatile("s_waitcnt lgkmcnt(0)" ::: "memory");
}

#define XB_TMO      128
#define XB_XCNT(j)  (256  + 64 * (j))
#define XB_XSUB(j)  (1280 + 64 * (j))
#define XB_XGEN(j)  (2304 + 64 * (j))
#define XB_TOP      3328
#define XB_TOPGEN   3392
#define XCD_BAR_WORDS 3456
#define XB_SPIN_CAP (1u << 18)

__device__ __forceinline__ unsigned xb_ld(unsigned* p)              { return __hip_atomic_load(p, __ATOMIC_RELAXED, __HIP_MEMORY_SCOPE_AGENT); }
__device__ __forceinline__ unsigned xb_add(unsigned* p, unsigned v) { return __hip_atomic_fetch_add(p, v, __ATOMIC_RELAXED, __HIP_MEMORY_SCOPE_AGENT); }
__device__ __forceinline__ unsigned xb_xcc_id() { return (unsigned)__builtin_amdgcn_s_getreg((3 << 11) | 20) & 0xFu; }
#define XB_SPIN(cond, bar) do { unsigned _sp = 0; while (cond) { __builtin_amdgcn_s_sleep(1); \
    if ((++_sp & 255u) == 0u) { if (xb_ld(&(bar)[XB_TMO])) break; if (_sp > XB_SPIN_CAP) { atomicAdd(&(bar)[XB_TMO], 1u); break; } } } } while (0)

struct XcdBarrier {
    unsigned* bar; unsigned x;
    volatile LAS unsigned* st;
};

__device__ __forceinline__ XcdBarrier xcd_barrier_post(unsigned* bar, volatile LAS unsigned* st) {
    XcdBarrier b; b.bar = bar; b.x = xb_xcc_id(); b.st = st;
    if (threadIdx.x == 0) (void)xb_add(&bar[XB_XCNT(b.x)], 1u);
    return b;
}
__device__ __forceinline__ void xcd_barrier_complete(unsigned* bar, unsigned x, unsigned& nloc, unsigned& nx) {
    const unsigned G = gridDim.x * gridDim.y * gridDim.z;
    unsigned sum, cnt, mine, sp = 0u;
    for (;;) {
        sum = 0u; cnt = 0u; mine = 0u;
#pragma unroll
        for (unsigned j = 0; j < 16; ++j) { const unsigned c = xb_ld(&bar[XB_XCNT(j)]); sum += c; cnt += (c > 0u) ? 1u : 0u; mine = (j == x) ? c : mine; }
        if (sum == G) break;
        __builtin_amdgcn_s_sleep(1);
        if ((++sp & 255u) == 0u) { if (xb_ld(&bar[XB_TMO])) break; if (sp > XB_SPIN_CAP) { atomicAdd(&bar[XB_TMO], 1u); break; } }
    }
    nloc = mine > 0u ? mine : 1u; nx = cnt > 0u ? cnt : 1u;
}

__device__ __forceinline__ void xcd_barrier(const XcdBarrier& b) {
    asm volatile("s_waitcnt vmcnt(0)" ::: "memory");
    __syncthreads();
    if (threadIdx.x == 0) {
        unsigned* bar = b.bar;
        __builtin_amdgcn_s_waitcnt(0);
        unsigned nloc = b.st[0], nx = b.st[1];
        if (nloc == 0u) { xcd_barrier_complete(bar, b.x, nloc, nx); b.st[0] = nloc; b.st[1] = nx; }
        const unsigned old = xb_add(&bar[XB_XSUB(b.x)], 1u);
        const unsigned gen = old / nloc;
        if (old + 1u == (gen + 1u) * nloc) {
            __builtin_amdgcn_fence(__ATOMIC_RELEASE, "agent");
            asm volatile("s_waitcnt vmcnt(0)" ::: "memory");
            const unsigned og = xb_add(&bar[XB_TOP], 1u);
            const unsigned tg = og / nx;
            if (og + 1u == (tg + 1u) * nx) xb_add(&bar[XB_TOPGEN], 1u);
            else XB_SPIN(xb_ld(&bar[XB_TOPGEN]) == tg, bar);
            __builtin_amdgcn_fence(__ATOMIC_ACQUIRE, "agent");
            xb_add(&bar[XB_XGEN(b.x)], 1u);
            asm volatile("s_waitcnt vmcnt(0)" ::: "memory");
        } else {
            XB_SPIN(xb_ld(&bar[XB_XGEN(b.x)]) == gen, bar);
            __builtin_amdgcn_fence(__ATOMIC_ACQUIRE, "agent");
            asm volatile("s_waitcnt vmcnt(0)" ::: "memory");
        }
    }
    __syncthreads();
}

struct PrefetchOrder {
    pg8::StaticOrder S; const char* base; unsigned row_bytes, tile_bytes; LAS unsigned char* dump;
    __device__ __forceinline__ bool next(int i, pg8::Unit& u) const { return S.next(i, u); }
    __device__ __forceinline__ void done(const pg8::Unit&) const {}
    __device__ __forceinline__ void a_ready(const pg8::Unit& u) const {
        const int tid = threadIdx.x, wid = __builtin_amdgcn_readfirstlane(tid >> 6); const unsigned lpr = tile_bytes >> 7, nline = 256u * lpr;
        const char* tb = base + (size_t)u.pm * 256 * row_bytes + (size_t)u.pn * tile_bytes;
        for (unsigned line = tid; line < nline; line += 512) { const unsigned r = line / lpr, l = line % lpr;
            __builtin_amdgcn_global_load_lds((const unsigned*)(tb + (size_t)r * row_bytes + l * 128), (LAS unsigned*)(dump + wid * 256), 4, 0, 0); }
    }
};
struct TwiceOrder { pg8::StaticOrder S; __device__ bool next(int i, pg8::Unit& u) const { return S.next(i >> 1, u); } __device__ __forceinline__ void a_ready(const pg8::Unit&) const {} __device__ __forceinline__ void done(const pg8::Unit&) const {} };
struct Args { const float* in[15]; float* out; unsigned char* ws; int ph_lo, ph_hi; };
enum { I_X = 0, I_ANW, I_WIN, I_LQ1, I_LK1, I_LQ2, I_LK2, I_SUBLN, I_SINKS, I_WOUT, I_FNW, I_WG, I_WU, I_WD, I_FINW };

__device__ __forceinline__ void item_kn(int r, int nblk_n, int& k0, int& n0) { const int g8 = r >> 3, w = r & 7, hn = nblk_n >> 1; n0 = 64 * (2 * (g8 % hn) + (w & 1)); k0 = 64 * (4 * (g8 / hn) + (w >> 1)); }
#ifndef CV_SPLIT
#define CV_SPLIT 0
#endif
#ifndef CV_SA
#define CV_SA 48
#endif
constexpr int CV_IN = (D / 64) * (INC / 64), CV_OUT = (D / 64) * (D / 64), CV_G = (D / 64) * (DFF / 64), CV_DN = (DFF / 64) * (D / 64), CV_ALL = CV_IN + CV_OUT + 2 * CV_G + CV_DN, CV_T0 = CV_IN + CV_OUT, CV_T1 = CV_T0 + CV_G;
template <int NB> __device__ __forceinline__ void convert_weights(const Args& args, unsigned char* ws, LAS float* scr, int first, int last, int skip0, int skip1, int widx, int nw, int lane) {
    bf16* Win_t = (bf16*)(ws + WS_WIN); bf16* Wout_t = (bf16*)(ws + WS_WOUT); bf16* Wgu_t = (bf16*)(ws + WS_WGU); bf16* Wdn_t = (bf16*)(ws + WS_WDN);
    for (int it = first + widx; it < last - (skip1 - skip0); it += nw) {
        int r = it; if (r >= skip0) r += skip1 - skip0;
        if (CV_ROT && first == 0 && last == CV_ALL) { r += CV_IN; if (r >= CV_ALL) r -= CV_ALL; }
        if (r < CV_IN) { int k0, n0; item_kn(r, INC / 64, k0, n0); const float cs = (n0 < 1024 || (n0 >= 3072 && n0 < 4096)) ? QSCALE2 : 1.f;
            transpose_item<NB>(args.in[I_WIN], D, INC, Win_t, n0, nullptr, cs, scr, k0, n0, lane); continue; } r -= CV_IN;
        if (r < CV_OUT) { int k0, n0; item_kn(r, D / 64, k0, n0); transpose_item<NB>(args.in[I_WOUT], D, D, Wout_t, n0, nullptr, 1.f, scr, k0, n0, lane, CV_NTS); continue; } r -= CV_OUT;
        if (r < 2 * CV_G) { const int up = r >= CV_G; if (up) r -= CV_G; int k0, n0; item_kn(r, DFF / 64, k0, n0);
            transpose_item<NB>(args.in[up ? I_WU : I_WG], D, DFF, Wgu_t, 256 * (n0 / 128) + 128 * up + (n0 % 128), args.in[I_FNW], 1.f, scr, k0, n0, lane, CV_NTS); continue; } r -= 2 * CV_G;
        { int k0, n0; item_kn(r, D / 64, k0, n0); transpose_item<NB>(args.in[I_WD], DFF, D, Wdn_t, n0, nullptr, 1.f, scr, k0, n0, lane, CV_NTS); }
    }
}

struct CvItem { const float* src; bf16* dst; const float* kscale; float cscale; int N, K; };
__device__ __forceinline__ bool cv_decode(const Args& args, unsigned char* ws, int r, int last, int lane, CvItem& it) {
    if (r >= last) return false;
    bf16* Win_t = (bf16*)(ws + WS_WIN); bf16* Wout_t = (bf16*)(ws + WS_WOUT); bf16* Wgu_t = (bf16*)(ws + WS_WGU); bf16* Wdn_t = (bf16*)(ws + WS_WDN);
    int k0, n0, row0; const float* W; bf16* WT; it.kscale = nullptr; it.cscale = 1.f;
    if (r < CV_IN) { item_kn(r, INC / 64, k0, n0); W = args.in[I_WIN]; WT = Win_t; it.N = INC; it.K = D; row0 = n0; it.cscale = (n0 < 1024 || (n0 >= 3072 && n0 < 4096)) ? QSCALE2 : 1.f; }
    else if ((r -= CV_IN) < CV_OUT) { item_kn(r, D / 64, k0, n0); W = args.in[I_WOUT]; WT = Wout_t; it.N = D; it.K = D; row0 = n0; }
    else if ((r -= CV_OUT) < 2 * CV_G) { const int up = r >= CV_G; if (up) r -= CV_G; item_kn(r, DFF / 64, k0, n0); W = args.in[up ? I_WU : I_WG]; WT = Wgu_t; it.N = DFF; it.K = D; row0 = 256 * (n0 / 128) + 128 * up + (n0 % 128); it.kscale = args.in[I_FNW] + k0; }
    else { r -= 2 * CV_G; item_kn(r, D / 64, k0, n0); W = args.in[I_WD]; WT = Wdn_t; it.N = D; it.K = DFF; row0 = n0; }
    it.src = W + (size_t)(k0 + (lane >> 4)) * it.N + n0 + 4 * (lane & 15);
    it.dst = WT + (size_t)row0 * it.K + k0;
    return true;
}
__device__ __forceinline__ void cv_load(const CvItem& it, f32x4 (&v)[16]) {
#pragma unroll
    for (int i = 0; i < 16; ++i) v[i] = *(const f32x4*)(it.src + (size_t)(4 * i) * it.N);
}
__device__ __forceinline__ void cv_finish(const CvItem& it, const f32x4 (&v)[16], LAS float* scr, int lane) {
#pragma unroll
    for (int i = 0; i < 16; ++i) { const int kk = 4 * i + (lane >> 4); float sc = it.cscale; if (it.kscale) sc *= it.kscale[kk];
        LAS float* d = scr + kk * 65 + 4 * (lane & 15); d[0] = v[i].x * sc; d[1] = v[i].y * sc; d[2] = v[i].z * sc; d[3] = v[i].w * sc; }
    asm volatile("s_waitcnt lgkmcnt(0)" ::: "memory");
    const int c = lane & 7;
#pragma unroll
    for (int j = 0; j < 8; ++j) { const int n = (lane >> 3) + 8 * j; const LAS float* s = scr + (8 * c) * 65 + n;
        v4u o; o.x = pk2(s[0 * 65], s[1 * 65]); o.y = pk2(s[2 * 65], s[3 * 65]); o.z = pk2(s[4 * 65], s[5 * 65]); o.w = pk2(s[6 * 65], s[7 * 65]);
        *(v4u*)(it.dst + (size_t)n * it.K + 8 * c) = o; }
    asm volatile("s_waitcnt lgkmcnt(0)" ::: "memory");
}
__device__ __forceinline__ void convert_weights_pipe(const Args& args, unsigned char* ws, LAS float* scr, int first, int last, int widx, int nw, int lane) {
    CvItem ia, ib; f32x4 va[16], vb[16];
    int r = first + widx;
    bool ha = cv_decode(args, ws, r, last, lane, ia); if (ha) cv_load(ia, va);
    while (ha) {
        const bool hb = cv_decode(args, ws, r + nw, last, lane, ib); if (hb) cv_load(ib, vb);
        cv_finish(ia, va, scr, lane);
        if (!hb) break;
        r += 2 * nw;
        ha = cv_decode(args, ws, r, last, lane, ia); if (ha) cv_load(ia, va);
        cv_finish(ib, vb, scr, lane);
    }
}

__global__ void __launch_bounds__(NWAVES * 64, 2) hymba_fwd(Args args) {
    extern __shared__ __attribute__((aligned(16))) unsigned char lds_raw[];
    cg::grid_group grid = cg::this_grid();
    LAS unsigned char* lds = (LAS unsigned char*)lds_raw;
    const int tid = threadIdx.x, lane = tid & 63, wave = __builtin_amdgcn_readfirstlane(tid >> 6);
    const int G = gridDim.x, bx = blockIdx.x, vcu = (G % 8 == 0) ? (bx % 8) * (G / 8) + bx / 8 : bx;
    unsigned char* ws = args.ws;
    const float* x = args.in[I_X]; float* out = args.out;
    bf16* Win_t = (bf16*)(ws + WS_WIN); bf16* Wout_t = (bf16*)(ws + WS_WOUT); bf16* Wgu_t = (bf16*)(ws + WS_WGU); bf16* Wdn_t = (bf16*)(ws + WS_WDN);
    bf16* XN = (bf16*)(ws + WS_XN); bf16* PROJ = (bf16*)(ws + WS_PROJ); bf16* MIX = (bf16*)(ws + WS_MIX); bf16* HB = (bf16*)(ws + WS_H);
    float* part1 = (float*)(ws + WS_PART1); float* part2 = (float*)(ws + WS_PART2);
    const int lo = args.ph_lo, hi = args.ph_hi;
    volatile LAS unsigned* bst = (volatile LAS unsigned*)(lds + LDS_BYTES - 64);
    if (tid < 2) bst[tid] = 0u;
    if (tid == 0) { *(LAS unsigned long long*)(lds + LDS_BYTES - 32) = 0ull; }
    __syncthreads();
    XcdBarrier gbar; gbar.bar = (unsigned*)ws; gbar.x = 0; gbar.st = bst;
    if (hi - lo > 1) gbar = xcd_barrier_post((unsigned*)ws, bst);
    if (hi > 1000) grid.sync();
#define IN(k) (lo <= (k) && (k) < hi)
#ifndef SYNC_REPEAT
#define SYNC_REPEAT 1
#endif
#define SEAM(k) do { if (IN(k) && IN((k) + 1)) { for (int sr_ = 0; sr_ < SYNC_REPEAT; ++sr_) xcd_barrier(gbar); } } while (0)
#ifndef PROBE_PHASE
#define PROBE_PHASE -1
#endif
#ifndef STAMP_SEL
#define STAMP_SEL 1
#endif
#ifdef STAMP_PHASE
#define STAMP_BEGIN(k) do { if ((k) == STAMP_PHASE || ((k) == 2 && (STAMP_PHASE == 30 || STAMP_PHASE == 31))) st0_ = __builtin_amdgcn_s_memrealtime(); } while (0)
#define STAMP_END(k) do { if ((k) == STAMP_PHASE) st1_ = __builtin_amdgcn_s_memrealtime(); } while (0)
#else
#define STAMP_BEGIN(k) do {} while (0)
#define STAMP_END(k) do {} while (0)
#endif
    unsigned long long st0_ = 0, st1_ = 0; (void)st0_; (void)st1_;
#define REP(k) for (int rep_ = 0; rep_ < ((PROBE_PHASE == (k)) ? 2 : 1); ++rep_, ((PROBE_PHASE == (k)) && rep_ < 2 ? (xcd_barrier(gbar), 0) : 0))

    STAMP_BEGIN(0); STAMP_BEGIN(41);
    REP(0) if (IN(0)) {
        LAS float* scr = (LAS float*)(lds + wave * 16640);
        const int gw = vcu * NWAVES + wave, NGW = G * NWAVES;
#if defined(P0_TOUCH) && P0_TOUCH
        {
            const int widx[5] = {I_WIN, I_WOUT, I_WG, I_WU, I_WD}; const size_t wn4[5] = {(size_t)D * INC / 4, (size_t)D * D / 4, (size_t)D * DFF / 4, (size_t)D * DFF / 4, (size_t)DFF * D / 4};
            f32x4 acc4 = {0.f, 0.f, 0.f, 0.f};
#pragma unroll
            for (int w = 0; w < 5; ++w) { const f32x4* src = (const f32x4*)args.in[widx[w]];
                for (size_t i = (size_t)gw * 64 + lane; i < wn4[w]; i += (size_t)NGW * 64 * 4) {
                    f32x4 a = src[i], b = (i + (size_t)NGW * 64 < wn4[w]) ? src[i + (size_t)NGW * 64] : acc4, c = (i + (size_t)NGW * 128 < wn4[w]) ? src[i + (size_t)NGW * 128] : acc4, d = (i + (size_t)NGW * 192 < wn4[w]) ? src[i + (size_t)NGW * 192] : acc4;
                    acc4 = acc4 + a + b + c + d; } }
            if (acc4.x + acc4.y + acc4.z + acc4.w == 1.2345e38f) ((float*)(ws + WS_PART2))[gw * 64 + lane] = acc4.x;
        }
#endif
#if defined(P0_MIX) && P0_MIX
#pragma unroll 1
        for (int pass_ = 0; pass_ < 2; ++pass_) {
        if ((pass_ == 0) != ((vcu & 1) != 0)) {
#if defined(CV_PIPE) && CV_PIPE
        convert_weights_pipe(args, ws, scr, 0, CV_SPLIT ? CV_IN : CV_ALL, gw, NGW, lane);
#else
        convert_weights<16>(args, ws, scr, 0, CV_SPLIT ? CV_ALL - 128 * CV_SA : CV_ALL, 0, 0, gw, NGW, lane);
#endif
        } else {
        STAMP_BEGIN(40); __syncthreads(); STAMP_END(41);
        const f32x4* wn = (const f32x4*)args.in[I_ANW] + lane;
        for (int rp_ = 0; rp_ < (PROBE_PHASE == 11 ? 2 : 1); ++rp_)
        for (int m = gw; m < M; m += NGW) {
            const f32x4* xr = (const f32x4*)(x + (size_t)m * D) + lane;
            f32x4 v[8]; float s = 0.f;
#pragma unroll
            for (int j = 0; j < 8; ++j) { v[j] = __builtin_nontemporal_load(xr + 64 * j); s += (v[j].x * v[j].x + v[j].y * v[j].y) + (v[j].z * v[j].z + v[j].w * v[j].w); }
            const float rstd = rsqrtf(wave_sum(s) * (1.f / D) + RMS_EPS);
            unsigned long long* o8 = (unsigned long long*)(XN + (size_t)m * D) + lane;
#pragma unroll
            for (int j = 0; j < 8; ++j) { const f32x4 w = wn[64 * j]; o8[64 * j] = (unsigned long long)pk2(v[j].x * rstd * w.x, v[j].y * rstd * w.y) | ((unsigned long long)pk2(v[j].z * rstd * w.z, v[j].w * rstd * w.w) << 32); }
        }
        }
        }
#else
#if defined(CV_PIPE) && CV_PIPE
        convert_weights_pipe(args, ws, scr, 0, CV_SPLIT ? CV_IN : CV_ALL, gw, NGW, lane);
#else
        convert_weights<16>(args, ws, scr, 0, CV_SPLIT ? CV_ALL - 128 * CV_SA : CV_ALL, 0, 0, gw, NGW, lane);
#endif
        STAMP_BEGIN(40); __syncthreads(); STAMP_END(41);
        const f32x4* wn = (const f32x4*)args.in[I_ANW] + lane;
        for (int rp_ = 0; rp_ < (PROBE_PHASE == 11 ? 2 : 1); ++rp_)
        for (int m = gw; m < M; m += NGW) {
            const f32x4* xr = (const f32x4*)(x + (size_t)m * D) + lane;
            f32x4 v[8]; float s = 0.f;
#pragma unroll
            for (int j = 0; j < 8; ++j) { v[j] = __builtin_nontemporal_load(xr + 64 * j); s += (v[j].x * v[j].x + v[j].y * v[j].y) + (v[j].z * v[j].z + v[j].w * v[j].w); }
            const float rstd = rsqrtf(wave_sum(s) * (1.f / D) + RMS_EPS);
            unsigned long long* o8 = (unsigned long long*)(XN + (size_t)m * D) + lane;
#pragma unroll
            for (int j = 0; j < 8; ++j) { const f32x4 w = wn[64 * j]; o8[64 * j] = (unsigned long long)pk2(v[j].x * rstd * w.x, v[j].y * rstd * w.y) | ((unsigned long long)pk2(v[j].z * rstd * w.z, v[j].w * rstd * w.w) << 32); }
        }
#endif
        __syncthreads();
    }
    SEAM(0);
    STAMP_END(0); STAMP_END(40);
    STAMP_BEGIN(1);
    REP(1) if (IN(1)) {
        pg8::Gemm g{XN, Win_t, M, INC, D}; pg8::StaticOrder S; S.init(M, INC, G, bx, WGM_P1);
        pg8::EpiStore E{PROJ, INC};
#if PROBE_PHASE == 21
        { TwiceOrder S2{S}; pg8::gemm_phase<pg8::EpiStore, TwiceOrder, true, true>(lds, g, S2, E); }
#else
        pg8::gemm_phase<pg8::EpiStore, pg8::StaticOrder, true, GEMM_SP2>(lds, g, S, E);
#endif
        if (CV_SPLIT) { const int nwg = (M / 256) * (INC / 256), maxU = (nwg + G - 1) / G, nIdle = G * maxU - nwg, idx = bx - (G - nIdle);
            const int nw_ = nIdle > 0 ? nIdle : G, id_ = nIdle > 0 ? idx : bx, per = (128 * CV_SA + nw_ - 1) / nw_, f0 = CV_ALL - 128 * CV_SA + id_ * per;
            if (id_ >= 0) convert_weights<8>(args, ws, (LAS float*)(lds + wave * 16640), f0, f0 + per < CV_ALL ? f0 + per : CV_ALL, 0, 0, wave, NWAVES, lane); }
        __syncthreads();
    }
    SEAM(1);
    STAMP_END(1);
    STAMP_BEGIN(2);
    REP(2) if (IN(2)) {
        const float* lq1 = args.in[I_LQ1]; const float* lk1 = args.in[I_LK1]; const float* lq2 = args.in[I_LQ2]; const float* lk2 = args.in[I_LK2];
        const float s1 = wave_sum(lq1[lane] * lk1[lane]), s2 = wave_sum(lq2[lane] * lk2[lane]);
        const float lam = expf(s1) - expf(s2) + 0.2f;
        const int wq = wave & 3, gsel = wave >> 2;
#ifdef ATT_PRIO
        if (gsel == 1) __builtin_amdgcn_s_setprio(1);
#endif
        STAMP_BEGIN(20);
        { const int np = vcu < 512 ? (512 - vcu + G - 1) / G : 0;
#define DIFF_UNIT(u_, up_) do { const int i_ = vcu + G * ((u_) >> 1), bh_ = (i_ >> 3) ^ (((u_) >> 1) & 1 ? 4 : 0)  , xq_ = i_ & 7, h_ = bh_ & 7, qblk_ = ((u_) & 1) ? 15 - xq_ : xq_; \
            up_.b = bh_ >> 3; up_.q0 = 128 * qblk_; up_.qcol = h_ * 128 + gsel * 64; up_.kcol = 1024 + h_ * 128; up_.vcol = 2048 + h_ * 128; up_.kofs = gsel * 128; \
            up_.slope2 = exp2f(-(float)(h_ + 1)) * 1.4426950408889634f; up_.m_init = 0.f; up_.l_init = 0.f; \
            up_.T0 = 0; up_.T1 = 2 * qblk_ + 1; up_.tlo = 0; up_.thi = (up_.q0 + 32 * wq) >> 6; up_.window = 1 << 20; up_.maskall = 0; up_.ocol = h_ * 128; } while (0)
#pragma unroll 1
          for (int u = 0; u < 2 * np; ++u) {
              att::UnitP up, nx; DIFF_UNIT(u, up); const bool hn = u + 1 < 2 * np; if (hn) DIFF_UNIT(u + 1, nx); else nx = up;
              att::attn_unit<128, 128>((LAS char*)lds, PROJ, MIX, up, true, lam, args.in[I_SUBLN], tid, u > 0, hn, nx.b, nx.kcol, nx.vcol, nx.T0, nx.T1);
          }
#undef DIFF_UNIT
        }
        STAMP_END(20); STAMP_BEGIN(21);
        { const int ns = vcu < 1024 ? (1024 - vcu + G - 1) / G : 0;
#define SWA_UNIT(u_, up_) do { const int i_ = vcu + G * (u_), qblk_ = i_ & 15, pair_ = (i_ >> 4) & 1, hkv_ = ((i_ >> 5) + (u_)) & 3, hq_ = hkv_ * 4 + pair_ * 2 + gsel, a_ = 2 * qblk_; \
            up_.b = i_ >> 7; up_.q0 = 128 * qblk_; up_.qcol = 3072 + hq_ * 64; up_.kcol = 4096 + hkv_ * 64; up_.vcol = 4352 + hkv_ * 64; up_.kofs = 0; \
            up_.slope2 = exp2f(-0.5f * (float)(hq_ + 1)) * 1.4426950408889634f; up_.m_init = args.in[I_SINKS][hq_] * 1.4426950408889634f; up_.l_init = 1.f; \
            up_.T0 = a_ - 2 < 0 ? 0 : a_ - 2; up_.T1 = a_ + 1; up_.tlo = a_ - 2 + (wq >> 1); up_.thi = a_ + (wq >> 1); up_.window = 128; up_.maskall = 1; up_.ocol = 1024 + hq_ * 64; } while (0)
#pragma unroll 1
          for (int u = 0; u < ns; ++u) {
              att::UnitP up, nx; SWA_UNIT(u, up); const bool hn = u + 1 < ns; if (hn) SWA_UNIT(u + 1, nx); else nx = up;
              att::attn_unit<64, 64>((LAS char*)lds, PROJ, MIX, up, false, 0.f, nullptr, tid, u > 0, hn, nx.b, nx.kcol, nx.vcol, nx.T0, nx.T1);
          }
#undef SWA_UNIT
        }
        STAMP_END(21);
#ifdef ATT_PRIO
        __builtin_amdgcn_s_setprio(0);
#endif
#if defined(P3_PREFETCH_X) && P3_PREFETCH_X
        {
            pg8::StaticOrder S3; S3.init(M, D, G, bx, WGM_P3); pg8::Unit u3; float pacc = 0.f;
            for (int i = 0; S3.next(i, u3); ++i) {
                const float* tb = x + (size_t)u3.pm * 256 * D + (size_t)u3.pn * 256;
#pragma unroll
                for (int k = 0; k < 4; ++k) { const int line = tid + 512 * k; pacc += tb[(size_t)(line >> 3) * D + (line & 7) * 32]; }
            }
            if (pacc == 1.2345e38f) part2[tid] = pacc;
        }
#endif
        __syncthreads();
#ifdef STAMP_PHASE
        if (STAMP_PHASE == 30 || STAMP_PHASE == 31) { if (tid == 0 && STAMP_SEL) { const unsigned d_ = (unsigned)(__builtin_amdgcn_s_memrealtime() - st0_);
            if (STAMP_PHASE == 30) __hip_atomic_fetch_max((unsigned*)ws + 3500, d_, __ATOMIC_RELAXED, __HIP_MEMORY_SCOPE_AGENT); else __hip_atomic_fetch_max((unsigned*)ws + 3500, ~d_, __ATOMIC_RELAXED, __HIP_MEMORY_SCOPE_AGENT) ; } }
#endif
    }
    SEAM(2);
#ifdef STAMP_PHASE
    if (STAMP_PHASE == 30 || STAMP_PHASE == 31) { const unsigned v_ = __hip_atomic_load((unsigned*)ws + 3500, __ATOMIC_RELAXED, __HIP_MEMORY_SCOPE_AGENT); st1_ = st0_ + (STAMP_PHASE == 30 ? v_ : ~v_); }
#endif
    STAMP_END(2);
    STAMP_BEGIN(3);
    REP(3) if (IN(3)) {
        pg8::Gemm g{MIX, Wout_t, M, D, D}; pg8::StaticOrder S; S.init(M, D, G, bx, WGM_P3);
        pg8::EpiResid<false> E{x, XN, part1, D};
        pg8::gemm_phase<pg8::EpiResid<false>, pg8::StaticOrder, true, GEMM_SP2>(lds, g, S, E);
    }
    SEAM(3);
    STAMP_END(3);
    STAMP_BEGIN(4);
    REP(4) if (IN(4)) {
        pg8::Gemm g{XN, Wgu_t, M, NGU, D}; pg8::StaticOrder S; S.init(M, NGU, G, bx, WGM_P4);
        int tpm = -1; { pg8::Unit u0; if (S.next(0, u0)) { tpm = u0.pm; if (tid < 256) { const f32x4* pp = (const f32x4*)(part1 + (size_t)(tpm * 256 + tid) * 32); float sacc = 0.f;
#pragma unroll
                    for (int k = 0; k < 8; ++k) { const f32x4 a = pp[k]; sacc += (a[0] + a[1]) + (a[2] + a[3]); }
                    ((LAS float*)(lds + RING_BYTES))[tid] = rsqrtf(sacc * (1.f / D) + RMS_EPS); } } }
        __syncthreads();
        pg8::EpiSwiGLU E{HB, DFF, part1, 1.f / D, RMS_EPS, (LAS const float*)(lds + RING_BYTES), tpm};
#if PROBE_PHASE == 24
        { TwiceOrder S2{S}; pg8::gemm_phase<pg8::EpiSwiGLU, TwiceOrder, true, true>(lds, g, S2, E); }
#else
        pg8::gemm_phase<pg8::EpiSwiGLU, pg8::StaticOrder, P4_ALIGN, GEMM_SP2>(lds, g, S, E);
#endif
    }
    SEAM(4);
    STAMP_END(4);
    STAMP_BEGIN(5);
    REP(5) if (IN(5)) {
        pg8::Gemm g{HB, Wdn_t, M, D, DFF}; pg8::StaticOrder S; S.init(M, D, G, bx, WGM_P5);
#if FUSE_FINAL
        pg8::EpiFinal E{XN, out, args.in[I_FINW], part2, (unsigned*)ws + 4096, lds + RING_BYTES, D, 1.f / D, RMS_EPS};
        pg8::gemm_phase<pg8::EpiFinal, pg8::StaticOrder, true, GEMM_SP2>(lds, g, S, E);
#else
        pg8::EpiResid<true> E{XN, XN, part2, D};
        pg8::gemm_phase<pg8::EpiResid<true>, pg8::StaticOrder, true, GEMM_SP2>(lds, g, S, E);
#endif
    }
#if !FUSE_FINAL
    SEAM(5);
#endif
    STAMP_END(5);
    STAMP_BEGIN(6);
    REP(6) if (IN(6) && !FUSE_FINAL) {
        const int gw = vcu * NWAVES + wave, NGW = G * NWAVES;
        const f32x4* wn = (const f32x4*)args.in[I_FINW] + 2 * lane;
        for (int m = gw; m < M; m += NGW) {
            const float s = wave_sum(lane < 32 ? part2[(size_t)m * 32 + lane] : 0.f);
            const float rstd = rsqrtf(s * (1.f / D) + RMS_EPS);
            const v4u* xr = (const v4u*)(XN + (size_t)m * D) + lane; f32x4* orow = (f32x4*)(out + (size_t)m * D) + 2 * lane;
#pragma unroll
            for (int j = 0; j < 4; ++j) { const v4u w = __builtin_nontemporal_load(xr + 64 * j); const f32x4 w0 = wn[128 * j], w1 = wn[128 * j + 1];
                const f32x4 a = {__uint_as_float(w.x << 16), __uint_as_float(w.x & 0xffff0000u), __uint_as_float(w.y << 16), __uint_as_float(w.y & 0xffff0000u)};
                const f32x4 b = {__uint_as_float(w.z << 16), __uint_as_float(w.z & 0xffff0000u), __uint_as_float(w.w << 16), __uint_as_float(w.w & 0xffff0000u)};
                __builtin_nontemporal_store(a * rstd * w0, orow + 128 * j); __builtin_nontemporal_store(b * rstd * w1, orow + 128 * j + 1); }
        }
    }
#ifdef ATT_TIMER
    if (bx == 0) { __syncthreads(); if (tid == 0) { const unsigned long long dt = *(LAS unsigned long long*)(lds + LDS_BYTES - 32), te = __builtin_amdgcn_s_memtime(); while (__builtin_amdgcn_s_memtime() - te < dt) __builtin_amdgcn_s_sleep(32); } }
#endif
#ifdef STAMP_PHASE
    if (STAMP_PHASE == 6) { __syncthreads(); st1_ = __builtin_amdgcn_s_memrealtime(); }
    if (bx == 0 && tid == 0) { const unsigned long long te = __builtin_amdgcn_s_memrealtime(), dt = st1_ - st0_; while (__builtin_amdgcn_s_memrealtime() - te < dt) __builtin_amdgcn_s_sleep(32); }
#endif
#undef IN
#undef SEAM
}

extern "C" void kernel_launch(void* const* d_in, const int* in_sizes, int n_in, void* d_out, int out_size, void* d_ws, size_t ws_size, hipStream_t stream) {
    static int grid = 0;
    if (grid == 0) {
        if (n_in != 15 || out_size != M * D || ws_size < WS_END) { fprintf(stderr, "kernel_launch: unexpected shapes (n_in %d out %d ws %zu)\n", n_in, out_size, ws_size); grid = -1; return; }
        int dev = 0, cus = 0, per_cu = 0;
        hipGetDevice(&dev); hipDeviceGetAttribute(&cus, hipDeviceAttributeMultiprocessorCount, dev);
        if (hipFuncSetAttribute((const void*)hymba_fwd, hipFuncAttributeMaxDynamicSharedMemorySize, LDS_BYTES) != hipSuccess) { fprintf(stderr, "kernel_launch: hipFuncSetAttribute failed\n"); grid = -1; return; }
        if (hipOccupancyMaxActiveBlocksPerMultiprocessor(&per_cu, (const void*)hymba_fwd, NWAVES * 64, LDS_BYTES) != hipSuccess || per_cu < 1) { fprintf(stderr, "kernel_launch: occupancy query says %d\n", per_cu); per_cu = 1; }
        (void)hipGetLastError();
        grid = cus * 1;
        fprintf(stderr, "kernel_launch: grid %d (cus %d, per_cu %d)\n", grid, cus, per_cu);
    }
    if (grid < 0) return;
    if (hipMemsetAsync(d_ws, 0, 65536, stream) != hipSuccess) { fprintf(stderr, "kernel_launch: memset failed\n"); return; }
    Args a{};
    for (int i = 0; i < 15; ++i) a.in[i] = (const float*)d_in[i];
    a.out = (float*)d_out; a.ws = (unsigned char*)d_ws;
#if MK_N_LAUNCHES == 1
    a.ph_lo = 0; a.ph_hi = N_PHASES;
    void* kargs[] = {&a};
    hipError_t e = hipLaunchCooperativeKernel((const void*)hymba_fwd, dim3(grid), dim3(NWAVES * 64), kargs, LDS_BYTES, stream);
    if (e != hipSuccess) fprintf(stderr, "kernel_launch: cooperative launch failed: %s\n", hipGetErrorString(e));
#else
    for (int p = 0; p < N_PHASES; ++p) { a.ph_lo = p; a.ph_hi = p + 1; hipLaunchKernelGGL(hymba_fwd, dim3(grid), dim3(NWAVES * 64), LDS_BYTES, stream, a); }
#endif
}
```

```cpp
#include <hip/hip_runtime.h>
#include <hip/hip_cooperative_groups.h>
#include <hip/hip_bf16.h>
#include <cstdio>
#include <cstdint>
#include <cmath>
namespace cg = cooperative_groups;
#define MK_N_LAUNCHES 1
#ifndef PG8_WGM
#define PG8_WGM 4
#endif
namespace pg8 {
#define PG8_LAS __attribute__((address_space(3)))
typedef unsigned short bf16_t;
typedef short bf16x8 __attribute__((ext_vector_type(8)));
typedef float f32x4 __attribute__((ext_vector_type(4)));
typedef unsigned u32x4 __attribute__((ext_vector_type(4)));
constexpr int BM = 256, BK = 64, HALF = 128, HTB = HALF * BK * 2  , STAGE_BYTES = 8 * HTB, NXCD = 8, WGM = PG8_WGM;

__host__ __device__ __forceinline__ int lds_byte(int r, int c) { const int st = (r >> 4) * 2 + (c >> 5), rr = r & 15, cc = c & 31, ob = rr * 64 + cc * 2; return st * 1024 + (ob ^ (((ob >> 9) & 1) << 5)); }
__host__ __device__ __forceinline__ void stage_rc(int b, int& R, int& C) { const int st = b / 1024, sb = b % 1024, swz = sb ^ (((sb >> 9) & 1) << 5); R = (st >> 1) * 16 + swz / 64; C = (st & 1) * 32 + (swz % 64) / 2; }
__host__ __device__ __forceinline__ int perm32(int rho) { const int n = rho >> 4, i = rho & 15; return 8 * (i >> 2) + 4 * n + (i & 3); }

struct Unit { int pm, pn; };
struct Gemm { const bf16_t* A; const bf16_t* Bt; int M, N, K; };

struct StaticOrder {
    int nM, nN, nwg, G, c, wgm;
    __host__ __device__ void init(int M, int N, int G_, int c_, int wgm_ = WGM) { nM = M / BM; nN = N / BM; nwg = nM * nN; G = G_; c = c_; wgm = wgm_; }
    __host__ __device__ bool next(int i, Unit& u) const {
        const long L = (long)i * G + c; if (L >= nwg) return false;
        int wgid = (int)L; { const int q = nwg / NXCD, r = nwg % NXCD, xcd = wgid % NXCD, off = wgid / NXCD; wgid = (xcd < r ? xcd * (q + 1) : r * (q + 1) + (xcd - r) * q) + off; }
        const int nig = wgm * nN, gid = wgid / nig, fm = gid * wgm, gsz = (nM - fm) < wgm ? (nM - fm) : wgm;
        u.pm = fm + ((wgid % nig) % gsz); u.pn = (wgid % nig) / gsz; return true;
    }
    __device__ __forceinline__ void a_ready(const Unit&) const {}
    __device__ __forceinline__ void done(const Unit&) const {}
};

__device__ __forceinline__ unsigned cvt_pk_bf16(float lo, float hi) { typedef float f2_t __attribute__((ext_vector_type(2))); typedef __bf16 b2_t __attribute__((ext_vector_type(2))); f2_t v = {lo, hi}; b2_t b = __builtin_convertvector(v, b2_t); return __builtin_bit_cast(unsigned, b); }
typedef unsigned u32x2 __attribute__((ext_vector_type(2)));
#ifndef P5_NT_A
#define P5_NT_A 0
#endif
#ifndef EPI_NT_H
#define EPI_NT_H 0
#endif
#ifndef EPI_NT_PROJ
#define EPI_NT_PROJ 0
#endif
struct EpiStore {
    static constexpr bool PERM = true, AFTER_DRAIN = false; static constexpr int AUX_A = 0, AUX_B = 0;
    bf16_t* O; int ldc;
    __device__ __forceinline__ void operator()(const f32x4 (&acc)[2][2][4][2], const Unit& u, int wr, int wc, int fr, int fq) const {
        const int row0 = u.pm * BM + wr * 64 + fr, col0 = u.pn * BM + wc * 32 + 8 * fq;
#pragma unroll
        for (int ai = 0; ai < 2; ++ai)
#pragma unroll
            for (int m = 0; m < 4; ++m) { bf16_t* rowp = O + (size_t)(row0 + ai * HALF + m * 16) * ldc + col0;
#pragma unroll
                for (int bj = 0; bj < 2; ++bj) { const f32x4 v0 = acc[ai][bj][m][0], v1 = acc[ai][bj][m][1];
                    u32x4 w; w.x = cvt_pk_bf16(v0[0], v0[1]); w.y = cvt_pk_bf16(v0[2], v0[3]); w.z = cvt_pk_bf16(v1[0], v1[1]); w.w = cvt_pk_bf16(v1[2], v1[3]);
                    if (EPI_NT_PROJ) __builtin_nontemporal_store(w, (u32x4*)(rowp + bj * HALF)); else *(u32x4*)(rowp + bj * HALF) = w; } }
    }
};
template <bool BASE_BF16> struct EpiResid {
    static constexpr bool PERM = true, AFTER_DRAIN = false; static constexpr int AUX_A = (BASE_BF16 && P5_NT_A) ? 2 : 0, AUX_B = 0;
    const void* base; bf16_t* xo; float* part; int ldc;
    __device__ __forceinline__ void operator()(const f32x4 (&acc)[2][2][4][2], const Unit& u, int wr, int wc, int fr, int fq) const {
        const int row0 = u.pm * BM + wr * 64 + fr, col0 = u.pn * BM + wc * 32 + 8 * fq;
#pragma unroll
        for (int ai = 0; ai < 2; ++ai)
#pragma unroll
            for (int m = 0; m < 4; ++m) { const int r = row0 + ai * HALF + m * 16; const size_t off = (size_t)r * ldc + col0; float ss = 0.f;
#pragma unroll
                for (int bj = 0; bj < 2; ++bj) { f32x4 b0, b1;
                    if (BASE_BF16) { const u32x4 w = *(const u32x4*)((const bf16_t*)base + off + bj * HALF);
                        b0 = (f32x4){__uint_as_float(w.x << 16), __uint_as_float(w.x & 0xffff0000u), __uint_as_float(w.y << 16), __uint_as_float(w.y & 0xffff0000u)};
                        b1 = (f32x4){__uint_as_float(w.z << 16), __uint_as_float(w.z & 0xffff0000u), __uint_as_float(w.w << 16), __uint_as_float(w.w & 0xffff0000u)}; }
                    else { const float* bp = (const float*)base + off + bj * HALF; b0 = __builtin_nontemporal_load((const f32x4*)bp); b1 = __builtin_nontemporal_load((const f32x4*)(bp + 4)); }
                    const f32x4 v0 = b0 + acc[ai][bj][m][0], v1 = b1 + acc[ai][bj][m][1];
                    ss += ((v0[0] * v0[0] + v0[1] * v0[1]) + (v0[2] * v0[2] + v0[3] * v0[3])) + ((v1[0] * v1[0] + v1[1] * v1[1]) + (v1[2] * v1[2] + v1[3] * v1[3]));
                    u32x4 w; w.x = cvt_pk_bf16(v0[0], v0[1]); w.y = cvt_pk_bf16(v0[2], v0[3]); w.z = cvt_pk_bf16(v1[0], v1[1]); w.w = cvt_pk_bf16(v1[2], v1[3]);
                    *(u32x4*)(xo + off + bj * HALF) = w; }
                ss += __shfl_xor(ss, 16); ss += __shfl_xor(ss, 32);
                if (fq == 0) part[(size_t)r * 32 + u.pn * 4 + wc] = ss; }
    }
};
struct EpiFinal {
    static constexpr bool PERM = true, AFTER_DRAIN = false; static constexpr int AUX_A = 0, AUX_B = 0;
    const bf16_t* xb; float* out; const float* wfin; float* xbuf; unsigned* cnt; PG8_LAS unsigned char* tab; int ldc; float inv_n, eps;
    __device__ __forceinline__ void operator()(f32x4 (&acc)[2][2][4][2], const Unit& u, int wr, int wc, int fr, int fq) const {
        const int lane = fq * 16 + fr, wid = wr * 4 + wc;
        PG8_LAS float* P = (PG8_LAS float*)tab;
        PG8_LAS float* S = (PG8_LAS float*)(tab + 4096);
        PG8_LAS unsigned* flag = (PG8_LAS unsigned*)(tab + 4096 + 1024);
        const int row0 = u.pm * BM + wr * 64 + fr, col0 = u.pn * BM + wc * 32 + 8 * fq;
#pragma unroll
        for (int ai = 0; ai < 2; ++ai)
#pragma unroll
            for (int m = 0; m < 4; ++m) { const int r = row0 + ai * HALF + m * 16; const size_t off = (size_t)r * ldc + col0; float ss = 0.f;
#pragma unroll
                for (int bj = 0; bj < 2; ++bj) { const u32x4 w = *(const u32x4*)(xb + off + bj * HALF);
                    const f32x4 b0 = {__uint_as_float(w.x << 16), __uint_as_float(w.x & 0xffff0000u), __uint_as_float(w.y << 16), __uint_as_float(w.y & 0xffff0000u)};
                    const f32x4 b1 = {__uint_as_float(w.z << 16), __uint_as_float(w.z & 0xffff0000u), __uint_as_float(w.w << 16), __uint_as_float(w.w & 0xffff0000u)};
                    const f32x4 v0 = b0 + acc[ai][bj][m][0], v1 = b1 + acc[ai][bj][m][1]; acc[ai][bj][m][0] = v0; acc[ai][bj][m][1] = v1;
                    ss += ((v0[0] * v0[0] + v0[1] * v0[1]) + (v0[2] * v0[2] + v0[3] * v0[3])) + ((v1[0] * v1[0] + v1[1] * v1[1]) + (v1[2] * v1[2] + v1[3] * v1[3])); }
                ss += __shfl_xor(ss, 16); ss += __shfl_xor(ss, 32);
                if (fq == 0) P[(ai * HALF + wr * 64 + m * 16 + fr) * 4 + wc] = ss; }
        asm volatile("s_waitcnt lgkmcnt(0)" ::: "memory"); __builtin_amdgcn_s_barrier(); asm volatile("" ::: "memory");
        const int row = wid * 32 + (lane & 31);
        if (lane < 32) { const f32x4 p4 = *(PG8_LAS const f32x4*)(P + row * 4);
            __hip_atomic_store(xbuf + ((size_t)(u.pm * BM + row) * 8 + u.pn), (p4[0] + p4[1]) + (p4[2] + p4[3]), __ATOMIC_RELAXED, __HIP_MEMORY_SCOPE_AGENT); }
        asm volatile("s_waitcnt vmcnt(0)" ::: "memory");
        if (lane == 0) __hip_atomic_fetch_add(cnt + 64 * u.pm, 1u, __ATOMIC_RELAXED, __HIP_MEMORY_SCOPE_AGENT);
        if (wid == 0) { bool dead = false; const unsigned long long t0 = __builtin_amdgcn_s_memrealtime();
            for (;;) { if ((unsigned)__builtin_amdgcn_readfirstlane(__hip_atomic_load(cnt + 64 * u.pm, __ATOMIC_RELAXED, __HIP_MEMORY_SCOPE_AGENT)) >= 64u) break;
                if (__builtin_amdgcn_s_memrealtime() - t0 > 2000000ull) { dead = true; break; }
                __builtin_amdgcn_s_sleep(2); }
            __builtin_amdgcn_fence(__ATOMIC_ACQUIRE, "agent");
            if (lane == 0) flag[0] = dead ? 1u : 0u; }
        asm volatile("s_waitcnt vmcnt(0) lgkmcnt(0)" ::: "memory"); __builtin_amdgcn_s_barrier(); asm volatile("" ::: "memory");
        const bool bad = flag[0] != 0u;
        if (lane < 32) { const float* slot = xbuf + (size_t)(u.pm * BM + row) * 8; float q = 0.f;
#pragma unroll
            for (int t = 0; t < 8; ++t) q += __hip_atomic_load(slot + t, __ATOMIC_RELAXED, __HIP_MEMORY_SCOPE_AGENT);
            S[row] = rsqrtf(q * inv_n + eps); }
        asm volatile("s_waitcnt vmcnt(0) lgkmcnt(0)" ::: "memory"); __builtin_amdgcn_s_barrier(); asm volatile("" ::: "memory");
        const float qnan = __builtin_nanf("");
        f32x4 wv[2][2];
#pragma unroll
        for (int bj = 0; bj < 2; ++bj) { wv[bj][0] = *(const f32x4*)(wfin + col0 + bj * HALF); wv[bj][1] = *(const f32x4*)(wfin + col0 + bj * HALF + 4); }
#pragma unroll
        for (int ai = 0; ai < 2; ++ai)
#pragma unroll
            for (int m = 0; m < 4; ++m) { const int rl = ai * HALF + wr * 64 + m * 16 + fr; const float rs = bad ? qnan : S[rl]; float* op = out + (size_t)(u.pm * BM + rl) * ldc + col0;
#pragma unroll
                for (int bj = 0; bj < 2; ++bj) { __builtin_nontemporal_store(acc[ai][bj][m][0] * rs * wv[bj][0], (f32x4*)(op + bj * HALF)); __builtin_nontemporal_store(acc[ai][bj][m][1] * rs * wv[bj][1], (f32x4*)(op + bj * HALF + 4)); } }
    }
};
struct EpiSwiGLU {
    static constexpr bool PERM = true, AFTER_DRAIN = false; static constexpr int AUX_A = 0, AUX_B = 0;
    bf16_t* H; int ldh; const float* part; float inv_n, eps; PG8_LAS const float* rtab; int rtab_pm;
    __device__ __forceinline__ static float silu_mul(float g, float uu) { const float e = __builtin_amdgcn_exp2f(g * -1.4426950408889634f); return g * uu * __builtin_amdgcn_rcpf(1.f + e); }
    __device__ __forceinline__ void operator()(const f32x4 (&acc)[2][2][4][2], const Unit& u, int wr, int wc, int fr, int fq) const {
        const int row0 = u.pm * BM + wr * 64 + fr, col0 = u.pn * HALF + wc * 32 + 8 * fq;
        float rt8[2][4];
        const bool tab = u.pm == rtab_pm;
#pragma unroll
        for (int ai = 0; ai < 2; ++ai)
#pragma unroll
            for (int m = 0; m < 4; ++m) rt8[ai][m] = tab ? rtab[ai * HALF + wr * 64 + m * 16 + fr] : 0.f;
#pragma unroll
        for (int ai = 0; ai < 2; ++ai)
#pragma unroll
            for (int m = 0; m < 4; ++m) { const int r = row0 + ai * HALF + m * 16;
                float rstd;
                if (tab) rstd = rt8[ai][m];
                else { const f32x4* pp = (const f32x4*)(part + (size_t)r * 32 + fq * 8); const f32x4 pa = pp[0], pb = pp[1];
                    float s = ((pa[0] + pa[1]) + (pa[2] + pa[3])) + ((pb[0] + pb[1]) + (pb[2] + pb[3]));
                    s += __shfl_xor(s, 16); s += __shfl_xor(s, 32);
                    rstd = rsqrtf(s * inv_n + eps); }
                const f32x4 g0 = acc[ai][0][m][0] * rstd, g1 = acc[ai][0][m][1] * rstd, u0 = acc[ai][1][m][0] * rstd, u1 = acc[ai][1][m][1] * rstd;
                u32x4 w; w.x = cvt_pk_bf16(silu_mul(g0[0], u0[0]), silu_mul(g0[1], u0[1])); w.y = cvt_pk_bf16(silu_mul(g0[2], u0[2]), silu_mul(g0[3], u0[3]));
                w.z = cvt_pk_bf16(silu_mul(g1[0], u1[0]), silu_mul(g1[1], u1[1])); w.w = cvt_pk_bf16(silu_mul(g1[2], u1[2]), silu_mul(g1[3], u1[3]));
                if (EPI_NT_H) __builtin_nontemporal_store(w, (u32x4*)(H + (size_t)r * ldh + col0)); else *(u32x4*)(H + (size_t)r * ldh + col0) = w; }
    }
};
template <class Epi, class Sched, bool ALIGN_EPI = false, bool SP2 = false>
__device__ __forceinline__ void gemm_phase(PG8_LAS unsigned char* lds, const Gemm g, const Sched& S, const Epi& E) {
    const int tid = threadIdx.x, wid = __builtin_amdgcn_readfirstlane(tid >> 6), lane = tid & 63, wr = wid >> 2, wc = wid & 3, fr = lane & 15, fq = lane >> 4;
    const int K = g.K, nt = K / BK;
    constexpr int AUXA = Epi::AUX_A, AUXB = Epi::AUX_B;
    unsigned voffA[2], voffB[2];
#pragma unroll
    for (int i = 0; i < 2; ++i) { int R, C; stage_rc(tid * 16 + i * 8192, R, C); const int Rb = Epi::PERM ? ((R & ~31) + perm32(R & 31)) : R;
        voffA[i] = (unsigned)(R * K + C) * 2u; voffB[i] = (unsigned)(Rb * K + C) * 2u; }
    const size_t kstep = (size_t)(BK * 2);
    const size_t hstep = (size_t)HALF * K * 2;
    const size_t tstep = 2 * hstep;
    const unsigned ldsw = (unsigned)wid * 1024u;
    const int aoff = lds_byte(wr * 64 + fr, fq * 8), boff = lds_byte(wc * 32 + fr, fq * 8);
#define PG8_SA(b, h) (((b) * 2 + (h)) * HTB)
#define PG8_SB(b, h) ((4 + (b) * 2 + (h)) * HTB)
#define PG8_STAGE_X(bufoff, gbase, voff, aux_) do { _Pragma("unroll") for (int _i = 0; _i < 2; ++_i) \
        __builtin_amdgcn_global_load_lds((const unsigned*)((const char*)(gbase) + (voff)[_i]), (PG8_LAS unsigned*)(lds + (bufoff) + ldsw + _i * 8192), 16, 0, aux_); } while (0)
#define PG8_LDA(dst, b, h) do { _Pragma("unroll") for (int m = 0; m < 4; ++m) _Pragma("unroll") for (int k = 0; k < 2; ++k) dst[m][k] = *(const PG8_LAS bf16x8*)(lds + PG8_SA(b, h) + aoff + m * 2048 + k * 1024); } while (0)
#define PG8_LDB(dst, b, h) do { _Pragma("unroll") for (int n = 0; n < 2; ++n) _Pragma("unroll") for (int k = 0; k < 2; ++k) dst[n][k] = *(const PG8_LAS bf16x8*)(lds + PG8_SB(b, h) + boff + n * 2048 + k * 1024); } while (0)
#define PG8_MMA(ai, bj, At, Bt) do { __builtin_amdgcn_s_setprio(1); _Pragma("unroll") for (int m = 0; m < 4; ++m) _Pragma("unroll") for (int n = 0; n < 2; ++n) _Pragma("unroll") for (int k = 0; k < 2; ++k) \
        acc[ai][bj][m][n] = __builtin_amdgcn_mfma_f32_16x16x32_bf16(Bt[n][k], At[m][k], acc[ai][bj][m][n], 0, 0, 0); __builtin_amdgcn_s_setprio(0); } while (0)
#define PG8_WAIT_V(n) asm volatile("s_waitcnt vmcnt(" #n ")" ::: "memory")
#define PG8_WAIT_L(n) asm volatile("s_waitcnt lgkmcnt(" #n ")" ::: "memory")
#define PG8_BAR __builtin_amdgcn_s_barrier()
#define PG8_SCHED __builtin_amdgcn_sched_barrier(0)
    Unit cur, nxt; int ui = 0;
    if (!S.next(0, cur)) return;
    f32x4 acc[2][2][4][2];
#pragma unroll
    for (int a = 0; a < 2; ++a)
#pragma unroll
        for (int b = 0; b < 2; ++b)
#pragma unroll
            for (int m = 0; m < 4; ++m)
#pragma unroll
                for (int n = 0; n < 2; ++n) acc[a][b][m][n] = (f32x4){0.f, 0.f, 0.f, 0.f};
    bf16x8 At[4][2], B0[2][2], B1[2][2];
    const char* cA = (const char*)g.A + (size_t)cur.pm * tstep; const char* cB = (const char*)g.Bt + (size_t)cur.pn * tstep;
    S.a_ready(cur);
    if constexpr (SP2) {
        PG8_STAGE_X(PG8_SB(0, 0), cB, voffB, AUXB); PG8_STAGE_X(PG8_SB(0, 1), cB + hstep, voffB, AUXB); PG8_STAGE_X(PG8_SA(0, 0), cA, voffA, AUXA); PG8_STAGE_X(PG8_SA(0, 1), cA + hstep, voffA, AUXA);
        if (wr == 1) PG8_BAR;
        PG8_WAIT_V(2); PG8_BAR;
        PG8_STAGE_X(PG8_SB(1, 0), cB + kstep, voffB, AUXB); PG8_STAGE_X(PG8_SA(1, 0), cA + kstep, voffA, AUXA); PG8_STAGE_X(PG8_SB(1, 1), cB + hstep + kstep, voffB, AUXB);
        PG8_WAIT_V(6); PG8_BAR;
    } else {
        PG8_STAGE_X(PG8_SB(0, 0), cB, voffB, AUXB); PG8_STAGE_X(PG8_SA(0, 0), cA, voffA, AUXA); PG8_STAGE_X(PG8_SB(0, 1), cB + hstep, voffB, AUXB); PG8_STAGE_X(PG8_SA(0, 1), cA + hstep, voffA, AUXA);
        if (wr == 1) PG8_BAR;
        PG8_WAIT_V(4); PG8_BAR;
        PG8_STAGE_X(PG8_SB(1, 0), cB + kstep, voffB, AUXB); PG8_STAGE_X(PG8_SA(1, 0), cA + kstep, voffA, AUXA); PG8_STAGE_X(PG8_SB(1, 1), cB + hstep + kstep, voffB, AUXB);
        PG8_WAIT_V(6); PG8_BAR;
    }
    for (;;) {
        const bool has_next = S.next(ui + 1, nxt);
        const char* nA = has_next ? (const char*)g.A + (size_t)nxt.pm * tstep : cA; const char* nB = has_next ? (const char*)g.Bt + (size_t)nxt.pn * tstep : cB;
        for (int t = 0; t < nt; t += 2) {
            const bool last = (t == nt - 2);
            const char* a1 = cA + (size_t)(t + 1) * kstep;
            const char* a2 = last ? nA : cA + (size_t)(t + 2) * kstep; const char* b2 = last ? nB : cB + (size_t)(t + 2) * kstep;
            const char* a3 = a2 + kstep; const char* b3 = b2 + kstep;
            if (last && has_next) S.a_ready(nxt);
            if constexpr (SP2) {
            PG8_LDB(B0, 0, 0); PG8_LDB(B1, 0, 1); PG8_SCHED; PG8_LDA(At, 0, 0); PG8_STAGE_X(PG8_SA(1, 1), a1 + hstep, voffA, AUXA);
            PG8_WAIT_V(8); PG8_WAIT_L(0); PG8_BAR; PG8_MMA(0, 0, At, B0); PG8_MMA(0, 1, At, B1); PG8_BAR; PG8_SCHED;
            PG8_LDA(At, 0, 1); PG8_STAGE_X(PG8_SB(0, 0), b2, voffB, AUXB); PG8_STAGE_X(PG8_SB(0, 1), b2 + hstep, voffB, AUXB); PG8_STAGE_X(PG8_SA(0, 0), a2, voffA, AUXA);
            PG8_WAIT_V(8); PG8_WAIT_L(0); PG8_BAR; PG8_MMA(1, 0, At, B0); PG8_MMA(1, 1, At, B1); PG8_BAR; PG8_SCHED;
            PG8_LDB(B0, 1, 0); PG8_LDB(B1, 1, 1); PG8_SCHED; PG8_LDA(At, 1, 0); PG8_STAGE_X(PG8_SA(0, 1), a2 + hstep, voffA, AUXA);
            PG8_WAIT_V(8); PG8_WAIT_L(0); PG8_BAR; PG8_MMA(0, 0, At, B0); PG8_MMA(0, 1, At, B1); PG8_BAR; PG8_SCHED;
            PG8_LDA(At, 1, 1); PG8_STAGE_X(PG8_SB(1, 0), b3, voffB, AUXB); PG8_STAGE_X(PG8_SB(1, 1), b3 + hstep, voffB, AUXB); PG8_STAGE_X(PG8_SA(1, 0), a3, voffA, AUXA);
            PG8_WAIT_V(8); PG8_WAIT_L(0); PG8_BAR; PG8_MMA(1, 0, At, B0); PG8_MMA(1, 1, At, B1); PG8_BAR; PG8_SCHED;
            } else {
            PG8_LDB(B0, 0, 0); PG8_SCHED; PG8_LDA(At, 0, 0); PG8_STAGE_X(PG8_SA(1, 1), a1 + hstep, voffA, AUXA);
            PG8_WAIT_L(8); PG8_BAR; PG8_WAIT_L(0); PG8_MMA(0, 0, At, B0); PG8_BAR; PG8_SCHED;
            PG8_LDB(B1, 0, 1); PG8_STAGE_X(PG8_SB(0, 0), b2, voffB, AUXB);
            PG8_BAR; PG8_WAIT_L(0); PG8_MMA(0, 1, At, B1); PG8_BAR;
            PG8_LDA(At, 0, 1); PG8_STAGE_X(PG8_SA(0, 0), a2, voffA, AUXA);
            PG8_BAR; PG8_WAIT_L(0); PG8_MMA(1, 0, At, B0); PG8_BAR; PG8_SCHED;
            PG8_STAGE_X(PG8_SB(0, 1), b2 + hstep, voffB, AUXB);
            PG8_WAIT_V(6); PG8_BAR; PG8_MMA(1, 1, At, B1); PG8_BAR;
            PG8_LDB(B0, 1, 0); PG8_SCHED; PG8_LDA(At, 1, 0); PG8_STAGE_X(PG8_SA(0, 1), a2 + hstep, voffA, AUXA);
            PG8_WAIT_L(8); PG8_BAR; PG8_WAIT_L(0); PG8_MMA(0, 0, At, B0); PG8_BAR; PG8_SCHED;
            PG8_LDB(B1, 1, 1); PG8_STAGE_X(PG8_SB(1, 0), b3, voffB, AUXB);
            PG8_BAR; PG8_WAIT_L(0); PG8_MMA(0, 1, At, B1); PG8_BAR;
            PG8_LDA(At, 1, 1); PG8_STAGE_X(PG8_SA(1, 0), a3, voffA, AUXA);
            PG8_BAR; PG8_WAIT_L(0); PG8_MMA(1, 0, At, B0); PG8_BAR; PG8_SCHED;
            PG8_STAGE_X(PG8_SB(1, 1), b3 + hstep, voffB, AUXB);
            PG8_WAIT_V(6); PG8_BAR; PG8_MMA(1, 1, At, B1); PG8_BAR;
            }
        }
        if constexpr (ALIGN_EPI) { if (wr == 0) PG8_BAR; }
        if constexpr (!Epi::AFTER_DRAIN) { E(acc, cur, wr, wc, fr, fq); S.done(cur); }
        if (!has_next) break;
#pragma unroll
        for (int a = 0; a < 2; ++a)
#pragma unroll
            for (int b = 0; b < 2; ++b)
#pragma unroll
                for (int m = 0; m < 4; ++m)
#pragma unroll
                    for (int n = 0; n < 2; ++n) acc[a][b][m][n] = (f32x4){0.f, 0.f, 0.f, 0.f};
        cur = nxt; cA = nA; cB = nB; ++ui;
        if constexpr (ALIGN_EPI) { if (wr == 1) PG8_BAR; }
    }
    PG8_WAIT_V(0);
    if constexpr (!ALIGN_EPI) { if (wr == 0) PG8_BAR; }
    PG8_BAR;
    if constexpr (Epi::AFTER_DRAIN) { E.fused(acc, cur, wr, wc, fr, fq, lds, wid, lane); S.done(cur); }
#undef PG8_SA
#undef PG8_SB
#undef PG8_STAGE_X
#undef PG8_LDA
#undef PG8_LDB
#undef PG8_MMA
#undef PG8_WAIT_V
#undef PG8_WAIT_L
#undef PG8_BAR
#undef PG8_SCHED
}
}
namespace att {
#ifndef ATT_NT_OUT
#define ATT_NT_OUT 0
#endif
#define ATT_LAS __attribute__((address_space(3)))
typedef unsigned short bf16_t;
typedef short bf16x8 __attribute__((ext_vector_type(8)));
typedef short s16x4 __attribute__((ext_vector_type(4)));
typedef float f32x16 __attribute__((ext_vector_type(16)));
typedef float f32x4 __attribute__((ext_vector_type(4)));
typedef unsigned u32x4 __attribute__((ext_vector_type(4)));
typedef unsigned u32x2 __attribute__((ext_vector_type(2)));
constexpr int SEQ = 2048, PITCH = 4608, OPITCH = 2048;
__device__ __forceinline__ unsigned cvtpk(float lo, float hi) { typedef float f2_t __attribute__((ext_vector_type(2))); typedef __bf16 b2_t __attribute__((ext_vector_type(2))); f2_t v = {lo, hi}; b2_t b = __builtin_convertvector(v, b2_t); return __builtin_bit_cast(unsigned, b); }
__device__ __forceinline__ float swapmax(float m) { auto rr = __builtin_amdgcn_permlane32_swap(__float_as_uint(m), __float_as_uint(m), false, false); return fmaxf(__uint_as_float(rr[0]), __uint_as_float(rr[1])); }
__device__ __forceinline__ float swapsum(float m) { auto rr = __builtin_amdgcn_permlane32_swap(__float_as_uint(m), __float_as_uint(m), false, false); return __uint_as_float(rr[0]) + __uint_as_float(rr[1]); }
__device__ __forceinline__ s16x4 vtr(ATT_LAS const char* p) { return __builtin_bit_cast(s16x4, __builtin_amdgcn_ds_read_tr16_b64_v4i16((ATT_LAS s16x4*)p)); }

struct UnitP {
    int b, q0;
    int qcol, kcol, vcol;
    int kofs;
    float slope2;
    float m_init, l_init;
    int T0, T1;
    int tlo, thi;
    int window;
    int maskall;
    int ocol;
};

template <int DV, int KW>
__device__ __forceinline__ void attn_unit(ATT_LAS char* lds, const bf16_t* __restrict__ P, bf16_t* __restrict__ MIX, const UnitP up, bool diff, float lam, const float* __restrict__ subln_w, int tid,
                                          bool prefetched  , bool has_next, int nb, int nkcol, int nvcol, int nT0, int nT1  ) {
    static_assert(KW == DV && (KW == 128 || KW == 64), "tile geometry");
    constexpr int ROWB = KW * 2, CPR = ROWB / 16, RPP = 1024 / ROWB, NP = 64 / RPP / 8, TILEB = 64 * ROWB, STG = 2 * TILEB, NSTG = 4, NEB = DV / 32, NI = 2 * NP;
    constexpr bool WIDE = (KW == 128);
    const int lane = tid & 63, wid = __builtin_amdgcn_readfirstlane(tid >> 6), r32 = lane & 31, hi = lane >> 5, wq = wid & 3, g = wid >> 2;
    const int qw = up.q0 + 32 * wq, q = qw + r32;
    const size_t rowbase = (size_t)up.b * SEQ;
    __syncthreads();
    unsigned kso[NP], vso[NP];
#pragma unroll
    for (int i = 0; i < NP; ++i) { const int piece = wid + 8 * i, row = RPP * piece + lane / CPR, slot = lane % CPR;
        const int kch = WIDE ? (slot ^ (row & 15)) : (slot ^ ((row >> 1) & 7));
        const int vch = ((((slot >> 2) ^ (WIDE ? (row & 3) : ((row >> 1) & 1))) << 2) | (slot & 3));
        kso[i] = (unsigned)(row * PITCH + up.kcol + kch * 8); vso[i] = (unsigned)(row * PITCH + up.vcol + vch * 8); }
    const bf16_t* Pb = P + rowbase * PITCH;
#define ATT_DMA2(pb_, dk_, dv_, t, sg) do { const bf16_t* tb_ = (pb_) + (size_t)(t) * 64 * PITCH; \
    _Pragma("unroll") for (int i_ = 0; i_ < NP; ++i_) { \
        __builtin_amdgcn_global_load_lds((const unsigned*)(tb_ + (kso[i_] + (dk_))), (ATT_LAS unsigned*)(lds + (sg) * STG + (wid + 8 * i_) * 1024), 16, 0, 0); \
        __builtin_amdgcn_global_load_lds((const unsigned*)(tb_ + (vso[i_] + (dv_))), (ATT_LAS unsigned*)(lds + (sg) * STG + TILEB + (wid + 8 * i_) * 1024), 16, 0, 0); } } while (0)
#define ATT_DMA(t, sg) ATT_DMA2(Pb, 0u, 0u, t, sg)
    const int rot = prefetched ? 2 : 0;
    bf16x8 qr[4];
    { const bf16_t* qp = P + (rowbase + q) * PITCH + up.qcol + hi * 8;
#pragma unroll
      for (int d0 = 0; d0 < 4; ++d0) qr[d0] = *(const bf16x8*)(qp + d0 * 16); }
    if (!prefetched) {
#pragma unroll
        for (int j = 0; j < 2; ++j) if (up.T0 + j <= up.T1) ATT_DMA(up.T0 + j, j); }
    f32x16 o[NEB];
#pragma unroll
    for (int e = 0; e < NEB; ++e)
#pragma unroll
        for (int r = 0; r < 16; ++r) o[e][r] = 0.f;
    float mhat = up.l_init != 0.f ? up.m_init + up.slope2 * (float)q : 0.f, l = hi == 0 ? up.l_init : 0.f;
    float cb[16];
#pragma unroll
    for (int r = 0; r < 16; ++r) cb[r] = up.slope2 * (float)((r & 3) + 8 * (r >> 2));
    int kad[4];
#pragma unroll
    for (int d0 = 0; d0 < 4; ++d0) { const int c = (up.kofs >> 4) + 2 * d0 + hi; kad[d0] = r32 * ROWB + ((WIDE ? (c ^ (r32 & 15)) : (c ^ ((r32 >> 1) & 7))) << 4); }
    const int i16 = lane & 15, q4 = i16 >> 2, vsw = WIDE ? q4 : (q4 >> 1);
    const int vlane = TILEB + (4 * hi + q4) * ROWB + 32 * ((lane >> 4) & 1) + 8 * (i16 & 3);
    int vad[NEB];
#pragma unroll
    for (int e = 0; e < NEB; ++e) vad[e] = vlane + ((e ^ vsw) << 6);
    bf16x8 pa[4];
#define ATT_PV(sgi) do { ATT_LAS const char* Sv_ = lds + (sgi) * STG; __builtin_amdgcn_s_setprio(1); \
    _Pragma("unroll") for (int e = 0; e < NEB; ++e) _Pragma("unroll") for (int ks = 0; ks < 4; ++ks) { \
        const s16x4 lo = vtr(Sv_ + vad[e] + ks * 16 * ROWB), hh = vtr(Sv_ + vad[e] + ks * 16 * ROWB + 8 * ROWB); \
        const bf16x8 vf = {lo[0], lo[1], lo[2], lo[3], hh[0], hh[1], hh[2], hh[3]}; \
        o[e] = __builtin_amdgcn_mfma_f32_32x32x16_bf16(vf, pa[ks], o[e], 0, 0, 0); } __builtin_amdgcn_s_setprio(0); } while (0)
    for (int t = up.T0; t <= up.T1 + 1; ++t) {
        const int sg = (t - up.T0 + rot) & (NSTG - 1);
        if (t + 1 <= up.T1) { if (NI == 4) asm volatile("s_waitcnt vmcnt(4) lgkmcnt(0)" ::: "memory"); else asm volatile("s_waitcnt vmcnt(2) lgkmcnt(0)" ::: "memory"); }
        else asm volatile("s_waitcnt vmcnt(0) lgkmcnt(0)" ::: "memory");
        __builtin_amdgcn_s_barrier();
        asm volatile("" ::: "memory");
        if (t + 2 <= up.T1) ATT_DMA(t + 2, (sg + 2) & (NSTG - 1));
        if (g == 1 && t - 1 >= up.tlo && t - 1 <= up.thi && t - 1 >= up.T0) ATT_PV((sg + NSTG - 1) & (NSTG - 1));
        if (t >= up.tlo && t <= up.thi && t <= up.T1) {
            ATT_LAS const char* Sb = lds + sg * STG;
            f32x16 p0, p1;
            { const float base0 = up.slope2 * (float)(64 * t + 4 * hi) - mhat, base1 = base0 + 32.f * up.slope2;
#pragma unroll
              for (int r = 0; r < 16; ++r) { p0[r] = cb[r] + base0; p1[r] = cb[r] + base1; } }
            __builtin_amdgcn_s_setprio(1);
#pragma unroll
            for (int d0 = 0; d0 < 4; ++d0) {
                const bf16x8 k0 = *(ATT_LAS const bf16x8*)(Sb + kad[d0]), k1 = *(ATT_LAS const bf16x8*)(Sb + kad[d0] + 32 * ROWB);
                p0 = __builtin_amdgcn_mfma_f32_32x32x16_bf16(k0, qr[d0], p0, 0, 0, 0);
                p1 = __builtin_amdgcn_mfma_f32_32x32x16_bf16(k1, qr[d0], p1, 0, 0, 0);
            }
            __builtin_amdgcn_s_setprio(0);
            if (up.maskall || t == up.thi) {
                const int kvb = 64 * t + 4 * hi, qlo = q - up.window;
#pragma unroll
                for (int r = 0; r < 16; ++r) { const int kv = kvb + (r & 3) + 8 * (r >> 2);
                    if (kv > q || kv <= qlo) p0[r] = -INFINITY;
                    if (kv + 32 > q || kv + 32 <= qlo) p1[r] = -INFINITY; }
            }
            float ra = fmaxf(fmaxf(p0[0], p0[1]), p1[0]), rb = fmaxf(fmaxf(p0[2], p0[3]), p1[1]); ra = fmaxf(fmaxf(ra, p1[2]), p1[3]);
#pragma unroll
            for (int r = 4; r < 16; r += 4) { ra = fmaxf(fmaxf(ra, p0[r]), p0[r + 1]); rb = fmaxf(fmaxf(rb, p0[r + 2]), p0[r + 3]); ra = fmaxf(fmaxf(ra, p1[r]), p1[r + 1]); rb = fmaxf(fmaxf(rb, p1[r + 2]), p1[r + 3]); }
            const float rm = swapmax(fmaxf(ra, rb));
            if (__any(rm > 8.f)) {
                const float dl = fmaxf(rm, 0.f), alpha = __builtin_amdgcn_exp2f(-dl);
                mhat += dl; l *= alpha;
#pragma unroll
                for (int r = 0; r < 16; ++r) { p0[r] -= dl; p1[r] -= dl; }
#pragma unroll
                for (int e = 0; e < NEB; ++e)
#pragma unroll
                    for (int r = 0; r < 16; ++r) o[e][r] *= alpha;
            }
            float ps = 0.f;
#pragma unroll
            for (int r = 0; r < 16; ++r) { p0[r] = __builtin_amdgcn_exp2f(p0[r]); p1[r] = __builtin_amdgcn_exp2f(p1[r]); ps += p0[r] + p1[r]; }
            l += ps;
#pragma unroll
            for (int s = 0; s < 2; ++s) {
                u32x4 w0, w1;
                w0.x = cvtpk(p0[8 * s + 0], p0[8 * s + 1]); w0.y = cvtpk(p0[8 * s + 2], p0[8 * s + 3]); w0.z = cvtpk(p0[8 * s + 4], p0[8 * s + 5]); w0.w = cvtpk(p0[8 * s + 6], p0[8 * s + 7]);
                w1.x = cvtpk(p1[8 * s + 0], p1[8 * s + 1]); w1.y = cvtpk(p1[8 * s + 2], p1[8 * s + 3]); w1.z = cvtpk(p1[8 * s + 4], p1[8 * s + 5]); w1.w = cvtpk(p1[8 * s + 6], p1[8 * s + 7]);
                pa[s] = __builtin_bit_cast(bf16x8, w0); pa[2 + s] = __builtin_bit_cast(bf16x8, w1);
            }
            if (g == 0) ATT_PV(sg);
        }
    }
#undef ATT_PV
    asm volatile("s_waitcnt vmcnt(0) lgkmcnt(0)" ::: "memory");
    __builtin_amdgcn_s_barrier();
    asm volatile("" ::: "memory");
    if (has_next) {
        const bf16_t* Pn = P + (size_t)nb * SEQ * PITCH; const unsigned dk = (unsigned)(nkcol - up.kcol), dv = (unsigned)(nvcol - up.vcol);
#pragma unroll
        for (int j = 0; j < 2; ++j) if (nT0 + j <= nT1) ATT_DMA2(Pn, dk, dv, nT0 + j, 2 + j);
    }
#undef ATT_DMA
#undef ATT_DMA2
    const float lt = swapsum(l), inv = 1.f / lt;
    constexpr int ORS = DV * 2 + 16, OCH = DV / 8, ORPI = 64 / OCH  ;
    if (!diff) {
        ATT_LAS char* ot = lds + 4 * STG + wid * (32 * ORS);
#pragma unroll
        for (int e = 0; e < NEB; ++e)
#pragma unroll
            for (int r4 = 0; r4 < 4; ++r4) { u32x2 w; w.x = cvtpk(o[e][4 * r4] * inv, o[e][4 * r4 + 1] * inv); w.y = cvtpk(o[e][4 * r4 + 2] * inv, o[e][4 * r4 + 3] * inv);
                *(ATT_LAS u32x2*)(ot + r32 * ORS + (e * 32 + 8 * r4 + 4 * hi) * 2) = w; }
        bf16_t* ob = MIX + (rowbase + qw) * OPITCH + up.ocol;
#pragma unroll
        for (int j = 0; j < 32 / ORPI; ++j) { const int row = j * ORPI + lane / OCH, ch = lane % OCH; const u32x4 v = *(ATT_LAS const u32x4*)(ot + row * ORS + ch * 16); *(u32x4*)(ob + (size_t)row * OPITCH + ch * 8) = v; }
    } else {
        ATT_LAS float* xb = (ATT_LAS float*)(lds + wq * (NEB * 16 * 64 * 4)) + lane;
        if (g == 1) { const float sc = lam * inv;
#pragma unroll
            for (int e = 0; e < NEB; ++e)
#pragma unroll
                for (int r = 0; r < 16; ++r) xb[(e * 16 + r) * 64] = o[e][r] * sc; }
        __syncthreads();
        if (g == 0) { float ss = 0.f;
#pragma unroll
            for (int e = 0; e < NEB; ++e)
#pragma unroll
                for (int r = 0; r < 16; ++r) { const float d = o[e][r] * inv - xb[(e * 16 + r) * 64]; o[e][r] = d; ss += d * d; }
            ss = swapsum(ss);
            const float rs = rsqrtf(ss * (1.f / DV) + 1e-5f) * 0.8f;
            ATT_LAS char* ot = lds + wq * (NEB * 16 * 64 * 4);
            asm volatile("s_waitcnt lgkmcnt(0)" ::: "memory");
#pragma unroll
            for (int e = 0; e < NEB; ++e)
#pragma unroll
                for (int r4 = 0; r4 < 4; ++r4) { const f32x4 wv = *(const f32x4*)(subln_w + e * 32 + 8 * r4 + 4 * hi);
                    u32x2 w; w.x = cvtpk(o[e][4 * r4] * rs * wv[0], o[e][4 * r4 + 1] * rs * wv[1]); w.y = cvtpk(o[e][4 * r4 + 2] * rs * wv[2], o[e][4 * r4 + 3] * rs * wv[3]);
                    *(ATT_LAS u32x2*)(ot + r32 * ORS + (e * 32 + 8 * r4 + 4 * hi) * 2) = w; }
            bf16_t* ob = MIX + (rowbase + qw) * OPITCH + up.ocol;
#pragma unroll
            for (int j = 0; j < 32 / ORPI; ++j) { const int row = j * ORPI + lane / OCH, ch = lane % OCH; const u32x4 v = *(ATT_LAS const u32x4*)(ot + row * ORS + ch * 16); *(u32x4*)(ob + (size_t)row * OPITCH + ch * 8) = v; } }
    }
}
}
constexpr int NWAVES = 8;
#ifndef CV_ROT
#define CV_ROT 0
#endif
#ifndef CV_NTS
#define CV_NTS false
#endif
#ifndef P4_ALIGN
#define P4_ALIGN true
#endif
#ifndef WGM_P1
#define WGM_P1 4
#endif
#ifndef WGM_P3
#define WGM_P3 4
#endif
#ifndef WGM_P4
#define WGM_P4 8
#endif
#ifndef WGM_P5
#define WGM_P5 4
#endif
#ifndef FUSE_FINAL
#define FUSE_FINAL 0
#endif
#ifndef GEMM_SP2
#define GEMM_SP2 true
#endif
#ifndef MK_N_LAUNCHES
#define MK_N_LAUNCHES 1
#endif
constexpr int N_PHASES = 7;
constexpr int BATCH = 8, SEQ = 2048, D = 2048, M = BATCH * SEQ, INC = 4608, DFF = 5632, NGU = 2 * DFF;
constexpr float RMS_EPS = 1e-5f;
constexpr float QSCALE2 = 0.125f * 1.4426950408889634f;
constexpr size_t MiB = 1u << 20;
constexpr size_t WS_PART1 = 1 * MiB, WS_PART2 = 3 * MiB;
constexpr size_t WS_WIN = 8 * MiB, WS_WOUT = 26 * MiB, WS_WGU = 34 * MiB, WS_WDN = 78 * MiB;
constexpr size_t WS_XN = 100 * MiB;
constexpr size_t WS_PROJ = 164 * MiB, WS_MIX = 308 * MiB;
constexpr size_t WS_H = 164 * MiB;
constexpr size_t WS_END = 372 * MiB;
static_assert(WS_H + (size_t)M * DFF * 2 <= WS_END && WS_MIX + (size_t)M * D * 2 <= WS_END && WS_PROJ + (size_t)M * INC * 2 <= WS_MIX, "ws map");
constexpr int RING_BYTES = 131072, LDS_BYTES = 147456;

#define LAS __attribute__((address_space(3)))
typedef unsigned short bf16;
typedef unsigned v4u __attribute__((ext_vector_type(4)));
typedef float f32x4 __attribute__((ext_vector_type(4)));
__device__ __forceinline__ unsigned pk2(float lo, float hi) { return pg8::cvt_pk_bf16(lo, hi); }
__device__ __forceinline__ float wave_sum(float v) {
#pragma unroll
    for (int o = 1; o < 64; o <<= 1) v += __shfl_xor(v, o);
    return v;
}
template <int NB> __device__ __forceinline__ void transpose_item(const float* __restrict__ W, int K, int N, bf16* __restrict__ WT, int dst_row0, const float* __restrict__ kscale, float cscale, LAS float* scr, int k0, int n0, int lane, bool nts = false) {
    const float* src = W + (size_t)(k0 + (lane >> 4)) * N + n0 + 4 * (lane & 15);
#pragma unroll
    for (int b = 0; b < 16 / NB; ++b) {
        f32x4 v[NB];
#pragma unroll
        for (int i = 0; i < NB; ++i) v[i] = __builtin_nontemporal_load((const f32x4*)(src + (size_t)(4 * (b * NB + i)) * N));
#pragma unroll
        for (int i = 0; i < NB; ++i) { const int kk = 4 * (b * NB + i) + (lane >> 4); float sc = cscale; if (kscale) sc *= kscale[k0 + kk];
            LAS float* d = scr + kk * 65 + 4 * (lane & 15); d[0] = v[i].x * sc; d[1] = v[i].y * sc; d[2] = v[i].z * sc; d[3] = v[i].w * sc; }
        if (NB < 16) asm volatile("" ::: "memory");
    }
    asm volatile("s_waitcnt lgkmcnt(0)" ::: "memory");
    const int c = lane & 7;
#pragma unroll
    for (int j = 0; j < 8; ++j) { const int n = (lane >> 3) + 8 * j; const LAS float* s = scr + (8 * c) * 65 + n;
        v4u o; o.x = pk2(s[0 * 65], s[1 * 65]); o.y = pk2(s[2 * 65], s[3 * 65]); o.z = pk2(s[4 * 65], s[5 * 65]); o.w = pk2(s[6 * 65], s[7 * 65]);
        v4u* dp = (v4u*)(WT + (size_t)(dst_row0 + n) * K + k0 + 8 * c); if (nts) __builtin_nontemporal_store(o, dp); else *dp = o; }
    asm volatile("s_waitcnt lgkmcnt(0)" ::: "memory");
}

#define XB_TMO      128
#define XB_XCNT(j)  (256  + 64 * (j))
#define XB_XSUB(j)  (1280 + 64 * (j))
#define XB_XGEN(j)  (2304 + 64 * (j))
#define XB_TOP      3328
#define XB_TOPGEN   3392
#define XCD_BAR_WORDS 3456
#define XB_SPIN_CAP (1u << 18)

__device__ __forceinline__ unsigned xb_ld(unsigned* p)              { return __hip_atomic_load(p, __ATOMIC_RELAXED, __HIP_MEMORY_SCOPE_AGENT); }
__device__ __forceinline__ unsigned xb_add(unsigned* p, unsigned v) { return __hip_atomic_fetch_add(p, v, __ATOMIC_RELAXED, __HIP_MEMORY_SCOPE_AGENT); }
__device__ __forceinline__ unsigned xb_xcc_id() { return (unsigned)__builtin_amdgcn_s_getreg((3 << 11) | 20) & 0xFu; }
#define XB_SPIN(cond, bar) do { unsigned _sp = 0; while (cond) { __builtin_amdgcn_s_sleep(1); \
    if ((++_sp & 255u) == 0u) { if (xb_ld(&(bar)[XB_TMO])) break; if (_sp > XB_SPIN_CAP) { atomicAdd(&(bar)[XB_TMO], 1u); break; } } } } while (0)

struct XcdBarrier {
    unsigned* bar; unsigned x;
    volatile LAS unsigned* st;
};

__device__ __forceinline__ XcdBarrier xcd_barrier_post(unsigned* bar, volatile LAS unsigned* st) {
    XcdBarrier b; b.bar = bar; b.x = xb_xcc_id(); b.st = st;
    if (threadIdx.x == 0) (void)xb_add(&bar[XB_XCNT(b.x)], 1u);
    return b;
}
__device__ __forceinline__ void xcd_barrier_complete(unsigned* bar, unsigned x, unsigned& nloc, unsigned& nx) {
    const unsigned G = gridDim.x * gridDim.y * gridDim.z;
    unsigned sum, cnt, mine, sp = 0u;
    for (;;) {
        sum = 0u; cnt = 0u; mine = 0u;
#pragma unroll
        for (unsigned j = 0; j < 16; ++j) { const unsigned c = xb_ld(&bar[XB_XCNT(j)]); sum += c; cnt += (c > 0u) ? 1u : 0u; mine = (j == x) ? c : mine; }
        if (sum == G) break;
        __builtin_amdgcn_s_sleep(1);
        if ((++sp & 255u) == 0u) { if (xb_ld(&bar[XB_TMO])) break; if (sp > XB_SPIN_CAP) { atomicAdd(&bar[XB_TMO], 1u); break; } }
    }
    nloc = mine > 0u ? mine : 1u; nx = cnt > 0u ? cnt : 1u;
}

__device__ __forceinline__ void xcd_barrier(const XcdBarrier& b) {
    asm volatile("s_waitcnt vmcnt(0)" ::: "memory");
    __syncthreads();
    if (threadIdx.x == 0) {
        unsigned* bar = b.bar;
        __builtin_amdgcn_s_waitcnt(0);
        unsigned nloc = b.st[0], nx = b.st[1];
        if (nloc == 0u) { xcd_barrier_complete(bar, b.x, nloc, nx); b.st[0] = nloc; b.st[1] = nx; }
        const unsigned old = xb_add(&bar[XB_XSUB(b.x)], 1u);
        const unsigned gen = old / nloc;
        if (old + 1u == (gen + 1u) * nloc) {
            __builtin_amdgcn_fence(__ATOMIC_RELEASE, "agent");
            asm volatile("s_waitcnt vmcnt(0)" ::: "memory");
            const unsigned og = xb_add(&bar[XB_TOP], 1u);
            const unsigned tg = og / nx;
            if (og + 1u == (tg + 1u) * nx) xb_add(&bar[XB_TOPGEN], 1u);
            else XB_SPIN(xb_ld(&bar[XB_TOPGEN]) == tg, bar);
            __builtin_amdgcn_fence(__ATOMIC_ACQUIRE, "agent");
            xb_add(&bar[XB_XGEN(b.x)], 1u);
            asm volatile("s_waitcnt vmcnt(0)" ::: "memory");
        } else {
            XB_SPIN(xb_ld(&bar[XB_XGEN(b.x)]) == gen, bar);
            __builtin_amdgcn_fence(__ATOMIC_ACQUIRE, "agent");
            asm volatile("s_waitcnt vmcnt(0)" ::: "memory");
        }
    }
    __syncthreads();
}

struct PrefetchOrder {
    pg8::StaticOrder S; const char* base; unsigned row_bytes, tile_bytes; LAS unsigned char* dump;
    __device__ __forceinline__ bool next(int i, pg8::Unit& u) const { return S.next(i, u); }
    __device__ __forceinline__ void done(const pg8::Unit&) const {}
    __device__ __forceinline__ void a_ready(const pg8::Unit& u) const {
        const int tid = threadIdx.x, wid = __builtin_amdgcn_readfirstlane(tid >> 6); const unsigned lpr = tile_bytes >> 7, nline = 256u * lpr;
        const char* tb = base + (size_t)u.pm * 256 * row_bytes + (size_t)u.pn * tile_bytes;
        for (unsigned line = tid; line < nline; line += 512) { const unsigned r = line / lpr, l = line % lpr;
            __builtin_amdgcn_global_load_lds((const unsigned*)(tb + (size_t)r * row_bytes + l * 128), (LAS unsigned*)(dump + wid * 256), 4, 0, 0); }
    }
};
struct TwiceOrder { pg8::StaticOrder S; __device__ bool next(int i, pg8::Unit& u) const { return S.next(i >> 1, u); } __device__ __forceinline__ void a_ready(const pg8::Unit&) const {} __device__ __forceinline__ void done(const pg8::Unit&) const {} };
struct Args { const float* in[15]; float* out; unsigned char* ws; int ph_lo, ph_hi; };
enum { I_X = 0, I_ANW, I_WIN, I_LQ1, I_LK1, I_LQ2, I_LK2, I_SUBLN, I_SINKS, I_WOUT, I_FNW, I_WG, I_WU, I_WD, I_FINW };

__device__ __forceinline__ void item_kn(int r, int nblk_n, int& k0, int& n0) { const int g8 = r >> 3, w = r & 7, hn = nblk_n >> 1; n0 = 64 * (2 * (g8 % hn) + (w & 1)); k0 = 64 * (4 * (g8 / hn) + (w >> 1)); }
#ifndef CV_SPLIT
#define CV_SPLIT 0
#endif
#ifndef CV_SA
#define CV_SA 48
#endif
constexpr int CV_IN = (D / 64) * (INC / 64), CV_OUT = (D / 64) * (D / 64), CV_G = (D / 64) * (DFF / 64), CV_DN = (DFF / 64) * (D / 64), CV_ALL = CV_IN + CV_OUT + 2 * CV_G + CV_DN, CV_T0 = CV_IN + CV_OUT, CV_T1 = CV_T0 + CV_G;
template <int NB> __device__ __forceinline__ void convert_weights(const Args& args, unsigned char* ws, LAS float* scr, int first, int last, int skip0, int skip1, int widx, int nw, int lane) {
    bf16* Win_t = (bf16*)(ws + WS_WIN); bf16* Wout_t = (bf16*)(ws + WS_WOUT); bf16* Wgu_t = (bf16*)(ws + WS_WGU); bf16* Wdn_t = (bf16*)(ws + WS_WDN);
    for (int it = first + widx; it < last - (skip1 - skip0); it += nw) {
        int r = it; if (r >= skip0) r += skip1 - skip0;
        if (CV_ROT && first == 0 && last == CV_ALL) { r += CV_IN; if (r >= CV_ALL) r -= CV_ALL; }
        if (r < CV_IN) { int k0, n0; item_kn(r, INC / 64, k0, n0); const float cs = (n0 < 1024 || (n0 >= 3072 && n0 < 4096)) ? QSCALE2 : 1.f;
            transpose_item<NB>(args.in[I_WIN], D, INC, Win_t, n0, nullptr, cs, scr, k0, n0, lane); continue; } r -= CV_IN;
        if (r < CV_OUT) { int k0, n0; item_kn(r, D / 64, k0, n0); transpose_item<NB>(args.in[I_WOUT], D, D, Wout_t, n0, nullptr, 1.f, scr, k0, n0, lane, CV_NTS); continue; } r -= CV_OUT;
        if (r < 2 * CV_G) { const int up = r >= CV_G; if (up) r -= CV_G; int k0, n0; item_kn(r, DFF / 64, k0, n0);
            transpose_item<NB>(args.in[up ? I_WU : I_WG], D, DFF, Wgu_t, 256 * (n0 / 128) + 128 * up + (n0 % 128), args.in[I_FNW], 1.f, scr, k0, n0, lane, CV_NTS); continue; } r -= 2 * CV_G;
        { int k0, n0; item_kn(r, D / 64, k0, n0); transpose_item<NB>(args.in[I_WD], DFF, D, Wdn_t, n0, nullptr, 1.f, scr, k0, n0, lane, CV_NTS); }
    }
}

struct CvItem { const float* src; bf16* dst; const float* kscale; float cscale; int N, K; };
__device__ __forceinline__ bool cv_decode(const Args& args, unsigned char* ws, int r, int last, int lane, CvItem& it) {
    if (r >= last) return false;
    bf16* Win_t = (bf16*)(ws + WS_WIN); bf16* Wout_t = (bf16*)(ws + WS_WOUT); bf16* Wgu_t = (bf16*)(ws + WS_WGU); bf16* Wdn_t = (bf16*)(ws + WS_WDN);
    int k0, n0, row0; const float* W; bf16* WT; it.kscale = nullptr; it.cscale = 1.f;
    if (r < CV_IN) { item_kn(r, INC / 64, k0, n0); W = args.in[I_WIN]; WT = Win_t; it.N = INC; it.K = D; row0 = n0; it.cscale = (n0 < 1024 || (n0 >= 3072 && n0 < 4096)) ? QSCALE2 : 1.f; }
    else if ((r -= CV_IN) < CV_OUT) { item_kn(r, D / 64, k0, n0); W = args.in[I_WOUT]; WT = Wout_t; it.N = D; it.K = D; row0 = n0; }
    else if ((r -= CV_OUT) < 2 * CV_G) { const int up = r >= CV_G; if (up) r -= CV_G; item_kn(r, DFF / 64, k0, n0); W = args.in[up ? I_WU : I_WG]; WT = Wgu_t; it.N = DFF; it.K = D; row0 = 256 * (n0 / 128) + 128 * up + (n0 % 128); it.kscale = args.in[I_FNW] + k0; }
    else { r -= 2 * CV_G; item_kn(r, D / 64, k0, n0); W = args.in[I_WD]; WT = Wdn_t; it.N = D; it.K = DFF; row0 = n0; }
    it.src = W + (size_t)(k0 + (lane >> 4)) * it.N + n0 + 4 * (lane & 15);
    it.dst = WT + (size_t)row0 * it.K + k0;
    return true;
}
__device__ __forceinline__ void cv_load(const CvItem& it, f32x4 (&v)[16]) {
#pragma unroll
    for (int i = 0; i < 16; ++i) v[i] = *(const f32x4*)(it.src + (size_t)(4 * i) * it.N);
}
__device__ __forceinline__ void cv_finish(const CvItem& it, const f32x4 (&v)[16], LAS float* scr, int lane) {
#pragma unroll
    for (int i = 0; i < 16; ++i) { const int kk = 4 * i + (lane >> 4); float sc = it.cscale; if (it.kscale) sc *= it.kscale[kk];
        LAS float* d = scr + kk * 65 + 4 * (lane & 15); d[0] = v[i].x * sc; d[1] = v[i].y * sc; d[2] = v[i].z * sc; d[3] = v[i].w * sc; }
    asm volatile("s_waitcnt lgkmcnt(0)" ::: "memory");
    const int c = lane & 7;
#pragma unroll
    for (int j = 0; j < 8; ++j) { const int n = (lane >> 3) + 8 * j; const LAS float* s = scr + (8 * c) * 65 + n;
        v4u o; o.x = pk2(s[0 * 65], s[1 * 65]); o.y = pk2(s[2 * 65], s[3 * 65]); o.z = pk2(s[4 * 65], s[5 * 65]); o.w = pk2(s[6 * 65], s[7 * 65]);
        *(v4u*)(it.dst + (size_t)n * it.K + 8 * c) = o; }
    asm volatile("s_waitcnt lgkmcnt(0)" ::: "memory");
}
__device__ __forceinline__ void convert_weights_pipe(const Args& args, unsigned char* ws, LAS float* scr, int first, int last, int widx, int nw, int lane) {
    CvItem ia, ib; f32x4 va[16], vb[16];
    int r = first + widx;
    bool ha = cv_decode(args, ws, r, last, lane, ia); if (ha) cv_load(ia, va);
    while (ha) {
        const bool hb = cv_decode(args, ws, r + nw, last, lane, ib); if (hb) cv_load(ib, vb);
        cv_finish(ia, va, scr, lane);
        if (!hb) break;
        r += 2 * nw;
        ha = cv_decode(args, ws, r, last, lane, ia); if (ha) cv_load(ia, va);
        cv_finish(ib, vb, scr, lane);
    }
}

__global__ void __launch_bounds__(NWAVES * 64, 2) hymba_fwd(Args args) {
    extern __shared__ __attribute__((aligned(16))) unsigned char lds_raw[];
    cg::grid_group grid = cg::this_grid();
    LAS unsigned char* lds = (LAS unsigned char*)lds_raw;
    const int tid = threadIdx.x, lane = tid & 63, wave = __builtin_amdgcn_readfirstlane(tid >> 6);
    const int G = gridDim.x, bx = blockIdx.x, vcu = (G % 8 == 0) ? (bx % 8) * (G / 8) + bx / 8 : bx;
    unsigned char* ws = args.ws;
    const float* x = args.in[I_X]; float* out = args.out;
    bf16* Win_t = (bf16*)(ws + WS_WIN); bf16* Wout_t = (bf16*)(ws + WS_WOUT); bf16* Wgu_t = (bf16*)(ws + WS_WGU); bf16* Wdn_t = (bf16*)(ws + WS_WDN);
    bf16* XN = (bf16*)(ws + WS_XN); bf16* PROJ = (bf16*)(ws + WS_PROJ); bf16* MIX = (bf16*)(ws + WS_MIX); bf16* HB = (bf16*)(ws + WS_H);
    float* part1 = (float*)(ws + WS_PART1); float* part2 = (float*)(ws + WS_PART2);
    const int lo = args.ph_lo, hi = args.ph_hi;
    volatile LAS unsigned* bst = (volatile LAS unsigned*)(lds + LDS_BYTES - 64);
    if (tid < 2) bst[tid] = 0u;
    if (tid == 0) { *(LAS unsigned long long*)(lds + LDS_BYTES - 32) = 0ull; }
    __syncthreads();
    XcdBarrier gbar; gbar.bar = (unsigned*)ws; gbar.x = 0; gbar.st = bst;
    if (hi - lo > 1) gbar = xcd_barrier_post((unsigned*)ws, bst);
    if (hi > 1000) grid.sync();
#define IN(k) (lo <= (k) && (k) < hi)
#ifndef SYNC_REPEAT
#define SYNC_REPEAT 1
#endif
#define SEAM(k) do { if (IN(k) && IN((k) + 1)) { for (int sr_ = 0; sr_ < SYNC_REPEAT; ++sr_) xcd_barrier(gbar); } } while (0)
#ifndef PROBE_PHASE
#define PROBE_PHASE -1
#endif
#ifndef STAMP_SEL
#define STAMP_SEL 1
#endif
#ifdef STAMP_PHASE
#define STAMP_BEGIN(k) do { if ((k) == STAMP_PHASE || ((k) == 2 && (STAMP_PHASE == 30 || STAMP_PHASE == 31))) st0_ = __builtin_amdgcn_s_memrealtime(); } while (0)
#define STAMP_END(k) do { if ((k) == STAMP_PHASE) st1_ = __builtin_amdgcn_s_memrealtime(); } while (0)
#else
#define STAMP_BEGIN(k) do {} while (0)
#define STAMP_END(k) do {} while (0)
#endif
    unsigned long long st0_ = 0, st1_ = 0; (void)st0_; (void)st1_;
#define REP(k) for (int rep_ = 0; rep_ < ((PROBE_PHASE == (k)) ? 2 : 1); ++rep_, ((PROBE_PHASE == (k)) && rep_ < 2 ? (xcd_barrier(gbar), 0) : 0))

    STAMP_BEGIN(0); STAMP_BEGIN(41);
    REP(0) if (IN(0)) {
        LAS float* scr = (LAS float*)(lds + wave * 16640);
        const int gw = vcu * NWAVES + wave, NGW = G * NWAVES;
#if defined(P0_TOUCH) && P0_TOUCH
        {
            const int widx[5] = {I_WIN, I_WOUT, I_WG, I_WU, I_WD}; const size_t wn4[5] = {(size_t)D * INC / 4, (size_t)D * D / 4, (size_t)D * DFF / 4, (size_t)D * DFF / 4, (size_t)DFF * D / 4};
            f32x4 acc4 = {0.f, 0.f, 0.f, 0.f};
#pragma unroll
            for (int w = 0; w < 5; ++w) { const f32x4* src = (const f32x4*)args.in[widx[w]];
                for (size_t i = (size_t)gw * 64 + lane; i < wn4[w]; i += (size_t)NGW * 64 * 4) {
                    f32x4 a = src[i], b = (i + (size_t)NGW * 64 < wn4[w]) ? src[i + (size_t)NGW * 64] : acc4, c = (i + (size_t)NGW * 128 < wn4[w]) ? src[i + (size_t)NGW * 128] : acc4, d = (i + (size_t)NGW * 192 < wn4[w]) ? src[i + (size_t)NGW * 192] : acc4;
                    acc4 = acc4 + a + b + c + d; } }
            if (acc4.x + acc4.y + acc4.z + acc4.w == 1.2345e38f) ((float*)(ws + WS_PART2))[gw * 64 + lane] = acc4.x;
        }
#endif
#if defined(P0_MIX) && P0_MIX
#pragma unroll 1
        for (int pass_ = 0; pass_ < 2; ++pass_) {
        if ((pass_ == 0) != ((vcu & 1) != 0)) {
#if defined(CV_PIPE) && CV_PIPE
        convert_weights_pipe(args, ws, scr, 0, CV_SPLIT ? CV_IN : CV_ALL, gw, NGW, lane);
#else
        convert_weights<16>(args, ws, scr, 0, CV_SPLIT ? CV_ALL - 128 * CV_SA : CV_ALL, 0, 0, gw, NGW, lane);
#endif
        } else {
        STAMP_BEGIN(40); __syncthreads(); STAMP_END(41);
        const f32x4* wn = (const f32x4*)args.in[I_ANW] + lane;
        for (int rp_ = 0; rp_ < (PROBE_PHASE == 11 ? 2 : 1); ++rp_)
        for (int m = gw; m < M; m += NGW) {
            const f32x4* xr = (const f32x4*)(x + (size_t)m * D) + lane;
            f32x4 v[8]; float s = 0.f;
#pragma unroll
            for (int j = 0; j < 8; ++j) { v[j] = __builtin_nontemporal_load(xr + 64 * j); s += (v[j].x * v[j].x + v[j].y * v[j].y) + (v[j].z * v[j].z + v[j].w * v[j].w); }
            const float rstd = rsqrtf(wave_sum(s) * (1.f / D) + RMS_EPS);
            unsigned long long* o8 = (unsigned long long*)(XN + (size_t)m * D) + lane;
#pragma unroll
            for (int j = 0; j < 8; ++j) { const f32x4 w = wn[64 * j]; o8[64 * j] = (unsigned long long)pk2(v[j].x * rstd * w.x, v[j].y * rstd * w.y) | ((unsigned long long)pk2(v[j].z * rstd * w.z, v[j].w * rstd * w.w) << 32); }
        }
        }
        }
#else
#if defined(CV_PIPE) && CV_PIPE
        convert_weights_pipe(args, ws, scr, 0, CV_SPLIT ? CV_IN : CV_ALL, gw, NGW, lane);
#else
        convert_weights<16>(args, ws, scr, 0, CV_SPLIT ? CV_ALL - 128 * CV_SA : CV_ALL, 0, 0, gw, NGW, lane);
#endif
        STAMP_BEGIN(40); __syncthreads(); STAMP_END(41);
        const f32x4* wn = (const f32x4*)args.in[I_ANW] + lane;
        for (int rp_ = 0; rp_ < (PROBE_PHASE == 11 ? 2 : 1); ++rp_)
        for (int m = gw; m < M; m += NGW) {
            const f32x4* xr = (const f32x4*)(x + (size_t)m * D) + lane;
            f32x4 v[8]; float s = 0.f;
#pragma unroll
            for (int j = 0; j < 8; ++j) { v[j] = __builtin_nontemporal_load(xr + 64 * j); s += (v[j].x * v[j].x + v[j].y * v[j].y) + (v[j].z * v[j].z + v[j].w * v[j].w); }
            const float rstd = rsqrtf(wave_sum(s) * (1.f / D) + RMS_EPS);
            unsigned long long* o8 = (unsigned long long*)(XN + (size_t)m * D) + lane;
#pragma unroll
            for (int j = 0; j < 8; ++j) { const f32x4 w = wn[64 * j]; o8[64 * j] = (unsigned long long)pk2(v[j].x * rstd * w.x, v[j].y * rstd * w.y) | ((unsigned long long)pk2(v[j].z * rstd * w.z, v[j].w * rstd * w.w) << 32); }
        }
#endif
        __syncthreads();
    }
    SEAM(0);
    STAMP_END(0); STAMP_END(40);
    STAMP_BEGIN(1);
    REP(1) if (IN(1)) {
        pg8::Gemm g{XN, Win_t, M, INC, D}; pg8::StaticOrder S; S.init(M, INC, G, bx, WGM_P1);
        pg8::EpiStore E{PROJ, INC};
#if PROBE_PHASE == 21
        { TwiceOrder S2{S}; pg8::gemm_phase<pg8::EpiStore, TwiceOrder, true, true>(lds, g, S2, E); }
#else
        pg8::gemm_phase<pg8::EpiStore, pg8::StaticOrder, true, GEMM_SP2>(lds, g, S, E);
#endif
        if (CV_SPLIT) { const int nwg = (M / 256) * (INC / 256), maxU = (nwg + G - 1) / G, nIdle = G * maxU - nwg, idx = bx - (G - nIdle);
            const int nw_ = nIdle > 0 ? nIdle : G, id_ = nIdle > 0 ? idx : bx, per = (128 * CV_SA + nw_ - 1) / nw_, f0 = CV_ALL - 128 * CV_SA + id_ * per;
            if (id_ >= 0) convert_weights<8>(args, ws, (LAS float*)(lds + wave * 16640), f0, f0 + per < CV_ALL ? f0 + per : CV_ALL, 0, 0, wave, NWAVES, lane); }
        __syncthreads();
    }
    SEAM(1);
    STAMP_END(1);
    STAMP_BEGIN(2);
    REP(2) if (IN(2)) {
        const float* lq1 = args.in[I_LQ1]; const float* lk1 = args.in[I_LK1]; const float* lq2 = args.in[I_LQ2]; const float* lk2 = args.in[I_LK2];
        const float s1 = wave_sum(lq1[lane] * lk1[lane]), s2 = wave_sum(lq2[lane] * lk2[lane]);
        const float lam = expf(s1) - expf(s2) + 0.2f;
        const int wq = wave & 3, gsel = wave >> 2;
#ifdef ATT_PRIO
        if (gsel == 1) __builtin_amdgcn_s_setprio(1);
#endif
        STAMP_BEGIN(20);
        { const int np = vcu < 512 ? (512 - vcu + G - 1) / G : 0;
#define DIFF_UNIT(u_, up_) do { const int i_ = vcu + G * ((u_) >> 1), bh_ = (i_ >> 3) ^ (((u_) >> 1) & 1 ? 4 : 0)  , xq_ = i_ & 7, h_ = bh_ & 7, qblk_ = ((u_) & 1) ? 15 - xq_ : xq_; \
            up_.b = bh_ >> 3; up_.q0 = 128 * qblk_; up_.qcol = h_ * 128 + gsel * 64; up_.kcol = 1024 + h_ * 128; up_.vcol = 2048 + h_ * 128; up_.kofs = gsel * 128; \
            up_.slope2 = exp2f(-(float)(h_ + 1)) * 1.4426950408889634f; up_.m_init = 0.f; up_.l_init = 0.f; \
            up_.T0 = 0; up_.T1 = 2 * qblk_ + 1; up_.tlo = 0; up_.thi = (up_.q0 + 32 * wq) >> 6; up_.window = 1 << 20; up_.maskall = 0; up_.ocol = h_ * 128; } while (0)
#pragma unroll 1
          for (int u = 0; u < 2 * np; ++u) {
              att::UnitP up, nx; DIFF_UNIT(u, up); const bool hn = u + 1 < 2 * np; if (hn) DIFF_UNIT(u + 1, nx); else nx = up;
              att::attn_unit<128, 128>((LAS char*)lds, PROJ, MIX, up, true, lam, args.in[I_SUBLN], tid, u > 0, hn, nx.b, nx.kcol, nx.vcol, nx.T0, nx.T1);
          }
#undef DIFF_UNIT
        }
        STAMP_END(20); STAMP_BEGIN(21);
        { const int ns = vcu < 1024 ? (1024 - vcu + G - 1) / G : 0;
#define SWA_UNIT(u_, up_) do { const int i_ = vcu + G * (u_), qblk_ = i_ & 15, pair_ = (i_ >> 4) & 1, hkv_ = ((i_ >> 5) + (u_)) & 3, hq_ = hkv_ * 4 + pair_ * 2 + gsel, a_ = 2 * qblk_; \
            up_.b = i_ >> 7; up_.q0 = 128 * qblk_; up_.qcol = 3072 + hq_ * 64; up_.kcol = 4096 + hkv_ * 64; up_.vcol = 4352 + hkv_ * 64; up_.kofs = 0; \
            up_.slope2 = exp2f(-0.5f * (float)(hq_ + 1)) * 1.4426950408889634f; up_.m_init = args.in[I_SINKS][hq_] * 1.4426950408889634f; up_.l_init = 1.f; \
            up_.T0 = a_ - 2 < 0 ? 0 : a_ - 2; up_.T1 = a_ + 1; up_.tlo = a_ - 2 + (wq >> 1); up_.thi = a_ + (wq >> 1); up_.window = 128; up_.maskall = 1; up_.ocol = 1024 + hq_ * 64; } while (0)
#pragma unroll 1
          for (int u = 0; u < ns; ++u) {
              att::UnitP up, nx; SWA_UNIT(u, up); const bool hn = u + 1 < ns; if (hn) SWA_UNIT(u + 1, nx); else nx = up;
              att::attn_unit<64, 64>((LAS char*)lds, PROJ, MIX, up, false, 0.f, nullptr, tid, u > 0, hn, nx.b, nx.kcol, nx.vcol, nx.T0, nx.T1);
          }
#undef SWA_UNIT
        }
        STAMP_END(21);
#ifdef ATT_PRIO
        __builtin_amdgcn_s_setprio(0);
#endif
#if defined(P3_PREFETCH_X) && P3_PREFETCH_X
        {
            pg8::StaticOrder S3; S3.init(M, D, G, bx, WGM_P3); pg8::Unit u3; float pacc = 0.f;
            for (int i = 0; S3.next(i, u3); ++i) {
                const float* tb = x + (size_t)u3.pm * 256 * D + (size_t)u3.pn * 256;
#pragma unroll
                for (int k = 0; k < 4; ++k) { const int line = tid + 512 * k; pacc += tb[(size_t)(line >> 3) * D + (line & 7) * 32]; }
            }
            if (pacc == 1.2345e38f) part2[tid] = pacc;
        }
#endif
        __syncthreads();
#ifdef STAMP_PHASE
        if (STAMP_PHASE == 30 || STAMP_PHASE == 31) { if (tid == 0 && STAMP_SEL) { const unsigned d_ = (unsigned)(__builtin_amdgcn_s_memrealtime() - st0_);
            if (STAMP_PHASE == 30) __hip_atomic_fetch_max((unsigned*)ws + 3500, d_, __ATOMIC_RELAXED, __HIP_MEMORY_SCOPE_AGENT); else __hip_atomic_fetch_max((unsigned*)ws + 3500, ~d_, __ATOMIC_RELAXED, __HIP_MEMORY_SCOPE_AGENT) ; } }
#endif
    }
    SEAM(2);
#ifdef STAMP_PHASE
    if (STAMP_PHASE == 30 || STAMP_PHASE == 31) { const unsigned v_ = __hip_atomic_load((unsigned*)ws + 3500, __ATOMIC_RELAXED, __HIP_MEMORY_SCOPE_AGENT); st1_ = st0_ + (STAMP_PHASE == 30 ? v_ : ~v_); }
#endif
    STAMP_END(2);
    STAMP_BEGIN(3);
    REP(3) if (IN(3)) {
        pg8::Gemm g{MIX, Wout_t, M, D, D}; pg8::StaticOrder S; S.init(M, D, G, bx, WGM_P3);
        pg8::EpiResid<false> E{x, XN, part1, D};
        pg8::gemm_phase<pg8::EpiResid<false>, pg8::StaticOrder, true, GEMM_SP2>(lds, g, S, E);
    }
    SEAM(3);
    STAMP_END(3);
    STAMP_BEGIN(4);
    REP(4) if (IN(4)) {
        pg8::Gemm g{XN, Wgu_t, M, NGU, D}; pg8::StaticOrder S; S.init(M, NGU, G, bx, WGM_P4);
        int tpm = -1; { pg8::Unit u0; if (S.next(0, u0)) { tpm = u0.pm; if (tid < 256) { const f32x4* pp = (const f32x4*)(part1 + (size_t)(tpm * 256 + tid) * 32); float sacc = 0.f;
#pragma unroll
                    for (int k = 0; k < 8; ++k) { const f32x4 a = pp[k]; sacc += (a[0] + a[1]) + (a[2] + a[3]); }
                    ((LAS float*)(lds + RING_BYTES))[tid] = rsqrtf(sacc * (1.f / D) + RMS_EPS); } } }
        __syncthreads();
        pg8::EpiSwiGLU E{HB, DFF, part1, 1.f / D, RMS_EPS, (LAS const float*)(lds + RING_BYTES), tpm};
#if PROBE_PHASE == 24
        { TwiceOrder S2{S}; pg8::gemm_phase<pg8::EpiSwiGLU, TwiceOrder, true, true>(lds, g, S2, E); }
#else
        pg8::gemm_phase<pg8::EpiSwiGLU, pg8::StaticOrder, P4_ALIGN, GEMM_SP2>(lds, g, S, E);
#endif
    }
    SEAM(4);
    STAMP_END(4);
    STAMP_BEGIN(5);
    REP(5) if (IN(5)) {
        pg8::Gemm g{HB, Wdn_t, M, D, DFF}; pg8::StaticOrder S; S.init(M, D, G, bx, WGM_P5);
#if FUSE_FINAL
        pg8::EpiFinal E{XN, out, args.in[I_FINW], part2, (unsigned*)ws + 4096, lds + RING_BYTES, D, 1.f / D, RMS_EPS};
        pg8::gemm_phase<pg8::EpiFinal, pg8::StaticOrder, true, GEMM_SP2>(lds, g, S, E);
#else
        pg8::EpiResid<true> E{XN, XN, part2, D};
        pg8::gemm_phase<pg8::EpiResid<true>, pg8::StaticOrder, true, GEMM_SP2>(lds, g, S, E);
#endif
    }
#if !FUSE_FINAL
    SEAM(5);
#endif
    STAMP_END(5);
    STAMP_BEGIN(6);
    REP(6) if (IN(6) && !FUSE_FINAL) {
        const int gw = vcu * NWAVES + wave, NGW = G * NWAVES;
        const f32x4* wn = (const f32x4*)args.in[I_FINW] + 2 * lane;
        for (int m = gw; m < M; m += NGW) {
            const float s = wave_sum(lane < 32 ? part2[(size_t)m * 32 + lane] : 0.f);
            const float rstd = rsqrtf(s * (1.f / D) + RMS_EPS);
            const v4u* xr = (const v4u*)(XN + (size_t)m * D) + lane; f32x4* orow = (f32x4*)(out + (size_t)m * D) + 2 * lane;
#pragma unroll
            for (int j = 0; j < 4; ++j) { const v4u w = __builtin_nontemporal_load(xr + 64 * j); const f32x4 w0 = wn[128 * j], w1 = wn[128 * j + 1];
                const f32x4 a = {__uint_as_float(w.x << 16), __uint_as_float(w.x & 0xffff0000u), __uint_as_float(w.y << 16), __uint_as_float(w.y & 0xffff0000u)};
                const f32x4 b = {__uint_as_float(w.z << 16), __uint_as_float(w.z & 0xffff0000u), __uint_as_float(w.w << 16), __uint_as_float(w.w & 0xffff0000u)};
                __builtin_nontemporal_store(a * rstd * w0, orow + 128 * j); __builtin_nontemporal_store(b * rstd * w1, orow + 128 * j + 1); }
        }
    }
#ifdef ATT_TIMER
    if (bx == 0) { __syncthreads(); if (tid == 0) { const unsigned long long dt = *(LAS unsigned long long*)(lds + LDS_BYTES - 32), te = __builtin_amdgcn_s_memtime(); while (__builtin_amdgcn_s_memtime() - te < dt) __builtin_amdgcn_s_sleep(32); } }
#endif
#ifdef STAMP_PHASE
    if (STAMP_PHASE == 6) { __syncthreads(); st1_ = __builtin_amdgcn_s_memrealtime(); }
    if (bx == 0 && tid == 0) { const unsigned long long te = __builtin_amdgcn_s_memrealtime(), dt = st1_ - st0_; while (__builtin_amdgcn_s_memrealtime() - te < dt) __builtin_amdgcn_s_sleep(32); }
#endif
#undef IN
#undef SEAM
}

extern "C" void kernel_launch(void* const* d_in, const int* in_sizes, int n_in, void* d_out, int out_size, void* d_ws, size_t ws_size, hipStream_t stream) {
    static int grid = 0;
    if (grid == 0) {
        if (n_in != 15 || out_size != M * D || ws_size < WS_END) { fprintf(stderr, "kernel_launch: unexpected shapes (n_in %d out %d ws %zu)\n", n_in, out_size, ws_size); grid = -1; return; }
        int dev = 0, cus = 0, per_cu = 0;
        hipGetDevice(&dev); hipDeviceGetAttribute(&cus, hipDeviceAttributeMultiprocessorCount, dev);
        if (hipFuncSetAttribute((const void*)hymba_fwd, hipFuncAttributeMaxDynamicSharedMemorySize, LDS_BYTES) != hipSuccess) { fprintf(stderr, "kernel_launch: hipFuncSetAttribute failed\n"); grid = -1; return; }
        if (hipOccupancyMaxActiveBlocksPerMultiprocessor(&per_cu, (const void*)hymba_fwd, NWAVES * 64, LDS_BYTES) != hipSuccess || per_cu < 1) { fprintf(stderr, "kernel_launch: occupancy query says %d\n", per_cu); per_cu = 1; }
        (void)hipGetLastError();
        grid = cus * 1;
        fprintf(stderr, "kernel_launch: grid %d (cus %d, per_cu %d)\n", grid, cus, per_cu);
    }
    if (grid < 0) return;
    if (hipMemsetAsync(d_ws, 0, 65536, stream) != hipSuccess) { fprintf(stderr, "kernel_launch: memset failed\n"); return; }
    Args a{};
    for (int i = 0; i < 15; ++i) a.in[i] = (const float*)d_in[i];
    a.out = (float*)d_out; a.ws = (unsigned char*)d_ws;
#if MK_N_LAUNCHES == 1
    a.ph_lo = 0; a.ph_hi = N_PHASES;
    void* kargs[] = {&a};
    hipError_t e = hipLaunchCooperativeKernel((const void*)hymba_fwd, dim3(grid), dim3(NWAVES * 64), kargs, LDS_BYTES, stream);
    if (e != hipSuccess) fprintf(stderr, "kernel_launch: cooperative launch failed: %s\n", hipGetErrorString(e));
#else
    for (int p = 0; p < N_PHASES; ++p) { a.ph_lo = p; a.ph_hi = p + 1; hipLaunchKernelGGL(hymba_fwd, dim3(grid), dim3(NWAVES * 64), LDS_BYTES, stream, a); }
#endif
}
```

```cpp
#include <hip/hip_runtime.h>
#include <hip/hip_cooperative_groups.h>
#include <hip/hip_bf16.h>
#include <cstdio>
#include <cstdint>
#include <cmath>
namespace cg = cooperative_groups;
#define MK_N_LAUNCHES 1
#ifndef PG8_WGM
#define PG8_WGM 4
#endif
namespace pg8 {
#define PG8_LAS __attribute__((address_space(3)))
typedef unsigned short bf16_t;
typedef short bf16x8 __attribute__((ext_vector_type(8)));
typedef float f32x4 __attribute__((ext_vector_type(4)));
typedef unsigned u32x4 __attribute__((ext_vector_type(4)));
constexpr int BM = 256, BK = 64, HALF = 128, HTB = HALF * BK * 2  , STAGE_BYTES = 8 * HTB, NXCD = 8, WGM = PG8_WGM;

__host__ __device__ __forceinline__ int lds_byte(int r, int c) { const int st = (r >> 4) * 2 + (c >> 5), rr = r & 15, cc = c & 31, ob = rr * 64 + cc * 2; return st * 1024 + (ob ^ (((ob >> 9) & 1) << 5)); }
__host__ __device__ __forceinline__ void stage_rc(int b, int& R, int& C) { const int st = b / 1024, sb = b % 1024, swz = sb ^ (((sb >> 9) & 1) << 5); R = (st >> 1) * 16 + swz / 64; C = (st & 1) * 32 + (swz % 64) / 2; }
__host__ __device__ __forceinline__ int perm32(int rho) { const int n = rho >> 4, i = rho & 15; return 8 * (i >> 2) + 4 * n + (i & 3); }

struct Unit { int pm, pn; };
struct Gemm { const bf16_t* A; const bf16_t* Bt; int M, N, K; };

struct StaticOrder {
    int nM, nN, nwg, G, c, wgm;
    __host__ __device__ void init(int M, int N, int G_, int c_, int wgm_ = WGM) { nM = M / BM; nN = N / BM; nwg = nM * nN; G = G_; c = c_; wgm = wgm_; }
    __host__ __device__ bool next(int i, Unit& u) const {
        const long L = (long)i * G + c; if (L >= nwg) return false;
        int wgid = (int)L; { const int q = nwg / NXCD, r = nwg % NXCD, xcd = wgid % NXCD, off = wgid / NXCD; wgid = (xcd < r ? xcd * (q + 1) : r * (q + 1) + (xcd - r) * q) + off; }
        const int nig = wgm * nN, gid = wgid / nig, fm = gid * wgm, gsz = (nM - fm) < wgm ? (nM - fm) : wgm;
        u.pm = fm + ((wgid % nig) % gsz); u.pn = (wgid % nig) / gsz; return true;
    }
    __device__ __forceinline__ void a_ready(const Unit&) const {}
    __device__ __forceinline__ void done(const Unit&) const {}
};

__device__ __forceinline__ unsigned cvt_pk_bf16(float lo, float hi) { typedef float f2_t __attribute__((ext_vector_type(2))); typedef __bf16 b2_t __attribute__((ext_vector_type(2))); f2_t v = {lo, hi}; b2_t b = __builtin_convertvector(v, b2_t); return __builtin_bit_cast(unsigned, b); }
typedef unsigned u32x2 __attribute__((ext_vector_type(2)));
#ifndef P5_NT_A
#define P5_NT_A 0
#endif
#ifndef EPI_NT_H
#define EPI_NT_H 0
#endif
#ifndef EPI_NT_PROJ
#define EPI_NT_PROJ 0
#endif
struct EpiStore {
    static constexpr bool PERM = true, AFTER_DRAIN = false; static constexpr int AUX_A = 0, AUX_B = 0;
    bf16_t* O; int ldc;
    __device__ __forceinline__ void operator()(const f32x4 (&acc)[2][2][4][2], const Unit& u, int wr, int wc, int fr, int fq) const {
        const int row0 = u.pm * BM + wr * 64 + fr, col0 = u.pn * BM + wc * 32 + 8 * fq;
#pragma unroll
        for (int ai = 0; ai < 2; ++ai)
#pragma unroll
            for (int m = 0; m < 4; ++m) { bf16_t* rowp = O + (size_t)(row0 + ai * HALF + m * 16) * ldc + col0;
#pragma unroll
                for (int bj = 0; bj < 2; ++bj) { const f32x4 v0 = acc[ai][bj][m][0], v1 = acc[ai][bj][m][1];
                    u32x4 w; w.x = cvt_pk_bf16(v0[0], v0[1]); w.y = cvt_pk_bf16(v0[2], v0[3]); w.z = cvt_pk_bf16(v1[0], v1[1]); w.w = cvt_pk_bf16(v1[2], v1[3]);
                    if (EPI_NT_PROJ) __builtin_nontemporal_store(w, (u32x4*)(rowp + bj * HALF)); else *(u32x4*)(rowp + bj * HALF) = w; } }
    }
};
template <bool BASE_BF16> struct EpiResid {
    static constexpr bool PERM = true, AFTER_DRAIN = false; static constexpr int AUX_A = (BASE_BF16 && P5_NT_A) ? 2 : 0, AUX_B = 0;
    const void* base; bf16_t* xo; float* part; int ldc;
    __device__ __forceinline__ void operator()(const f32x4 (&acc)[2][2][4][2], const Unit& u, int wr, int wc, int fr, int fq) const {
        const int row0 = u.pm * BM + wr * 64 + fr, col0 = u.pn * BM + wc * 32 + 8 * fq;
        float ssq[2][4];
#pragma unroll
        for (int ai = 0; ai < 2; ++ai)
#pragma unroll
            for (int m = 0; m < 4; ++m) { const int r = row0 + ai * HALF + m * 16; const size_t off = (size_t)r * ldc + col0; float ss = 0.f;
#pragma unroll
                for (int bj = 0; bj < 2; ++bj) { f32x4 b0, b1;
                    if (BASE_BF16) { const u32x4 w = *(const u32x4*)((const bf16_t*)base + off + bj * HALF);
                        b0 = (f32x4){__uint_as_float(w.x << 16), __uint_as_float(w.x & 0xffff0000u), __uint_as_float(w.y << 16), __uint_as_float(w.y & 0xffff0000u)};
                        b1 = (f32x4){__uint_as_float(w.z << 16), __uint_as_float(w.z & 0xffff0000u), __uint_as_float(w.w << 16), __uint_as_float(w.w & 0xffff0000u)}; }
                    else { const float* bp = (const float*)base + off + bj * HALF; b0 = __builtin_nontemporal_load((const f32x4*)bp); b1 = __builtin_nontemporal_load((const f32x4*)(bp + 4)); }
                    const f32x4 v0 = b0 + acc[ai][bj][m][0], v1 = b1 + acc[ai][bj][m][1];
                    ss += ((v0[0] * v0[0] + v0[1] * v0[1]) + (v0[2] * v0[2] + v0[3] * v0[3])) + ((v1[0] * v1[0] + v1[1] * v1[1]) + (v1[2] * v1[2] + v1[3] * v1[3]));
                    u32x4 w; w.x = cvt_pk_bf16(v0[0], v0[1]); w.y = cvt_pk_bf16(v0[2], v0[3]); w.z = cvt_pk_bf16(v1[0], v1[1]); w.w = cvt_pk_bf16(v1[2], v1[3]);
                    *(u32x4*)(xo + off + bj * HALF) = w; }
                ssq[ai][m] = ss; }
#pragma unroll
        for (int ai = 0; ai < 2; ++ai)
#pragma unroll
            for (int m = 0; m < 4; ++m) { float ss = ssq[ai][m]; ss += __shfl_xor(ss, 16); ss += __shfl_xor(ss, 32);
                if (fq == 0) part[(size_t)(row0 + ai * HALF + m * 16) * 32 + u.pn * 4 + wc] = ss; }
    }
};
struct EpiFinal {
    static constexpr bool PERM = true, AFTER_DRAIN = false; static constexpr int AUX_A = 0, AUX_B = 0;
    const bf16_t* xb; float* out; const float* wfin; float* xbuf; unsigned* cnt; PG8_LAS unsigned char* tab; int ldc; float inv_n, eps;
    __device__ __forceinline__ void operator()(f32x4 (&acc)[2][2][4][2], const Unit& u, int wr, int wc, int fr, int fq) const {
        const int lane = fq * 16 + fr, wid = wr * 4 + wc;
        PG8_LAS float* P = (PG8_LAS float*)tab;
        PG8_LAS float* S = (PG8_LAS float*)(tab + 4096);
        PG8_LAS unsigned* flag = (PG8_LAS unsigned*)(tab + 4096 + 1024);
        const int row0 = u.pm * BM + wr * 64 + fr, col0 = u.pn * BM + wc * 32 + 8 * fq;
#pragma unroll
        for (int ai = 0; ai < 2; ++ai)
#pragma unroll
            for (int m = 0; m < 4; ++m) { const int r = row0 + ai * HALF + m * 16; const size_t off = (size_t)r * ldc + col0; float ss = 0.f;
#pragma unroll
                for (int bj = 0; bj < 2; ++bj) { const u32x4 w = *(const u32x4*)(xb + off + bj * HALF);
                    const f32x4 b0 = {__uint_as_float(w.x << 16), __uint_as_float(w.x & 0xffff0000u), __uint_as_float(w.y << 16), __uint_as_float(w.y & 0xffff0000u)};
                    const f32x4 b1 = {__uint_as_float(w.z << 16), __uint_as_float(w.z & 0xffff0000u), __uint_as_float(w.w << 16), __uint_as_float(w.w & 0xffff0000u)};
                    const f32x4 v0 = b0 + acc[ai][bj][m][0], v1 = b1 + acc[ai][bj][m][1]; acc[ai][bj][m][0] = v0; acc[ai][bj][m][1] = v1;
                    ss += ((v0[0] * v0[0] + v0[1] * v0[1]) + (v0[2] * v0[2] + v0[3] * v0[3])) + ((v1[0] * v1[0] + v1[1] * v1[1]) + (v1[2] * v1[2] + v1[3] * v1[3])); }
                ss += __shfl_xor(ss, 16); ss += __shfl_xor(ss, 32);
                if (fq == 0) P[(ai * HALF + wr * 64 + m * 16 + fr) * 4 + wc] = ss; }
        asm volatile("s_waitcnt lgkmcnt(0)" ::: "memory"); __builtin_amdgcn_s_barrier(); asm volatile("" ::: "memory");
        const int row = wid * 32 + (lane & 31);
        if (lane < 32) { const f32x4 p4 = *(PG8_LAS const f32x4*)(P + row * 4);
            __hip_atomic_store(xbuf + ((size_t)(u.pm * BM + row) * 8 + u.pn), (p4[0] + p4[1]) + (p4[2] + p4[3]), __ATOMIC_RELAXED, __HIP_MEMORY_SCOPE_AGENT); }
        asm volatile("s_waitcnt vmcnt(0)" ::: "memory");
        if (lane == 0) __hip_atomic_fetch_add(cnt + 64 * u.pm, 1u, __ATOMIC_RELAXED, __HIP_MEMORY_SCOPE_AGENT);
        if (wid == 0) { bool dead = false; const unsigned long long t0 = __builtin_amdgcn_s_memrealtime();
            for (;;) { if ((unsigned)__builtin_amdgcn_readfirstlane(__hip_atomic_load(cnt + 64 * u.pm, __ATOMIC_RELAXED, __HIP_MEMORY_SCOPE_AGENT)) >= 64u) break;
                if (__builtin_amdgcn_s_memrealtime() - t0 > 2000000ull) { dead = true; break; }
                __builtin_amdgcn_s_sleep(2); }
            __builtin_amdgcn_fence(__ATOMIC_ACQUIRE, "agent");
            if (lane == 0) flag[0] = dead ? 1u : 0u; }
        asm volatile("s_waitcnt vmcnt(0) lgkmcnt(0)" ::: "memory"); __builtin_amdgcn_s_barrier(); asm volatile("" ::: "memory");
        const bool bad = flag[0] != 0u;
        if (lane < 32) { const float* slot = xbuf + (size_t)(u.pm * BM + row) * 8; float q = 0.f;
#pragma unroll
            for (int t = 0; t < 8; ++t) q += __hip_atomic_load(slot + t, __ATOMIC_RELAXED, __HIP_MEMORY_SCOPE_AGENT);
            S[row] = rsqrtf(q * inv_n + eps); }
        asm volatile("s_waitcnt vmcnt(0) lgkmcnt(0)" ::: "memory"); __builtin_amdgcn_s_barrier(); asm volatile("" ::: "memory");
        const float qnan = __builtin_nanf("");
        f32x4 wv[2][2];
#pragma unroll
        for (int bj = 0; bj < 2; ++bj) { wv[bj][0] = *(const f32x4*)(wfin + col0 + bj * HALF); wv[bj][1] = *(const f32x4*)(wfin + col0 + bj * HALF + 4); }
#pragma unroll
        for (int ai = 0; ai < 2; ++ai)
#pragma unroll
            for (int m = 0; m < 4; ++m) { const int rl = ai * HALF + wr * 64 + m * 16 + fr; const float rs = bad ? qnan : S[rl]; float* op = out + (size_t)(u.pm * BM + rl) * ldc + col0;
#pragma unroll
                for (int bj = 0; bj < 2; ++bj) { __builtin_nontemporal_store(acc[ai][bj][m][0] * rs * wv[bj][0], (f32x4*)(op + bj * HALF)); __builtin_nontemporal_store(acc[ai][bj][m][1] * rs * wv[bj][1], (f32x4*)(op + bj * HALF + 4)); } }
    }
};
struct EpiSwiGLU {
    static constexpr bool PERM = true, AFTER_DRAIN = false; static constexpr int AUX_A = 0, AUX_B = 0;
    bf16_t* H; int ldh; const float* part; float inv_n, eps; PG8_LAS const float* rtab; int rtab_pm;
    __device__ __forceinline__ static float silu_mul(float g, float uu) { const float e = __builtin_amdgcn_exp2f(g * -1.4426950408889634f); return g * uu * __builtin_amdgcn_rcpf(1.f + e); }
    __device__ __forceinline__ void operator()(const f32x4 (&acc)[2][2][4][2], const Unit& u, int wr, int wc, int fr, int fq) const {
        const int row0 = u.pm * BM + wr * 64 + fr, col0 = u.pn * HALF + wc * 32 + 8 * fq;
        float rt8[2][4];
        const bool tab = u.pm == rtab_pm;
#pragma unroll
        for (int ai = 0; ai < 2; ++ai)
#pragma unroll
            for (int m = 0; m < 4; ++m) rt8[ai][m] = tab ? rtab[ai * HALF + wr * 64 + m * 16 + fr] : 0.f;
#pragma unroll
        for (int ai = 0; ai < 2; ++ai)
#pragma unroll
            for (int m = 0; m < 4; ++m) { const int r = row0 + ai * HALF + m * 16;
                float rstd;
                if (tab) rstd = rt8[ai][m];
                else { const f32x4* pp = (const f32x4*)(part + (size_t)r * 32 + fq * 8); const f32x4 pa = pp[0], pb = pp[1];
                    float s = ((pa[0] + pa[1]) + (pa[2] + pa[3])) + ((pb[0] + pb[1]) + (pb[2] + pb[3]));
                    s += __shfl_xor(s, 16); s += __shfl_xor(s, 32);
                    rstd = rsqrtf(s * inv_n + eps); }
                const f32x4 g0 = acc[ai][0][m][0] * rstd, g1 = acc[ai][0][m][1] * rstd, u0 = acc[ai][1][m][0] * rstd, u1 = acc[ai][1][m][1] * rstd;
                u32x4 w; w.x = cvt_pk_bf16(silu_mul(g0[0], u0[0]), silu_mul(g0[1], u0[1])); w.y = cvt_pk_bf16(silu_mul(g0[2], u0[2]), silu_mul(g0[3], u0[3]));
                w.z = cvt_pk_bf16(silu_mul(g1[0], u1[0]), silu_mul(g1[1], u1[1])); w.w = cvt_pk_bf16(silu_mul(g1[2], u1[2]), silu_mul(g1[3], u1[3]));
                if (EPI_NT_H) __builtin_nontemporal_store(w, (u32x4*)(H + (size_t)r * ldh + col0)); else *(u32x4*)(H + (size_t)r * ldh + col0) = w; }
    }
};
template <class Epi, class Sched, bool ALIGN_EPI = false, bool SP2 = false>
__device__ __forceinline__ void gemm_phase(PG8_LAS unsigned char* lds, const Gemm g, const Sched& S, const Epi& E) {
    const int tid = threadIdx.x, wid = __builtin_amdgcn_readfirstlane(tid >> 6), lane = tid & 63, wr = wid >> 2, wc = wid & 3, fr = lane & 15, fq = lane >> 4;
    const int K = g.K, nt = K / BK;
    constexpr int AUXA = Epi::AUX_A, AUXB = Epi::AUX_B;
    unsigned voffA[2], voffB[2];
#pragma unroll
    for (int i = 0; i < 2; ++i) { int R, C; stage_rc(tid * 16 + i * 8192, R, C); const int Rb = Epi::PERM ? ((R & ~31) + perm32(R & 31)) : R;
        voffA[i] = (unsigned)(R * K + C) * 2u; voffB[i] = (unsigned)(Rb * K + C) * 2u; }
    const size_t kstep = (size_t)(BK * 2);
    const size_t hstep = (size_t)HALF * K * 2;
    const size_t tstep = 2 * hstep;
    const unsigned ldsw = (unsigned)wid * 1024u;
    const int aoff = lds_byte(wr * 64 + fr, fq * 8), boff = lds_byte(wc * 32 + fr, fq * 8);
#define PG8_SA(b, h) (((b) * 2 + (h)) * HTB)
#define PG8_SB(b, h) ((4 + (b) * 2 + (h)) * HTB)
#define PG8_STAGE_X(bufoff, gbase, voff, aux_) do { _Pragma("unroll") for (int _i = 0; _i < 2; ++_i) \
        __builtin_amdgcn_global_load_lds((const unsigned*)((const char*)(gbase) + (voff)[_i]), (PG8_LAS unsigned*)(lds + (bufoff) + ldsw + _i * 8192), 16, 0, aux_); } while (0)
#define PG8_LDA(dst, b, h) do { _Pragma("unroll") for (int m = 0; m < 4; ++m) _Pragma("unroll") for (int k = 0; k < 2; ++k) dst[m][k] = *(const PG8_LAS bf16x8*)(lds + PG8_SA(b, h) + aoff + m * 2048 + k * 1024); } while (0)
#define PG8_LDB(dst, b, h) do { _Pragma("unroll") for (int n = 0; n < 2; ++n) _Pragma("unroll") for (int k = 0; k < 2; ++k) dst[n][k] = *(const PG8_LAS bf16x8*)(lds + PG8_SB(b, h) + boff + n * 2048 + k * 1024); } while (0)
#define PG8_MMA(ai, bj, At, Bt) do { __builtin_amdgcn_s_setprio(1); _Pragma("unroll") for (int m = 0; m < 4; ++m) _Pragma("unroll") for (int n = 0; n < 2; ++n) _Pragma("unroll") for (int k = 0; k < 2; ++k) \
        acc[ai][bj][m][n] = __builtin_amdgcn_mfma_f32_16x16x32_bf16(Bt[n][k], At[m][k], acc[ai][bj][m][n], 0, 0, 0); __builtin_amdgcn_s_setprio(0); } while (0)
#define PG8_WAIT_V(n) asm volatile("s_waitcnt vmcnt(" #n ")" ::: "memory")
#define PG8_WAIT_L(n) asm volatile("s_waitcnt lgkmcnt(" #n ")" ::: "memory")
#define PG8_BAR __builtin_amdgcn_s_barrier()
#define PG8_SCHED __builtin_amdgcn_sched_barrier(0)
    Unit cur, nxt; int ui = 0;
    if (!S.next(0, cur)) return;
    f32x4 acc[2][2][4][2];
#pragma unroll
    for (int a = 0; a < 2; ++a)
#pragma unroll
        for (int b = 0; b < 2; ++b)
#pragma unroll
            for (int m = 0; m < 4; ++m)
#pragma unroll
                for (int n = 0; n < 2; ++n) acc[a][b][m][n] = (f32x4){0.f, 0.f, 0.f, 0.f};
    bf16x8 At[4][2], B0[2][2], B1[2][2];
    const char* cA = (const char*)g.A + (size_t)cur.pm * tstep; const char* cB = (const char*)g.Bt + (size_t)cur.pn * tstep;
    S.a_ready(cur);
    if constexpr (SP2) {
        PG8_STAGE_X(PG8_SB(0, 0), cB, voffB, AUXB); PG8_STAGE_X(PG8_SB(0, 1), cB + hstep, voffB, AUXB); PG8_STAGE_X(PG8_SA(0, 0), cA, voffA, AUXA); PG8_STAGE_X(PG8_SA(0, 1), cA + hstep, voffA, AUXA);
        if (wr == 1) PG8_BAR;
        PG8_WAIT_V(2); PG8_BAR;
        PG8_STAGE_X(PG8_SB(1, 0), cB + kstep, voffB, AUXB); PG8_STAGE_X(PG8_SA(1, 0), cA + kstep, voffA, AUXA); PG8_STAGE_X(PG8_SB(1, 1), cB + hstep + kstep, voffB, AUXB);
        PG8_WAIT_V(6); PG8_BAR;
    } else {
        PG8_STAGE_X(PG8_SB(0, 0), cB, voffB, AUXB); PG8_STAGE_X(PG8_SA(0, 0), cA, voffA, AUXA); PG8_STAGE_X(PG8_SB(0, 1), cB + hstep, voffB, AUXB); PG8_STAGE_X(PG8_SA(0, 1), cA + hstep, voffA, AUXA);
        if (wr == 1) PG8_BAR;
        PG8_WAIT_V(4); PG8_BAR;
        PG8_STAGE_X(PG8_SB(1, 0), cB + kstep, voffB, AUXB); PG8_STAGE_X(PG8_SA(1, 0), cA + kstep, voffA, AUXA); PG8_STAGE_X(PG8_SB(1, 1), cB + hstep + kstep, voffB, AUXB);
        PG8_WAIT_V(6); PG8_BAR;
    }
    for (;;) {
        const bool has_next = S.next(ui + 1, nxt);
        const char* nA = has_next ? (const char*)g.A + (size_t)nxt.pm * tstep : cA; const char* nB = has_next ? (const char*)g.Bt + (size_t)nxt.pn * tstep : cB;
        for (int t = 0; t < nt; t += 2) {
            const bool last = (t == nt - 2);
            const char* a1 = cA + (size_t)(t + 1) * kstep;
            const char* a2 = last ? nA : cA + (size_t)(t + 2) * kstep; const char* b2 = last ? nB : cB + (size_t)(t + 2) * kstep;
            const char* a3 = a2 + kstep; const char* b3 = b2 + kstep;
            if (last && has_next) S.a_ready(nxt);
            if constexpr (SP2) {
            PG8_LDB(B0, 0, 0); PG8_LDB(B1, 0, 1); PG8_SCHED; PG8_LDA(At, 0, 0); PG8_STAGE_X(PG8_SA(1, 1), a1 + hstep, voffA, AUXA);
            PG8_WAIT_V(8); PG8_WAIT_L(0); PG8_BAR; PG8_MMA(0, 0, At, B0); PG8_MMA(0, 1, At, B1); PG8_BAR; PG8_SCHED;
            PG8_LDA(At, 0, 1); PG8_STAGE_X(PG8_SB(0, 0), b2, voffB, AUXB); PG8_STAGE_X(PG8_SB(0, 1), b2 + hstep, voffB, AUXB); PG8_STAGE_X(PG8_SA(0, 0), a2, voffA, AUXA);
            PG8_WAIT_V(8); PG8_WAIT_L(0); PG8_BAR; PG8_MMA(1, 0, At, B0); PG8_MMA(1, 1, At, B1); PG8_BAR; PG8_SCHED;
            PG8_LDB(B0, 1, 0); PG8_LDB(B1, 1, 1); PG8_SCHED; PG8_LDA(At, 1, 0); PG8_STAGE_X(PG8_SA(0, 1), a2 + hstep, voffA, AUXA);
            PG8_WAIT_V(8); PG8_WAIT_L(0); PG8_BAR; PG8_MMA(0, 0, At, B0); PG8_MMA(0, 1, At, B1); PG8_BAR; PG8_SCHED;
            PG8_LDA(At, 1, 1); PG8_STAGE_X(PG8_SB(1, 0), b3, voffB, AUXB); PG8_STAGE_X(PG8_SB(1, 1), b3 + hstep, voffB, AUXB); PG8_STAGE_X(PG8_SA(1, 0), a3, voffA, AUXA);
            PG8_WAIT_V(8); PG8_WAIT_L(0); PG8_BAR; PG8_MMA(1, 0, At, B0); PG8_MMA(1, 1, At, B1); PG8_BAR; PG8_SCHED;
            } else {
            PG8_LDB(B0, 0, 0); PG8_SCHED; PG8_LDA(At, 0, 0); PG8_STAGE_X(PG8_SA(1, 1), a1 + hstep, voffA, AUXA);
            PG8_WAIT_L(8); PG8_BAR; PG8_WAIT_L(0); PG8_MMA(0, 0, At, B0); PG8_BAR; PG8_SCHED;
            PG8_LDB(B1, 0, 1); PG8_STAGE_X(PG8_SB(0, 0), b2, voffB, AUXB);
            PG8_BAR; PG8_WAIT_L(0); PG8_MMA(0, 1, At, B1); PG8_BAR;
            PG8_LDA(At, 0, 1); PG8_STAGE_X(PG8_SA(0, 0), a2, voffA, AUXA);
            PG8_BAR; PG8_WAIT_L(0); PG8_MMA(1, 0, At, B0); PG8_BAR; PG8_SCHED;
            PG8_STAGE_X(PG8_SB(0, 1), b2 + hstep, voffB, AUXB);
            PG8_WAIT_V(6); PG8_BAR; PG8_MMA(1, 1, At, B1); PG8_BAR;
            PG8_LDB(B0, 1, 0); PG8_SCHED; PG8_LDA(At, 1, 0); PG8_STAGE_X(PG8_SA(0, 1), a2 + hstep, voffA, AUXA);
            PG8_WAIT_L(8); PG8_BAR; PG8_WAIT_L(0); PG8_MMA(0, 0, At, B0); PG8_BAR; PG8_SCHED;
            PG8_LDB(B1, 1, 1); PG8_STAGE_X(PG8_SB(1, 0), b3, voffB, AUXB);
            PG8_BAR; PG8_WAIT_L(0); PG8_MMA(0, 1, At, B1); PG8_BAR;
            PG8_LDA(At, 1, 1); PG8_STAGE_X(PG8_SA(1, 0), a3, voffA, AUXA);
            PG8_BAR; PG8_WAIT_L(0); PG8_MMA(1, 0, At, B0); PG8_BAR; PG8_SCHED;
            PG8_STAGE_X(PG8_SB(1, 1), b3 + hstep, voffB, AUXB);
            PG8_WAIT_V(6); PG8_BAR; PG8_MMA(1, 1, At, B1); PG8_BAR;
            }
        }
        if constexpr (ALIGN_EPI) { if (wr == 0) PG8_BAR; }
        if constexpr (!Epi::AFTER_DRAIN) { E(acc, cur, wr, wc, fr, fq); S.done(cur); }
        if (!has_next) break;
#pragma unroll
        for (int a = 0; a < 2; ++a)
#pragma unroll
            for (int b = 0; b < 2; ++b)
#pragma unroll
                for (int m = 0; m < 4; ++m)
#pragma unroll
                    for (int n = 0; n < 2; ++n) acc[a][b][m][n] = (f32x4){0.f, 0.f, 0.f, 0.f};
        cur = nxt; cA = nA; cB = nB; ++ui;
        if constexpr (ALIGN_EPI) { if (wr == 1) PG8_BAR; }
    }
    PG8_WAIT_V(0);
    if constexpr (!ALIGN_EPI) { if (wr == 0) PG8_BAR; }
    PG8_BAR;
    if constexpr (Epi::AFTER_DRAIN) { E.fused(acc, cur, wr, wc, fr, fq, lds, wid, lane); S.done(cur); }
#undef PG8_SA
#undef PG8_SB
#undef PG8_STAGE_X
#undef PG8_LDA
#undef PG8_LDB
#undef PG8_MMA
#undef PG8_WAIT_V
#undef PG8_WAIT_L
#undef PG8_BAR
#undef PG8_SCHED
}
}
namespace att {
#ifndef ATT_NT_OUT
#define ATT_NT_OUT 0
#endif
#define ATT_LAS __attribute__((address_space(3)))
typedef unsigned short bf16_t;
typedef short bf16x8 __attribute__((ext_vector_type(8)));
typedef short s16x4 __attribute__((ext_vector_type(4)));
typedef float f32x16 __attribute__((ext_vector_type(16)));
typedef float f32x4 __attribute__((ext_vector_type(4)));
typedef unsigned u32x4 __attribute__((ext_vector_type(4)));
typedef unsigned u32x2 __attribute__((ext_vector_type(2)));
constexpr int SEQ = 2048, PITCH = 4608, OPITCH = 2048;
__device__ __forceinline__ unsigned cvtpk(float lo, float hi) { typedef float f2_t __attribute__((ext_vector_type(2))); typedef __bf16 b2_t __attribute__((ext_vector_type(2))); f2_t v = {lo, hi}; b2_t b = __builtin_convertvector(v, b2_t); return __builtin_bit_cast(unsigned, b); }
__device__ __forceinline__ float swapmax(float m) { auto rr = __builtin_amdgcn_permlane32_swap(__float_as_uint(m), __float_as_uint(m), false, false); return fmaxf(__uint_as_float(rr[0]), __uint_as_float(rr[1])); }
__device__ __forceinline__ float swapsum(float m) { auto rr = __builtin_amdgcn_permlane32_swap(__float_as_uint(m), __float_as_uint(m), false, false); return __uint_as_float(rr[0]) + __uint_as_float(rr[1]); }
__device__ __forceinline__ s16x4 vtr(ATT_LAS const char* p) { return __builtin_bit_cast(s16x4, __builtin_amdgcn_ds_read_tr16_b64_v4i16((ATT_LAS s16x4*)p)); }

struct UnitP {
    int b, q0;
    int qcol, kcol, vcol;
    int kofs;
    float slope2;
    float m_init, l_init;
    int T0, T1;
    int tlo, thi;
    int window;
    int maskall;
    int ocol;
};

template <int DV, int KW>
__device__ __forceinline__ void attn_unit(ATT_LAS char* lds, const bf16_t* __restrict__ P, bf16_t* __restrict__ MIX, const UnitP up, bool diff, float lam, const float* __restrict__ subln_w, int tid,
                                          bool prefetched  , bool has_next, int nb, int nkcol, int nvcol, int nT0, int nT1  ) {
    static_assert(KW == DV && (KW == 128 || KW == 64), "tile geometry");
    constexpr int ROWB = KW * 2, CPR = ROWB / 16, RPP = 1024 / ROWB, NP = 64 / RPP / 8, TILEB = 64 * ROWB, STG = 2 * TILEB, NSTG = 4, NEB = DV / 32, NI = 2 * NP;
    constexpr bool WIDE = (KW == 128);
    const int lane = tid & 63, wid = __builtin_amdgcn_readfirstlane(tid >> 6), r32 = lane & 31, hi = lane >> 5, wq = wid & 3, g = wid >> 2;
    const int qw = up.q0 + 32 * wq, q = qw + r32;
    const size_t rowbase = (size_t)up.b * SEQ;
    __syncthreads();
    unsigned kso[NP], vso[NP];
#pragma unroll
    for (int i = 0; i < NP; ++i) { const int piece = wid + 8 * i, row = RPP * piece + lane / CPR, slot = lane % CPR;
        const int kch = WIDE ? (slot ^ (row & 15)) : (slot ^ ((row >> 1) & 7));
        const int vch = ((((slot >> 2) ^ (WIDE ? (row & 3) : ((row >> 1) & 1))) << 2) | (slot & 3));
        kso[i] = (unsigned)(row * PITCH + up.kcol + kch * 8); vso[i] = (unsigned)(row * PITCH + up.vcol + vch * 8); }
    const bf16_t* Pb = P + rowbase * PITCH;
#define ATT_DMA2(pb_, dk_, dv_, t, sg) do { const bf16_t* tb_ = (pb_) + (size_t)(t) * 64 * PITCH; \
    _Pragma("unroll") for (int i_ = 0; i_ < NP; ++i_) { \
        __builtin_amdgcn_global_load_lds((const unsigned*)(tb_ + (kso[i_] + (dk_))), (ATT_LAS unsigned*)(lds + (sg) * STG + (wid + 8 * i_) * 1024), 16, 0, 0); \
        __builtin_amdgcn_global_load_lds((const unsigned*)(tb_ + (vso[i_] + (dv_))), (ATT_LAS unsigned*)(lds + (sg) * STG + TILEB + (wid + 8 * i_) * 1024), 16, 0, 0); } } while (0)
#define ATT_DMA(t, sg) ATT_DMA2(Pb, 0u, 0u, t, sg)
    const int rot = prefetched ? 2 : 0;
    bf16x8 qr[4];
    { const bf16_t* qp = P + (rowbase + q) * PITCH + up.qcol + hi * 8;
#pragma unroll
      for (int d0 = 0; d0 < 4; ++d0) qr[d0] = *(const bf16x8*)(qp + d0 * 16); }
    if (!prefetched) {
#pragma unroll
        for (int j = 0; j < 2; ++j) if (up.T0 + j <= up.T1) ATT_DMA(up.T0 + j, j); }
    f32x16 o[NEB];
#pragma unroll
    for (int e = 0; e < NEB; ++e)
#pragma unroll
        for (int r = 0; r < 16; ++r) o[e][r] = 0.f;
    float mhat = up.l_init != 0.f ? up.m_init + up.slope2 * (float)q : 0.f, l = hi == 0 ? up.l_init : 0.f;
    float cb[16];
#pragma unroll
    for (int r = 0; r < 16; ++r) cb[r] = up.slope2 * (float)((r & 3) + 8 * (r >> 2));
    int kad[4];
#pragma unroll
    for (int d0 = 0; d0 < 4; ++d0) { const int c = (up.kofs >> 4) + 2 * d0 + hi; kad[d0] = r32 * ROWB + ((WIDE ? (c ^ (r32 & 15)) : (c ^ ((r32 >> 1) & 7))) << 4); }
    const int i16 = lane & 15, q4 = i16 >> 2, vsw = WIDE ? q4 : (q4 >> 1);
    const int vlane = TILEB + (4 * hi + q4) * ROWB + 32 * ((lane >> 4) & 1) + 8 * (i16 & 3);
    int vad[NEB];
#pragma unroll
    for (int e = 0; e < NEB; ++e) vad[e] = vlane + ((e ^ vsw) << 6);
    bf16x8 pa[4];
#define ATT_PV(sgi) do { ATT_LAS const char* Sv_ = lds + (sgi) * STG; __builtin_amdgcn_s_setprio(1); \
    _Pragma("unroll") for (int e = 0; e < NEB; ++e) _Pragma("unroll") for (int ks = 0; ks < 4; ++ks) { \
        const s16x4 lo = vtr(Sv_ + vad[e] + ks * 16 * ROWB), hh = vtr(Sv_ + vad[e] + ks * 16 * ROWB + 8 * ROWB); \
        const bf16x8 vf = {lo[0], lo[1], lo[2], lo[3], hh[0], hh[1], hh[2], hh[3]}; \
        o[e] = __builtin_amdgcn_mfma_f32_32x32x16_bf16(vf, pa[ks], o[e], 0, 0, 0); } __builtin_amdgcn_s_setprio(0); } while (0)
    for (int t = up.T0; t <= up.T1 + 1; ++t) {
        const int sg = (t - up.T0 + rot) & (NSTG - 1);
        if (t + 1 <= up.T1) { if (NI == 4) asm volatile("s_waitcnt vmcnt(4) lgkmcnt(0)" ::: "memory"); else asm volatile("s_waitcnt vmcnt(2) lgkmcnt(0)" ::: "memory"); }
        else asm volatile("s_waitcnt vmcnt(0) lgkmcnt(0)" ::: "memory");
        __builtin_amdgcn_s_barrier();
        asm volatile("" ::: "memory");
        if (t + 2 <= up.T1) ATT_DMA(t + 2, (sg + 2) & (NSTG - 1));
        if (g == 1 && t - 1 >= up.tlo && t - 1 <= up.thi && t - 1 >= up.T0) ATT_PV((sg + NSTG - 1) & (NSTG - 1));
        if (t >= up.tlo && t <= up.thi && t <= up.T1) {
            ATT_LAS const char* Sb = lds + sg * STG;
            f32x16 p0, p1;
            { const float base0 = up.slope2 * (float)(64 * t + 4 * hi) - mhat, base1 = base0 + 32.f * up.slope2;
#pragma unroll
              for (int r = 0; r < 16; ++r) { p0[r] = cb[r] + base0; p1[r] = cb[r] + base1; } }
            __builtin_amdgcn_s_setprio(1);
#pragma unroll
            for (int d0 = 0; d0 < 4; ++d0) {
                const bf16x8 k0 = *(ATT_LAS const bf16x8*)(Sb + kad[d0]), k1 = *(ATT_LAS const bf16x8*)(Sb + kad[d0] + 32 * ROWB);
                p0 = __builtin_amdgcn_mfma_f32_32x32x16_bf16(k0, qr[d0], p0, 0, 0, 0);
                p1 = __builtin_amdgcn_mfma_f32_32x32x16_bf16(k1, qr[d0], p1, 0, 0, 0);
            }
            __builtin_amdgcn_s_setprio(0);
            if (up.maskall || t == up.thi) {
                const int kvb = 64 * t + 4 * hi, qlo = q - up.window;
#pragma unroll
                for (int r = 0; r < 16; ++r) { const int kv = kvb + (r & 3) + 8 * (r >> 2);
                    if (kv > q || kv <= qlo) p0[r] = -INFINITY;
                    if (kv + 32 > q || kv + 32 <= qlo) p1[r] = -INFINITY; }
            }
            float ra = fmaxf(fmaxf(p0[0], p0[1]), p1[0]), rb = fmaxf(fmaxf(p0[2], p0[3]), p1[1]); ra = fmaxf(fmaxf(ra, p1[2]), p1[3]);
#pragma unroll
            for (int r = 4; r < 16; r += 4) { ra = fmaxf(fmaxf(ra, p0[r]), p0[r + 1]); rb = fmaxf(fmaxf(rb, p0[r + 2]), p0[r + 3]); ra = fmaxf(fmaxf(ra, p1[r]), p1[r + 1]); rb = fmaxf(fmaxf(rb, p1[r + 2]), p1[r + 3]); }
            const float rm = swapmax(fmaxf(ra, rb));
            if (__any(rm > 8.f)) {
                const float dl = fmaxf(rm, 0.f), alpha = __builtin_amdgcn_exp2f(-dl);
                mhat += dl; l *= alpha;
#pragma unroll
                for (int r = 0; r < 16; ++r) { p0[r] -= dl; p1[r] -= dl; }
#pragma unroll
                for (int e = 0; e < NEB; ++e)
#pragma unroll
                    for (int r = 0; r < 16; ++r) o[e][r] *= alpha;
            }
            float ps = 0.f;
#pragma unroll
            for (int r = 0; r < 16; ++r) { p0[r] = __builtin_amdgcn_exp2f(p0[r]); p1[r] = __builtin_amdgcn_exp2f(p1[r]); ps += p0[r] + p1[r]; }
            l += ps;
#pragma unroll
            for (int s = 0; s < 2; ++s) {
                u32x4 w0, w1;
                w0.x = cvtpk(p0[8 * s + 0], p0[8 * s + 1]); w0.y = cvtpk(p0[8 * s + 2], p0[8 * s + 3]); w0.z = cvtpk(p0[8 * s + 4], p0[8 * s + 5]); w0.w = cvtpk(p0[8 * s + 6], p0[8 * s + 7]);
                w1.x = cvtpk(p1[8 * s + 0], p1[8 * s + 1]); w1.y = cvtpk(p1[8 * s + 2], p1[8 * s + 3]); w1.z = cvtpk(p1[8 * s + 4], p1[8 * s + 5]); w1.w = cvtpk(p1[8 * s + 6], p1[8 * s + 7]);
                pa[s] = __builtin_bit_cast(bf16x8, w0); pa[2 + s] = __builtin_bit_cast(bf16x8, w1);
            }
            if (g == 0) ATT_PV(sg);
        }
    }
#undef ATT_PV
    asm volatile("s_waitcnt vmcnt(0) lgkmcnt(0)" ::: "memory");
    __builtin_amdgcn_s_barrier();
    asm volatile("" ::: "memory");
    if (has_next) {
        const bf16_t* Pn = P + (size_t)nb * SEQ * PITCH; const unsigned dk = (unsigned)(nkcol - up.kcol), dv = (unsigned)(nvcol - up.vcol);
#pragma unroll
        for (int j = 0; j < 2; ++j) if (nT0 + j <= nT1) ATT_DMA2(Pn, dk, dv, nT0 + j, 2 + j);
    }
#undef ATT_DMA
#undef ATT_DMA2
    const float lt = swapsum(l), inv = 1.f / lt;
    constexpr int ORS = DV * 2 + 16, OCH = DV / 8, ORPI = 64 / OCH  ;
    if (!diff) {
        ATT_LAS char* ot = lds + 4 * STG + wid * (32 * ORS);
#pragma unroll
        for (int e = 0; e < NEB; ++e)
#pragma unroll
            for (int r4 = 0; r4 < 4; ++r4) { u32x2 w; w.x = cvtpk(o[e][4 * r4] * inv, o[e][4 * r4 + 1] * inv); w.y = cvtpk(o[e][4 * r4 + 2] * inv, o[e][4 * r4 + 3] * inv);
                *(ATT_LAS u32x2*)(ot + r32 * ORS + (e * 32 + 8 * r4 + 4 * hi) * 2) = w; }
        bf16_t* ob = MIX + (rowbase + qw) * OPITCH + up.ocol;
#pragma unroll
        for (int j = 0; j < 32 / ORPI; ++j) { const int row = j * ORPI + lane / OCH, ch = lane % OCH; const u32x4 v = *(ATT_LAS const u32x4*)(ot + row * ORS + ch * 16); *(u32x4*)(ob + (size_t)row * OPITCH + ch * 8) = v; }
    } else {
        ATT_LAS float* xb = (ATT_LAS float*)(lds + wq * (NEB * 16 * 64 * 4)) + lane;
        if (g == 1) { const float sc = lam * inv;
#pragma unroll
            for (int e = 0; e < NEB; ++e)
#pragma unroll
                for (int r = 0; r < 16; ++r) xb[(e * 16 + r) * 64] = o[e][r] * sc; }
        __syncthreads();
        if (g == 0) { float ss = 0.f;
#pragma unroll
            for (int e = 0; e < NEB; ++e)
#pragma unroll
                for (int r = 0; r < 16; ++r) { const float d = o[e][r] * inv - xb[(e * 16 + r) * 64]; o[e][r] = d; ss += d * d; }
            ss = swapsum(ss);
            const float rs = rsqrtf(ss * (1.f / DV) + 1e-5f) * 0.8f;
            ATT_LAS char* ot = lds + wq * (NEB * 16 * 64 * 4);
            asm volatile("s_waitcnt lgkmcnt(0)" ::: "memory");
#pragma unroll
            for (int e = 0; e < NEB; ++e)
#pragma unroll
                for (int r4 = 0; r4 < 4; ++r4) { const f32x4 wv = *(const f32x4*)(subln_w + e * 32 + 8 * r4 + 4 * hi);
                    u32x2 w; w.x = cvtpk(o[e][4 * r4] * rs * wv[0], o[e][4 * r4 + 1] * rs * wv[1]); w.y = cvtpk(o[e][4 * r4 + 2] * rs * wv[2], o[e][4 * r4 + 3] * rs * wv[3]);
                    *(ATT_LAS u32x2*)(ot + r32 * ORS + (e * 32 + 8 * r4 + 4 * hi) * 2) = w; }
            bf16_t* ob = MIX + (rowbase + qw) * OPITCH + up.ocol;
#pragma unroll
            for (int j = 0; j < 32 / ORPI; ++j) { const int row = j * ORPI + lane / OCH, ch = lane % OCH; const u32x4 v = *(ATT_LAS const u32x4*)(ot + row * ORS + ch * 16); *(u32x4*)(ob + (size_t)row * OPITCH + ch * 8) = v; } }
    }
}
}
constexpr int NWAVES = 8;
#ifndef CV_ROT
#define CV_ROT 0
#endif
#ifndef CV_NTS
#define CV_NTS false
#endif
#ifndef P4_ALIGN
#define P4_ALIGN true
#endif
#ifndef WGM_P1
#define WGM_P1 4
#endif
#ifndef WGM_P3
#define WGM_P3 4
#endif
#ifndef WGM_P4
#define WGM_P4 8
#endif
#ifndef WGM_P5
#define WGM_P5 4
#endif
#ifndef FUSE_FINAL
#define FUSE_FINAL 0
#endif
#ifndef GEMM_SP2
#define GEMM_SP2 true
#endif
#ifndef MK_N_LAUNCHES
#define MK_N_LAUNCHES 1
#endif
constexpr int N_PHASES = 7;
constexpr int BATCH = 8, SEQ = 2048, D = 2048, M = BATCH * SEQ, INC = 4608, DFF = 5632, NGU = 2 * DFF;
constexpr float RMS_EPS = 1e-5f;
constexpr float QSCALE2 = 0.125f * 1.4426950408889634f;
constexpr size_t MiB = 1u << 20;
constexpr size_t WS_PART1 = 1 * MiB, WS_PART2 = 3 * MiB;
constexpr size_t WS_WIN = 8 * MiB, WS_WOUT = 26 * MiB, WS_WGU = 34 * MiB, WS_WDN = 78 * MiB;
constexpr size_t WS_XN = 100 * MiB;
constexpr size_t WS_PROJ = 164 * MiB, WS_MIX = 308 * MiB;
constexpr size_t WS_H = 164 * MiB;
constexpr size_t WS_END = 372 * MiB;
static_assert(WS_H + (size_t)M * DFF * 2 <= WS_END && WS_MIX + (size_t)M * D * 2 <= WS_END && WS_PROJ + (size_t)M * INC * 2 <= WS_MIX, "ws map");
constexpr int RING_BYTES = 131072, LDS_BYTES = 147456;

#define LAS __attribute__((address_space(3)))
typedef unsigned short bf16;
typedef unsigned v4u __attribute__((ext_vector_type(4)));
typedef float f32x4 __attribute__((ext_vector_type(4)));
__device__ __forceinline__ unsigned pk2(float lo, float hi) { return pg8::cvt_pk_bf16(lo, hi); }
__device__ __forceinline__ float wave_sum(float v) {
#pragma unroll
    for (int o = 1; o < 64; o <<= 1) v += __shfl_xor(v, o);
    return v;
}
template <int NB> __device__ __forceinline__ void transpose_item(const float* __restrict__ W, int K, int N, bf16* __restrict__ WT, int dst_row0, const float* __restrict__ kscale, float cscale, LAS float* scr, int k0, int n0, int lane, bool nts = false) {
    const float* src = W + (size_t)(k0 + (lane >> 4)) * N + n0 + 4 * (lane & 15);
#pragma unroll
    for (int b = 0; b < 16 / NB; ++b) {
        f32x4 v[NB];
#pragma unroll
        for (int i = 0; i < NB; ++i) v[i] = __builtin_nontemporal_load((const f32x4*)(src + (size_t)(4 * (b * NB + i)) * N));
#pragma unroll
        for (int i = 0; i < NB; ++i) { const int kk = 4 * (b * NB + i) + (lane >> 4); float sc = cscale; if (kscale) sc *= kscale[k0 + kk];
            LAS float* d = scr + kk * 65 + 4 * (lane & 15); d[0] = v[i].x * sc; d[1] = v[i].y * sc; d[2] = v[i].z * sc; d[3] = v[i].w * sc; }
        if (NB < 16) asm volatile("" ::: "memory");
    }
    asm volatile("s_waitcnt lgkmcnt(0)" ::: "memory");
    const int c = lane & 7;
#pragma unroll
    for (int j = 0; j < 8; ++j) { const int n = (lane >> 3) + 8 * j; const LAS float* s = scr + (8 * c) * 65 + n;
        v4u o; o.x = pk2(s[0 * 65], s[1 * 65]); o.y = pk2(s[2 * 65], s[3 * 65]); o.z = pk2(s[4 * 65], s[5 * 65]); o.w = pk2(s[6 * 65], s[7 * 65]);
        v4u* dp = (v4u*)(WT + (size_t)(dst_row0 + n) * K + k0 + 8 * c); if (nts) __builtin_nontemporal_store(o, dp); else *dp = o; }
    asm volatile("s_waitcnt lgkmcnt(0)" ::: "memory");
}

#define XB_TMO      128
#define XB_XCNT(j)  (256  + 64 * (j))
#define XB_XSUB(j)  (1280 + 64 * (j))
#define XB_XGEN(j)  (2304 + 64 * (j))
#define XB_TOP      3328
#define XB_TOPGEN   3392
#define XCD_BAR_WORDS 3456
#define XB_SPIN_CAP (1u << 18)

__device__ __forceinline__ unsigned xb_ld(unsigned* p)              { return __hip_atomic_load(p, __ATOMIC_RELAXED, __HIP_MEMORY_SCOPE_AGENT); }
__device__ __forceinline__ unsigned xb_add(unsigned* p, unsigned v) { return __hip_atomic_fetch_add(p, v, __ATOMIC_RELAXED, __HIP_MEMORY_SCOPE_AGENT); }
__device__ __forceinline__ unsigned xb_xcc_id() { return (unsigned)__builtin_amdgcn_s_getreg((3 << 11) | 20) & 0xFu; }
#define XB_SPIN(cond, bar) do { unsigned _sp = 0; while (cond) { __builtin_amdgcn_s_sleep(1); \
    if ((++_sp & 255u) == 0u) { if (xb_ld(&(bar)[XB_TMO])) break; if (_sp > XB_SPIN_CAP) { atomicAdd(&(bar)[XB_TMO], 1u); break; } } } } while (0)

struct XcdBarrier {
    unsigned* bar; unsigned x;
    volatile LAS unsigned* st;
};

__device__ __forceinline__ XcdBarrier xcd_barrier_post(unsigned* bar, volatile LAS unsigned* st) {
    XcdBarrier b; b.bar = bar; b.x = xb_xcc_id(); b.st = st;
    if (threadIdx.x == 0) (void)xb_add(&bar[XB_XCNT(b.x)], 1u);
    return b;
}
__device__ __forceinline__ void xcd_barrier_complete(unsigned* bar, unsigned x, unsigned& nloc, unsigned& nx) {
    const unsigned G = gridDim.x * gridDim.y * gridDim.z;
    unsigned sum, cnt, mine, sp = 0u;
    for (;;) {
        sum = 0u; cnt = 0u; mine = 0u;
#pragma unroll
        for (unsigned j = 0; j < 16; ++j) { const unsigned c = xb_ld(&bar[XB_XCNT(j)]); sum += c; cnt += (c > 0u) ? 1u : 0u; mine = (j == x) ? c : mine; }
        if (sum == G) break;
        __builtin_amdgcn_s_sleep(1);
        if ((++sp & 255u) == 0u) { if (xb_ld(&bar[XB_TMO])) break; if (sp > XB_SPIN_CAP) { atomicAdd(&bar[XB_TMO], 1u); break; } }
    }
    nloc = mine > 0u ? mine : 1u; nx = cnt > 0u ? cnt : 1u;
}

__device__ __forceinline__ void xcd_barrier(const XcdBarrier& b) {
    asm volatile("s_waitcnt vmcnt(0)" ::: "memory");
    __syncthreads();
    if (threadIdx.x == 0) {
        unsigned* bar = b.bar;
        __builtin_amdgcn_s_waitcnt(0);
        unsigned nloc = b.st[0], nx = b.st[1];
        if (nloc == 0u) { xcd_barrier_complete(bar, b.x, nloc, nx); b.st[0] = nloc; b.st[1] = nx; }
        const unsigned old = xb_add(&bar[XB_XSUB(b.x)], 1u);
        const unsigned gen = old / nloc;
        if (old + 1u == (gen + 1u) * nloc) {
            __builtin_amdgcn_fence(__ATOMIC_RELEASE, "agent");
            asm volatile("s_waitcnt vmcnt(0)" ::: "memory");
            const unsigned og = xb_add(&bar[XB_TOP], 1u);
            const unsigned tg = og / nx;
            if (og + 1u == (tg + 1u) * nx) xb_add(&bar[XB_TOPGEN], 1u);
            else XB_SPIN(xb_ld(&bar[XB_TOPGEN]) == tg, bar);
            __builtin_amdgcn_fence(__ATOMIC_ACQUIRE, "agent");
            xb_add(&bar[XB_XGEN(b.x)], 1u);
            asm volatile("s_waitcnt vmcnt(0)" ::: "memory");
        } else {
            XB_SPIN(xb_ld(&bar[XB_XGEN(b.x)]) == gen, bar);
            __builtin_amdgcn_fence(__ATOMIC_ACQUIRE, "agent");
            asm volatile("s_waitcnt vmcnt(0)" ::: "memory");
        }
    }
    __syncthreads();
}

struct PrefetchOrder {
    pg8::StaticOrder S; const char* base; unsigned row_bytes, tile_bytes; LAS unsigned char* dump;
    __device__ __forceinline__ bool next(int i, pg8::Unit& u) const { return S.next(i, u); }
    __device__ __forceinline__ void done(const pg8::Unit&) const {}
    __device__ __forceinline__ void a_ready(const pg8::Unit& u) const {
        const int tid = threadIdx.x, wid = __builtin_amdgcn_readfirstlane(tid >> 6); const unsigned lpr = tile_bytes >> 7, nline = 256u * lpr;
        const char* tb = base + (size_t)u.pm * 256 * row_bytes + (size_t)u.pn * tile_bytes;
        for (unsigned line = tid; line < nline; line += 512) { const unsigned r = line / lpr, l = line % lpr;
            __builtin_amdgcn_global_load_lds((const unsigned*)(tb + (size_t)r * row_bytes + l * 128), (LAS unsigned*)(dump + wid * 256), 4, 0, 0); }
    }
};
struct TwiceOrder { pg8::StaticOrder S; __device__ bool next(int i, pg8::Unit& u) const { return S.next(i >> 1, u); } __device__ __forceinline__ void a_ready(const pg8::Unit&) const {} __device__ __forceinline__ void done(const pg8::Unit&) const {} };
struct Args { const float* in[15]; float* out; unsigned char* ws; int ph_lo, ph_hi; };
enum { I_X = 0, I_ANW, I_WIN, I_LQ1, I_LK1, I_LQ2, I_LK2, I_SUBLN, I_SINKS, I_WOUT, I_FNW, I_WG, I_WU, I_WD, I_FINW };

__device__ __forceinline__ void item_kn(int r, int nblk_n, int& k0, int& n0) { const int g8 = r >> 3, w = r & 7, hn = nblk_n >> 1; n0 = 64 * (2 * (g8 % hn) + (w & 1)); k0 = 64 * (4 * (g8 / hn) + (w >> 1)); }
#ifndef CV_SPLIT
#define CV_SPLIT 0
#endif
#ifndef CV_SA
#define CV_SA 48
#endif
constexpr int CV_IN = (D / 64) * (INC / 64), CV_OUT = (D / 64) * (D / 64), CV_G = (D / 64) * (DFF / 64), CV_DN = (DFF / 64) * (D / 64), CV_ALL = CV_IN + CV_OUT + 2 * CV_G + CV_DN, CV_T0 = CV_IN + CV_OUT, CV_T1 = CV_T0 + CV_G;
template <int NB> __device__ __forceinline__ void convert_weights(const Args& args, unsigned char* ws, LAS float* scr, int first, int last, int skip0, int skip1, int widx, int nw, int lane) {
    bf16* Win_t = (bf16*)(ws + WS_WIN); bf16* Wout_t = (bf16*)(ws + WS_WOUT); bf16* Wgu_t = (bf16*)(ws + WS_WGU); bf16* Wdn_t = (bf16*)(ws + WS_WDN);
    for (int it = first + widx; it < last - (skip1 - skip0); it += nw) {
        int r = it; if (r >= skip0) r += skip1 - skip0;
        if (CV_ROT && first == 0 && last == CV_ALL) { r += CV_IN; if (r >= CV_ALL) r -= CV_ALL; }
        if (r < CV_IN) { int k0, n0; item_kn(r, INC / 64, k0, n0); const float cs = (n0 < 1024 || (n0 >= 3072 && n0 < 4096)) ? QSCALE2 : 1.f;
            transpose_item<NB>(args.in[I_WIN], D, INC, Win_t, n0, nullptr, cs, scr, k0, n0, lane); continue; } r -= CV_IN;
        if (r < CV_OUT) { int k0, n0; item_kn(r, D / 64, k0, n0); transpose_item<NB>(args.in[I_WOUT], D, D, Wout_t, n0, nullptr, 1.f, scr, k0, n0, lane, CV_NTS); continue; } r -= CV_OUT;
        if (r < 2 * CV_G) { const int up = r >= CV_G; if (up) r -= CV_G; int k0, n0; item_kn(r, DFF / 64, k0, n0);
            transpose_item<NB>(args.in[up ? I_WU : I_WG], D, DFF, Wgu_t, 256 * (n0 / 128) + 128 * up + (n0 % 128), args.in[I_FNW], 1.f, scr, k0, n0, lane, CV_NTS); continue; } r -= 2 * CV_G;
        { int k0, n0; item_kn(r, D / 64, k0, n0); transpose_item<NB>(args.in[I_WD], DFF, D, Wdn_t, n0, nullptr, 1.f, scr, k0, n0, lane, CV_NTS); }
    }
}

struct CvItem { const float* src; bf16* dst; const float* kscale; float cscale; int N, K; };
__device__ __forceinline__ bool cv_decode(const Args& args, unsigned char* ws, int r, int last, int lane, CvItem& it) {
    if (r >= last) return false;
    bf16* Win_t = (bf16*)(ws + WS_WIN); bf16* Wout_t = (bf16*)(ws + WS_WOUT); bf16* Wgu_t = (bf16*)(ws + WS_WGU); bf16* Wdn_t = (bf16*)(ws + WS_WDN);
    int k0, n0, row0; const float* W; bf16* WT; it.kscale = nullptr; it.cscale = 1.f;
    if (r < CV_IN) { item_kn(r, INC / 64, k0, n0); W = args.in[I_WIN]; WT = Win_t; it.N = INC; it.K = D; row0 = n0; it.cscale = (n0 < 1024 || (n0 >= 3072 && n0 < 4096)) ? QSCALE2 : 1.f; }
    else if ((r -= CV_IN) < CV_OUT) { item_kn(r, D / 64, k0, n0); W = args.in[I_WOUT]; WT = Wout_t; it.N = D; it.K = D; row0 = n0; }
    else if ((r -= CV_OUT) < 2 * CV_G) { const int up = r >= CV_G; if (up) r -= CV_G; item_kn(r, DFF / 64, k0, n0); W = args.in[up ? I_WU : I_WG]; WT = Wgu_t; it.N = DFF; it.K = D; row0 = 256 * (n0 / 128) + 128 * up + (n0 % 128); it.kscale = args.in[I_FNW] + k0; }
    else { r -= 2 * CV_G; item_kn(r, D / 64, k0, n0); W = args.in[I_WD]; WT = Wdn_t; it.N = D; it.K = DFF; row0 = n0; }
    it.src = W + (size_t)(k0 + (lane >> 4)) * it.N + n0 + 4 * (lane & 15);
    it.dst = WT + (size_t)row0 * it.K + k0;
    return true;
}
__device__ __forceinline__ void cv_load(const CvItem& it, f32x4 (&v)[16]) {
#pragma unroll
    for (int i = 0; i < 16; ++i) v[i] = *(const f32x4*)(it.src + (size_t)(4 * i) * it.N);
}
__device__ __forceinline__ void cv_finish(const CvItem& it, const f32x4 (&v)[16], LAS float* scr, int lane) {
#pragma unroll
    for (int i = 0; i < 16; ++i) { const int kk = 4 * i + (lane >> 4); float sc = it.cscale; if (it.kscale) sc *= it.kscale[kk];
        LAS float* d = scr + kk * 65 + 4 * (lane & 15); d[0] = v[i].x * sc; d[1] = v[i].y * sc; d[2] = v[i].z * sc; d[3] = v[i].w * sc; }
    asm volatile("s_waitcnt lgkmcnt(0)" ::: "memory");
    const int c = lane & 7;
#pragma unroll
    for (int j = 0; j < 8; ++j) { const int n = (lane >> 3) + 8 * j; const LAS float* s = scr + (8 * c) * 65 + n;
        v4u o; o.x = pk2(s[0 * 65], s[1 * 65]); o.y = pk2(s[2 * 65], s[3 * 65]); o.z = pk2(s[4 * 65], s[5 * 65]); o.w = pk2(s[6 * 65], s[7 * 65]);
        *(v4u*)(it.dst + (size_t)n * it.K + 8 * c) = o; }
    asm volatile("s_waitcnt lgkmcnt(0)" ::: "memory");
}
__device__ __forceinline__ void convert_weights_pipe(const Args& args, unsigned char* ws, LAS float* scr, int first, int last, int widx, int nw, int lane) {
    CvItem ia, ib; f32x4 va[16], vb[16];
    int r = first + widx;
    bool ha = cv_decode(args, ws, r, last, lane, ia); if (ha) cv_load(ia, va);
    while (ha) {
        const bool hb = cv_decode(args, ws, r + nw, last, lane, ib); if (hb) cv_load(ib, vb);
        cv_finish(ia, va, scr, lane);
        if (!hb) break;
        r += 2 * nw;
        ha = cv_decode(args, ws, r, last, lane, ia); if (ha) cv_load(ia, va);
        cv_finish(ib, vb, scr, lane);
    }
}

__global__ void __launch_bounds__(NWAVES * 64, 2) hymba_fwd(Args args) {
    extern __shared__ __attribute__((aligned(16))) unsigned char lds_raw[];
    cg::grid_group grid = cg::this_grid();
    LAS unsigned char* lds = (LAS unsigned char*)lds_raw;
    const int tid = threadIdx.x, lane = tid & 63, wave = __builtin_amdgcn_readfirstlane(tid >> 6);
    const int G = gridDim.x, bx = blockIdx.x, vcu = (G % 8 == 0) ? (bx % 8) * (G / 8) + bx / 8 : bx;
    unsigned char* ws = args.ws;
    const float* x = args.in[I_X]; float* out = args.out;
    bf16* Win_t = (bf16*)(ws + WS_WIN); bf16* Wout_t = (bf16*)(ws + WS_WOUT); bf16* Wgu_t = (bf16*)(ws + WS_WGU); bf16* Wdn_t = (bf16*)(ws + WS_WDN);
    bf16* XN = (bf16*)(ws + WS_XN); bf16* PROJ = (bf16*)(ws + WS_PROJ); bf16* MIX = (bf16*)(ws + WS_MIX); bf16* HB = (bf16*)(ws + WS_H);
    float* part1 = (float*)(ws + WS_PART1); float* part2 = (float*)(ws + WS_PART2);
    const int lo = args.ph_lo, hi = args.ph_hi;
    volatile LAS unsigned* bst = (volatile LAS unsigned*)(lds + LDS_BYTES - 64);
    if (tid < 2) bst[tid] = 0u;
    if (tid == 0) { *(LAS unsigned long long*)(lds + LDS_BYTES - 32) = 0ull; }
    __syncthreads();
    XcdBarrier gbar; gbar.bar = (unsigned*)ws; gbar.x = 0; gbar.st = bst;
    if (hi - lo > 1) gbar = xcd_barrier_post((unsigned*)ws, bst);
    if (hi > 1000) grid.sync();
#define IN(k) (lo <= (k) && (k) < hi)
#ifndef SYNC_REPEAT
#define SYNC_REPEAT 1
#endif
#define SEAM(k) do { if (IN(k) && IN((k) + 1)) { for (int sr_ = 0; sr_ < SYNC_REPEAT; ++sr_) xcd_barrier(gbar); } } while (0)
#ifndef PROBE_PHASE
#define PROBE_PHASE -1
#endif
#ifndef STAMP_SEL
#define STAMP_SEL 1
#endif
#ifdef STAMP_PHASE
#define STAMP_BEGIN(k) do { if ((k) == STAMP_PHASE || ((k) == 2 && (STAMP_PHASE == 30 || STAMP_PHASE == 31))) st0_ = __builtin_amdgcn_s_memrealtime(); } while (0)
#define STAMP_END(k) do { if ((k) == STAMP_PHASE) st1_ = __builtin_amdgcn_s_memrealtime(); } while (0)
#else
#define STAMP_BEGIN(k) do {} while (0)
#define STAMP_END(k) do {} while (0)
#endif
    unsigned long long st0_ = 0, st1_ = 0; (void)st0_; (void)st1_;
#define REP(k) for (int rep_ = 0; rep_ < ((PROBE_PHASE == (k)) ? 2 : 1); ++rep_, ((PROBE_PHASE == (k)) && rep_ < 2 ? (xcd_barrier(gbar), 0) : 0))

    STAMP_BEGIN(0); STAMP_BEGIN(41);
    REP(0) if (IN(0)) {
        LAS float* scr = (LAS float*)(lds + wave * 16640);
        const int gw = vcu * NWAVES + wave, NGW = G * NWAVES;
#if defined(P0_TOUCH) && P0_TOUCH
        {
            const int widx[5] = {I_WIN, I_WOUT, I_WG, I_WU, I_WD}; const size_t wn4[5] = {(size_t)D * INC / 4, (size_t)D * D / 4, (size_t)D * DFF / 4, (size_t)D * DFF / 4, (size_t)DFF * D / 4};
            f32x4 acc4 = {0.f, 0.f, 0.f, 0.f};
#pragma unroll
            for (int w = 0; w < 5; ++w) { const f32x4* src = (const f32x4*)args.in[widx[w]];
                for (size_t i = (size_t)gw * 64 + lane; i < wn4[w]; i += (size_t)NGW * 64 * 4) {
                    f32x4 a = src[i], b = (i + (size_t)NGW * 64 < wn4[w]) ? src[i + (size_t)NGW * 64] : acc4, c = (i + (size_t)NGW * 128 < wn4[w]) ? src[i + (size_t)NGW * 128] : acc4, d = (i + (size_t)NGW * 192 < wn4[w]) ? src[i + (size_t)NGW * 192] : acc4;
                    acc4 = acc4 + a + b + c + d; } }
            if (acc4.x + acc4.y + acc4.z + acc4.w == 1.2345e38f) ((float*)(ws + WS_PART2))[gw * 64 + lane] = acc4.x;
        }
#endif
#if defined(P0_MIX) && P0_MIX
#pragma unroll 1
        for (int pass_ = 0; pass_ < 2; ++pass_) {
        if ((pass_ == 0) != ((vcu & 1) != 0)) {
#if defined(CV_PIPE) && CV_PIPE
        convert_weights_pipe(args, ws, scr, 0, CV_SPLIT ? CV_IN : CV_ALL, gw, NGW, lane);
#else
        convert_weights<16>(args, ws, scr, 0, CV_SPLIT ? CV_ALL - 128 * CV_SA : CV_ALL, 0, 0, gw, NGW, lane);
#endif
        } else {
        STAMP_BEGIN(40); __syncthreads(); STAMP_END(41);
        const f32x4* wn = (const f32x4*)args.in[I_ANW] + lane;
        for (int rp_ = 0; rp_ < (PROBE_PHASE == 11 ? 2 : 1); ++rp_)
        for (int m = gw; m < M; m += NGW) {
            const f32x4* xr = (const f32x4*)(x + (size_t)m * D) + lane;
            f32x4 v[8]; float s = 0.f;
#pragma unroll
            for (int j = 0; j < 8; ++j) { v[j] = __builtin_nontemporal_load(xr + 64 * j); s += (v[j].x * v[j].x + v[j].y * v[j].y) + (v[j].z * v[j].z + v[j].w * v[j].w); }
            const float rstd = rsqrtf(wave_sum(s) * (1.f / D) + RMS_EPS);
            unsigned long long* o8 = (unsigned long long*)(XN + (size_t)m * D) + lane;
#pragma unroll
            for (int j = 0; j < 8; ++j) { const f32x4 w = wn[64 * j]; o8[64 * j] = (unsigned long long)pk2(v[j].x * rstd * w.x, v[j].y * rstd * w.y) | ((unsigned long long)pk2(v[j].z * rstd * w.z, v[j].w * rstd * w.w) << 32); }
        }
        }
        }
#else
#if defined(CV_PIPE) && CV_PIPE
        convert_weights_pipe(args, ws, scr, 0, CV_SPLIT ? CV_IN : CV_ALL, gw, NGW, lane);
#else
        convert_weights<16>(args, ws, scr, 0, CV_SPLIT ? CV_ALL - 128 * CV_SA : CV_ALL, 0, 0, gw, NGW, lane);
#endif
        STAMP_BEGIN(40); __syncthreads(); STAMP_END(41);
        const f32x4* wn = (const f32x4*)args.in[I_ANW] + lane;
        for (int rp_ = 0; rp_ < (PROBE_PHASE == 11 ? 2 : 1); ++rp_)
        for (int m = gw; m < M; m += NGW) {
            const f32x4* xr = (const f32x4*)(x + (size_t)m * D) + lane;
            f32x4 v[8]; float s = 0.f;
#pragma unroll
            for (int j = 0; j < 8; ++j) { v[j] = __builtin_nontemporal_load(xr + 64 * j); s += (v[j].x * v[j].x + v[j].y * v[j].y) + (v[j].z * v[j].z + v[j].w * v[j].w); }
            const float rstd = rsqrtf(wave_sum(s) * (1.f / D) + RMS_EPS);
            unsigned long long* o8 = (unsigned long long*)(XN + (size_t)m * D) + lane;
#pragma unroll
            for (int j = 0; j < 8; ++j) { const f32x4 w = wn[64 * j]; o8[64 * j] = (unsigned long long)pk2(v[j].x * rstd * w.x, v[j].y * rstd * w.y) | ((unsigned long long)pk2(v[j].z * rstd * w.z, v[j].w * rstd * w.w) << 32); }
        }
#endif
        __syncthreads();
    }
    SEAM(0);
    STAMP_END(0); STAMP_END(40);
    STAMP_BEGIN(1);
    REP(1) if (IN(1)) {
        pg8::Gemm g{XN, Win_t, M, INC, D}; pg8::StaticOrder S; S.init(M, INC, G, bx, WGM_P1);
        pg8::EpiStore E{PROJ, INC};
#if PROBE_PHASE == 21
        { TwiceOrder S2{S}; pg8::gemm_phase<pg8::EpiStore, TwiceOrder, true, true>(lds, g, S2, E); }
#else
        pg8::gemm_phase<pg8::EpiStore, pg8::StaticOrder, true, GEMM_SP2>(lds, g, S, E);
#endif
        if (CV_SPLIT) { const int nwg = (M / 256) * (INC / 256), maxU = (nwg + G - 1) / G, nIdle = G * maxU - nwg, idx = bx - (G - nIdle);
            const int nw_ = nIdle > 0 ? nIdle : G, id_ = nIdle > 0 ? idx : bx, per = (128 * CV_SA + nw_ - 1) / nw_, f0 = CV_ALL - 128 * CV_SA + id_ * per;
            if (id_ >= 0) convert_weights<8>(args, ws, (LAS float*)(lds + wave * 16640), f0, f0 + per < CV_ALL ? f0 + per : CV_ALL, 0, 0, wave, NWAVES, lane); }
        __syncthreads();
    }
    SEAM(1);
    STAMP_END(1);
    STAMP_BEGIN(2);
    REP(2) if (IN(2)) {
        const float* lq1 = args.in[I_LQ1]; const float* lk1 = args.in[I_LK1]; const float* lq2 = args.in[I_LQ2]; const float* lk2 = args.in[I_LK2];
        const float s1 = wave_sum(lq1[lane] * lk1[lane]), s2 = wave_sum(lq2[lane] * lk2[lane]);
        const float lam = expf(s1) - expf(s2) + 0.2f;
        const int wq = wave & 3, gsel = wave >> 2;
#ifdef ATT_PRIO
        if (gsel == 1) __builtin_amdgcn_s_setprio(1);
#endif
        STAMP_BEGIN(20);
        { const int np = vcu < 512 ? (512 - vcu + G - 1) / G : 0;
#define DIFF_UNIT(u_, up_) do { const int i_ = vcu + G * ((u_) >> 1), bh_ = (i_ >> 3) ^ (((u_) >> 1) & 1 ? 4 : 0)  , xq_ = i_ & 7, h_ = bh_ & 7, qblk_ = ((u_) & 1) ? 15 - xq_ : xq_; \
            up_.b = bh_ >> 3; up_.q0 = 128 * qblk_; up_.qcol = h_ * 128 + gsel * 64; up_.kcol = 1024 + h_ * 128; up_.vcol = 2048 + h_ * 128; up_.kofs = gsel * 128; \
            up_.slope2 = exp2f(-(float)(h_ + 1)) * 1.4426950408889634f; up_.m_init = 0.f; up_.l_init = 0.f; \
            up_.T0 = 0; up_.T1 = 2 * qblk_ + 1; up_.tlo = 0; up_.thi = (up_.q0 + 32 * wq) >> 6; up_.window = 1 << 20; up_.maskall = 0; up_.ocol = h_ * 128; } while (0)
#pragma unroll 1
          for (int u = 0; u < 2 * np; ++u) {
              att::UnitP up, nx; DIFF_UNIT(u, up); const bool hn = u + 1 < 2 * np; if (hn) DIFF_UNIT(u + 1, nx); else nx = up;
              att::attn_unit<128, 128>((LAS char*)lds, PROJ, MIX, up, true, lam, args.in[I_SUBLN], tid, u > 0, hn, nx.b, nx.kcol, nx.vcol, nx.T0, nx.T1);
          }
#undef DIFF_UNIT
        }
        STAMP_END(20); STAMP_BEGIN(21);
        { const int ns = vcu < 1024 ? (1024 - vcu + G - 1) / G : 0;
#define SWA_UNIT(u_, up_) do { const int i_ = vcu + G * (u_), qblk_ = i_ & 15, pair_ = (i_ >> 4) & 1, hkv_ = ((i_ >> 5) + (u_)) & 3, hq_ = hkv_ * 4 + pair_ * 2 + gsel, a_ = 2 * qblk_; \
            up_.b = i_ >> 7; up_.q0 = 128 * qblk_; up_.qcol = 3072 + hq_ * 64; up_.kcol = 4096 + hkv_ * 64; up_.vcol = 4352 + hkv_ * 64; up_.kofs = 0; \
            up_.slope2 = exp2f(-0.5f * (float)(hq_ + 1)) * 1.4426950408889634f; up_.m_init = args.in[I_SINKS][hq_] * 1.4426950408889634f; up_.l_init = 1.f; \
            up_.T0 = a_ - 2 < 0 ? 0 : a_ - 2; up_.T1 = a_ + 1; up_.tlo = a_ - 2 + (wq >> 1); up_.thi = a_ + (wq >> 1); up_.window = 128; up_.maskall = 1; up_.ocol = 1024 + hq_ * 64; } while (0)
#pragma unroll 1
          for (int u = 0; u < ns; ++u) {
              att::UnitP up, nx; SWA_UNIT(u, up); const bool hn = u + 1 < ns; if (hn) SWA_UNIT(u + 1, nx); else nx = up;
              att::attn_unit<64, 64>((LAS char*)lds, PROJ, MIX, up, false, 0.f, nullptr, tid, u > 0, hn, nx.b, nx.kcol, nx.vcol, nx.T0, nx.T1);
          }
#undef SWA_UNIT
        }
        STAMP_END(21);
#ifdef ATT_PRIO
        __builtin_amdgcn_s_setprio(0);
#endif
#if defined(P3_PREFETCH_X) && P3_PREFETCH_X
        {
            pg8::StaticOrder S3; S3.init(M, D, G, bx, WGM_P3); pg8::Unit u3; float pacc = 0.f;
            for (int i = 0; S3.next(i, u3); ++i) {
                const float* tb = x + (size_t)u3.pm * 256 * D + (size_t)u3.pn * 256;
#pragma unroll
                for (int k = 0; k < 4; ++k) { const int line = tid + 512 * k; pacc += tb[(size_t)(line >> 3) * D + (line & 7) * 32]; }
            }
            if (pacc == 1.2345e38f) part2[tid] = pacc;
        }
#endif
        __syncthreads();
#ifdef STAMP_PHASE
        if (STAMP_PHASE == 30 || STAMP_PHASE == 31) { if (tid == 0 && STAMP_SEL) { const unsigned d_ = (unsigned)(__builtin_amdgcn_s_memrealtime() - st0_);
            if (STAMP_PHASE == 30) __hip_atomic_fetch_max((unsigned*)ws + 3500, d_, __ATOMIC_RELAXED, __HIP_MEMORY_SCOPE_AGENT); else __hip_atomic_fetch_max((unsigned*)ws + 3500, ~d_, __ATOMIC_RELAXED, __HIP_MEMORY_SCOPE_AGENT) ; } }
#endif
    }
    SEAM(2);
#ifdef STAMP_PHASE
    if (STAMP_PHASE == 30 || STAMP_PHASE == 31) { const unsigned v_ = __hip_atomic_load((unsigned*)ws + 3500, __ATOMIC_RELAXED, __HIP_MEMORY_SCOPE_AGENT); st1_ = st0_ + (STAMP_PHASE == 30 ? v_ : ~v_); }
#endif
    STAMP_END(2);
    STAMP_BEGIN(3);
    REP(3) if (IN(3)) {
        pg8::Gemm g{MIX, Wout_t, M, D, D}; pg8::StaticOrder S; S.init(M, D, G, bx, WGM_P3);
        pg8::EpiResid<false> E{x, XN, part1, D};
        pg8::gemm_phase<pg8::EpiResid<false>, pg8::StaticOrder, true, GEMM_SP2>(lds, g, S, E);
    }
    SEAM(3);
    STAMP_END(3);
    STAMP_BEGIN(4);
    REP(4) if (IN(4)) {
        pg8::Gemm g{XN, Wgu_t, M, NGU, D}; pg8::StaticOrder S; S.init(M, NGU, G, bx, WGM_P4);
        int tpm = -1; { pg8::Unit u0; if (S.next(0, u0)) { tpm = u0.pm; if (tid < 256) { const f32x4* pp = (const f32x4*)(part1 + (size_t)(tpm * 256 + tid) * 32); float sacc = 0.f;
#pragma unroll
                    for (int k = 0; k < 8; ++k) { const f32x4 a = pp[k]; sacc += (a[0] + a[1]) + (a[2] + a[3]); }
                    ((LAS float*)(lds + RING_BYTES))[tid] = rsqrtf(sacc * (1.f / D) + RMS_EPS); } } }
        __syncthreads();
        pg8::EpiSwiGLU E{HB, DFF, part1, 1.f / D, RMS_EPS, (LAS const float*)(lds + RING_BYTES), tpm};
#if PROBE_PHASE == 24
        { TwiceOrder S2{S}; pg8::gemm_phase<pg8::EpiSwiGLU, TwiceOrder, true, true>(lds, g, S2, E); }
#else
        pg8::gemm_phase<pg8::EpiSwiGLU, pg8::StaticOrder, P4_ALIGN, GEMM_SP2>(lds, g, S, E);
#endif
    }
    SEAM(4);
    STAMP_END(4);
    STAMP_BEGIN(5);
    REP(5) if (IN(5)) {
        pg8::Gemm g{HB, Wdn_t, M, D, DFF}; pg8::StaticOrder S; S.init(M, D, G, bx, WGM_P5);
#if FUSE_FINAL
        pg8::EpiFinal E{XN, out, args.in[I_FINW], part2, (unsigned*)ws + 4096, lds + RING_BYTES, D, 1.f / D, RMS_EPS};
        pg8::gemm_phase<pg8::EpiFinal, pg8::StaticOrder, true, GEMM_SP2>(lds, g, S, E);
#else
        pg8::EpiResid<true> E{XN, XN, part2, D};
        pg8::gemm_phase<pg8::EpiResid<true>, pg8::StaticOrder, true, GEMM_SP2>(lds, g, S, E);
#endif
    }
#if !FUSE_FINAL
    SEAM(5);
#endif
    STAMP_END(5);
    STAMP_BEGIN(6);
    REP(6) if (IN(6) && !FUSE_FINAL) {
        const int gw = vcu * NWAVES + wave, NGW = G * NWAVES;
        const f32x4* wn = (const f32x4*)args.in[I_FINW] + 2 * lane;
        for (int m = gw; m < M; m += NGW) {
            const float s = wave_sum(lane < 32 ? part2[(size_t)m * 32 + lane] : 0.f);
            const float rstd = rsqrtf(s * (1.f / D) + RMS_EPS);
            const v4u* xr = (const v4u*)(XN + (size_t)m * D) + lane; f32x4* orow = (f32x4*)(out + (size_t)m * D) + 2 * lane;
#pragma unroll
            for (int j = 0; j < 4; ++j) { const v4u w = __builtin_nontemporal_load(xr + 64 * j); const f32x4 w0 = wn[128 * j], w1 = wn[128 * j + 1];
                const f32x4 a = {__uint_as_float(w.x << 16), __uint_as_float(w.x & 0xffff0000u), __uint_as_float(w.y << 16), __uint_as_float(w.y & 0xffff0000u)};
                const f32x4 b = {__uint_as_float(w.z << 16), __uint_as_float(w.z & 0xffff0000u), __uint_as_float(w.w << 16), __uint_as_float(w.w & 0xffff0000u)};
                __builtin_nontemporal_store(a * rstd * w0, orow + 128 * j); __builtin_nontemporal_store(b * rstd * w1, orow + 128 * j + 1); }
        }
    }
#ifdef ATT_TIMER
    if (bx == 0) { __syncthreads(); if (tid == 0) { const unsigned long long dt = *(LAS unsigned long long*)(lds + LDS_BYTES - 32), te = __builtin_amdgcn_s_memtime(); while (__builtin_amdgcn_s_memtime() - te < dt) __builtin_amdgcn_s_sleep(32); } }
#endif
#ifdef STAMP_PHASE
    if (STAMP_PHASE == 6) { __syncthreads(); st1_ = __builtin_amdgcn_s_memrealtime(); }
    if (bx == 0 && tid == 0) { const unsigned long long te = __builtin_amdgcn_s_memrealtime(), dt = st1_ - st0_; while (__builtin_amdgcn_s_memrealtime() - te < dt) __builtin_amdgcn_s_sleep(32); }
#endif
#undef IN
#undef SEAM
}

extern "C" void kernel_launch(void* const* d_in, const int* in_sizes, int n_in, void* d_out, int out_size, void* d_ws, size_t ws_size, hipStream_t stream) {
    static int grid = 0;
    if (grid == 0) {
        if (n_in != 15 || out_size != M * D || ws_size < WS_END) { fprintf(stderr, "kernel_launch: unexpected shapes (n_in %d out %d ws %zu)\n", n_in, out_size, ws_size); grid = -1; return; }
        int dev = 0, cus = 0, per_cu = 0;
        hipGetDevice(&dev); hipDeviceGetAttribute(&cus, hipDeviceAttributeMultiprocessorCount, dev);
        if (hipFuncSetAttribute((const void*)hymba_fwd, hipFuncAttributeMaxDynamicSharedMemorySize, LDS_BYTES) != hipSuccess) { fprintf(stderr, "kernel_launch: hipFuncSetAttribute failed\n"); grid = -1; return; }
        if (hipOccupancyMaxActiveBlocksPerMultiprocessor(&per_cu, (const void*)hymba_fwd, NWAVES * 64, LDS_BYTES) != hipSuccess || per_cu < 1) { fprintf(stderr, "kernel_launch: occupancy query says %d\n", per_cu); per_cu = 1; }
        (void)hipGetLastError();
        grid = cus * 1;
        fprintf(stderr, "kernel_launch: grid %d (cus %d, per_cu %d)\n", grid, cus, per_cu);
    }
    if (grid < 0) return;
    if (hipMemsetAsync(d_ws, 0, 65536, stream) != hipSuccess) { fprintf(stderr, "kernel_launch: memset failed\n"); return; }
    Args a{};
    for (int i = 0; i < 15; ++i) a.in[i] = (const float*)d_in[i];
    a.out = (float*)d_out; a.ws = (unsigned char*)d_ws;
#if MK_N_LAUNCHES == 1
    a.ph_lo = 0; a.ph_hi = N_PHASES;
    void* kargs[] = {&a};
    hipError_t e = hipLaunchCooperativeKernel((const void*)hymba_fwd, dim3(grid), dim3(NWAVES * 64), kargs, LDS_BYTES, stream);
    if (e != hipSuccess) fprintf(stderr, "kernel_launch: cooperative launch failed: %s\n", hipGetErrorString(e));
#else
    for (int p = 0; p < N_PHASES; ++p) { a.ph_lo = p; a.ph_hi = p + 1; hipLaunchKernelGGL(hymba_fwd, dim3(grid), dim3(NWAVES * 64), LDS_BYTES, stream, a); }
#endif
}
```
